# Optimizing an MI355X kernel written in HIP

```python
import math
import jax, jax.numpy as jnp
from jax import lax
import numpy as np

D_MODEL = 1024
BATCH = 2
SEQ = 8192
DEPTH = 2

GRID_W = 64
CTX_LEN = 256
HEAD_DIM = 64
ROPE_THETA = 10000.0
EPS = 1e-6
Q_BLOCK = 128

A_HEADS = 4
A_VDIM = 2 * HEAD_DIM
A_WIDTH = A_HEADS * A_VDIM
B_HEADS = 8
B_KV = 2
B_REP = B_HEADS // B_KV
B_WIDTH = B_HEADS * HEAD_DIM
C_WIDTH = 512
C_KW = 31
P_HEADS = 8
P_NKEYS = 128
P_EXPERTS = P_NKEYS * P_NKEYS
P_TOPK = 16
P_DKEY = 128
P_BLOCK = 128

COL_KA = A_HEADS * 2 * HEAD_DIM
COL_VA = A_WIDTH
COL_KB = B_KV * HEAD_DIM
COL_VB = B_KV * HEAD_DIM
COL_QA = A_HEADS * 2 * HEAD_DIM
COL_QB = B_HEADS * HEAD_DIM
COL_GLU = 2 * C_WIDTH
COL_GATE = 3 * D_MODEL
KV_COLS = COL_KA + COL_VA + COL_KB + COL_VB
Q_COLS = COL_QA + COL_QB
IN_COLS = KV_COLS + Q_COLS + COL_GLU + COL_GATE
KV_SPLITS = [COL_KA, COL_KA + COL_VA, COL_KA + COL_VA + COL_KB]
MAIN_SPLITS = [KV_COLS, KV_COLS + Q_COLS, KV_COLS + Q_COLS + COL_GLU]

kernel_name = "hybrid_diffattn_gqa_conformer_peer_dit"


def rms_norm(x, w=None):
    xf = x.astype(jnp.float32)
    y = xf * lax.rsqrt(jnp.mean(xf * xf, axis=-1, keepdims=True) + EPS)
    if w is not None:
        y = y * w.astype(jnp.float32)
    return y.astype(x.dtype)


def modulate(x, shift, scale):
    return rms_norm(x) * (1 + scale) + shift


def axial_rope(n):
    t = jnp.arange(n, dtype=jnp.int32)
    row = (t // GRID_W).astype(jnp.float32)
    col = (t % GRID_W).astype(jnp.float32)
    axis_dim = HEAD_DIM // 2
    inv = ROPE_THETA ** (-jnp.arange(0, axis_dim, 2, dtype=jnp.float32) / axis_dim)
    ar = row[:, None] * inv[None, :]
    ac = col[:, None] * inv[None, :]
    ang = jnp.concatenate([ar, ar, ac, ac], axis=-1)
    return jnp.cos(ang), jnp.sin(ang)


def apply_rope(x, cos, sin):
    x1, x2, x3, x4 = jnp.split(x, 4, axis=-1)
    rot = jnp.concatenate([-x2, x1, -x4, x3], axis=-1)
    return (x.astype(jnp.float32) * cos + rot.astype(jnp.float32) * sin).astype(x.dtype)


def kv_heads(p_kv, k_norm_w):
    b, n = p_kv.shape[:2]
    k_a, v_a, k_b, v_b = jnp.split(p_kv, KV_SPLITS, axis=-1)
    k_a = k_a.reshape(b, n, A_HEADS, 2, HEAD_DIM).transpose(0, 2, 3, 1, 4)
    v_a = v_a.reshape(b, n, A_HEADS, A_VDIM).transpose(0, 2, 1, 3)
    k_b = rms_norm(k_b.reshape(b, n, B_KV, HEAD_DIM), k_norm_w).transpose(0, 2, 1, 3)
    v_b = v_b.reshape(b, n, B_KV, HEAD_DIM).transpose(0, 2, 1, 3)
    return k_a, v_a, k_b, v_b


def q_heads(p_q, q_norm_w):
    b, n = p_q.shape[:2]
    q_a, q_b = jnp.split(p_q, [COL_QA], axis=-1)
    q_a = q_a.reshape(b, n, A_HEADS, 2, HEAD_DIM).transpose(0, 2, 3, 1, 4)
    q_b = rms_norm(q_b.reshape(b, n, B_KV, B_REP, HEAD_DIM), q_norm_w).transpose(0, 2, 3, 1, 4)
    return q_a, q_b


def diff_core(q, k, v, lam):
    s = jnp.einsum('bhmqd,bhmkd->bhmqk', q, k).astype(jnp.float32) * (HEAD_DIM ** -0.5)
    p = jax.nn.softmax(s, axis=-1)
    a = p[:, :, 0] - lam * p[:, :, 1]
    return jnp.einsum('bhqk,bhkv->bhqv', a.astype(v.dtype), v)


def gqa_core(q, k, v):
    s = jnp.einsum('bgrqd,bgkd->bgrqk', q, k).astype(jnp.float32) * (HEAD_DIM ** -0.5)
    p = jax.nn.softmax(s, axis=-1)
    return jnp.einsum('bgrqk,bgkv->bgrqv', p.astype(v.dtype), v)


def sweep_blocks(core, q, *rest):
    s, d = q.shape[-2], q.shape[-1]
    nb = s // Q_BLOCK
    qb = jnp.moveaxis(q.reshape(q.shape[:-2] + (nb, Q_BLOCK, d)), -3, 0)
    ob = lax.map(lambda qq: core(qq, *rest), qb)
    ob = jnp.moveaxis(ob, 0, -3)
    return ob.reshape(ob.shape[:-3] + (s, ob.shape[-1]))


def conformer_conv(glu_in, conv_w, conv_b, ln_w, ln_b):
    a, g = jnp.split(glu_in, 2, axis=-1)
    u = a * jax.nn.sigmoid(g)
    y = lax.conv_general_dilated(
        u, conv_w.astype(u.dtype)[:, None, :], window_strides=(1,),
        padding=[(C_KW // 2, C_KW // 2)], dimension_numbers=('NWC', 'WIO', 'NWC'),
        feature_group_count=C_WIDTH) + conv_b
    yf = y.astype(jnp.float32)
    mu = jnp.mean(yf, axis=-1, keepdims=True)
    var = jnp.mean(jnp.square(yf - mu), axis=-1, keepdims=True)
    yn = (yf - mu) * lax.rsqrt(var + EPS) * ln_w.astype(jnp.float32) + ln_b.astype(jnp.float32)
    return jax.nn.silu(yn).astype(u.dtype)


def merge_branches(o_a, o_b, glu_in, gate_logits, lam_init, subln_w, conv_w, conv_b, ln_w, ln_b,
                   w_a, w_b, w_c, w_o):
    b, _, n, _ = o_a.shape
    o_a = rms_norm(o_a.transpose(0, 2, 1, 3), subln_w) * (1.0 - lam_init)
    o_a = o_a.reshape(b, n, A_WIDTH)
    o_b = o_b.transpose(0, 3, 1, 2, 4).reshape(b, n, B_WIDTH)
    o_c = conformer_conv(glu_in, conv_w, conv_b, ln_w, ln_b)
    g_a, g_b, g_c = jnp.split(jax.nn.sigmoid(gate_logits), 3, axis=-1)
    merged = g_a * (o_a @ w_a) + g_b * (o_b @ w_b) + g_c * (o_c @ w_c)
    return merged @ w_o


def peer(h, w_q, sub_keys, u_tab, v_tab):
    shp = h.shape
    t = h.reshape(-1, D_MODEL)
    n_tok = t.shape[0]
    q = (t @ w_q).reshape(n_tok, P_HEADS, 2, P_DKEY // 2)
    s = jnp.einsum('thpd,hpkd->thpk', q, sub_keys).astype(jnp.float32)
    sv, si = lax.top_k(s, P_TOPK)
    cand = (sv[:, :, 0, :, None] + sv[:, :, 1, None, :]).reshape(n_tok, P_HEADS, P_TOPK * P_TOPK)
    cand_idx = (si[:, :, 0, :, None] * P_NKEYS + si[:, :, 1, None, :]).reshape(n_tok, P_HEADS, P_TOPK * P_TOPK)
    fv, fi = lax.top_k(cand, P_TOPK)
    eidx = jnp.take_along_axis(cand_idx, fi, axis=-1)
    g = jax.nn.softmax(fv, axis=-1).astype(t.dtype)
    nb = n_tok // P_BLOCK

    def block(args):
        tb, eb, gb = args
        act = jax.nn.gelu(jnp.einsum('pd,pkd->pk', tb, u_tab[eb]), approximate=False)
        return jnp.einsum('pk,pkd->pd', act * gb, v_tab[eb])

    out = lax.map(block, (t.reshape(nb, P_BLOCK, D_MODEL),
                          eidx.reshape(nb, P_BLOCK, P_HEADS * P_TOPK),
                          g.reshape(nb, P_BLOCK, P_HEADS * P_TOPK)))
    return out.reshape(shp)


def setup_inputs(seed: int = 0) -> dict:
    key = jax.random.key(seed)
    ks = jax.random.split(key, 32)
    f32 = jnp.float32
    nrm = lambda k, shape, s: jax.random.normal(k, shape, f32) * s
    L = DEPTH
    return {
        "x": nrm(ks[0], (BATCH, SEQ, D_MODEL), 1.0),
        "c": nrm(ks[1], (BATCH, D_MODEL), 1.0),
        "ctx": nrm(ks[2], (BATCH, CTX_LEN, D_MODEL), 1.0),
        "c_ctx": nrm(ks[3], (D_MODEL,), 1.0),
        "w_ada": nrm(ks[4], (L, D_MODEL, 6 * D_MODEL), D_MODEL ** -0.5),
        "b_ada": nrm(ks[5], (L, 6 * D_MODEL), 0.01),
        "w_in": nrm(ks[6], (L, D_MODEL, IN_COLS), D_MODEL ** -0.5),
        "lam_q1": nrm(ks[7], (L, HEAD_DIM), 0.1),
        "lam_k1": nrm(ks[8], (L, HEAD_DIM), 0.1),
        "lam_q2": nrm(ks[9], (L, HEAD_DIM), 0.1),
        "lam_k2": nrm(ks[10], (L, HEAD_DIM), 0.1),
        "subln_w": 1.0 + nrm(ks[11], (L, A_VDIM), 0.01),
        "q_norm_w": 1.0 + nrm(ks[12], (L, HEAD_DIM), 0.01),
        "k_norm_w": 1.0 + nrm(ks[13], (L, HEAD_DIM), 0.01),
        "conv_w": nrm(ks[14], (L, C_KW, C_WIDTH), C_KW ** -0.5),
        "conv_b": nrm(ks[15], (L, C_WIDTH), 0.01),
        "conv_ln_w": 1.0 + nrm(ks[16], (L, C_WIDTH), 0.01),
        "conv_ln_b": nrm(ks[17], (L, C_WIDTH), 0.01),
        "w_branch_a": nrm(ks[18], (L, A_WIDTH, D_MODEL), A_WIDTH ** -0.5),
        "w_branch_b": nrm(ks[19], (L, B_WIDTH, D_MODEL), B_WIDTH ** -0.5),
        "w_branch_c": nrm(ks[20], (L, C_WIDTH, D_MODEL), C_WIDTH ** -0.5),
        "w_out": nrm(ks[21], (L, D_MODEL, D_MODEL), D_MODEL ** -0.5),
        "peer_wq": nrm(ks[22], (L, D_MODEL, P_HEADS * P_DKEY), D_MODEL ** -0.5),
        "peer_keys": nrm(ks[23], (L, P_HEADS, 2, P_NKEYS, P_DKEY // 2), (P_DKEY // 2) ** -0.5),
        "peer_u": nrm(ks[24], (L, P_EXPERTS, D_MODEL), D_MODEL ** -0.5),
        "peer_v": nrm(ks[25], (L, P_EXPERTS, D_MODEL), P_HEADS ** -0.5),
        "final_norm_w": 1.0 + nrm(ks[26], (D_MODEL,), 0.01),
    }


def reference(x, c, ctx, c_ctx, w_ada, b_ada, w_in, lam_q1, lam_k1, lam_q2, lam_k2, subln_w,
              q_norm_w, k_norm_w, conv_w, conv_b, conv_ln_w, conv_ln_b, w_branch_a, w_branch_b,
              w_branch_c, w_out, peer_wq, peer_keys, peer_u, peer_v, final_norm_w):
    n_lat = x.shape[1]
    cos, sin = axial_rope(n_lat)
    sc = jax.nn.silu(c)
    scc = jax.nn.silu(c_ctx)
    y = ctx
    for l in range(DEPTH):
        last = l == DEPTH - 1
        lam_init = 0.8 - 0.6 * math.exp(-0.3 * l)
        lam = (jnp.exp(jnp.sum(lam_q1[l] * lam_k1[l]).astype(jnp.float32))
               - jnp.exp(jnp.sum(lam_q2[l] * lam_k2[l]).astype(jnp.float32)) + lam_init)
        mod = (sc @ w_ada[l] + b_ada[l])[:, None, :]
        sh1, sc1, g1, sh2, sc2, g2 = jnp.split(mod, 6, axis=-1)
        modc = scc @ w_ada[l] + b_ada[l]
        csh1, csc1, cg1, csh2, csc2, cg2 = jnp.split(modc, 6, axis=-1)
        branch_params = (subln_w[l], conv_w[l], conv_b[l], conv_ln_w[l], conv_ln_b[l],
                         w_branch_a[l], w_branch_b[l], w_branch_c[l], w_out[l])

        hc = modulate(y, csh1, csc1)
        if last:
            pc_kv = hc @ w_in[l][:, :KV_COLS]
        else:
            pc = hc @ w_in[l]
            pc_kv, pc_q, pc_glu, pc_gate = jnp.split(pc, MAIN_SPLITS, axis=-1)
        ka_c, va_c, kb_c, vb_c = kv_heads(pc_kv, k_norm_w[l])

        hx = modulate(x, sh1, sc1)
        px = hx @ w_in[l]
        px_kv, px_q, px_glu, px_gate = jnp.split(px, MAIN_SPLITS, axis=-1)
        ka_x, va_x, kb_x, vb_x = kv_heads(px_kv, k_norm_w[l])
        qa_x, qb_x = q_heads(px_q, q_norm_w[l])
        ka_all = jnp.concatenate([apply_rope(ka_x, cos, sin), ka_c], axis=-2)
        va_all = jnp.concatenate([va_x, va_c], axis=-2)
        kb_all = jnp.concatenate([apply_rope(kb_x, cos, sin), kb_c], axis=-2)
        vb_all = jnp.concatenate([vb_x, vb_c], axis=-2)
        o_a = sweep_blocks(diff_core, apply_rope(qa_x, cos, sin), ka_all, va_all, lam)
        o_b = sweep_blocks(gqa_core, apply_rope(qb_x, cos, sin), kb_all, vb_all)
        x = x + g1 * merge_branches(o_a, o_b, px_glu, px_gate, lam_init, *branch_params)
        x = x + g2 * peer(modulate(x, sh2, sc2), peer_wq[l], peer_keys[l], peer_u[l], peer_v[l])

        if not last:
            qa_c, qb_c = q_heads(pc_q, q_norm_w[l])
            oa_c = diff_core(qa_c, ka_c, va_c, lam)
            ob_c = gqa_core(qb_c, kb_c, vb_c)
            y = y + cg1 * merge_branches(oa_c, ob_c, pc_glu, pc_gate, lam_init, *branch_params)
            y = y + cg2 * peer(modulate(y, csh2, csc2), peer_wq[l], peer_keys[l], peer_u[l], peer_v[l])
    return rms_norm(x, final_norm_w)
```

```cpp
#include <hip/hip_runtime.h>
#include <cstdio>
#include <cstdint>
#include <cmath>
namespace pg8 {
#define PG8_LAS __attribute__((address_space(3)))
typedef unsigned short bf16_t;
typedef short bf16x8 __attribute__((ext_vector_type(8)));
typedef float f32x4 __attribute__((ext_vector_type(4)));
typedef unsigned u32x4 __attribute__((ext_vector_type(4)));
constexpr int BM = 256, BK = 64, HALF = 128, HTB = HALF * BK * 2  , STAGE_BYTES = 8 * HTB, NXCD = 8, WGM = 8;

__host__ __device__ __forceinline__ int lds_byte(int r, int c) { const int st = (r >> 4) * 2 + (c >> 5), rr = r & 15, cc = c & 31, ob = rr * 64 + cc * 2; return st * 1024 + (ob ^ (((ob >> 9) & 1) << 5)); }
__host__ __device__ __forceinline__ void stage_rc(int b, int& R, int& C) { const int st = b / 1024, sb = b % 1024, swz = sb ^ (((sb >> 9) & 1) << 5); R = (st >> 1) * 16 + swz / 64; C = (st & 1) * 32 + (swz % 64) / 2; }
__host__ __device__ __forceinline__ int perm32(int rho) { const int n = rho >> 4, i = rho & 15; return 8 * (i >> 2) + 4 * n + (i & 3); }

struct Unit { int pm, pn; };
struct Gemm { const bf16_t* A; const bf16_t* Bt; int M, N, K; };

struct StaticOrder {
    int nM, nN, nwg, G, c;
    __host__ __device__ void init(int M, int N, int G_, int c_) { nM = M / BM; nN = N / BM; nwg = nM * nN; G = G_; c = c_; }
    __host__ __device__ bool next(int i, Unit& u) const {
        const long L = (long)i * G + c; if (L >= nwg) return false;
        int wgid = (int)L; { const int q = nwg / NXCD, r = nwg % NXCD, xcd = wgid % NXCD, off = wgid / NXCD; wgid = (xcd < r ? xcd * (q + 1) : r * (q + 1) + (xcd - r) * q) + off; }
        const int nig = WGM * nN, gid = wgid / nig, fm = gid * WGM, gsz = (nM - fm) < WGM ? (nM - fm) : WGM;
        u.pm = fm + ((wgid % nig) % gsz); u.pn = (wgid % nig) / gsz; return true;
    }
    __device__ __forceinline__ void a_ready(const Unit&) const {}
    __device__ __forceinline__ void done(const Unit&) const {}
};

__device__ __forceinline__ unsigned cvt_pk_bf16(float lo, float hi) { unsigned r; asm volatile("v_cvt_pk_bf16_f32 %0, %1, %2" : "=v"(r) : "v"(lo), "v"(hi)); return r; }
typedef float f32x2 __attribute__((ext_vector_type(2)));
__device__ __forceinline__ float sigmoidf_(float x) { return 1.0f / (1.0f + __expf(-x)); }
__device__ __forceinline__ float bf_lo(unsigned w) { return __uint_as_float(w << 16); }
__device__ __forceinline__ float bf_hi(unsigned w) { return __uint_as_float(w & 0xffff0000u); }
struct EpiG1 {
    static constexpr bool PERM = true, AFTER_DRAIN = false;
    bf16_t* Oa; bf16_t* Ob;
    __device__ __forceinline__ void operator()(const f32x4 (&acc)[2][2][4][2], const Unit& u, int wr, int wc, int fr, int fq) const {
        const int row0 = u.pm * BM + wr * 64 + fr; int colt = u.pn * BM; bf16_t* base = Oa; int ldc = 2304;
        if (colt >= 2304) { base = Ob; ldc = 4096; colt -= 2304; }
        const int col0 = colt + wc * 32 + 8 * fq;
#pragma unroll
        for (int ai = 0; ai < 2; ++ai)
#pragma unroll
            for (int m = 0; m < 4; ++m) { bf16_t* rowp = base + (size_t)(row0 + ai * HALF + m * 16) * ldc + col0;
#pragma unroll
                for (int bj = 0; bj < 2; ++bj) { const f32x4 v0 = acc[ai][bj][m][0], v1 = acc[ai][bj][m][1];
                    u32x4 w; w.x = cvt_pk_bf16(v0[0], v0[1]); w.y = cvt_pk_bf16(v0[2], v0[3]); w.z = cvt_pk_bf16(v1[0], v1[1]); w.w = cvt_pk_bf16(v1[2], v1[3]);
                    *(u32x4*)(rowp + bj * HALF) = w; } }
    }
};
struct EpiG2 {
    static constexpr bool PERM = true, AFTER_DRAIN = false;
    const bf16_t* gate;   float* M32; bf16_t* Mb; int pass;
    __device__ __forceinline__ void operator()(const f32x4 (&acc)[2][2][4][2], const Unit& u, int wr, int wc, int fr, int fq) const {
        const int row0 = u.pm * BM + wr * 64 + fr; const int col0 = u.pn * BM + wc * 32 + 8 * fq;
#pragma unroll
        for (int ai = 0; ai < 2; ++ai)
#pragma unroll
            for (int m = 0; m < 4; ++m) { const size_t row = (size_t)(row0 + ai * HALF + m * 16);
#pragma unroll
                for (int bj = 0; bj < 2; ++bj) { const int c = col0 + bj * HALF;
                    const u32x4 gw = *(const u32x4*)(gate + row * 4096 + c);
                    f32x4 v0 = acc[ai][bj][m][0], v1 = acc[ai][bj][m][1];
                    v0[0] *= sigmoidf_(bf_lo(gw.x)); v0[1] *= sigmoidf_(bf_hi(gw.x)); v0[2] *= sigmoidf_(bf_lo(gw.y)); v0[3] *= sigmoidf_(bf_hi(gw.y));
                    v1[0] *= sigmoidf_(bf_lo(gw.z)); v1[1] *= sigmoidf_(bf_hi(gw.z)); v1[2] *= sigmoidf_(bf_lo(gw.w)); v1[3] *= sigmoidf_(bf_hi(gw.w));
                    float* mp = M32 + row * 1024 + c;
                    if (pass != 0) { v0 += *(const f32x4*)mp; v1 += *(const f32x4*)(mp + 4); }
                    if (pass != 2) { *(f32x4*)mp = v0; *(f32x4*)(mp + 4) = v1; }
                    else { u32x4 w; w.x = cvt_pk_bf16(v0[0], v0[1]); w.y = cvt_pk_bf16(v0[2], v0[3]); w.z = cvt_pk_bf16(v1[0], v1[1]); w.w = cvt_pk_bf16(v1[2], v1[3]);
                        *(u32x4*)(Mb + row * 1024 + c) = w; } } }
    }
};
struct EpiG3 {
    static constexpr bool PERM = true, AFTER_DRAIN = false;
    float* X; const float* g1;
    __device__ __forceinline__ void operator()(const f32x4 (&acc)[2][2][4][2], const Unit& u, int wr, int wc, int fr, int fq) const {
        const int row0 = u.pm * BM + wr * 64 + fr; const int col0 = u.pn * BM + wc * 32 + 8 * fq;
        const int rt = u.pm * BM; const int mi = rt < 8192 ? 0 : (rt < 16384 ? 1 : 2); const float* gp = g1 + mi * 6144;
#pragma unroll
        for (int bj = 0; bj < 2; ++bj) { const int c = col0 + bj * HALF; const f32x4 ga = *(const f32x4*)(gp + c), gb = *(const f32x4*)(gp + c + 4);
#pragma unroll
            for (int ai = 0; ai < 2; ++ai)
#pragma unroll
                for (int m = 0; m < 4; ++m) { float* xp = X + (size_t)(row0 + ai * HALF + m * 16) * 1024 + c;
                    const f32x4 x0 = *(const f32x4*)xp, x1 = *(const f32x4*)(xp + 4);
                    *(f32x4*)xp = x0 + ga * acc[ai][bj][m][0]; *(f32x4*)(xp + 4) = x1 + gb * acc[ai][bj][m][1]; } }
    }
};
struct EpiG4 {
    static constexpr bool PERM = true, AFTER_DRAIN = false;
    float* O;
    __device__ __forceinline__ void operator()(const f32x4 (&acc)[2][2][4][2], const Unit& u, int wr, int wc, int fr, int fq) const {
        const int row0 = u.pm * BM + wr * 64 + fr; const int col0 = u.pn * BM + wc * 32 + 8 * fq;
#pragma unroll
        for (int ai = 0; ai < 2; ++ai)
#pragma unroll
            for (int m = 0; m < 4; ++m) { float* op = O + (size_t)(row0 + ai * HALF + m * 16) * 1024 + col0;
#pragma unroll
                for (int bj = 0; bj < 2; ++bj) { *(f32x4*)(op + bj * HALF) = acc[ai][bj][m][0]; *(f32x4*)(op + bj * HALF + 4) = acc[ai][bj][m][1]; } }
    }
};
template <class Epi, class Sched, bool ALIGN_EPI = false, bool SP2 = false>
__device__ __forceinline__ void gemm_phase(PG8_LAS unsigned char* lds, const Gemm g, const Sched& S, const Epi& E) {
    const int tid = threadIdx.x, wid = __builtin_amdgcn_readfirstlane(tid >> 6), lane = tid & 63, wr = wid >> 2, wc = wid & 3, fr = lane & 15, fq = lane >> 4;
    const int K = g.K, nt = K / BK;
    unsigned voffA[2], voffB[2];
#pragma unroll
    for (int i = 0; i < 2; ++i) { int R, C; stage_rc(tid * 16 + i * 8192, R, C); const int Rb = Epi::PERM ? ((R & ~31) + perm32(R & 31)) : R;
        voffA[i] = (unsigned)(R * K + C) * 2u; voffB[i] = (unsigned)(Rb * K + C) * 2u; }
    const size_t kstep = (size_t)(BK * 2);
    const size_t hstep = (size_t)HALF * K * 2;
    const size_t tstep = 2 * hstep;
    const unsigned ldsw = (unsigned)wid * 1024u;
    const int aoff = lds_byte(wr * 64 + fr, fq * 8), boff = lds_byte(wc * 32 + fr, fq * 8);
#define PG8_SA(b, h) (((b) * 2 + (h)) * HTB)
#define PG8_SB(b, h) ((4 + (b) * 2 + (h)) * HTB)
#define PG8_STAGE(bufoff, gbase, voff) do { _Pragma("unroll") for (int _i = 0; _i < 2; ++_i) \
        __builtin_amdgcn_global_load_lds((const unsigned*)((const char*)(gbase) + (voff)[_i]), (PG8_LAS unsigned*)(lds + (bufoff) + ldsw + _i * 8192), 16, 0, 0); } while (0)
#define PG8_LDA(dst, b, h) do { _Pragma("unroll") for (int m = 0; m < 4; ++m) _Pragma("unroll") for (int k = 0; k < 2; ++k) dst[m][k] = *(const PG8_LAS bf16x8*)(lds + PG8_SA(b, h) + aoff + m * 2048 + k * 1024); } while (0)
#define PG8_LDB(dst, b, h) do { _Pragma("unroll") for (int n = 0; n < 2; ++n) _Pragma("unroll") for (int k = 0; k < 2; ++k) dst[n][k] = *(const PG8_LAS bf16x8*)(lds + PG8_SB(b, h) + boff + n * 2048 + k * 1024); } while (0)
#define PG8_MMA(ai, bj, At, Bt) do { __builtin_amdgcn_s_setprio(1); _Pragma("unroll") for (int m = 0; m < 4; ++m) _Pragma("unroll") for (int n = 0; n < 2; ++n) _Pragma("unroll") for (int k = 0; k < 2; ++k) \
        acc[ai][bj][m][n] = __builtin_amdgcn_mfma_f32_16x16x32_bf16(Bt[n][k], At[m][k], acc[ai][bj][m][n], 0, 0, 0); __builtin_amdgcn_s_setprio(0); } while (0)
#define PG8_WAIT_V(n) asm volatile("s_waitcnt vmcnt(" #n ")" ::: "memory")
#define PG8_WAIT_L(n) asm volatile("s_waitcnt lgkmcnt(" #n ")" ::: "memory")
#define PG8_BAR __builtin_amdgcn_s_barrier()
#define PG8_SCHED __builtin_amdgcn_sched_barrier(0)
    Unit cur, nxt; int ui = 0;
    if (!S.next(0, cur)) return;
    f32x4 acc[2][2][4][2];
#pragma unroll
    for (int a = 0; a < 2; ++a)
#pragma unroll
        for (int b = 0; b < 2; ++b)
#pragma unroll
            for (int m = 0; m < 4; ++m)
#pragma unroll
                for (int n = 0; n < 2; ++n) acc[a][b][m][n] = (f32x4){0.f, 0.f, 0.f, 0.f};
    bf16x8 At[4][2], B0[2][2], B1[2][2];
    const char* cA = (const char*)g.A + (size_t)cur.pm * tstep; const char* cB = (const char*)g.Bt + (size_t)cur.pn * tstep;
    S.a_ready(cur);
    if constexpr (SP2) {
        PG8_STAGE(PG8_SB(0, 0), cB, voffB); PG8_STAGE(PG8_SB(0, 1), cB + hstep, voffB); PG8_STAGE(PG8_SA(0, 0), cA, voffA); PG8_STAGE(PG8_SA(0, 1), cA + hstep, voffA);
        if (wr == 1) PG8_BAR;
        PG8_WAIT_V(2); PG8_BAR;
        PG8_STAGE(PG8_SB(1, 0), cB + kstep, voffB); PG8_STAGE(PG8_SA(1, 0), cA + kstep, voffA); PG8_STAGE(PG8_SB(1, 1), cB + hstep + kstep, voffB);
        PG8_WAIT_V(6); PG8_BAR;
    } else {
        PG8_STAGE(PG8_SB(0, 0), cB, voffB); PG8_STAGE(PG8_SA(0, 0), cA, voffA); PG8_STAGE(PG8_SB(0, 1), cB + hstep, voffB); PG8_STAGE(PG8_SA(0, 1), cA + hstep, voffA);
        if (wr == 1) PG8_BAR;
        PG8_WAIT_V(4); PG8_BAR;
        PG8_STAGE(PG8_SB(1, 0), cB + kstep, voffB); PG8_STAGE(PG8_SA(1, 0), cA + kstep, voffA); PG8_STAGE(PG8_SB(1, 1), cB + hstep + kstep, voffB);
        PG8_WAIT_V(6); PG8_BAR;
    }
    for (;;) {
        const bool has_next = S.next(ui + 1, nxt);
        const char* nA = has_next ? (const char*)g.A + (size_t)nxt.pm * tstep : cA; const char* nB = has_next ? (const char*)g.Bt + (size_t)nxt.pn * tstep : cB;
        for (int t = 0; t < nt; t += 2) {
            const bool last = (t == nt - 2);
            const char* a1 = cA + (size_t)(t + 1) * kstep;
            const char* a2 = last ? nA : cA + (size_t)(t + 2) * kstep; const char* b2 = last ? nB : cB + (size_t)(t + 2) * kstep;
            const char* a3 = a2 + kstep; const char* b3 = b2 + kstep;
            if (last && has_next) S.a_ready(nxt);
            if constexpr (SP2) {
            PG8_LDB(B0, 0, 0); PG8_LDB(B1, 0, 1); PG8_SCHED; PG8_LDA(At, 0, 0); PG8_STAGE(PG8_SA(1, 1), a1 + hstep, voffA);
            PG8_WAIT_V(8); PG8_WAIT_L(0); PG8_BAR; PG8_MMA(0, 0, At, B0); PG8_MMA(0, 1, At, B1); PG8_BAR; PG8_SCHED;
            PG8_LDA(At, 0, 1); PG8_STAGE(PG8_SB(0, 0), b2, voffB); PG8_STAGE(PG8_SB(0, 1), b2 + hstep, voffB); PG8_STAGE(PG8_SA(0, 0), a2, voffA);
            PG8_WAIT_V(8); PG8_WAIT_L(0); PG8_BAR; PG8_MMA(1, 0, At, B0); PG8_MMA(1, 1, At, B1); PG8_BAR; PG8_SCHED;
            PG8_LDB(B0, 1, 0); PG8_LDB(B1, 1, 1); PG8_SCHED; PG8_LDA(At, 1, 0); PG8_STAGE(PG8_SA(0, 1), a2 + hstep, voffA);
            PG8_WAIT_V(8); PG8_WAIT_L(0); PG8_BAR; PG8_MMA(0, 0, At, B0); PG8_MMA(0, 1, At, B1); PG8_BAR; PG8_SCHED;
            PG8_LDA(At, 1, 1); PG8_STAGE(PG8_SB(1, 0), b3, voffB); PG8_STAGE(PG8_SB(1, 1), b3 + hstep, voffB); PG8_STAGE(PG8_SA(1, 0), a3, voffA);
            PG8_WAIT_V(8); PG8_WAIT_L(0); PG8_BAR; PG8_MMA(1, 0, At, B0); PG8_MMA(1, 1, At, B1); PG8_BAR; PG8_SCHED;
            } else {
            PG8_LDB(B0, 0, 0); PG8_SCHED; PG8_LDA(At, 0, 0); PG8_STAGE(PG8_SA(1, 1), a1 + hstep, voffA);
            PG8_WAIT_L(8); PG8_BAR; PG8_WAIT_L(0); PG8_MMA(0, 0, At, B0); PG8_BAR; PG8_SCHED;
            PG8_LDB(B1, 0, 1); PG8_STAGE(PG8_SB(0, 0), b2, voffB);
            PG8_BAR; PG8_WAIT_L(0); PG8_MMA(0, 1, At, B1); PG8_BAR;
            PG8_LDA(At, 0, 1); PG8_STAGE(PG8_SA(0, 0), a2, voffA);
            PG8_BAR; PG8_WAIT_L(0); PG8_MMA(1, 0, At, B0); PG8_BAR; PG8_SCHED;
            PG8_STAGE(PG8_SB(0, 1), b2 + hstep, voffB);
            PG8_WAIT_V(6); PG8_BAR; PG8_MMA(1, 1, At, B1); PG8_BAR;
            PG8_LDB(B0, 1, 0); PG8_SCHED; PG8_LDA(At, 1, 0); PG8_STAGE(PG8_SA(0, 1), a2 + hstep, voffA);
            PG8_WAIT_L(8); PG8_BAR; PG8_WAIT_L(0); PG8_MMA(0, 0, At, B0); PG8_BAR; PG8_SCHED;
            PG8_LDB(B1, 1, 1); PG8_STAGE(PG8_SB(1, 0), b3, voffB);
            PG8_BAR; PG8_WAIT_L(0); PG8_MMA(0, 1, At, B1); PG8_BAR;
            PG8_LDA(At, 1, 1); PG8_STAGE(PG8_SA(1, 0), a3, voffA);
            PG8_BAR; PG8_WAIT_L(0); PG8_MMA(1, 0, At, B0); PG8_BAR; PG8_SCHED;
            PG8_STAGE(PG8_SB(1, 1), b3 + hstep, voffB);
            PG8_WAIT_V(6); PG8_BAR; PG8_MMA(1, 1, At, B1); PG8_BAR;
            }
        }
        if constexpr (ALIGN_EPI) { if (wr == 0) PG8_BAR; }
        if constexpr (!Epi::AFTER_DRAIN) { E(acc, cur, wr, wc, fr, fq); S.done(cur); }
        if (!has_next) break;
#pragma unroll
        for (int a = 0; a < 2; ++a)
#pragma unroll
            for (int b = 0; b < 2; ++b)
#pragma unroll
                for (int m = 0; m < 4; ++m)
#pragma unroll
                    for (int n = 0; n < 2; ++n) acc[a][b][m][n] = (f32x4){0.f, 0.f, 0.f, 0.f};
        cur = nxt; cA = nA; cB = nB; ++ui;
        if constexpr (ALIGN_EPI) { if (wr == 1) PG8_BAR; }
    }
    PG8_WAIT_V(0);
    if constexpr (!ALIGN_EPI) { if (wr == 0) PG8_BAR; }
    PG8_BAR;
    if constexpr (Epi::AFTER_DRAIN) { E.fused(acc, cur, wr, wc, fr, fq, lds, wid, lane); S.done(cur); }
#undef PG8_SA
#undef PG8_SB
#undef PG8_STAGE
#undef PG8_LDA
#undef PG8_LDB
#undef PG8_MMA
#undef PG8_WAIT_V
#undef PG8_WAIT_L
#undef PG8_BAR
#undef PG8_SCHED
}
}
#define GAS __attribute__((address_space(1)))
#define LAS __attribute__((address_space(3)))
typedef unsigned short bf16;
typedef unsigned v4u __attribute__((ext_vector_type(4)));
typedef float f32x4 __attribute__((ext_vector_type(4)));
typedef short bf16x8 __attribute__((ext_vector_type(8)));
typedef GAS unsigned gu32;
typedef GAS unsigned long long gu64;
#define RLX_AGENT __ATOMIC_RELAXED, __HIP_MEMORY_SCOPE_AGENT
#define LDS_WAIT() asm volatile("s_waitcnt lgkmcnt(0)" ::: "memory")
#define VM_WAIT() asm volatile("s_waitcnt vmcnt(0)" ::: "memory")
__device__ __forceinline__ unsigned long long rt() { return __builtin_amdgcn_s_memrealtime(); }
__device__ __forceinline__ unsigned f2bf(float f) { unsigned u = __builtin_bit_cast(unsigned, f); return (u + 0x7fffu + ((u >> 16) & 1u)) >> 16; }
__device__ __forceinline__ unsigned pk2(float lo, float hi) { return f2bf(lo) | (f2bf(hi) << 16); }
#define XB_TMO      128
#define XB_XCNT(j)  (256  + 64 * (j))
#define XB_XSUB(j)  (1280 + 64 * (j))
#define XB_XGEN(j)  (2304 + 64 * (j))
#define XB_TOP      3328
#define XB_TOPGEN   3392
#define XCD_BAR_WORDS 3456
#define XB_SPIN_CAP (1u << 24)

__device__ __forceinline__ unsigned xb_ld(unsigned* p)              { return __hip_atomic_load(p, __ATOMIC_RELAXED, __HIP_MEMORY_SCOPE_AGENT); }
__device__ __forceinline__ unsigned xb_add(unsigned* p, unsigned v) { return __hip_atomic_fetch_add(p, v, __ATOMIC_RELAXED, __HIP_MEMORY_SCOPE_AGENT); }
__device__ __forceinline__ unsigned xb_xcc_id() { return (unsigned)__builtin_amdgcn_s_getreg((3 << 11) | 20) & 0xFu; }
#define XB_SPIN(cond, bar) do { unsigned _sp = 0; while (cond) { __builtin_amdgcn_s_sleep(1); \
    if ((++_sp & 255u) == 0u) { if (xb_ld(&(bar)[XB_TMO])) break; if (_sp > XB_SPIN_CAP) { atomicAdd(&(bar)[XB_TMO], 1u); break; } } } } while (0)

struct XcdBarrier {
    unsigned* bar; unsigned x;
    volatile LAS unsigned* st;
};

__device__ __forceinline__ XcdBarrier xcd_barrier_post(unsigned* bar, volatile LAS unsigned* st) {
    XcdBarrier b; b.bar = bar; b.x = xb_xcc_id(); b.st = st;
    if (threadIdx.x == 0) (void)xb_add(&bar[XB_XCNT(b.x)], 1u);
    return b;
}
__device__ __forceinline__ void xcd_barrier_complete(unsigned* bar, unsigned x, unsigned& nloc, unsigned& nx) {
    const unsigned G = gridDim.x * gridDim.y * gridDim.z;
    unsigned sum, cnt, mine, sp = 0u;
    for (;;) {
        sum = 0u; cnt = 0u; mine = 0u;
#pragma unroll
        for (unsigned j = 0; j < 16; ++j) { const unsigned c = xb_ld(&bar[XB_XCNT(j)]); sum += c; cnt += (c > 0u) ? 1u : 0u; mine = (j == x) ? c : mine; }
        if (sum == G) break;
        __builtin_amdgcn_s_sleep(1);
        if ((++sp & 255u) == 0u) { if (xb_ld(&bar[XB_TMO])) break; if (sp > XB_SPIN_CAP) { atomicAdd(&bar[XB_TMO], 1u); break; } }
    }
    nloc = mine > 0u ? mine : 1u; nx = cnt > 0u ? cnt : 1u;
}

__device__ __forceinline__ void xcd_barrier(const XcdBarrier& b) {
    asm volatile("s_waitcnt vmcnt(0)" ::: "memory");
    __syncthreads();
    if (threadIdx.x == 0) {
        unsigned* bar = b.bar;
        __builtin_amdgcn_s_waitcnt(0);
        unsigned nloc = b.st[0], nx = b.st[1];
        if (nloc == 0u) { xcd_barrier_complete(bar, b.x, nloc, nx); b.st[0] = nloc; b.st[1] = nx; }
        const unsigned old = xb_add(&bar[XB_XSUB(b.x)], 1u);
        const unsigned gen = old / nloc;
        if (old + 1u == (gen + 1u) * nloc) {
            __builtin_amdgcn_fence(__ATOMIC_RELEASE, "agent");
            asm volatile("s_waitcnt vmcnt(0)" ::: "memory");
            const unsigned og = xb_add(&bar[XB_TOP], 1u);
            const unsigned tg = og / nx;
            if (og + 1u == (tg + 1u) * nx) xb_add(&bar[XB_TOPGEN], 1u);
            else XB_SPIN(xb_ld(&bar[XB_TOPGEN]) == tg, bar);
            __builtin_amdgcn_fence(__ATOMIC_ACQUIRE, "agent");
            xb_add(&bar[XB_XGEN(b.x)], 1u);
            asm volatile("s_waitcnt vmcnt(0)" ::: "memory");
        } else {
            XB_SPIN(xb_ld(&bar[XB_XGEN(b.x)]) == gen, bar);
            __builtin_amdgcn_fence(__ATOMIC_ACQUIRE, "agent");
            asm volatile("s_waitcnt vmcnt(0)" ::: "memory");
        }
    }
    __syncthreads();
}
__device__ __forceinline__ float wave_sum(float v) {
#pragma unroll
    for (int o = 1; o < 64; o <<= 1) v += __shfl_xor(v, o);
    return v;
}
__device__ __forceinline__ void p0_transpose_item(const float* W, int K, int N, bf16* WT, int row_off, LAS float* scr, int item, int lane) {
    const int nblk = N / 32, kb = item / nblk, nb = item % nblk, k0 = 64 * kb, n0 = 32 * nb;
#pragma unroll 8
    for (int i = 0; i < 32; ++i) { const int kk = 2 * i + (lane >> 5); scr[kk * 33 + (lane & 31)] = W[(size_t)(k0 + kk) * N + n0 + (lane & 31)]; }
    LDS_WAIT(); asm volatile("" ::: "memory");
    const int c = lane & 7;
#pragma unroll
    for (int j = 0; j < 4; ++j) { const int n = (lane >> 3) + 8 * j; const LAS float* s = scr + (8 * c) * 33 + n;
        v4u o; o.x = pk2(s[0 * 33], s[1 * 33]); o.y = pk2(s[2 * 33], s[3 * 33]); o.z = pk2(s[4 * 33], s[5 * 33]); o.w = pk2(s[6 * 33], s[7 * 33]);
        *(GAS v4u*)(WT + (size_t)(row_off + n0 + n) * K + k0 + 8 * c) = o; }
    LDS_WAIT(); asm volatile("" ::: "memory");
}

constexpr int NWAVES = 8;
constexpr int DM = 1024, SEQ = 8192, NB = 2, CTXL = 256, NLAT = NB * SEQ, T = NLAT + NB * CTXL  , NKEY = SEQ + CTXL  ;
constexpr int NPXA = 2304, NPXB = 4096, INC = NPXA + NPXB;
constexpr float EPS = 1e-6f;
constexpr size_t MiB = 1u << 20;
constexpr size_t WS_CTL = 0, CTL_ZERO_BYTES = 1 * MiB, WS_MOD = 512 * 1024;
constexpr size_t WS_ROPE = 1 * MiB, WS_LAM = 1 * MiB + 65536;
constexpr size_t WS_WIN = 2 * MiB, WS_WA = 15 * MiB, WS_WB = 16 * MiB, WS_WC = 17 * MiB, WS_WO = 18 * MiB, WS_WQ = 20 * MiB;
constexpr size_t WS_U16 = 22 * MiB, WS_V16 = 54 * MiB;
constexpr size_t WS_X = 86 * MiB;
constexpr size_t WS_R1 = 152 * MiB;
constexpr size_t WS_R2 = 227 * MiB;
constexpr size_t SZ_QA = (size_t)NB * 4 * 2 * NKEY * 64 * 2, SZ_VA = (size_t)NB * 4 * NKEY * 128 * 2, SZ_QB = (size_t)NB * 8 * NKEY * 64 * 2, SZ_KB = (size_t)NB * 2 * NKEY * 64 * 2;
constexpr size_t WS_QA = WS_R2, WS_KA = WS_QA + SZ_QA, WS_VA = WS_KA + SZ_QA, WS_QB = WS_VA + SZ_VA, WS_KB = WS_QB + SZ_QB, WS_VB = WS_KB + SZ_KB;
constexpr size_t WS_MB = WS_R2, WS_EIDX = WS_R2 + 33 * MiB, WS_GW = WS_EIDX + (size_t)T * 128 * 4;
constexpr size_t WS_R3 = 306 * MiB;
constexpr size_t WS_R4 = 438 * MiB;
constexpr size_t SZ_O = (size_t)T * 512 * 2;
constexpr size_t WS_OA = WS_R4, WS_OB = WS_OA + SZ_O, WS_OC = WS_OB + SZ_O, WS_HX = WS_R4;
constexpr size_t WS_END = 488 * MiB;
static_assert(WS_VB + SZ_KB <= WS_R3 && WS_GW + (size_t)T * 128 * 4 <= WS_R3 && WS_R1 + (size_t)T * NPXA * 2 <= WS_R2 && WS_R3 + (size_t)T * NPXB * 2 <= WS_R4 && WS_OC + SZ_O <= WS_END, "d_ws map");
constexpr int CW_TMO = 0, CW_BAR = 4096;

constexpr int RING_BYTES = 131072, LDSCTL_OFF = RING_BYTES, MISC_OFF = LDSCTL_OFF + 320, LDS_BYTES = 147456;

struct Args { const float* in[27]; float* out; unsigned char* ws; int ph_lo, ph_hi; };
struct Frame { LAS unsigned char* lds; volatile LAS unsigned* MISC; gu32* ctl; int tid, lane, wave, G, bid; };

typedef float f32x16 __attribute__((ext_vector_type(16)));
typedef short s16x4 __attribute__((ext_vector_type(4)));
typedef unsigned u32x2 __attribute__((ext_vector_type(2)));
__device__ __forceinline__ float bf2f(unsigned short b) { return __uint_as_float((unsigned)b << 16); }
__device__ __forceinline__ float bflo(unsigned w) { return __uint_as_float(w << 16); }
__device__ __forceinline__ float bfhi(unsigned w) { return __uint_as_float(w & 0xffff0000u); }
__device__ __forceinline__ float sigm(float x) { return 1.0f / (1.0f + __expf(-x)); }
__device__ __forceinline__ int mod_index(int row) { return row < SEQ ? 0 : (row < NLAT ? 1 : 2); }
__device__ __forceinline__ void row_to_bn(int row, int& b, int& nd) { if (row < NLAT) { b = row >> 13; nd = row & (SEQ - 1); } else { const int r = row - NLAT; b = r >> 8; nd = SEQ + (r & 255); } }

__device__ __forceinline__ void ph_prep0(const Args& a, Frame& F) {
    const int gtid = F.bid * 512 + F.tid, NT = F.G * 512;
    {
        const f32x4* xs = (const f32x4*)a.in[0]; f32x4* X4 = (f32x4*)(a.ws + WS_X);
        for (int i = gtid; i < NLAT * DM / 4; i += NT) X4[i] = xs[i];
        const f32x4* cs = (const f32x4*)a.in[2];
        for (int i = gtid; i < NB * CTXL * DM / 4; i += NT) X4[NLAT * DM / 4 + i] = cs[i];
    }
    if (gtid < 2048) {
        const int pos = gtid >> 4, i = gtid & 15;
        double inv = 1.0; for (int k = 0; k < i; ++k) inv *= 0.5623413251903491;
        const double x = (double)pos * inv, TWO_PI = 6.283185307179586476925;
        const double kk = rint(x / TWO_PI), y = x - kk * TWO_PI, y2 = y * y;
        double ts = 1.0, tc = 1.0;
        for (int n = 14; n >= 1; --n) { ts = 1.0 - ts * y2 / (double)((2 * n) * (2 * n + 1)); tc = 1.0 - tc * y2 / (double)((2 * n - 1) * (2 * n)); }
        float* rp = (float*)(a.ws + WS_ROPE) + gtid * 2; rp[0] = (float)tc; rp[1] = (float)(y * ts);
    }
    if (gtid < 2) {
        const int l = gtid; float s1 = 0.f, s2 = 0.f;
        for (int d = 0; d < 64; ++d) { s1 += a.in[7][l * 64 + d] * a.in[8][l * 64 + d]; s2 += a.in[9][l * 64 + d] * a.in[10][l * 64 + d]; }
        const float lam_init = l == 0 ? 0.2f : 0.35550906759096926f;
        float* lp = (float*)(a.ws + WS_LAM); lp[l * 2] = expf(s1) - expf(s2) + lam_init; lp[l * 2 + 1] = 1.0f - lam_init;
    }
    {
        float* MOD = (float*)(a.ws + WS_MOD); LAS float* red = (LAS float*)F.lds;
        for (int u = F.bid; u < 192; u += F.G) {
            const int l = u / 96, cc = u % 96, kg = F.tid >> 6, col = cc * 64 + (F.tid & 63);
            const float* W = a.in[4] + (size_t)l * 1024 * 6144;
            float s0 = 0.f, s1 = 0.f, s2 = 0.f;
            for (int k = kg * 128; k < kg * 128 + 128; ++k) {
                const float w = W[(size_t)k * 6144 + col]; const float c0 = a.in[1][k], c1 = a.in[1][1024 + k], c2 = a.in[3][k];
                s0 += c0 * sigm(c0) * w; s1 += c1 * sigm(c1) * w; s2 += c2 * sigm(c2) * w;
            }
            red[(kg * 3 + 0) * 64 + (F.tid & 63)] = s0; red[(kg * 3 + 1) * 64 + (F.tid & 63)] = s1; red[(kg * 3 + 2) * 64 + (F.tid & 63)] = s2;
            __syncthreads();
            if (F.tid < 192) { const int mi = F.tid >> 6, c = F.tid & 63; float s = a.in[5][l * 6144 + cc * 64 + c];
                for (int g = 0; g < 8; ++g) s += red[(g * 3 + mi) * 64 + c];
                MOD[(l * 3 + mi) * 6144 + cc * 64 + c] = s; }
            __syncthreads();
        }
    }
}
__device__ __forceinline__ void ph_convw(const Args& a, Frame& F, int l) {
    LAS float* scr = (LAS float*)(F.lds + F.wave * 16384);
    const int gw = F.bid * NWAVES + F.wave, NGW = F.G * NWAVES;
    constexpr int I_IN = 16 * 200, I_BR = 8 * 32, I_O = 16 * 32, NITEMS = I_IN + 3 * I_BR + 2 * I_O;
    for (int it = gw; it < NITEMS; it += NGW) {
        int r = it;
        if (r < I_IN) { p0_transpose_item(a.in[6] + (size_t)l * 1024 * INC, 1024, INC, (bf16*)(a.ws + WS_WIN), 0, scr, r, F.lane); continue; } r -= I_IN;
        if (r < I_BR) { p0_transpose_item(a.in[18] + (size_t)l * 512 * 1024, 512, 1024, (bf16*)(a.ws + WS_WA), 0, scr, r, F.lane); continue; } r -= I_BR;
        if (r < I_BR) { p0_transpose_item(a.in[19] + (size_t)l * 512 * 1024, 512, 1024, (bf16*)(a.ws + WS_WB), 0, scr, r, F.lane); continue; } r -= I_BR;
        if (r < I_BR) { p0_transpose_item(a.in[20] + (size_t)l * 512 * 1024, 512, 1024, (bf16*)(a.ws + WS_WC), 0, scr, r, F.lane); continue; } r -= I_BR;
        if (r < I_O) { p0_transpose_item(a.in[21] + (size_t)l * 1024 * 1024, 1024, 1024, (bf16*)(a.ws + WS_WO), 0, scr, r, F.lane); continue; } r -= I_O;
        p0_transpose_item(a.in[22] + (size_t)l * 1024 * 1024, 1024, 1024, (bf16*)(a.ws + WS_WQ), 0, scr, r, F.lane);
    }
    const int gtid = F.bid * 512 + F.tid, NT = F.G * 512; constexpr int N8 = 16384 * 1024 / 8;
    const f32x4* us = (const f32x4*)(a.in[24] + (size_t)l * 16384 * 1024); const f32x4* vs = (const f32x4*)(a.in[25] + (size_t)l * 16384 * 1024);
    v4u* ud = (v4u*)(a.ws + WS_U16); v4u* vd = (v4u*)(a.ws + WS_V16);
    for (int i = gtid; i < N8; i += NT) { const f32x4 p = us[2 * (size_t)i], q = us[2 * (size_t)i + 1]; v4u o; o.x = pk2(p[0], p[1]); o.y = pk2(p[2], p[3]); o.z = pk2(q[0], q[1]); o.w = pk2(q[2], q[3]); ud[i] = o; }
    for (int i = gtid; i < N8; i += NT) { const f32x4 p = vs[2 * (size_t)i], q = vs[2 * (size_t)i + 1]; v4u o; o.x = pk2(p[0], p[1]); o.y = pk2(p[2], p[3]); o.z = pk2(q[0], q[1]); o.w = pk2(q[2], q[3]); vd[i] = o; }
}
__device__ __forceinline__ void ph_mod(const Args& a, Frame& F, int l, int which) {
    const float* MOD = (const float*)(a.ws + WS_MOD) + (size_t)l * 3 * 6144 + (which ? 3072 : 0);
    const float* X = (const float*)(a.ws + WS_X); bf16* HX = (bf16*)(a.ws + WS_HX);
    const int gw = F.bid * NWAVES + F.wave, NGW = F.G * NWAVES;
    for (int row = gw; row < T; row += NGW) {
        const float* sh = MOD + mod_index(row) * 6144; const float* sc = sh + 1024;
        const f32x4* xr = (const f32x4*)(X + (size_t)row * DM) + F.lane;
        f32x4 v[4]; float ss = 0.f;
#pragma unroll
        for (int j = 0; j < 4; ++j) { v[j] = xr[64 * j]; ss += (v[j][0] * v[j][0] + v[j][1] * v[j][1]) + (v[j][2] * v[j][2] + v[j][3] * v[j][3]); }
        const float rstd = rsqrtf(wave_sum(ss) * (1.0f / DM) + EPS);
#pragma unroll
        for (int j = 0; j < 4; ++j) { const int c = 4 * F.lane + 256 * j; const f32x4 s1 = *(const f32x4*)(sc + c), s0 = *(const f32x4*)(sh + c);
            const f32x4 h = v[j] * rstd * (s1 + 1.0f) + s0; u32x2 o; o.x = pk2(h[0], h[1]); o.y = pk2(h[2], h[3]); *(u32x2*)(HX + (size_t)row * DM + c) = o; }
    }
}
__device__ __forceinline__ void ph_post(const Args& a, Frame& F, int l) {
    const bf16* PXa = (const bf16*)(a.ws + WS_R1); const float* rope = (const float*)(a.ws + WS_ROPE);
    bf16* QA = (bf16*)(a.ws + WS_QA); bf16* KA = (bf16*)(a.ws + WS_KA); bf16* VA = (bf16*)(a.ws + WS_VA); bf16* QB = (bf16*)(a.ws + WS_QB); bf16* KB = (bf16*)(a.ws + WS_KB); bf16* VB = (bf16*)(a.ws + WS_VB);
    const int gw = F.bid * NWAVES + F.wave, NGW = F.G * NWAVES, lane = F.lane;
    const float qnw = a.in[12][l * 64 + lane], knw = a.in[13][l * 64 + lane];
    for (int row = gw; row < T; row += NGW) {
        int b, nd; row_to_bn(row, b, nd);
        const bool lat = row < NLAT; const int pos = (lane & 32) ? (nd & 63) : ((nd >> 6) & 127);
        float cs = 1.f, sn = 0.f; if (lat) { cs = rope[(pos * 16 + (lane & 15)) * 2]; sn = rope[(pos * 16 + (lane & 15)) * 2 + 1]; }
        const bf16* pr = PXa + (size_t)row * NPXA;
        for (int hv = 0; hv < 36; ++hv) {
            float x = bf2f(pr[hv * 64 + lane]);
            const bool is_v = (hv >= 8 && hv < 16) || hv == 18 || hv == 19;
            const bool nrm = (hv == 16 || hv == 17 || hv >= 28);
            if (nrm) { const float ss = wave_sum(x * x); x = x * rsqrtf(ss * (1.0f / 64.0f) + EPS) * (hv >= 28 ? qnw : knw); }
            if (!is_v) { const float p = __shfl_xor(x, 16); x = x * cs + ((lane & 16) ? p : -p) * sn; }
            const unsigned short o = (unsigned short)f2bf(x);
            if (hv < 8) KA[((size_t)(b * 8 + hv) * NKEY + nd) * 64 + lane] = o;
            else if (hv < 16) VA[((size_t)(b * 4 + ((hv - 8) >> 1)) * NKEY + nd) * 128 + ((hv - 8) & 1) * 64 + lane] = o;
            else if (hv < 18) KB[((size_t)(b * 2 + (hv - 16)) * NKEY + nd) * 64 + lane] = o;
            else if (hv < 20) VB[((size_t)(b * 2 + (hv - 18)) * NKEY + nd) * 64 + lane] = o;
            else if (hv < 28) QA[((size_t)(b * 8 + (hv - 20)) * NKEY + nd) * 64 + lane] = o;
            else QB[((size_t)(b * 8 + (hv - 28)) * NKEY + nd) * 64 + lane] = o;
        }
    }
    __syncthreads();
    const bf16* PXb = (const bf16*)(a.ws + WS_R3); bf16* OC = (bf16*)(a.ws + WS_OC);
    LAS float* Y = (LAS float*)F.lds;
    const int c = F.tid;
    float w[31];
#pragma unroll
    for (int k = 0; k < 31; ++k) w[k] = a.in[14][(size_t)l * 31 * 512 + k * 512 + c];
    const float cb = a.in[15][l * 512 + c];
    for (int ct = F.bid; ct < T / 32; ct += F.G) {
        const int t0 = ct * 32; int s0, s1; if (t0 < NLAT) { s0 = t0 & ~(SEQ - 1); s1 = s0 + SEQ; } else { s0 = NLAT + ((t0 - NLAT) & ~(CTXL - 1)); s1 = s0 + CTXL; }
        float u[62];
#pragma unroll
        for (int i = 0; i < 62; ++i) { const int r = t0 - 15 + i; float v = 0.f;
            if (r >= s0 && r < s1) { const float av = bf2f(PXb[(size_t)r * NPXB + c]), gv = bf2f(PXb[(size_t)r * NPXB + 512 + c]); v = av * sigm(gv); }
            u[i] = v; }
#pragma unroll
        for (int n = 0; n < 32; ++n) { float y = cb;
#pragma unroll
            for (int k = 0; k < 31; ++k) y += w[k] * u[n + k];
            Y[n * 512 + c] = y; }
        __syncthreads();
#pragma unroll
        for (int q = 0; q < 4; ++q) { const int n = F.wave + 8 * q; float yv[8], s = 0.f;
#pragma unroll
            for (int j = 0; j < 8; ++j) { yv[j] = Y[n * 512 + lane + 64 * j]; s += yv[j]; }
            const float mu = wave_sum(s) * (1.0f / 512.0f); float q2 = 0.f;
#pragma unroll
            for (int j = 0; j < 8; ++j) { yv[j] -= mu; q2 += yv[j] * yv[j]; }
            const float rstd = rsqrtf(wave_sum(q2) * (1.0f / 512.0f) + EPS);
#pragma unroll
            for (int j = 0; j < 8; ++j) { const int ch = lane + 64 * j; const float yn = yv[j] * rstd * a.in[16][l * 512 + ch] + a.in[17][l * 512 + ch];
                OC[(size_t)(t0 + n) * 512 + ch] = (unsigned short)f2bf(yn * sigm(yn)); } }
        __syncthreads();
    }
}
__device__ __forceinline__ s16x4 vtr(const LAS unsigned char* p) { typedef short v4i16_t __attribute__((ext_vector_type(4))); return __builtin_bit_cast(s16x4, __builtin_amdgcn_ds_read_tr16_b64_v4i16((LAS v4i16_t*)p)); }
template <int DV>
__device__ __forceinline__ void attn_unit(Frame& F, const bf16* Qp, const bf16* Kp, const bf16* Vp, int nkt, float* of, bf16* ob, size_t ob_ld) {
    const int tid = F.tid, lane = F.lane, wid = F.wave, r32 = lane & 31, hi = lane >> 5;
    constexpr int KSTR = 144, VSTR = DV * 2 + 16, KBYTES = 64 * KSTR, VBYTES = 64 * VSTR, BUF = KBYTES + VBYTES, NVP = DV / 64;
    constexpr float C2 = 0.125f * 1.4426950408889634f;
    bf16x8 qf[4];
    { const bf16* qrow = Qp + (size_t)(wid * 32 + r32) * 64;
#pragma unroll
      for (int d0 = 0; d0 < 4; ++d0) qf[d0] = *(const bf16x8*)(qrow + d0 * 16 + hi * 8); }
    f32x16 o[DV / 32];
#pragma unroll
    for (int i = 0; i < DV / 32; ++i)
#pragma unroll
        for (int r = 0; r < 16; ++r) o[i][r] = 0.f;
    float m_run = -INFINITY, l_run = 0.f;
    const int kr = tid >> 3, kc = tid & 7;
    v4u kreg, vreg[NVP];
#define LOAD_TILE(t) do { kreg = *(const v4u*)(Kp + ((size_t)(t) * 64 + kr) * 64 + kc * 8); \
        _Pragma("unroll") for (int i_ = 0; i_ < NVP; ++i_) { const int idx_ = tid + 512 * i_; const int vr_ = idx_ / (DV / 8), vc_ = idx_ % (DV / 8); vreg[i_] = *(const v4u*)(Vp + ((size_t)(t) * 64 + vr_) * DV + vc_ * 8); } } while (0)
#define STORE_TILE(buf) do { LAS unsigned char* base_ = F.lds + (buf) * BUF; *(LAS v4u*)(base_ + kr * KSTR + kc * 16) = kreg; \
        _Pragma("unroll") for (int i_ = 0; i_ < NVP; ++i_) { const int idx_ = tid + 512 * i_; const int vr_ = idx_ / (DV / 8), vc_ = idx_ % (DV / 8); *(LAS v4u*)(base_ + KBYTES + vr_ * VSTR + vc_ * 16) = vreg[i_]; } } while (0)
    LOAD_TILE(0); STORE_TILE(0); __syncthreads();
    for (int t = 0; t < nkt; ++t) {
        const bool more = (t + 1 < nkt);
        if (more) LOAD_TILE(t + 1);
        const LAS unsigned char* kb = F.lds + (t & 1) * BUF; const LAS unsigned char* vb = kb + KBYTES;
        f32x16 p0, p1;
#pragma unroll
        for (int r = 0; r < 16; ++r) { p0[r] = 0.f; p1[r] = 0.f; }
#pragma unroll
        for (int d0 = 0; d0 < 4; ++d0) {
            const bf16x8 k0 = *(const LAS bf16x8*)(kb + r32 * KSTR + d0 * 32 + hi * 16);
            const bf16x8 k1 = *(const LAS bf16x8*)(kb + (32 + r32) * KSTR + d0 * 32 + hi * 16);
            p0 = __builtin_amdgcn_mfma_f32_32x32x16_bf16(k0, qf[d0], p0, 0, 0, 0);
            p1 = __builtin_amdgcn_mfma_f32_32x32x16_bf16(k1, qf[d0], p1, 0, 0, 0);
        }
        float mx = -INFINITY;
#pragma unroll
        for (int r = 0; r < 16; ++r) { p0[r] *= C2; p1[r] *= C2; mx = fmaxf(mx, fmaxf(p0[r], p1[r])); }
        mx = fmaxf(mx, __shfl_xor(mx, 32));
        const float m_new = fmaxf(m_run, mx), alpha = __builtin_amdgcn_exp2f(m_run - m_new); m_run = m_new;
        float ps = 0.f;
#pragma unroll
        for (int r = 0; r < 16; ++r) { p0[r] = __builtin_amdgcn_exp2f(p0[r] - m_new); p1[r] = __builtin_amdgcn_exp2f(p1[r] - m_new); ps += p0[r] + p1[r]; }
        l_run = l_run * alpha + ps;
#pragma unroll
        for (int i = 0; i < DV / 32; ++i)
#pragma unroll
            for (int r = 0; r < 16; ++r) o[i][r] *= alpha;
        v4u pw[4];
        pw[0] = (v4u){pk2(p0[0], p0[1]), pk2(p0[2], p0[3]), pk2(p0[4], p0[5]), pk2(p0[6], p0[7])};
        pw[1] = (v4u){pk2(p0[8], p0[9]), pk2(p0[10], p0[11]), pk2(p0[12], p0[13]), pk2(p0[14], p0[15])};
        pw[2] = (v4u){pk2(p1[0], p1[1]), pk2(p1[2], p1[3]), pk2(p1[4], p1[5]), pk2(p1[6], p1[7])};
        pw[3] = (v4u){pk2(p1[8], p1[9]), pk2(p1[10], p1[11]), pk2(p1[12], p1[13]), pk2(p1[14], p1[15])};
        const LAS unsigned char* vl = vb + (4 * hi + ((lane & 15) >> 2)) * VSTR + (16 * ((lane >> 4) & 1) + 4 * (lane & 3)) * 2;
#pragma unroll
        for (int db = 0; db < DV / 32; ++db)
#pragma unroll
            for (int s = 0; s < 4; ++s) {
                const s16x4 lo = vtr(vl + (16 * s) * VSTR + db * 64), hh = vtr(vl + (16 * s + 8) * VSTR + db * 64);
                const bf16x8 vf = (bf16x8){lo[0], lo[1], lo[2], lo[3], hh[0], hh[1], hh[2], hh[3]};
                o[db] = __builtin_amdgcn_mfma_f32_32x32x16_bf16(vf, __builtin_bit_cast(bf16x8, pw[s]), o[db], 0, 0, 0);
            }
        if (more) STORE_TILE((t + 1) & 1);
        __syncthreads();
    }
    l_run += __shfl_xor(l_run, 32);
    const float inv = 1.0f / l_run; const int qrow = wid * 32 + r32;
#pragma unroll
    for (int db = 0; db < DV / 32; ++db)
#pragma unroll
        for (int g = 0; g < 4; ++g) { const int d = 32 * db + 8 * g + 4 * hi;
            const f32x4 v = (f32x4){o[db][4 * g], o[db][4 * g + 1], o[db][4 * g + 2], o[db][4 * g + 3]} * inv;
            if (of) *(f32x4*)(of + (size_t)qrow * DV + d) = v;
            else { u32x2 w; w.x = pk2(v[0], v[1]); w.y = pk2(v[2], v[3]); *(u32x2*)(ob + (size_t)qrow * ob_ld + d) = w; } }
}
__device__ __forceinline__ void ph_attn(const Args& a, Frame& F) {
    const bf16* QA = (const bf16*)(a.ws + WS_QA); const bf16* KA = (const bf16*)(a.ws + WS_KA); const bf16* VA = (const bf16*)(a.ws + WS_VA);
    const bf16* QB = (const bf16*)(a.ws + WS_QB); const bf16* KB = (const bf16*)(a.ws + WS_KB); const bf16* VB = (const bf16*)(a.ws + WS_VB);
    float* OAm = (float*)(a.ws + WS_R1); bf16* OB = (bf16*)(a.ws + WS_OB);
    for (int ui = F.bid; ui < 1056; ui += F.G) {
        int kind, st, qb;
        if (ui < 512) { kind = 0; st = ui & 15; qb = ui >> 4; } else if (ui < 1024) { kind = 1; st = (ui - 512) & 15; qb = (ui - 512) >> 4; }
        else if (ui < 1040) { kind = 0; st = ui - 1024; qb = 32; } else { kind = 1; st = ui - 1040; qb = 32; }
        const int kt0 = qb == 32 ? 128 : 0, nkt = qb == 32 ? 4 : 132; const int b = st >> 3;
        if (kind == 0) {
            const bf16* Qp = QA + ((size_t)st * NKEY + qb * 256) * 64; const bf16* Kp = KA + ((size_t)st * NKEY + kt0 * 64) * 64; const bf16* Vp = VA + ((size_t)(st >> 1) * NKEY + kt0 * 64) * 128;
            attn_unit<128>(F, Qp, Kp, Vp, nkt, OAm + ((size_t)st * NKEY + qb * 256) * 128, nullptr, 0);
        } else {
            const int qh = st & 7, kvh = b * 2 + (qh >> 2);
            const bf16* Qp = QB + ((size_t)st * NKEY + qb * 256) * 64; const bf16* Kp = KB + ((size_t)kvh * NKEY + kt0 * 64) * 64; const bf16* Vp = VB + ((size_t)kvh * NKEY + kt0 * 64) * 64;
            const int trow = qb == 32 ? NLAT + b * CTXL : b * SEQ + qb * 256;
            attn_unit<64>(F, Qp, Kp, Vp, nkt, nullptr, OB + (size_t)trow * 512 + qh * 64, 512);
        }
    }
}
__device__ __forceinline__ void ph_comb(const Args& a, Frame& F, int l) {
    const float* OAm = (const float*)(a.ws + WS_R1); bf16* OA = (bf16*)(a.ws + WS_OA);
    const float lam = ((const float*)(a.ws + WS_LAM))[l * 2], oml = ((const float*)(a.ws + WS_LAM))[l * 2 + 1];
    const int gw = F.bid * NWAVES + F.wave, NGW = F.G * NWAVES, lane = F.lane;
    const float w0 = a.in[11][l * 128 + lane] * oml, w1 = a.in[11][l * 128 + 64 + lane] * oml;
    for (int it = gw; it < T * 4; it += NGW) {
        const int row = it >> 2, h = it & 3; int b, nd; row_to_bn(row, b, nd);
        const float* p1 = OAm + ((size_t)((b * 4 + h) * 2 + 0) * NKEY + nd) * 128; const float* p2 = OAm + ((size_t)((b * 4 + h) * 2 + 1) * NKEY + nd) * 128;
        const float x0 = p1[lane] - lam * p2[lane], x1 = p1[64 + lane] - lam * p2[64 + lane];
        const float rstd = rsqrtf(wave_sum(x0 * x0 + x1 * x1) * (1.0f / 128.0f) + EPS);
        OA[(size_t)row * 512 + h * 128 + lane] = (unsigned short)f2bf(x0 * rstd * w0); OA[(size_t)row * 512 + h * 128 + 64 + lane] = (unsigned short)f2bf(x1 * rstd * w1);
    }
}
__device__ __forceinline__ void wave_argmax(float& bv, int& bi) {
#pragma unroll
    for (int off = 32; off >= 1; off >>= 1) { const float ov = __shfl_xor(bv, off); const int oi = __shfl_xor(bi, off); if (ov > bv || (ov == bv && oi < bi)) { bv = ov; bi = oi; } }
}
__device__ __forceinline__ void ph_topk(const Args& a, Frame& F, int l) {
    const float* PQ = (const float*)(a.ws + WS_R1); int* EIDX = (int*)(a.ws + WS_EIDX); float* GW = (float*)(a.ws + WS_GW);
    LAS float* KEYS = (LAS float*)F.lds;
    LAS float* QT = (LAS float*)(F.lds + 65536);
    LAS float* S = (LAS float*)(F.lds + 65536 + 16896);
    LAS float* SV = (LAS float*)(F.lds + 65536 + 16896 + 32896);
    LAS int* SI = (LAS int*)(F.lds + 65536 + 16896 + 32896 + 4096);
    const int tid = F.tid, lane = F.lane, wave = F.wave;
    const int h = F.bid & 7;
    { const f32x4* ks = (const f32x4*)(a.in[23] + ((size_t)l * 8 + h) * 2 * 128 * 64);
      for (int i = tid; i < 4096; i += 512) ((LAS f32x4*)KEYS)[i] = ks[i]; }
    __syncthreads();
    for (int tile = F.bid >> 3; tile < T / 32; tile += (F.G >> 3)) {
        const int t0 = tile * 32;
#pragma unroll
        for (int i = 0; i < 8; ++i) { const int idx = tid + 512 * i, tok = idx >> 7, c = idx & 127; QT[tok * 132 + c] = PQ[(size_t)(t0 + tok) * 1024 + h * 128 + c]; }
        __syncthreads();
        {
            const int tok = tid & 31, kg = tid >> 5, p = kg >> 3, k0 = (kg & 7) * 16;
            f32x4 q[16];
#pragma unroll
            for (int j = 0; j < 16; ++j) q[j] = *(const LAS f32x4*)(QT + tok * 132 + p * 64 + 4 * j);
            for (int k = 0; k < 16; ++k) { const LAS f32x4* kp = (const LAS f32x4*)(KEYS + (size_t)(p * 128 + k0 + k) * 64); float s = 0.f;
#pragma unroll
                for (int j = 0; j < 16; ++j) { const f32x4 kv = kp[j]; s += (q[j][0] * kv[0] + q[j][1] * kv[1]) + (q[j][2] * kv[2] + q[j][3] * kv[3]); }
                S[tok * 257 + p * 128 + k0 + k] = s; }
        }
        __syncthreads();
        for (int it = 0; it < 8; ++it) {
            const int li = wave + 8 * it, tok = li >> 1, p = li & 1;
            float v0 = S[tok * 257 + p * 128 + lane], v1 = S[tok * 257 + p * 128 + 64 + lane]; float keepv = 0.f; int keepi = 0;
            for (int r = 0; r < 16; ++r) {
                float bv; int bi; if (v0 >= v1) { bv = v0; bi = lane; } else { bv = v1; bi = lane + 64; }
                wave_argmax(bv, bi);
                if (lane == r) { keepv = bv; keepi = bi; }
                if (bi == lane) v0 = -INFINITY; if (bi == lane + 64) v1 = -INFINITY;
            }
            if (lane < 16) { SV[(tok * 2 + p) * 16 + lane] = keepv; SI[(tok * 2 + p) * 16 + lane] = keepi; }
        }
        __syncthreads();
        for (int it = 0; it < 4; ++it) {
            const int tok = wave + 8 * it;
            const float a0 = SV[(tok * 2 + 0) * 16 + (lane >> 2)]; float cv[4];
#pragma unroll
            for (int e = 0; e < 4; ++e) cv[e] = a0 + SV[(tok * 2 + 1) * 16 + (lane & 3) * 4 + e];
            float keepv = 0.f; int keepi = 0;
            for (int r = 0; r < 16; ++r) {
                float bv = cv[0]; int bi = lane * 4;
#pragma unroll
                for (int e = 1; e < 4; ++e) if (cv[e] > bv) { bv = cv[e]; bi = lane * 4 + e; }
                wave_argmax(bv, bi);
                if (lane == r) { keepv = bv; keepi = bi; }
#pragma unroll
                for (int e = 0; e < 4; ++e) if (bi == lane * 4 + e) cv[e] = -INFINITY;
            }
            const float mx = __shfl(keepv, 0); float ev = lane < 16 ? __expf(keepv - mx) : 0.f; float sum = ev;
#pragma unroll
            for (int off = 8; off >= 1; off >>= 1) sum += __shfl_xor(sum, off);
            if (lane < 16) { const int e = SI[(tok * 2 + 0) * 16 + (keepi >> 4)] * 128 + SI[(tok * 2 + 1) * 16 + (keepi & 15)];
                EIDX[(size_t)(t0 + tok) * 128 + h * 16 + lane] = e; GW[(size_t)(t0 + tok) * 128 + h * 16 + lane] = ev / sum; }
        }
        __syncthreads();
    }
}
__device__ __forceinline__ void ph_expert(const Args& a, Frame& F, int l) {
    const bf16* H2 = (const bf16*)(a.ws + WS_HX); const bf16* U16 = (const bf16*)(a.ws + WS_U16); const bf16* V16 = (const bf16*)(a.ws + WS_V16);
    const int* EIDX = (const int*)(a.ws + WS_EIDX); const float* GW = (const float*)(a.ws + WS_GW); float* X = (float*)(a.ws + WS_X);
    const float* MOD = (const float*)(a.ws + WS_MOD) + (size_t)l * 3 * 6144 + 5120;
    const int gw = F.bid * NWAVES + F.wave, NGW = F.G * NWAVES, lane = F.lane;
    for (int row = gw; row < T; row += NGW) {
        float hx[16];
        { const v4u h0 = *(const v4u*)(H2 + (size_t)row * DM + 8 * lane), h1 = *(const v4u*)(H2 + (size_t)row * DM + 512 + 8 * lane);
          hx[0] = bflo(h0.x); hx[1] = bfhi(h0.x); hx[2] = bflo(h0.y); hx[3] = bfhi(h0.y); hx[4] = bflo(h0.z); hx[5] = bfhi(h0.z); hx[6] = bflo(h0.w); hx[7] = bfhi(h0.w);
          hx[8] = bflo(h1.x); hx[9] = bfhi(h1.x); hx[10] = bflo(h1.y); hx[11] = bfhi(h1.y); hx[12] = bflo(h1.z); hx[13] = bfhi(h1.z); hx[14] = bflo(h1.w); hx[15] = bfhi(h1.w); }
        const int e_a = EIDX[(size_t)row * 128 + lane], e_b = EIDX[(size_t)row * 128 + 64 + lane];
        const float g_a = GW[(size_t)row * 128 + lane], g_b = GW[(size_t)row * 128 + 64 + lane];
        float acc[16];
#pragma unroll
        for (int i = 0; i < 16; ++i) acc[i] = 0.f;
        for (int k0 = 0; k0 < 128; k0 += 4) {
            v4u ua[4], ub[4], va[4], vb[4]; float gk[4];
#pragma unroll
            for (int j = 0; j < 4; ++j) { const int k = k0 + j; const int e = __shfl(k < 64 ? e_a : e_b, k & 63); gk[j] = __shfl(k < 64 ? g_a : g_b, k & 63);
                const bf16* up = U16 + (size_t)e * DM; const bf16* vp = V16 + (size_t)e * DM;
                ua[j] = *(const v4u*)(up + 8 * lane); ub[j] = *(const v4u*)(up + 512 + 8 * lane); va[j] = *(const v4u*)(vp + 8 * lane); vb[j] = *(const v4u*)(vp + 512 + 8 * lane); }
#pragma unroll
            for (int j = 0; j < 4; ++j) {
                float d = (hx[0] * bflo(ua[j].x) + hx[1] * bfhi(ua[j].x)) + (hx[2] * bflo(ua[j].y) + hx[3] * bfhi(ua[j].y)) + (hx[4] * bflo(ua[j].z) + hx[5] * bfhi(ua[j].z)) + (hx[6] * bflo(ua[j].w) + hx[7] * bfhi(ua[j].w))
                        + (hx[8] * bflo(ub[j].x) + hx[9] * bfhi(ub[j].x)) + (hx[10] * bflo(ub[j].y) + hx[11] * bfhi(ub[j].y)) + (hx[12] * bflo(ub[j].z) + hx[13] * bfhi(ub[j].z)) + (hx[14] * bflo(ub[j].w) + hx[15] * bfhi(ub[j].w));
                d = wave_sum(d);
                const float act = 0.5f * d * (1.0f + erff(d * 0.70710678118654752f)) * gk[j];
                acc[0] += act * bflo(va[j].x); acc[1] += act * bfhi(va[j].x); acc[2] += act * bflo(va[j].y); acc[3] += act * bfhi(va[j].y);
                acc[4] += act * bflo(va[j].z); acc[5] += act * bfhi(va[j].z); acc[6] += act * bflo(va[j].w); acc[7] += act * bfhi(va[j].w);
                acc[8] += act * bflo(vb[j].x); acc[9] += act * bfhi(vb[j].x); acc[10] += act * bflo(vb[j].y); acc[11] += act * bfhi(vb[j].y);
                acc[12] += act * bflo(vb[j].z); acc[13] += act * bfhi(vb[j].z); acc[14] += act * bflo(vb[j].w); acc[15] += act * bfhi(vb[j].w);
            }
        }
        const float* g2 = MOD + mod_index(row) * 6144; float* xr = X + (size_t)row * DM;
#pragma unroll
        for (int hh = 0; hh < 2; ++hh)
#pragma unroll
            for (int q = 0; q < 2; ++q) { const int c = hh * 512 + 8 * lane + 4 * q; const f32x4 g = *(const f32x4*)(g2 + c); f32x4 x = *(const f32x4*)(xr + c);
                x[0] += g[0] * acc[hh * 8 + q * 4 + 0]; x[1] += g[1] * acc[hh * 8 + q * 4 + 1]; x[2] += g[2] * acc[hh * 8 + q * 4 + 2]; x[3] += g[3] * acc[hh * 8 + q * 4 + 3];
                *(f32x4*)(xr + c) = x; }
    }
}
__device__ __forceinline__ void ph_final(const Args& a, Frame& F) {
    const float* X = (const float*)(a.ws + WS_X); const float* fw = a.in[26];
    const int gw = F.bid * NWAVES + F.wave, NGW = F.G * NWAVES;
    for (int row = gw; row < NLAT; row += NGW) {
        const f32x4* xr = (const f32x4*)(X + (size_t)row * DM) + F.lane; f32x4 v[4]; float ss = 0.f;
#pragma unroll
        for (int j = 0; j < 4; ++j) { v[j] = xr[64 * j]; ss += (v[j][0] * v[j][0] + v[j][1] * v[j][1]) + (v[j][2] * v[j][2] + v[j][3] * v[j][3]); }
        const float rstd = rsqrtf(wave_sum(ss) * (1.0f / DM) + EPS);
#pragma unroll
        for (int j = 0; j < 4; ++j) { const int c = 4 * F.lane + 256 * j; *(f32x4*)(a.out + (size_t)row * DM + c) = v[j] * rstd * *(const f32x4*)(fw + c); }
    }
}
#define GEMM_RUN(EPI, g, E) do { pg8::StaticOrder S_; S_.init((g).M, (g).N, F.G, F.bid); pg8::gemm_phase<EPI, pg8::StaticOrder, true, true>(F.lds, g, S_, E); } while (0)

constexpr int N_PHASES = 25;
#ifndef MK_ONE_LAUNCH
#define MK_ONE_LAUNCH 0
#endif
__global__ void __launch_bounds__(NWAVES * 64, 2) mk_fwd(Args args) {
    extern __shared__ __attribute__((aligned(16))) unsigned char lds_raw[];
    Frame F;
    F.lds = (LAS unsigned char*)lds_raw; F.MISC = (volatile LAS unsigned*)(F.lds + MISC_OFF);
    F.tid = threadIdx.x; F.lane = F.tid & 63; F.wave = __builtin_amdgcn_readfirstlane(F.tid >> 6); F.G = gridDim.x; F.bid = blockIdx.x;
    F.ctl = (gu32*)(args.ws + WS_CTL);
    for (int u = F.tid; u < (LDS_BYTES - LDSCTL_OFF) / 4; u += NWAVES * 64) ((LAS unsigned*)(F.lds + LDSCTL_OFF))[u] = 0u;
    __syncthreads();
    XcdBarrier bar; bar.bar = (unsigned*)(F.ctl + CW_BAR); bar.x = 0; bar.st = nullptr;
    const bool multi = (args.ph_hi - args.ph_lo) > 1;
    if (multi) bar = xcd_barrier_post((unsigned*)(F.ctl + CW_BAR), F.MISC + 8);
    unsigned char* ws = args.ws;
    const int lo = args.ph_lo, hi = args.ph_hi;
#define IN(k) (lo <= (k) && (k) < hi)
#define SEAM(k) do { if (IN(k) && IN((k) + 1)) xcd_barrier(bar); } while (0)
#ifndef ONLY_PHASE
#define ONLY_PHASE(s) 1
#endif
#define LAYER(l, B) \
    if (ONLY_PHASE(1) && IN((B) + 1)) { ph_mod(args, F, l, 0); } SEAM((B) + 1); \
    if (ONLY_PHASE(2) && IN((B) + 2)) { pg8::Gemm g{(const pg8::bf16_t*)(ws + WS_HX), (const pg8::bf16_t*)(ws + WS_WIN), T, INC, DM}; pg8::EpiG1 E{(pg8::bf16_t*)(ws + WS_R1), (pg8::bf16_t*)(ws + WS_R3)}; GEMM_RUN(pg8::EpiG1, g, E); } SEAM((B) + 2); \
    if (ONLY_PHASE(3) && IN((B) + 3)) { ph_post(args, F, l); } SEAM((B) + 3); \
    if (ONLY_PHASE(4) && IN((B) + 4)) { ph_attn(args, F); } SEAM((B) + 4); \
    if (ONLY_PHASE(5) && IN((B) + 5)) { ph_comb(args, F, l); } SEAM((B) + 5); \
    if (ONLY_PHASE(6) && IN((B) + 6)) { const pg8::bf16_t* gate = (const pg8::bf16_t*)(ws + WS_R3) + 1024; \
        for (int pass = 0; pass < 3; ++pass) { \
            const size_t ao = pass == 0 ? WS_OA : (pass == 1 ? WS_OB : WS_OC), bo = pass == 0 ? WS_WA : (pass == 1 ? WS_WB : WS_WC); \
            pg8::Gemm g{(const pg8::bf16_t*)(ws + ao), (const pg8::bf16_t*)(ws + bo), T, DM, 512}; pg8::EpiG2 E{gate + 1024 * pass, (float*)(ws + WS_R1), (pg8::bf16_t*)(ws + WS_MB), pass}; GEMM_RUN(pg8::EpiG2, g, E); } } SEAM((B) + 6); \
    if (ONLY_PHASE(7) && IN((B) + 7)) { pg8::Gemm g{(const pg8::bf16_t*)(ws + WS_MB), (const pg8::bf16_t*)(ws + WS_WO), T, DM, DM}; pg8::EpiG3 E{(float*)(ws + WS_X), (const float*)(ws + WS_MOD) + (size_t)(l) * 3 * 6144 + 2048}; GEMM_RUN(pg8::EpiG3, g, E); } SEAM((B) + 7); \
    if (ONLY_PHASE(8) && IN((B) + 8)) { ph_mod(args, F, l, 1); } SEAM((B) + 8); \
    if (ONLY_PHASE(9) && IN((B) + 9)) { pg8::Gemm g{(const pg8::bf16_t*)(ws + WS_HX), (const pg8::bf16_t*)(ws + WS_WQ), T, DM, DM}; pg8::EpiG4 E{(float*)(ws + WS_R1)}; GEMM_RUN(pg8::EpiG4, g, E); } SEAM((B) + 9); \
    if (ONLY_PHASE(10) && IN((B) + 10)) { ph_topk(args, F, l); } SEAM((B) + 10); \
    if (ONLY_PHASE(11) && IN((B) + 11)) { ph_expert(args, F, l); } SEAM((B) + 11);

    if (ONLY_PHASE(0) && IN(0)) { ph_prep0(args, F); ph_convw(args, F, 0); } SEAM(0);
    LAYER(0, 0)
    if (ONLY_PHASE(12) && IN(12)) { ph_convw(args, F, 1); } SEAM(12);
    LAYER(1, 12)
    if (ONLY_PHASE(24) && IN(24)) { ph_final(args, F); }
#undef IN
#undef SEAM
}

extern "C" void kernel_launch(void* const* d_in, const int* in_sizes, int n_in, void* d_out, int out_size, void* d_ws, size_t ws_size, hipStream_t stream) {
    static int grid = 0;
    if (grid == 0) {
        if (n_in != 27 || out_size != NLAT * DM || ws_size < WS_END) { fprintf(stderr, "kernel_launch: unexpected shapes (n_in %d, out %d, ws %zu)\n", n_in, out_size, ws_size); grid = -1; return; }
        int dev = 0, cus = 0, per_cu = 0;
        if (hipGetDevice(&dev) != hipSuccess || hipDeviceGetAttribute(&cus, hipDeviceAttributeMultiprocessorCount, dev) != hipSuccess) { grid = -1; return; }
        if (hipFuncSetAttribute((const void*)mk_fwd, hipFuncAttributeMaxDynamicSharedMemorySize, LDS_BYTES) != hipSuccess) { fprintf(stderr, "kernel_launch: hipFuncSetAttribute failed\n"); grid = -1; return; }
        if (hipOccupancyMaxActiveBlocksPerMultiprocessor(&per_cu, (const void*)mk_fwd, NWAVES * 64, LDS_BYTES) != hipSuccess || per_cu < 1) { fprintf(stderr, "kernel_launch: occupancy query says %d blocks per CU\n", per_cu); (void)hipGetLastError(); grid = -1; return; }
        grid = cus;
    }
    if (grid < 0) return;
    (void)hipMemsetAsync((char*)d_ws + WS_CTL, 0, CTL_ZERO_BYTES, stream);
    Args a{};
    for (int i = 0; i < 27; ++i) a.in[i] = (const float*)d_in[i];
    a.out = (float*)d_out; a.ws = (unsigned char*)d_ws;
#if MK_ONE_LAUNCH
    a.ph_lo = 0; a.ph_hi = N_PHASES;
    hipLaunchKernelGGL(mk_fwd, dim3(grid), dim3(NWAVES * 64), LDS_BYTES, stream, a);
#else
    for (int ph = 0; ph < N_PHASES; ++ph) { a.ph_lo = ph; a.ph_hi = ph + 1; hipLaunchKernelGGL(mk_fwd, dim3(grid), dim3(NWAVES * 64), LDS_BYTES, stream, a); }
#endif
}
```

```cpp
#include <hip/hip_runtime.h>
#include <cstdio>
#include <cstdint>
#include <cmath>
namespace pg8 {
#define PG8_LAS __attribute__((address_space(3)))
typedef unsigned short bf16_t;
typedef short bf16x8 __attribute__((ext_vector_type(8)));
typedef float f32x4 __attribute__((ext_vector_type(4)));
typedef unsigned u32x4 __attribute__((ext_vector_type(4)));
constexpr int BM = 256, BK = 64, HALF = 128, HTB = HALF * BK * 2  , STAGE_BYTES = 8 * HTB, NXCD = 8, WGM = 8;

__host__ __device__ __forceinline__ int lds_byte(int r, int c) { const int st = (r >> 4) * 2 + (c >> 5), rr = r & 15, cc = c & 31, ob = rr * 64 + cc * 2; return st * 1024 + (ob ^ (((ob >> 9) & 1) << 5)); }
__host__ __device__ __forceinline__ void stage_rc(int b, int& R, int& C) { const int st = b / 1024, sb = b % 1024, swz = sb ^ (((sb >> 9) & 1) << 5); R = (st >> 1) * 16 + swz / 64; C = (st & 1) * 32 + (swz % 64) / 2; }
__host__ __device__ __forceinline__ int perm32(int rho) { const int n = rho >> 4, i = rho & 15; return 8 * (i >> 2) + 4 * n + (i & 3); }

struct Unit { int pm, pn; };
struct Gemm { const bf16_t* A; const bf16_t* Bt; int M, N, K; };

struct StaticOrder {
    int nM, nN, nwg, G, c;
    __host__ __device__ void init(int M, int N, int G_, int c_) { nM = M / BM; nN = N / BM; nwg = nM * nN; G = G_; c = c_; }
    __host__ __device__ bool next(int i, Unit& u) const {
        const long L = (long)i * G + c; if (L >= nwg) return false;
        int wgid = (int)L; { const int q = nwg / NXCD, r = nwg % NXCD, xcd = wgid % NXCD, off = wgid / NXCD; wgid = (xcd < r ? xcd * (q + 1) : r * (q + 1) + (xcd - r) * q) + off; }
        const int nig = WGM * nN, gid = wgid / nig, fm = gid * WGM, gsz = (nM - fm) < WGM ? (nM - fm) : WGM;
        u.pm = fm + ((wgid % nig) % gsz); u.pn = (wgid % nig) / gsz; return true;
    }
    __device__ __forceinline__ void a_ready(const Unit&) const {}
    __device__ __forceinline__ void done(const Unit&) const {}
};

__device__ __forceinline__ unsigned cvt_pk_bf16(float lo, float hi) { unsigned r; asm volatile("v_cvt_pk_bf16_f32 %0, %1, %2" : "=v"(r) : "v"(lo), "v"(hi)); return r; }
typedef float f32x2 __attribute__((ext_vector_type(2)));
__device__ __forceinline__ float sigmoidf_(float x) { return __builtin_amdgcn_rcpf(1.0f + __expf(-x)); }
__device__ __forceinline__ float bf_lo(unsigned w) { return __uint_as_float(w << 16); }
__device__ __forceinline__ float bf_hi(unsigned w) { return __uint_as_float(w & 0xffff0000u); }
struct EpiG1 {
    static constexpr bool PERM = true, AFTER_DRAIN = false;
    bf16_t* Oa; bf16_t* Ob;
    __device__ __forceinline__ void operator()(const f32x4 (&acc)[2][2][4][2], const Unit& u, int wr, int wc, int fr, int fq) const {
        const int row0 = u.pm * BM + wr * 64 + fr; int colt = u.pn * BM; bf16_t* base = Oa; int ldc = 2304;
        if (colt >= 2304) { base = Ob; ldc = 4096; colt -= 2304; }
        const int col0 = colt + wc * 32 + 8 * fq;
#pragma unroll
        for (int ai = 0; ai < 2; ++ai)
#pragma unroll
            for (int m = 0; m < 4; ++m) { bf16_t* rowp = base + (size_t)(row0 + ai * HALF + m * 16) * ldc + col0;
#pragma unroll
                for (int bj = 0; bj < 2; ++bj) { const f32x4 v0 = acc[ai][bj][m][0], v1 = acc[ai][bj][m][1];
                    u32x4 w; w.x = cvt_pk_bf16(v0[0], v0[1]); w.y = cvt_pk_bf16(v0[2], v0[3]); w.z = cvt_pk_bf16(v1[0], v1[1]); w.w = cvt_pk_bf16(v1[2], v1[3]);
                    *(u32x4*)(rowp + bj * HALF) = w; } }
    }
};
struct MidG2 {
    static constexpr int SEG = 8;
    const bf16_t* gate;
    __device__ __forceinline__ void operator()(f32x4 (&acc)[2][2][4][2], const Unit& u, int wr, int wc, int fr, int fq, int seg) const {
        const int row0 = u.pm * BM + wr * 64 + fr; const int col0 = u.pn * BM + wc * 32 + 8 * fq; const bf16_t* gp = gate + (seg - 1) * 1024;
#define PG8_RATIO(N, D) ((1.0f + __expf(-(D))) * __builtin_amdgcn_rcpf(1.0f + __expf(-(N))))
#pragma unroll
        for (int ai = 0; ai < 2; ++ai)
          {
            u32x4 gn[4][2], gd[4][2];
#pragma unroll
            for (int mm = 0; mm < 4; ++mm)
#pragma unroll
                for (int bj = 0; bj < 2; ++bj) { const bf16_t* p = gp + (size_t)(row0 + ai * HALF + mm * 16) * 4096 + col0 + bj * HALF; gn[mm][bj] = *(const u32x4*)p; gd[mm][bj] = *(const u32x4*)(p + 1024); }
#pragma unroll
            for (int mm = 0; mm < 4; ++mm)
#pragma unroll
                for (int bj = 0; bj < 2; ++bj) { f32x4& v0 = acc[ai][bj][mm][0]; f32x4& v1 = acc[ai][bj][mm][1]; const u32x4 a_ = gn[mm][bj], b_ = gd[mm][bj];
                    v0[0] *= PG8_RATIO(bf_lo(a_.x), bf_lo(b_.x)); v0[1] *= PG8_RATIO(bf_hi(a_.x), bf_hi(b_.x)); v0[2] *= PG8_RATIO(bf_lo(a_.y), bf_lo(b_.y)); v0[3] *= PG8_RATIO(bf_hi(a_.y), bf_hi(b_.y));
                    v1[0] *= PG8_RATIO(bf_lo(a_.z), bf_lo(b_.z)); v1[1] *= PG8_RATIO(bf_hi(a_.z), bf_hi(b_.z)); v1[2] *= PG8_RATIO(bf_lo(a_.w), bf_lo(b_.w)); v1[3] *= PG8_RATIO(bf_hi(a_.w), bf_hi(b_.w)); }
            __builtin_amdgcn_sched_barrier(0);
          }
#undef PG8_RATIO
    }
};
struct EpiG2 {
    static constexpr bool PERM = true, AFTER_DRAIN = false;
    const bf16_t* gate;   bf16_t* Mb;
    __device__ __forceinline__ void operator()(const f32x4 (&acc)[2][2][4][2], const Unit& u, int wr, int wc, int fr, int fq) const {
        const int row0 = u.pm * BM + wr * 64 + fr; const int col0 = u.pn * BM + wc * 32 + 8 * fq;
#pragma unroll
        for (int ai = 0; ai < 2; ++ai)
#pragma unroll
            for (int m = 0; m < 4; ++m) { const size_t row = (size_t)(row0 + ai * HALF + m * 16);
#pragma unroll
                for (int bj = 0; bj < 2; ++bj) { const int c = col0 + bj * HALF;
                    const u32x4 gw = *(const u32x4*)(gate + row * 4096 + c);
                    f32x4 v0 = acc[ai][bj][m][0], v1 = acc[ai][bj][m][1];
                    v0[0] *= sigmoidf_(bf_lo(gw.x)); v0[1] *= sigmoidf_(bf_hi(gw.x)); v0[2] *= sigmoidf_(bf_lo(gw.y)); v0[3] *= sigmoidf_(bf_hi(gw.y));
                    v1[0] *= sigmoidf_(bf_lo(gw.z)); v1[1] *= sigmoidf_(bf_hi(gw.z)); v1[2] *= sigmoidf_(bf_lo(gw.w)); v1[3] *= sigmoidf_(bf_hi(gw.w));
                    u32x4 w; w.x = cvt_pk_bf16(v0[0], v0[1]); w.y = cvt_pk_bf16(v0[2], v0[3]); w.z = cvt_pk_bf16(v1[0], v1[1]); w.w = cvt_pk_bf16(v1[2], v1[3]);
                    *(u32x4*)(Mb + row * 1024 + c) = w; } }
    }
};
struct EpiG3 {
    static constexpr bool PERM = true, AFTER_DRAIN = false;
    float* X; const float* base;   const float* g1;
    bf16_t* Xs; const float* sc2;   float* SSQ;
    __device__ __forceinline__ void operator()(const f32x4 (&acc)[2][2][4][2], const Unit& u, int wr, int wc, int fr, int fq) const {
        const int row0 = u.pm * BM + wr * 64 + fr; const int col0 = u.pn * BM + wc * 32 + 8 * fq;
        const int rt = u.pm * BM; const int mi = rt < 8192 ? 0 : (rt < 16384 ? 1 : 2); const float* gp = g1 + mi * 6144; const float* sp = sc2 + mi * 6144;
        float ssq[2][4];
#pragma unroll
        for (int ai = 0; ai < 2; ++ai)
#pragma unroll
            for (int m = 0; m < 4; ++m) ssq[ai][m] = 0.f;
#pragma unroll
        for (int bj = 0; bj < 2; ++bj) { const int c = col0 + bj * HALF; const f32x4 ga = *(const f32x4*)(gp + c), gb = *(const f32x4*)(gp + c + 4);
            const f32x4 sa = *(const f32x4*)(sp + c) + 1.0f, sb = *(const f32x4*)(sp + c + 4) + 1.0f;
#pragma unroll
            for (int ai = 0; ai < 2; ++ai)
#pragma unroll
                for (int m = 0; m < 4; ++m) { const size_t ro = (size_t)(row0 + ai * HALF + m * 16) * 1024 + c; float* xp = X + ro; const float* bp = base + ro;
                    const f32x4 x0 = *(const f32x4*)bp + ga * acc[ai][bj][m][0], x1 = *(const f32x4*)(bp + 4) + gb * acc[ai][bj][m][1];
                    *(f32x4*)xp = x0; *(f32x4*)(xp + 4) = x1;
                    ssq[ai][m] += (x0[0] * x0[0] + x0[1] * x0[1]) + (x0[2] * x0[2] + x0[3] * x0[3]) + (x1[0] * x1[0] + x1[1] * x1[1]) + (x1[2] * x1[2] + x1[3] * x1[3]);
                    const f32x4 y0 = x0 * sa, y1 = x1 * sb; u32x4 w; w.x = cvt_pk_bf16(y0[0], y0[1]); w.y = cvt_pk_bf16(y0[2], y0[3]); w.z = cvt_pk_bf16(y1[0], y1[1]); w.w = cvt_pk_bf16(y1[2], y1[3]);
                    *(u32x4*)(Xs + ro) = w; } }
#pragma unroll
        for (int ai = 0; ai < 2; ++ai)
#pragma unroll
            for (int m = 0; m < 4; ++m) { float v = ssq[ai][m]; v += __shfl_xor(v, 16); v += __shfl_xor(v, 32);
                if (fq == 0) SSQ[(size_t)(row0 + ai * HALF + m * 16) * 16 + u.pn * 4 + wc] = v; }
    }
};
struct EpiG4 {
    static constexpr bool PERM = true, AFTER_DRAIN = false;
    float* O; const float* SSQ; const float* biasq;
    __device__ __forceinline__ void operator()(const f32x4 (&acc)[2][2][4][2], const Unit& u, int wr, int wc, int fr, int fq) const {
        const int row0 = u.pm * BM + wr * 64 + fr; const int col0 = u.pn * BM + wc * 32 + 8 * fq;
        const int rt = u.pm * BM; const int mi = rt < 8192 ? 0 : (rt < 16384 ? 1 : 2); const float* bq = biasq + mi * 1024;
        f32x4 ba[2], bb[2];
#pragma unroll
        for (int bj = 0; bj < 2; ++bj) { ba[bj] = *(const f32x4*)(bq + col0 + bj * HALF); bb[bj] = *(const f32x4*)(bq + col0 + bj * HALF + 4); }
#pragma unroll
        for (int ai = 0; ai < 2; ++ai)
#pragma unroll
            for (int m = 0; m < 4; ++m) { const size_t row = (size_t)(row0 + ai * HALF + m * 16); const f32x4* sq = (const f32x4*)(SSQ + row * 16);
                const f32x4 s = (sq[0] + sq[1]) + (sq[2] + sq[3]); const float rstd = rsqrtf(((s[0] + s[1]) + (s[2] + s[3])) * (1.0f / 1024.0f) + 1e-6f);
                float* op = O + row * 1024 + col0;
#pragma unroll
                for (int bj = 0; bj < 2; ++bj) { *(f32x4*)(op + bj * HALF) = acc[ai][bj][m][0] * rstd + ba[bj]; *(f32x4*)(op + bj * HALF + 4) = acc[ai][bj][m][1] * rstd + bb[bj]; } }
    }
};
struct NoMid { static constexpr int SEG = 0; __device__ __forceinline__ void operator()(f32x4 (&)[2][2][4][2], const Unit&, int, int, int, int, int) const {} };
template <class Epi, class Sched, bool ALIGN_EPI = false, bool SP2 = false, class Mid = NoMid>
__device__ __forceinline__ void gemm_phase(PG8_LAS unsigned char* lds, const Gemm g, const Sched& S, const Epi& E, const Mid& Mh = Mid()) {
    const int tid = threadIdx.x, wid = __builtin_amdgcn_readfirstlane(tid >> 6), lane = tid & 63, wr = wid >> 2, wc = wid & 3, fr = lane & 15, fq = lane >> 4;
    const int K = g.K, nt = K / BK;
    unsigned voffA[2], voffB[2];
#pragma unroll
    for (int i = 0; i < 2; ++i) { int R, C; stage_rc(tid * 16 + i * 8192, R, C); const int Rb = Epi::PERM ? ((R & ~31) + perm32(R & 31)) : R;
        voffA[i] = (unsigned)(R * K + C) * 2u; voffB[i] = (unsigned)(Rb * K + C) * 2u; }
    const size_t kstep = (size_t)(BK * 2);
    const size_t hstep = (size_t)HALF * K * 2;
    const size_t tstep = 2 * hstep;
    const unsigned ldsw = (unsigned)wid * 1024u;
    const int aoff = lds_byte(wr * 64 + fr, fq * 8), boff = lds_byte(wc * 32 + fr, fq * 8);
#define PG8_SA(b, h) (((b) * 2 + (h)) * HTB)
#define PG8_SB(b, h) ((4 + (b) * 2 + (h)) * HTB)
#define PG8_STAGE(bufoff, gbase, voff) do { _Pragma("unroll") for (int _i = 0; _i < 2; ++_i) \
        __builtin_amdgcn_global_load_lds((const unsigned*)((const char*)(gbase) + (voff)[_i]), (PG8_LAS unsigned*)(lds + (bufoff) + ldsw + _i * 8192), 16, 0, 0); } while (0)
#define PG8_LDA(dst, b, h) do { _Pragma("unroll") for (int m = 0; m < 4; ++m) _Pragma("unroll") for (int k = 0; k < 2; ++k) dst[m][k] = *(const PG8_LAS bf16x8*)(lds + PG8_SA(b, h) + aoff + m * 2048 + k * 1024); } while (0)
#define PG8_LDB(dst, b, h) do { _Pragma("unroll") for (int n = 0; n < 2; ++n) _Pragma("unroll") for (int k = 0; k < 2; ++k) dst[n][k] = *(const PG8_LAS bf16x8*)(lds + PG8_SB(b, h) + boff + n * 2048 + k * 1024); } while (0)
#define PG8_MMA(ai, bj, At, Bt) do { __builtin_amdgcn_s_setprio(1); _Pragma("unroll") for (int m = 0; m < 4; ++m) _Pragma("unroll") for (int n = 0; n < 2; ++n) _Pragma("unroll") for (int k = 0; k < 2; ++k) \
        acc[ai][bj][m][n] = __builtin_amdgcn_mfma_f32_16x16x32_bf16(Bt[n][k], At[m][k], acc[ai][bj][m][n], 0, 0, 0); __builtin_amdgcn_s_setprio(0); } while (0)
#define PG8_WAIT_V(n) asm volatile("s_waitcnt vmcnt(" #n ")" ::: "memory")
#define PG8_WAIT_L(n) asm volatile("s_waitcnt lgkmcnt(" #n ")" ::: "memory")
#define PG8_BAR __builtin_amdgcn_s_barrier()
#define PG8_SCHED __builtin_amdgcn_sched_barrier(0)
    Unit cur, nxt; int ui = 0;
    if (!S.next(0, cur)) return;
    f32x4 acc[2][2][4][2];
#pragma unroll
    for (int a = 0; a < 2; ++a)
#pragma unroll
        for (int b = 0; b < 2; ++b)
#pragma unroll
            for (int m = 0; m < 4; ++m)
#pragma unroll
                for (int n = 0; n < 2; ++n) acc[a][b][m][n] = (f32x4){0.f, 0.f, 0.f, 0.f};
    bf16x8 At[4][2], B0[2][2], B1[2][2];
    const char* cA = (const char*)g.A + (size_t)cur.pm * tstep; const char* cB = (const char*)g.Bt + (size_t)cur.pn * tstep;
    S.a_ready(cur);
    if constexpr (SP2) {
        PG8_STAGE(PG8_SB(0, 0), cB, voffB); PG8_STAGE(PG8_SB(0, 1), cB + hstep, voffB); PG8_STAGE(PG8_SA(0, 0), cA, voffA); PG8_STAGE(PG8_SA(0, 1), cA + hstep, voffA);
        if (wr == 1) PG8_BAR;
        PG8_WAIT_V(2); PG8_BAR;
        PG8_STAGE(PG8_SB(1, 0), cB + kstep, voffB); PG8_STAGE(PG8_SA(1, 0), cA + kstep, voffA); PG8_STAGE(PG8_SB(1, 1), cB + hstep + kstep, voffB);
        PG8_WAIT_V(6); PG8_BAR;
    } else {
        PG8_STAGE(PG8_SB(0, 0), cB, voffB); PG8_STAGE(PG8_SA(0, 0), cA, voffA); PG8_STAGE(PG8_SB(0, 1), cB + hstep, voffB); PG8_STAGE(PG8_SA(0, 1), cA + hstep, voffA);
        if (wr == 1) PG8_BAR;
        PG8_WAIT_V(4); PG8_BAR;
        PG8_STAGE(PG8_SB(1, 0), cB + kstep, voffB); PG8_STAGE(PG8_SA(1, 0), cA + kstep, voffA); PG8_STAGE(PG8_SB(1, 1), cB + hstep + kstep, voffB);
        PG8_WAIT_V(6); PG8_BAR;
    }
    for (;;) {
        const bool has_next = S.next(ui + 1, nxt);
        const char* nA = has_next ? (const char*)g.A + (size_t)nxt.pm * tstep : cA; const char* nB = has_next ? (const char*)g.Bt + (size_t)nxt.pn * tstep : cB;
        for (int t = 0; t < nt; t += 2) {
            if constexpr (Mid::SEG > 0) { if (t != 0 && (t % Mid::SEG) == 0) Mh(acc, cur, wr, wc, fr, fq, t / Mid::SEG); }
            const bool last = (t == nt - 2);
            const char* a1 = cA + (size_t)(t + 1) * kstep;
            const char* a2 = last ? nA : cA + (size_t)(t + 2) * kstep; const char* b2 = last ? nB : cB + (size_t)(t + 2) * kstep;
            const char* a3 = a2 + kstep; const char* b3 = b2 + kstep;
            if (last && has_next) S.a_ready(nxt);
            if constexpr (SP2) {
            PG8_LDB(B0, 0, 0); PG8_LDB(B1, 0, 1); PG8_SCHED; PG8_LDA(At, 0, 0); PG8_STAGE(PG8_SA(1, 1), a1 + hstep, voffA);
            PG8_WAIT_V(8); PG8_WAIT_L(0); PG8_BAR; PG8_MMA(0, 0, At, B0); PG8_MMA(0, 1, At, B1); PG8_BAR; PG8_SCHED;
            PG8_LDA(At, 0, 1); PG8_STAGE(PG8_SB(0, 0), b2, voffB); PG8_STAGE(PG8_SB(0, 1), b2 + hstep, voffB); PG8_STAGE(PG8_SA(0, 0), a2, voffA);
            PG8_WAIT_V(8); PG8_WAIT_L(0); PG8_BAR; PG8_MMA(1, 0, At, B0); PG8_MMA(1, 1, At, B1); PG8_BAR; PG8_SCHED;
            PG8_LDB(B0, 1, 0); PG8_LDB(B1, 1, 1); PG8_SCHED; PG8_LDA(At, 1, 0); PG8_STAGE(PG8_SA(0, 1), a2 + hstep, voffA);
            PG8_WAIT_V(8); PG8_WAIT_L(0); PG8_BAR; PG8_MMA(0, 0, At, B0); PG8_MMA(0, 1, At, B1); PG8_BAR; PG8_SCHED;
            PG8_LDA(At, 1, 1); PG8_STAGE(PG8_SB(1, 0), b3, voffB); PG8_STAGE(PG8_SB(1, 1), b3 + hstep, voffB); PG8_STAGE(PG8_SA(1, 0), a3, voffA);
            PG8_WAIT_V(8); PG8_WAIT_L(0); PG8_BAR; PG8_MMA(1, 0, At, B0); PG8_MMA(1, 1, At, B1); PG8_BAR; PG8_SCHED;
            } else {
            PG8_LDB(B0, 0, 0); PG8_SCHED; PG8_LDA(At, 0, 0); PG8_STAGE(PG8_SA(1, 1), a1 + hstep, voffA);
            PG8_WAIT_L(8); PG8_BAR; PG8_WAIT_L(0); PG8_MMA(0, 0, At, B0); PG8_BAR; PG8_SCHED;
            PG8_LDB(B1, 0, 1); PG8_STAGE(PG8_SB(0, 0), b2, voffB);
            PG8_BAR; PG8_WAIT_L(0); PG8_MMA(0, 1, At, B1); PG8_BAR;
            PG8_LDA(At, 0, 1); PG8_STAGE(PG8_SA(0, 0), a2, voffA);
            PG8_BAR; PG8_WAIT_L(0); PG8_MMA(1, 0, At, B0); PG8_BAR; PG8_SCHED;
            PG8_STAGE(PG8_SB(0, 1), b2 + hstep, voffB);
            PG8_WAIT_V(6); PG8_BAR; PG8_MMA(1, 1, At, B1); PG8_BAR;
            PG8_LDB(B0, 1, 0); PG8_SCHED; PG8_LDA(At, 1, 0); PG8_STAGE(PG8_SA(0, 1), a2 + hstep, voffA);
            PG8_WAIT_L(8); PG8_BAR; PG8_WAIT_L(0); PG8_MMA(0, 0, At, B0); PG8_BAR; PG8_SCHED;
            PG8_LDB(B1, 1, 1); PG8_STAGE(PG8_SB(1, 0), b3, voffB);
            PG8_BAR; PG8_WAIT_L(0); PG8_MMA(0, 1, At, B1); PG8_BAR;
            PG8_LDA(At, 1, 1); PG8_STAGE(PG8_SA(1, 0), a3, voffA);
            PG8_BAR; PG8_WAIT_L(0); PG8_MMA(1, 0, At, B0); PG8_BAR; PG8_SCHED;
            PG8_STAGE(PG8_SB(1, 1), b3 + hstep, voffB);
            PG8_WAIT_V(6); PG8_BAR; PG8_MMA(1, 1, At, B1); PG8_BAR;
            }
        }
        if constexpr (ALIGN_EPI) { if (wr == 0) PG8_BAR; }
        if constexpr (!Epi::AFTER_DRAIN) { E(acc, cur, wr, wc, fr, fq); S.done(cur); }
        if (!has_next) break;
#pragma unroll
        for (int a = 0; a < 2; ++a)
#pragma unroll
            for (int b = 0; b < 2; ++b)
#pragma unroll
                for (int m = 0; m < 4; ++m)
#pragma unroll
                    for (int n = 0; n < 2; ++n) acc[a][b][m][n] = (f32x4){0.f, 0.f, 0.f, 0.f};
        cur = nxt; cA = nA; cB = nB; ++ui;
        if constexpr (ALIGN_EPI) { if (wr == 1) PG8_BAR; }
    }
    PG8_WAIT_V(0);
    if constexpr (!ALIGN_EPI) { if (wr == 0) PG8_BAR; }
    PG8_BAR;
    if constexpr (Epi::AFTER_DRAIN) { E.fused(acc, cur, wr, wc, fr, fq, lds, wid, lane); S.done(cur); }
#undef PG8_SA
#undef PG8_SB
#undef PG8_STAGE
#undef PG8_LDA
#undef PG8_LDB
#undef PG8_MMA
#undef PG8_WAIT_V
#undef PG8_WAIT_L
#undef PG8_BAR
#undef PG8_SCHED
}
}
#define GAS __attribute__((address_space(1)))
#define LAS __attribute__((address_space(3)))
typedef unsigned short bf16;
typedef unsigned v4u __attribute__((ext_vector_type(4)));
typedef float f32x4 __attribute__((ext_vector_type(4)));
typedef short bf16x8 __attribute__((ext_vector_type(8)));
typedef GAS unsigned gu32;
typedef GAS unsigned long long gu64;
#define RLX_AGENT __ATOMIC_RELAXED, __HIP_MEMORY_SCOPE_AGENT
#define LDS_WAIT() asm volatile("s_waitcnt lgkmcnt(0)" ::: "memory")
#define VM_WAIT() asm volatile("s_waitcnt vmcnt(0)" ::: "memory")
__device__ __forceinline__ unsigned long long rt() { return __builtin_amdgcn_s_memrealtime(); }
__device__ __forceinline__ unsigned f2bf(float f) { unsigned u = __builtin_bit_cast(unsigned, f); return (u + 0x7fffu + ((u >> 16) & 1u)) >> 16; }
__device__ __forceinline__ unsigned pk2(float lo, float hi) { return f2bf(lo) | (f2bf(hi) << 16); }
#define XB_TMO      128
#define XB_XCNT(j)  (256  + 64 * (j))
#define XB_XSUB(j)  (1280 + 64 * (j))
#define XB_XGEN(j)  (2304 + 64 * (j))
#define XB_TOP      3328
#define XB_TOPGEN   3392
#define XCD_BAR_WORDS 3456
#define XB_SPIN_CAP (1u << 24)

__device__ __forceinline__ unsigned xb_ld(unsigned* p)              { return __hip_atomic_load(p, __ATOMIC_RELAXED, __HIP_MEMORY_SCOPE_AGENT); }
__device__ __forceinline__ unsigned xb_add(unsigned* p, unsigned v) { return __hip_atomic_fetch_add(p, v, __ATOMIC_RELAXED, __HIP_MEMORY_SCOPE_AGENT); }
__device__ __forceinline__ unsigned xb_xcc_id() { return (unsigned)__builtin_amdgcn_s_getreg((3 << 11) | 20) & 0xFu; }
#define XB_SPIN(cond, bar) do { unsigned _sp = 0; while (cond) { __builtin_amdgcn_s_sleep(1); \
    if ((++_sp & 255u) == 0u) { if (xb_ld(&(bar)[XB_TMO])) break; if (_sp > XB_SPIN_CAP) { atomicAdd(&(bar)[XB_TMO], 1u); break; } } } } while (0)

struct XcdBarrier {
    unsigned* bar; unsigned x;
    volatile LAS unsigned* st;
};

__device__ __forceinline__ XcdBarrier xcd_barrier_post(unsigned* bar, volatile LAS unsigned* st) {
    XcdBarrier b; b.bar = bar; b.x = xb_xcc_id(); b.st = st;
    if (threadIdx.x == 0) (void)xb_add(&bar[XB_XCNT(b.x)], 1u);
    return b;
}
__device__ __forceinline__ void xcd_barrier_complete(unsigned* bar, unsigned x, unsigned& nloc, unsigned& nx) {
    const unsigned G = gridDim.x * gridDim.y * gridDim.z;
    unsigned sum, cnt, mine, sp = 0u;
    for (;;) {
        sum = 0u; cnt = 0u; mine = 0u;
#pragma unroll
        for (unsigned j = 0; j < 16; ++j) { const unsigned c = xb_ld(&bar[XB_XCNT(j)]); sum += c; cnt += (c > 0u) ? 1u : 0u; mine = (j == x) ? c : mine; }
        if (sum == G) break;
        __builtin_amdgcn_s_sleep(1);
        if ((++sp & 255u) == 0u) { if (xb_ld(&bar[XB_TMO])) break; if (sp > XB_SPIN_CAP) { atomicAdd(&bar[XB_TMO], 1u); break; } }
    }
    nloc = mine > 0u ? mine : 1u; nx = cnt > 0u ? cnt : 1u;
}

__device__ __forceinline__ void xcd_barrier(const XcdBarrier& b) {
    asm volatile("s_waitcnt vmcnt(0)" ::: "memory");
    __syncthreads();
    if (threadIdx.x == 0) {
        unsigned* bar = b.bar;
        __builtin_amdgcn_s_waitcnt(0);
        unsigned nloc = b.st[0], nx = b.st[1];
        if (nloc == 0u) { xcd_barrier_complete(bar, b.x, nloc, nx); b.st[0] = nloc; b.st[1] = nx; }
        const unsigned old = xb_add(&bar[XB_XSUB(b.x)], 1u);
        const unsigned gen = old / nloc;
        if (old + 1u == (gen + 1u) * nloc) {
            __builtin_amdgcn_fence(__ATOMIC_RELEASE, "agent");
            asm volatile("s_waitcnt vmcnt(0)" ::: "memory");
            const unsigned og = xb_add(&bar[XB_TOP], 1u);
            const unsigned tg = og / nx;
            if (og + 1u == (tg + 1u) * nx) xb_add(&bar[XB_TOPGEN], 1u);
            else XB_SPIN(xb_ld(&bar[XB_TOPGEN]) == tg, bar);
            __builtin_amdgcn_fence(__ATOMIC_ACQUIRE, "agent");
            xb_add(&bar[XB_XGEN(b.x)], 1u);
            asm volatile("s_waitcnt vmcnt(0)" ::: "memory");
        } else {
            XB_SPIN(xb_ld(&bar[XB_XGEN(b.x)]) == gen, bar);
            __builtin_amdgcn_fence(__ATOMIC_ACQUIRE, "agent");
            asm volatile("s_waitcnt vmcnt(0)" ::: "memory");
        }
    }
    __syncthreads();
}
__device__ __forceinline__ float wave_sum(float v) {
#pragma unroll
    for (int o = 1; o < 64; o <<= 1) v += __shfl_xor(v, o);
    return v;
}
__device__ __forceinline__ void p0_transpose_item(const float* W, int K, int N, bf16* WT, int row_off, LAS float* scr, int item, int lane) {
    const int nblk = N / 32, kb = item / nblk, nb = item % nblk, k0 = 64 * kb, n0 = 32 * nb;
#pragma unroll 8
    for (int i = 0; i < 32; ++i) { const int kk = 2 * i + (lane >> 5); scr[kk * 33 + (lane & 31)] = W[(size_t)(k0 + kk) * N + n0 + (lane & 31)]; }
    LDS_WAIT(); asm volatile("" ::: "memory");
    const int c = lane & 7;
#pragma unroll
    for (int j = 0; j < 4; ++j) { const int n = (lane >> 3) + 8 * j; const LAS float* s = scr + (8 * c) * 33 + n;
        v4u o; o.x = pk2(s[0 * 33], s[1 * 33]); o.y = pk2(s[2 * 33], s[3 * 33]); o.z = pk2(s[4 * 33], s[5 * 33]); o.w = pk2(s[6 * 33], s[7 * 33]);
        *(GAS v4u*)(WT + (size_t)(row_off + n0 + n) * K + k0 + 8 * c) = o; }
    LDS_WAIT(); asm volatile("" ::: "memory");
}
__device__ __forceinline__ void p0_transpose_item_p(const float* W, int K, int N, bf16* WT, int pitch, int col_off, LAS float* scr, int item, int lane) {
    const int nblk = N / 32, kb = item / nblk, nb = item % nblk, k0 = 64 * kb, n0 = 32 * nb;
#pragma unroll 8
    for (int i = 0; i < 32; ++i) { const int kk = 2 * i + (lane >> 5); scr[kk * 33 + (lane & 31)] = W[(size_t)(k0 + kk) * N + n0 + (lane & 31)]; }
    LDS_WAIT(); asm volatile("" ::: "memory");
    const int c = lane & 7;
#pragma unroll
    for (int j = 0; j < 4; ++j) { const int n = (lane >> 3) + 8 * j; const LAS float* s = scr + (8 * c) * 33 + n;
        v4u o; o.x = pk2(s[0 * 33], s[1 * 33]); o.y = pk2(s[2 * 33], s[3 * 33]); o.z = pk2(s[4 * 33], s[5 * 33]); o.w = pk2(s[6 * 33], s[7 * 33]);
        *(GAS v4u*)(WT + (size_t)(n0 + n) * pitch + col_off + k0 + 8 * c) = o; }
    LDS_WAIT(); asm volatile("" ::: "memory");
}
#include <hip/hip_bf16.h>
#include <cmath>
namespace attn_body {
using bf16=__hip_bfloat16;
using bf16x8=__attribute__((ext_vector_type(8)))short;
using s16x4=__attribute__((ext_vector_type(4)))short;
using f32x16=__attribute__((ext_vector_type(16)))float;
using u32x4=__attribute__((ext_vector_type(4)))unsigned;
constexpr int D=64;
constexpr int NW=8,QBLK=32,QB=QBLK*NW,KVBLK=64;
constexpr int ATTN_UNIT_ROWS=QB;
__device__ __forceinline__ int crow(int r,int hi){return (r&3)+8*(r>>2)+4*hi;}
#define SBAR() __builtin_amdgcn_sched_barrier(0)
constexpr int NSLOT=3, SLOTB=8192;
constexpr int LDS_K=0, LDS_V=NSLOT*SLOTB, LDS_WS=2*NSLOT*SLOTB, LDS_OST=LDS_WS+NW*64*4, LDS_BYTES=LDS_OST+NW*4096;
constexpr float C2=0.125f*1.4426950408889634f;
__device__ __forceinline__ void glds16(const void*gsrc,unsigned lds_dst){unsigned keep;
  asm volatile("s_mov_b32 %0, m0\n\ts_mov_b32 m0, %2\n\ts_nop 0\n\tglobal_load_lds_dwordx4 %1, off\n\ts_mov_b32 m0, %0":"=&s"(keep):"v"(gsrc),"s"(lds_dst):"memory");}
__device__ __forceinline__ float max3f(float a,float b,float c){float r;asm("v_max3_f32 %0, %1, %2, %3":"=v"(r):"v"(a),"v"(b),"v"(c));return r;}
__device__ __forceinline__ float max2f(float a,float b){float r;asm("v_max_f32_e32 %0, %1, %2":"=v"(r):"v"(a),"v"(b));return r;}
__device__ __forceinline__ float fadd_s(float a,float b){float r;asm("v_add_f32_e32 %0, %1, %2":"=v"(r):"v"(a),"v"(b));return r;}
__device__ __forceinline__ float fsub_s(float a,float b){float r;asm("v_sub_f32_e32 %0, %1, %2":"=v"(r):"v"(a),"v"(b));return r;}
typedef float f32x2_t __attribute__((ext_vector_type(2))); typedef __bf16 bf16x2_t __attribute__((ext_vector_type(2)));
__device__ __forceinline__ unsigned cvtpk_s(float lo,float hi){f32x2_t v={lo,hi};bf16x2_t b=__builtin_convertvector(v,bf16x2_t);return __builtin_bit_cast(unsigned,b);}
#define WAIT_BAR(N) asm volatile("s_waitcnt vmcnt(" #N ") lgkmcnt(0)\n\ts_barrier":::"memory")

__device__ __forceinline__ void qkt(f32x16&p0,f32x16&p1,const char*Kslot,const bf16x8*qr,const f32x16&negm,int r32,int hi){
  const char*kb=Kslot+hi*1024+r32*16;
  #pragma unroll
  for(int d0=0;d0<4;++d0){
    const bf16x8 b0=*reinterpret_cast<const bf16x8*>(kb+d0*2048);
    const bf16x8 b1=*reinterpret_cast<const bf16x8*>(kb+d0*2048+512);
    if(d0==0){p0=__builtin_amdgcn_mfma_f32_32x32x16_bf16(b0,qr[0],negm,0,0,0);p1=__builtin_amdgcn_mfma_f32_32x32x16_bf16(b1,qr[0],negm,0,0,0);}
    else{p0=__builtin_amdgcn_mfma_f32_32x32x16_bf16(b0,qr[d0],p0,0,0,0);p1=__builtin_amdgcn_mfma_f32_32x32x16_bf16(b1,qr[d0],p1,0,0,0);}}
}
typedef __attribute__((address_space(3))) const char* lds_cptr;
typedef short v4i16_t __attribute__((ext_vector_type(4)));
__device__ __forceinline__ void kload8(bf16x8*kf,lds_cptr kp){
  kf[0]=*(const __attribute__((address_space(3))) bf16x8*)(kp);      kf[1]=*(const __attribute__((address_space(3))) bf16x8*)(kp+512);
  kf[2]=*(const __attribute__((address_space(3))) bf16x8*)(kp+2048); kf[3]=*(const __attribute__((address_space(3))) bf16x8*)(kp+2560);
  kf[4]=*(const __attribute__((address_space(3))) bf16x8*)(kp+4096); kf[5]=*(const __attribute__((address_space(3))) bf16x8*)(kp+4608);
  kf[6]=*(const __attribute__((address_space(3))) bf16x8*)(kp+6144); kf[7]=*(const __attribute__((address_space(3))) bf16x8*)(kp+6656);
}
__device__ __forceinline__ void kload2(bf16x8*kf,lds_cptr kp,int j){ kf[2*j]=*(const __attribute__((address_space(3))) bf16x8*)(kp+j*2048); kf[2*j+1]=*(const __attribute__((address_space(3))) bf16x8*)(kp+j*2048+512); }
__device__ __forceinline__ s16x4 vtr(lds_cptr p){ return __builtin_bit_cast(s16x4,__builtin_amdgcn_ds_read_tr16_b64_v4i16((__attribute__((address_space(3))) v4i16_t*)p)); }
__device__ __forceinline__ float rowmax(const f32x16&p0,const f32x16&p1){
  float a=max3f(p0[0],p0[1],p1[0]),b=max3f(p0[2],p0[3],p1[1]);a=max3f(a,p1[2],p1[3]);
  #pragma unroll
  for(int r=4;r<16;r+=4){a=max3f(a,p0[r],p0[r+1]);b=max3f(b,p0[r+2],p0[r+3]);a=max3f(a,p1[r],p1[r+1]);b=max3f(b,p1[r+2],p1[r+3]);}
  const float m=max2f(a,b);
  auto rr=__builtin_amdgcn_permlane32_swap(__float_as_uint(m),__float_as_uint(m),false,false);
  return max2f(__uint_as_float(rr[0]),__uint_as_float(rr[1]));
}
__device__ __forceinline__ void pv(f32x16*o,int vb,bf16x8 pa0,bf16x8 pa1,bf16x8 pa2,bf16x8 pa3){
  #pragma unroll
  for(int d0=0;d0<2;++d0){s16x4 lo[4],hi[4];
    #pragma unroll
    for(int ks=0;ks<4;++ks){
      asm volatile("ds_read_b64_tr_b16 %0,%1 offset:%c2":"=&v"(lo[ks]):"v"(vb),"i"(d0*4096+ks*1024):"memory");
      asm volatile("ds_read_b64_tr_b16 %0,%1 offset:%c2":"=&v"(hi[ks]):"v"(vb),"i"(d0*4096+ks*1024+512):"memory");}
    asm volatile("s_waitcnt lgkmcnt(0)":::"memory");SBAR();
    #define PK(k) (bf16x8){lo[k][0],lo[k][1],lo[k][2],lo[k][3],hi[k][0],hi[k][1],hi[k][2],hi[k][3]}
    o[d0]=__builtin_amdgcn_mfma_f32_32x32x16_bf16(pa0,PK(0),o[d0],0,0,0);
    o[d0]=__builtin_amdgcn_mfma_f32_32x32x16_bf16(pa1,PK(1),o[d0],0,0,0);
    o[d0]=__builtin_amdgcn_mfma_f32_32x32x16_bf16(pa2,PK(2),o[d0],0,0,0);
    o[d0]=__builtin_amdgcn_mfma_f32_32x32x16_bf16(pa3,PK(3),o[d0],0,0,0);
    #undef PK
  }
}

#ifndef ATTN_STORE16
#define ATTN_STORE16(p,v) (*(u32x4*)(p)=(v))
#endif
template<int THRL> __device__ __forceinline__ void attn_unit(const bf16*Qw0,int QP,const bf16*Kh,int KP,const bf16*Vh,int VP,bf16*Ow0,int OP,int NT,char*shm,float mref){
  int tid=threadIdx.x; asm volatile("":"+v"(tid));
  const int lane=tid&63,r32=lane&31,hi=lane>>5; const int wid=__builtin_amdgcn_readfirstlane(tid>>6);
  const bf16*Qw=Qw0+(long)wid*QBLK*QP;
  const unsigned lds0=(unsigned)(uintptr_t)shm;
  float*wsf=(float*)(shm+LDS_WS)+wid*64;
  const bf16*ksrc=Kh+(long)lane*KP+wid*8;
  const bf16*vsrc=Vh+(long)(16*(wid&3)+(lane>>2))*VP+(wid>>2)*32+(lane&3)*8;
  const unsigned kdst=lds0+LDS_K+wid*1024, vdst=lds0+LDS_V+wid*1024;
  #define DMA_K(t,slot) glds16(ksrc+(long)(t)*KVBLK*KP,(unsigned)__builtin_amdgcn_readfirstlane(kdst+(slot)))
  #define DMA_V(t,slot) glds16(vsrc+(long)(t)*KVBLK*VP,(unsigned)__builtin_amdgcn_readfirstlane(vdst+(slot)))
  const int vb0=(int)(lds0+LDS_V)+((lane>>4)&1)*32+(lane&3)*8+(4*hi+((lane&15)>>2))*64;
  const char*Kbase=shm+LDS_K; bf16x8 kf[8];
  const lds_cptr shm3=(lds_cptr)shm; const lds_cptr kp0=shm3+LDS_K+hi*1024+r32*16; const lds_cptr vp0=shm3+LDS_V+((lane>>4)&1)*32+(lane&3)*8+(4*hi+((lane&15)>>2))*64;
  DMA_K(0,0);DMA_V(0,0);DMA_K(1,SLOTB);
  bf16x8 qr[4];
  #pragma unroll
  for(int d0=0;d0<4;++d0)qr[d0]=*reinterpret_cast<const bf16x8*>(&Qw[(long)r32*QP+d0*16+hi*8]);
  float l_reg=0.f;f32x16 o[2];o[0]=f32x16{};o[1]=f32x16{};f32x16 negm; _Pragma("unroll") for(int r=0;r<16;++r)negm[r]=-mref; asm volatile("":"+v"(negm));
  #define CMASK(P0,P1,t) do{}while(0)
  #define START(P0,P1) do{ _Pragma("unroll") for(int r=0;r<16;++r)P0[r]=__builtin_amdgcn_exp2f(P0[r]); }while(0)
  #define RESC() do{}while(0)
  f32x16 pA0,pA1,pB0,pB1;
  int sl_prev=0,sl_cur=0,sl_next=SLOTB;
  #define ROT() do{sl_prev=sl_cur;sl_cur=sl_next;sl_next=(sl_next==(NSLOT-1)*SLOTB)?0:sl_next+SLOTB;}while(0)
  DMA_K(2,2*SLOTB);
  WAIT_BAR(3);
  qkt(pA0,pA1,Kbase,qr,negm,r32,hi);asm volatile("s_nop 15\n\ts_nop 7":"+v"(pA0),"+v"(pA1));CMASK(pA0,pA1,0);
  START(pA0,pA1);
  _Pragma("unroll") for(int r=0;r<16;++r)pA1[r]=__builtin_amdgcn_exp2f(pA1[r]);
  WAIT_BAR(0);
  DMA_K(3,0);DMA_V(1,SLOTB);
  ROT();
  kload8(kf,kp0+sl_cur);
  WAIT_BAR(2);
  s16x4 vlo[8],vhi[8]; u32x4 pw0,pw1,pw2,pw3;
  #define PKW(P,B) cvtpk_s(P[B],P[B+1])
  #define PAF(k) __builtin_bit_cast(bf16x8,pw##k)
  #define VFR(i) (bf16x8){vlo[i][0],vlo[i][1],vlo[i][2],vlo[i][3],vhi[i][0],vhi[i][1],vhi[i][2],vhi[i][3]}
  #define PIN(x) asm volatile("":"+v"(x))
  #define MX3(a,b,c) __builtin_fmaxf(__builtin_fmaxf((a),(b)),(c))
  #define GAPA(MF,A0,A1,A2,A3,W0,W1,PW) do{ MF; sacc+=A0; sacc+=A1; sacc+=A2; sacc+=A3; PIN(sacc); W0; W1; PIN(PW); SBAR(); }while(0)
  #define EX(v) __builtin_amdgcn_exp2f(v)
  #define GAPB(MF,X,B) do{ MF; X[B]=EX(X[B]); X[B+1]=EX(X[B+1]); X[B+2]=EX(X[B+2]); X[B+3]=EX(X[B+3]); PIN(X); SBAR(); }while(0)
  #define VRD(i) do{ vlo[i]=vtr(vp_+(((i)>>2)*4096+((i)&3)*1024)); vhi[i]=vtr(vp_+(((i)>>2)*4096+((i)&3)*1024+512)); }while(0)
  #define KRD(G,j) do{ if(G){ kload2(kf,kp0+sl_next,j); SBAR(); } }while(0)
  #define STEP(C0,C1,P0,P1,t,GK,GV,GL) do{ SBAR(); \
    const lds_cptr vp_=vp0+sl_prev; \
    VRD(0); SBAR(); float sacc=(P0[0]+P0[1]); \
    GAPA(C0=__builtin_amdgcn_mfma_f32_32x32x16_bf16(kf[0],qr[0],negm,0,0,0), P0[2],P0[3],P0[4],P0[5],     pw0[0]=PKW(P0,0), pw0[1]=PKW(P0,2), pw0); \
    VRD(4); SBAR(); GAPA(C1=__builtin_amdgcn_mfma_f32_32x32x16_bf16(kf[1],qr[0],negm,0,0,0), P0[6],P0[7],P0[8],P0[9],     pw0[2]=PKW(P0,4), pw0[3]=PKW(P0,6), pw0); \
    VRD(1); SBAR(); GAPA(C0=__builtin_amdgcn_mfma_f32_32x32x16_bf16(kf[2],qr[1],C0,0,0,0),   P0[10],P0[11],P0[12],P0[13], pw1[0]=PKW(P0,8), pw1[1]=PKW(P0,10), pw1); \
    VRD(5); SBAR(); GAPA(C1=__builtin_amdgcn_mfma_f32_32x32x16_bf16(kf[3],qr[1],C1,0,0,0),   P0[14],P0[15],P1[0],P1[1],   pw1[2]=PKW(P0,12),pw1[3]=PKW(P0,14), pw1); \
    VRD(2); SBAR(); GAPA(C0=__builtin_amdgcn_mfma_f32_32x32x16_bf16(kf[4],qr[2],C0,0,0,0),   P1[2],P1[3],P1[4],P1[5],     pw2[0]=PKW(P1,0), pw2[1]=PKW(P1,2), pw2); \
    VRD(6); SBAR(); GAPA(C1=__builtin_amdgcn_mfma_f32_32x32x16_bf16(kf[5],qr[2],C1,0,0,0),   P1[6],P1[7],P1[8],P1[9],     pw2[2]=PKW(P1,4), pw2[3]=PKW(P1,6), pw2); \
    VRD(3); SBAR(); GAPA(C0=__builtin_amdgcn_mfma_f32_32x32x16_bf16(kf[6],qr[3],C0,0,0,0),   P1[10],P1[11],P1[12],P1[13], pw3[0]=PKW(P1,8), pw3[1]=PKW(P1,10), pw3); \
    VRD(7); SBAR(); GAPA(C1=__builtin_amdgcn_mfma_f32_32x32x16_bf16(kf[7],qr[3],C1,0,0,0),   P1[14],P1[15],0.f,0.f,       pw3[2]=PKW(P1,12),pw3[3]=PKW(P1,14), pw3); \
    l_reg+=sacc; \
    if(GK){DMA_K((t)+3,sl_cur);} if(GV){DMA_V((t)+1,sl_next);} \
    CMASK(C0,C1,t); \
    SBAR(); \
    GAPB(o[0]=__builtin_amdgcn_mfma_f32_32x32x16_bf16(PAF(0),VFR(0),o[0],0,0,0), C0,0); \
    GAPB(o[1]=__builtin_amdgcn_mfma_f32_32x32x16_bf16(PAF(0),VFR(4),o[1],0,0,0), C0,4); \
    KRD(GL,0); GAPB(o[0]=__builtin_amdgcn_mfma_f32_32x32x16_bf16(PAF(1),VFR(1),o[0],0,0,0), C0,8); \
    KRD(GL,1); GAPB(o[1]=__builtin_amdgcn_mfma_f32_32x32x16_bf16(PAF(1),VFR(5),o[1],0,0,0), C0,12); \
    KRD(GL,2); GAPB(o[0]=__builtin_amdgcn_mfma_f32_32x32x16_bf16(PAF(2),VFR(2),o[0],0,0,0), C1,0); \
    KRD(GL,3); GAPB(o[1]=__builtin_amdgcn_mfma_f32_32x32x16_bf16(PAF(2),VFR(6),o[1],0,0,0), C1,4); \
    GAPB(o[0]=__builtin_amdgcn_mfma_f32_32x32x16_bf16(PAF(3),VFR(3),o[0],0,0,0), C1,8); \
    GAPB(o[1]=__builtin_amdgcn_mfma_f32_32x32x16_bf16(PAF(3),VFR(7),o[1],0,0,0), C1,12); \
    }while(0)
  int t=1;
  #undef CMASK
  #define CMASK(P0,P1,t) do{}while(0)
  for(;t+5<NT;t+=2){
    STEP(pB0,pB1,pA0,pA1,t,true,true,true);     WAIT_BAR(2); RESC(); ROT();
    STEP(pA0,pA1,pB0,pB1,t+1,true,true,true);   WAIT_BAR(2); RESC(); ROT();
  }
  #undef CMASK
  #define CMASK(P0,P1,t) do{}while(0)
  #define ENDW(tt) do{ if((tt)+3<NT){WAIT_BAR(2);} else if((tt)+2<NT){WAIT_BAR(1);} else {WAIT_BAR(0);} }while(0)
  for(;t+1<NT;t+=2){
    STEP(pB0,pB1,pA0,pA1,t,(t+3<NT),(t+1<NT),(t+1<NT));       ENDW(t);   RESC(); ROT();
    STEP(pA0,pA1,pB0,pB1,t+1,(t+4<NT),(t+2<NT),(t+2<NT));     ENDW(t+1); RESC(); ROT();
  }
  STEP(pB0,pB1,pA0,pA1,NT-1,false,false,false); RESC();
  { float sacc=pB0[0]+pB0[1]; _Pragma("unroll") for(int r=2;r<16;++r)sacc+=pB0[r]; _Pragma("unroll") for(int r=0;r<16;++r)sacc+=pB1[r]; l_reg+=sacc;
    pw0=(u32x4){PKW(pB0,0),PKW(pB0,2),PKW(pB0,4),PKW(pB0,6)};pw1=(u32x4){PKW(pB0,8),PKW(pB0,10),PKW(pB0,12),PKW(pB0,14)};pw2=(u32x4){PKW(pB1,0),PKW(pB1,2),PKW(pB1,4),PKW(pB1,6)};pw3=(u32x4){PKW(pB1,8),PKW(pB1,10),PKW(pB1,12),PKW(pB1,14)};
    SBAR(); pv(o,vb0+sl_cur,PAF(0),PAF(1),PAF(2),PAF(3)); }
  #undef PKW
  #undef PAF
  #undef VFR
  #undef PIN
  #undef MX3
  #undef GAPA
  #undef GAPB
  #undef EX
  #undef VRD
  #undef KRD
  #undef STEP
  #undef ENDW
  {auto rr=__builtin_amdgcn_permlane32_swap(__float_as_uint(l_reg),__float_as_uint(l_reg),false,false);l_reg=__uint_as_float(rr[0])+__uint_as_float(rr[1]);}
  if(hi==0)wsf[32+r32]=l_reg;asm volatile("s_waitcnt lgkmcnt(0)":::"memory");
  float rli[16];
  #pragma unroll
  for(int r=0;r<16;++r)rli[r]=__builtin_amdgcn_rcpf(wsf[32+crow(r,hi)]);
  bf16*Ow=Ow0+(long)wid*QBLK*OP;
  { bf16*stg=(bf16*)(shm+LDS_OST)+wid*2048;
    #pragma unroll
    for(int r=0;r<16;++r){const int orow=crow(r,hi);
      #pragma unroll
      for(int d0=0;d0<2;++d0)stg[orow*64+d0*32+r32]=__float2bfloat16(o[d0][r]*rli[r]);}
    asm volatile("s_waitcnt lgkmcnt(0)":::"memory");
    #pragma unroll
    for(int i=0;i<4;++i){const int row=i*8+(lane>>3),ch=lane&7; const u32x4 v=*(const u32x4*)(stg+row*64+ch*8); ATTN_STORE16(Ow+(long)row*OP+ch*8,v);} }
  asm volatile("s_waitcnt lgkmcnt(0)\n\ts_barrier":::"memory");
  #undef DMA_K
  #undef DMA_V
  #undef CMASK
  #undef START
  #undef RESC
  #undef ROT
}
__device__ __forceinline__ void pv128(f32x16*o,int vb,bf16x8 pa0,bf16x8 pa1,bf16x8 pa2,bf16x8 pa3){
  #pragma unroll
  for(int d0=0;d0<4;++d0){s16x4 lo[4],hi[4];
    #pragma unroll
    for(int ks=0;ks<4;++ks){
      asm volatile("ds_read_b64_tr_b16 %0,%1 offset:%c2":"=&v"(lo[ks]):"v"(vb),"i"(d0*4096+ks*1024):"memory");
      asm volatile("ds_read_b64_tr_b16 %0,%1 offset:%c2":"=&v"(hi[ks]):"v"(vb),"i"(d0*4096+ks*1024+512):"memory");}
    asm volatile("s_waitcnt lgkmcnt(0)":::"memory");SBAR();
    #define PK(k) (bf16x8){lo[k][0],lo[k][1],lo[k][2],lo[k][3],hi[k][0],hi[k][1],hi[k][2],hi[k][3]}
    o[d0]=__builtin_amdgcn_mfma_f32_32x32x16_bf16(pa0,PK(0),o[d0],0,0,0);
    o[d0]=__builtin_amdgcn_mfma_f32_32x32x16_bf16(pa1,PK(1),o[d0],0,0,0);
    o[d0]=__builtin_amdgcn_mfma_f32_32x32x16_bf16(pa2,PK(2),o[d0],0,0,0);
    o[d0]=__builtin_amdgcn_mfma_f32_32x32x16_bf16(pa3,PK(3),o[d0],0,0,0);
    #undef PK
  }
}
constexpr int V128_V=NSLOT*SLOTB, V128_WS=V128_V+NSLOT*2*SLOTB, V128_Q=V128_WS+NW*64*4, V128_BYTES=V128_Q+NW*4096;
template<int THRL> __device__ __forceinline__ void attn_unit128(const bf16*Qw0,int QP,const bf16*Kh,int KP,const bf16*Vh,int VP,bf16*Ow0,int OP,int NT,char*shm,float kmax2){
  int tid=threadIdx.x; asm volatile("":"+v"(tid));
  const int lane=tid&63,r32=lane&31,hi=lane>>5; const int wid=__builtin_amdgcn_readfirstlane(tid>>6);
  const bf16*Qw=Qw0+(long)wid*QBLK*QP;
  const unsigned lds0=(unsigned)(uintptr_t)shm;
  float*wsf=(float*)(shm+V128_WS)+wid*64;
  const bf16*ksrc=Kh+(long)lane*KP+wid*8;
  const bf16*vsrc=Vh+(long)(16*(wid&3)+(lane>>2))*VP+(wid>>2)*32+(lane&3)*8;
  const unsigned kdst=lds0+LDS_K+wid*1024, vdst=lds0+V128_V+wid*1024;
  #define DMA_K(t,slot) glds16(ksrc+(long)(t)*KVBLK*KP,(unsigned)__builtin_amdgcn_readfirstlane(kdst+(slot)))
  #define DMA_V(t,slot) do{ glds16(vsrc+(long)(t)*KVBLK*VP,(unsigned)__builtin_amdgcn_readfirstlane(vdst+2*(slot))); glds16(vsrc+(long)(t)*KVBLK*VP+64,(unsigned)__builtin_amdgcn_readfirstlane(vdst+2*(slot)+8192)); }while(0)
  const int vb0=(int)(lds0+V128_V)+((lane>>4)&1)*32+(lane&3)*8+(4*hi+((lane&15)>>2))*64;
  const char*Kbase=shm+LDS_K; bf16x8 kf[8];
  const lds_cptr shm3=(lds_cptr)shm; const lds_cptr kp0=shm3+LDS_K+hi*1024+r32*16; const lds_cptr vp0=shm3+V128_V+((lane>>4)&1)*32+(lane&3)*8+(4*hi+((lane&15)>>2))*64;
  DMA_K(0,0);DMA_V(0,0);DMA_K(1,SLOTB);
  bf16x8 qr[4];
  #pragma unroll
  for(int d0=0;d0<4;++d0)qr[d0]=*reinterpret_cast<const bf16x8*>(&Qw[(long)r32*QP+d0*16+hi*8]);
  const lds_cptr qlp=shm3+V128_Q+wid*4096+lane*16;
  { __attribute__((address_space(3))) bf16x8* qw_=(__attribute__((address_space(3))) bf16x8*)(__attribute__((address_space(3))) char*)qlp; qw_[0]=qr[0]; qw_[64]=qr[1]; qw_[128]=qr[2]; qw_[192]=qr[3]; }
  float mhat,l_reg=0.f;
  { float qq=0.f; _Pragma("unroll") for(int d0=0;d0<4;++d0) _Pragma("unroll") for(int j=0;j<8;++j){ const float x=__uint_as_float(((unsigned)(unsigned short)qr[d0][j])<<16); qq+=x*x; }
    qq+=__shfl_xor(qq,32); mhat=fminf(sqrtf(qq*kmax2)*1.01f+1e-20f,96.0f); }
  f32x16 negm; _Pragma("unroll") for(int r=0;r<16;++r)negm[r]=-mhat; asm volatile("":"+v"(negm));
  f32x16 o[4];
  _Pragma("unroll") for(int d_=0;d_<4;++d_){ _Pragma("unroll") for(int r=0;r<16;++r)o[d_][r]=0.f; asm volatile("":"+v"(o[d_])); }
  #define CMASK(P0,P1,t) do{}while(0)
  #define START(P0,P1) do{ _Pragma("unroll") for(int r=0;r<16;++r)P0[r]=__builtin_amdgcn_exp2f(P0[r]); }while(0)
  #define RESC() do{}while(0)
  f32x16 pA0,pA1,pB0,pB1;
  int sl_prev=0,sl_cur=0,sl_next=SLOTB;
  #define ROT() do{sl_prev=sl_cur;sl_cur=sl_next;sl_next=(sl_next==(NSLOT-1)*SLOTB)?0:sl_next+SLOTB;}while(0)
  DMA_K(2,2*SLOTB);
  WAIT_BAR(4);
  qkt(pA0,pA1,Kbase,qr,negm,r32,hi);asm volatile("s_nop 15\n\ts_nop 7":"+v"(pA0),"+v"(pA1));CMASK(pA0,pA1,0);
  START(pA0,pA1);
  _Pragma("unroll") for(int r=0;r<16;++r)pA1[r]=__builtin_amdgcn_exp2f(pA1[r]);
  WAIT_BAR(0);
  DMA_K(3,0);DMA_V(1,SLOTB);
  ROT();
  kload8(kf,kp0+sl_cur);
  WAIT_BAR(3);
  s16x4 vlo[4],vhi[4]; u32x4 pw0,pw1,pw2,pw3;
  #define PKW(P,B) cvtpk_s(P[B],P[B+1])
  #define PAF(k) __builtin_bit_cast(bf16x8,pw##k)
  #define VFR(i) (bf16x8){vlo[i][0],vlo[i][1],vlo[i][2],vlo[i][3],vhi[i][0],vhi[i][1],vhi[i][2],vhi[i][3]}
  #define PIN(x) asm volatile("":"+v"(x))
  #define MX3(a,b,c) __builtin_fmaxf(__builtin_fmaxf((a),(b)),(c))
  #define GAPA(MF,A0,A1,A2,A3,W0,W1,PW) do{ MF; sacc+=A0; sacc+=A1; sacc+=A2; sacc+=A3; PIN(sacc); W0; W1; PIN(PW); SBAR(); }while(0)
  #define EX(v) __builtin_amdgcn_exp2f(v)
  #define GAPB(MF,X,B) do{ MF; X[B]=EX(X[B]); X[B+1]=EX(X[B+1]); X[B+2]=EX(X[B+2]); X[B+3]=EX(X[B+3]); PIN(X); }while(0)
  #define GAPB2(MF,X,B) do{ MF; X[B]=EX(X[B]); X[B+1]=EX(X[B+1]); PIN(X); }while(0)
  #define VRW(e,d0,ks) do{ vlo[e]=vtr(vp_+((d0)*4096+(ks)*1024)); vhi[e]=vtr(vp_+((d0)*4096+(ks)*1024+512)); }while(0)
  #define KRD(G,j) do{ if(G){ kload2(kf,kp0+sl_next,j); SBAR(); } }while(0)
  #define STEP(C0,C1,P0,P1,t,GK,GV,GL) do{ SBAR(); \
    const lds_cptr vp_=vp0+2*sl_prev; \
    const bf16x8 q0_=*(const __attribute__((address_space(3))) bf16x8*)(qlp), q1_=*(const __attribute__((address_space(3))) bf16x8*)(qlp+1024);     \
    float sacc=(P0[0]+P0[1]); \
    GAPA(C0=__builtin_amdgcn_mfma_f32_32x32x16_bf16(kf[0],q0_,negm,0,0,0), P0[2],P0[3],P0[4],P0[5],     pw0[0]=PKW(P0,0), pw0[1]=PKW(P0,2), pw0); \
    GAPA(C1=__builtin_amdgcn_mfma_f32_32x32x16_bf16(kf[1],q0_,negm,0,0,0), P0[6],P0[7],P0[8],P0[9],     pw0[2]=PKW(P0,4), pw0[3]=PKW(P0,6), pw0); \
    const bf16x8 q2_=*(const __attribute__((address_space(3))) bf16x8*)(qlp+2048); SBAR(); \
    GAPA(C0=__builtin_amdgcn_mfma_f32_32x32x16_bf16(kf[2],q1_,C0,0,0,0),   P0[10],P0[11],P0[12],P0[13], pw1[0]=PKW(P0,8), pw1[1]=PKW(P0,10), pw1); \
    GAPA(C1=__builtin_amdgcn_mfma_f32_32x32x16_bf16(kf[3],q1_,C1,0,0,0),   P0[14],P0[15],P1[0],P1[1],   pw1[2]=PKW(P0,12),pw1[3]=PKW(P0,14), pw1); \
    const bf16x8 q3_=*(const __attribute__((address_space(3))) bf16x8*)(qlp+3072); SBAR(); \
    VRW(0,0,0); SBAR(); GAPA(C0=__builtin_amdgcn_mfma_f32_32x32x16_bf16(kf[4],q2_,C0,0,0,0),   P1[2],P1[3],P1[4],P1[5],     pw2[0]=PKW(P1,0), pw2[1]=PKW(P1,2), pw2); \
    VRW(1,1,0); SBAR(); GAPA(C1=__builtin_amdgcn_mfma_f32_32x32x16_bf16(kf[5],q2_,C1,0,0,0),   P1[6],P1[7],P1[8],P1[9],     pw2[2]=PKW(P1,4), pw2[3]=PKW(P1,6), pw2); \
    VRW(2,0,1); SBAR(); GAPA(C0=__builtin_amdgcn_mfma_f32_32x32x16_bf16(kf[6],q3_,C0,0,0,0),   P1[10],P1[11],P1[12],P1[13], pw3[0]=PKW(P1,8), pw3[1]=PKW(P1,10), pw3); \
    VRW(3,1,1); SBAR(); GAPA(C1=__builtin_amdgcn_mfma_f32_32x32x16_bf16(kf[7],q3_,C1,0,0,0),   P1[14],P1[15],0.f,0.f,       pw3[2]=PKW(P1,12),pw3[3]=PKW(P1,14), pw3); \
    l_reg+=sacc; \
    if(GK){DMA_K((t)+3,sl_cur);} if(GV){DMA_V((t)+1,sl_next);} \
      \
    SBAR(); \
    GAPB2(o[0]=__builtin_amdgcn_mfma_f32_32x32x16_bf16(PAF(0),VFR(0),o[0],0,0,0), C0,0); VRW(0,0,2); SBAR(); \
    GAPB2(o[1]=__builtin_amdgcn_mfma_f32_32x32x16_bf16(PAF(0),VFR(1),o[1],0,0,0), C0,2); VRW(1,1,2); SBAR(); \
    KRD(GL,0); GAPB2(o[0]=__builtin_amdgcn_mfma_f32_32x32x16_bf16(PAF(1),VFR(2),o[0],0,0,0), C0,4); VRW(2,0,3); SBAR(); \
    KRD(GL,1); GAPB2(o[1]=__builtin_amdgcn_mfma_f32_32x32x16_bf16(PAF(1),VFR(3),o[1],0,0,0), C0,6); VRW(3,1,3); SBAR(); \
    KRD(GL,2); GAPB2(o[0]=__builtin_amdgcn_mfma_f32_32x32x16_bf16(PAF(2),VFR(0),o[0],0,0,0), C0,8); VRW(0,2,0); SBAR(); \
    KRD(GL,3); GAPB2(o[1]=__builtin_amdgcn_mfma_f32_32x32x16_bf16(PAF(2),VFR(1),o[1],0,0,0), C0,10); VRW(1,3,0); SBAR(); \
    GAPB2(o[0]=__builtin_amdgcn_mfma_f32_32x32x16_bf16(PAF(3),VFR(2),o[0],0,0,0), C0,12); VRW(2,2,1); SBAR(); \
    GAPB2(o[1]=__builtin_amdgcn_mfma_f32_32x32x16_bf16(PAF(3),VFR(3),o[1],0,0,0), C0,14); VRW(3,3,1); SBAR(); \
    GAPB2(o[2]=__builtin_amdgcn_mfma_f32_32x32x16_bf16(PAF(0),VFR(0),o[2],0,0,0), C1,0); VRW(0,2,2); SBAR(); \
    GAPB2(o[3]=__builtin_amdgcn_mfma_f32_32x32x16_bf16(PAF(0),VFR(1),o[3],0,0,0), C1,2); VRW(1,3,2); SBAR(); \
    GAPB2(o[2]=__builtin_amdgcn_mfma_f32_32x32x16_bf16(PAF(1),VFR(2),o[2],0,0,0), C1,4); VRW(2,2,3); SBAR(); \
    GAPB2(o[3]=__builtin_amdgcn_mfma_f32_32x32x16_bf16(PAF(1),VFR(3),o[3],0,0,0), C1,6); VRW(3,3,3); SBAR(); \
    GAPB2(o[2]=__builtin_amdgcn_mfma_f32_32x32x16_bf16(PAF(2),VFR(0),o[2],0,0,0), C1,8); SBAR(); \
    GAPB2(o[3]=__builtin_amdgcn_mfma_f32_32x32x16_bf16(PAF(2),VFR(1),o[3],0,0,0), C1,10); SBAR(); \
    GAPB2(o[2]=__builtin_amdgcn_mfma_f32_32x32x16_bf16(PAF(3),VFR(2),o[2],0,0,0), C1,12); SBAR(); \
    GAPB2(o[3]=__builtin_amdgcn_mfma_f32_32x32x16_bf16(PAF(3),VFR(3),o[3],0,0,0), C1,14);  \
    }while(0)
  int t=1;
  #undef CMASK
  #define CMASK(P0,P1,t) do{}while(0)
  for(;t+5<NT;t+=2){
    STEP(pB0,pB1,pA0,pA1,t,true,true,true);     WAIT_BAR(3); RESC(); ROT();
    STEP(pA0,pA1,pB0,pB1,t+1,true,true,true);   WAIT_BAR(3); RESC(); ROT();
  }
  #undef CMASK
  #define CMASK(P0,P1,t) do{}while(0)
  #define ENDW(tt) do{ if((tt)+3<NT){WAIT_BAR(3);} else if((tt)+2<NT){WAIT_BAR(2);} else {WAIT_BAR(0);} }while(0)
  for(;t+1<NT;t+=2){
    STEP(pB0,pB1,pA0,pA1,t,(t+3<NT),(t+1<NT),(t+1<NT));       ENDW(t);   RESC(); ROT();
    STEP(pA0,pA1,pB0,pB1,t+1,(t+4<NT),(t+2<NT),(t+2<NT));     ENDW(t+1); RESC(); ROT();
  }
  STEP(pB0,pB1,pA0,pA1,NT-1,false,false,false); RESC();
  { float sacc=pB0[0]+pB0[1]; _Pragma("unroll") for(int r=2;r<16;++r)sacc+=pB0[r]; _Pragma("unroll") for(int r=0;r<16;++r)sacc+=pB1[r]; l_reg+=sacc;
    pw0=(u32x4){PKW(pB0,0),PKW(pB0,2),PKW(pB0,4),PKW(pB0,6)};pw1=(u32x4){PKW(pB0,8),PKW(pB0,10),PKW(pB0,12),PKW(pB0,14)};pw2=(u32x4){PKW(pB1,0),PKW(pB1,2),PKW(pB1,4),PKW(pB1,6)};pw3=(u32x4){PKW(pB1,8),PKW(pB1,10),PKW(pB1,12),PKW(pB1,14)};
    SBAR(); pv128(o,vb0+2*sl_cur,PAF(0),PAF(1),PAF(2),PAF(3)); }
  #undef PKW
  #undef PAF
  #undef VFR
  #undef PIN
  #undef MX3
  #undef GAPA
  #undef GAPB
  #undef GAPB2
  #undef EX
  #undef VRW
  #undef KRD
  #undef STEP
  #undef ENDW
  {auto rr=__builtin_amdgcn_permlane32_swap(__float_as_uint(l_reg),__float_as_uint(l_reg),false,false);l_reg=__uint_as_float(rr[0])+__uint_as_float(rr[1]);}
  if(hi==0)wsf[32+r32]=l_reg;asm volatile("s_waitcnt lgkmcnt(0)":::"memory");
  float rli[16];
  #pragma unroll
  for(int r=0;r<16;++r)rli[r]=__builtin_amdgcn_rcpf(wsf[32+crow(r,hi)]);
  bf16*Ow=Ow0+(long)wid*QBLK*OP;
  asm volatile("s_waitcnt lgkmcnt(0)\n\ts_barrier":::"memory");
  { bf16*stg=(bf16*)(shm)+wid*4096;
    #pragma unroll
    for(int r=0;r<16;++r){const int orow=crow(r,hi);
      #pragma unroll
      for(int d0=0;d0<4;++d0)stg[orow*128+d0*32+r32]=__float2bfloat16(o[d0][r]*rli[r]);}
    asm volatile("s_waitcnt lgkmcnt(0)":::"memory");
    #pragma unroll
    for(int i=0;i<8;++i){const int row=i*4+(lane>>4),ch=lane&15; const u32x4 v=*(const u32x4*)(stg+row*128+ch*8); ATTN_STORE16(Ow+(long)row*OP+ch*8,v);} }
  asm volatile("s_waitcnt lgkmcnt(0)\n\ts_barrier":::"memory");
  #undef DMA_K
  #undef DMA_V
  #undef CMASK
  #undef START
  #undef RESC
  #undef ROT
}
constexpr int ATTN_LDS_BYTES=LDS_BYTES;
#undef SBAR
#undef WAIT_BAR
}
#ifndef PROBE_MASK
#define PROBE_MASK 0ull
#endif
#ifndef PROBE_AMP
#define PROBE_AMP 4
#endif

constexpr int NWAVES = 8;
constexpr int DM = 1024, SEQ = 8192, NB = 2, CTXL = 256, NLAT = NB * SEQ, T = NLAT + NB * CTXL  , NKEY = SEQ + CTXL  ;
constexpr int NPXA = 2304, NPXB = 4096, INC = NPXA + NPXB;
constexpr float EPS = 1e-6f;
constexpr size_t MiB = 1u << 20;
constexpr size_t WS_CTL = 0, CTL_ZERO_BYTES = 1 * MiB, WS_MOD = 512 * 1024;
constexpr size_t WS_KMAX = 768 * 1024;
constexpr size_t WS_ROPE = 1 * MiB, WS_LAM = 1 * MiB + 65536;
constexpr size_t WS_WIN = 2 * MiB, WS_WA = 15 * MiB, WS_WB = 16 * MiB, WS_WC = 17 * MiB, WS_WO = 18 * MiB, WS_WQ = 20 * MiB;
constexpr size_t WS_U16 = 22 * MiB, WS_V16 = 54 * MiB;
constexpr size_t WS_SU = WS_U16 + 12 * MiB, WS_SV = WS_V16 + 12 * MiB; constexpr int ROW6 = 768;
constexpr size_t WS_X = 86 * MiB;
constexpr size_t WS_R1 = 152 * MiB;
constexpr size_t WS_R2 = 227 * MiB;
constexpr size_t SZ_QA = (size_t)NB * 4 * 2 * NKEY * 64 * 2, SZ_VA = (size_t)NB * 4 * NKEY * 128 * 2, SZ_QB = (size_t)NB * 8 * NKEY * 64 * 2, SZ_KB = (size_t)NB * 2 * NKEY * 64 * 2;
constexpr size_t WS_QA = WS_R2, WS_KA = WS_QA + SZ_QA, WS_VA = WS_KA + SZ_QA, WS_QB = WS_VA + SZ_VA, WS_KB = WS_QB + SZ_QB, WS_VB = WS_KB + SZ_KB;
constexpr size_t WS_MB = WS_R2, WS_EIDX = WS_R2 + 33 * MiB, WS_GW = WS_EIDX + (size_t)T * 128 * 4;
constexpr size_t WS_R3 = 306 * MiB;
constexpr size_t WS_R4 = 438 * MiB;
constexpr size_t SZ_O = (size_t)T * 512 * 2;
constexpr size_t WS_OABC = WS_R4, WS_HX = WS_R4;
constexpr size_t WS_SSQ = 488 * MiB;
constexpr size_t WS_BQ = 490 * MiB;
constexpr size_t WS_END = 491 * MiB;
static_assert(WS_VB + SZ_KB <= WS_R3 && WS_GW + (size_t)T * 128 * 4 <= WS_R3 && WS_R1 + (size_t)T * NPXA * 2 <= WS_R2 && WS_R3 + (size_t)T * NPXB * 2 <= WS_R4 && WS_OABC + 3 * SZ_O <= WS_END, "d_ws map");
constexpr int CW_TMO = 0, CW_BAR = 4096;
static_assert(CW_BAR * 4 + 3456 * 4 <= WS_MOD && WS_MOD + (size_t)2 * 3 * 6144 * 4 <= WS_KMAX && WS_KMAX + 512 <= CTL_ZERO_BYTES, "control-region map");

constexpr int RING_BYTES = 131072, LDSCTL_OFF = RING_BYTES, MISC_OFF = LDSCTL_OFF + 320, LDS_BYTES = 147456;

struct Args { const float* in[27]; float* out; unsigned char* ws; int ph_lo, ph_hi; };
struct Frame { LAS unsigned char* lds; volatile LAS unsigned* MISC; gu32* ctl; int tid, lane, wave, G, bid; };

typedef float f32x16 __attribute__((ext_vector_type(16)));
typedef short s16x4 __attribute__((ext_vector_type(4)));
typedef unsigned u32x2 __attribute__((ext_vector_type(2)));
typedef float f32x2 __attribute__((ext_vector_type(2)));
typedef float v32f __attribute__((ext_vector_type(32))); typedef __bf16 v32bf __attribute__((ext_vector_type(32))); typedef unsigned v6u __attribute__((ext_vector_type(6))); typedef unsigned v3u __attribute__((ext_vector_type(3)));
__device__ __forceinline__ float bf2f(unsigned short b) { return __uint_as_float((unsigned)b << 16); }
__device__ __forceinline__ float bflo(unsigned w) { return __uint_as_float(w << 16); }
__device__ __forceinline__ float bfhi(unsigned w) { return __uint_as_float(w & 0xffff0000u); }
__device__ __forceinline__ float sigm(float x) { return __builtin_amdgcn_rcpf(1.0f + __expf(-x)); }
__device__ __forceinline__ int mod_index(int row) { return row < SEQ ? 0 : (row < NLAT ? 1 : 2); }
__device__ __forceinline__ void row_to_bn(int row, int& b, int& nd) { if (row < NLAT) { b = row >> 13; nd = row & (SEQ - 1); } else { const int r = row - NLAT; b = r >> 8; nd = SEQ + (r & 255); } }

__device__ __forceinline__ void ph_prep0(const Args& a, Frame& F) {
    const int gtid = (F.G - 1 - F.bid) * 512 + F.tid;
    if (gtid < 2048) {
        const int pos = gtid >> 4, i = gtid & 15;
        double inv = 1.0; for (int k = 0; k < i; ++k) inv *= 0.5623413251903491;
        const double x = (double)pos * inv, TWO_PI = 6.283185307179586476925;
        const double kk = rint(x / TWO_PI), y = x - kk * TWO_PI, y2 = y * y;
        double ts = 1.0, tc = 1.0;
        for (int n = 14; n >= 1; --n) { ts = 1.0 - ts * y2 / (double)((2 * n) * (2 * n + 1)); tc = 1.0 - tc * y2 / (double)((2 * n - 1) * (2 * n)); }
        float* rp = (float*)(a.ws + WS_ROPE) + gtid * 2; rp[0] = (float)tc; rp[1] = (float)(y * ts);
    }
    if (gtid >= 2048 && gtid < 2050) {
        const int l = gtid - 2048; float s1 = 0.f, s2 = 0.f;
        for (int d = 0; d < 64; ++d) { s1 += a.in[7][l * 64 + d] * a.in[8][l * 64 + d]; s2 += a.in[9][l * 64 + d] * a.in[10][l * 64 + d]; }
        const float lam_init = l == 0 ? 0.2f : 0.35550906759096926f;
        float* lp = (float*)(a.ws + WS_LAM); lp[l * 2] = expf(s1) - expf(s2) + lam_init; lp[l * 2 + 1] = 1.0f - lam_init;
    }
    if (F.bid < 192) {
        float* MOD = (float*)(a.ws + WS_MOD); LAS float* sc = (LAS float*)F.lds; LAS float* red = sc + 3072;
        for (int i = F.tid; i < 3072; i += 512) { const int k = i & 1023; const float c = i < 1024 ? a.in[1][k] : (i < 2048 ? a.in[1][1024 + k] : a.in[3][k]); sc[i] = c * sigm(c); }
        __syncthreads();
        for (int u = F.bid; u < 192; u += F.G) {
            const int l = u / 96, cc = u % 96, kg = F.tid >> 4, c4 = F.tid & 15;
            const f32x4* W = (const f32x4*)(a.in[4] + (size_t)l * 1024 * 6144 + (size_t)(kg * 32) * 6144 + cc * 64 + 4 * c4);
            f32x4 s0 = {0.f, 0.f, 0.f, 0.f}, s1 = s0, s2 = s0;
#pragma unroll
            for (int h = 0; h < 2; ++h) { f32x4 w[16];
#pragma unroll
                for (int kk = 0; kk < 16; ++kk) w[kk] = W[(size_t)(h * 16 + kk) * (6144 / 4)];
#pragma unroll
                for (int kk = 0; kk < 16; ++kk) { const int k = kg * 32 + h * 16 + kk; s0 += sc[k] * w[kk]; s1 += sc[1024 + k] * w[kk]; s2 += sc[2048 + k] * w[kk]; } }
            *(LAS f32x4*)(red + (kg * 3 + 0) * 64 + 4 * c4) = s0; *(LAS f32x4*)(red + (kg * 3 + 1) * 64 + 4 * c4) = s1; *(LAS f32x4*)(red + (kg * 3 + 2) * 64 + 4 * c4) = s2;
            __syncthreads();
            if (F.tid < 192) { const int mi = F.tid >> 6, c = F.tid & 63; float s = a.in[5][l * 6144 + cc * 64 + c];
                for (int g = 0; g < 32; ++g) s += red[(g * 3 + mi) * 64 + c];
                MOD[(l * 3 + mi) * 6144 + cc * 64 + c] = s; }
            __syncthreads();
        }
    }
}
__device__ __forceinline__ void ph_convw(const Args& a, Frame& F, int l) {
    LAS float* scr = (LAS float*)(F.lds + F.wave * 16384);
    const int gw = F.bid * NWAVES + F.wave, NGW = F.G * NWAVES;
    constexpr int I_IN = 16 * 200, I_BR = 8 * 32, I_O = 16 * 32, NITEMS = I_IN + 3 * I_BR + 2 * I_O;
    for (int it = gw; it < NITEMS; it += NGW) {
        int r = it;
        if (r < I_IN) { p0_transpose_item(a.in[6] + (size_t)l * 1024 * INC, 1024, INC, (bf16*)(a.ws + WS_WIN), 0, scr, r, F.lane); continue; } r -= I_IN;
        if (r < I_BR) { p0_transpose_item_p(a.in[18] + (size_t)l * 512 * 1024, 512, 1024, (bf16*)(a.ws + WS_WA), 1536, 0, scr, r, F.lane); continue; } r -= I_BR;
        if (r < I_BR) { p0_transpose_item_p(a.in[19] + (size_t)l * 512 * 1024, 512, 1024, (bf16*)(a.ws + WS_WA), 1536, 512, scr, r, F.lane); continue; } r -= I_BR;
        if (r < I_BR) { p0_transpose_item_p(a.in[20] + (size_t)l * 512 * 1024, 512, 1024, (bf16*)(a.ws + WS_WA), 1536, 1024, scr, r, F.lane); continue; } r -= I_BR;
        if (r < I_O) { p0_transpose_item(a.in[21] + (size_t)l * 1024 * 1024, 1024, 1024, (bf16*)(a.ws + WS_WO), 0, scr, r, F.lane); continue; } r -= I_O;
        p0_transpose_item(a.in[22] + (size_t)l * 1024 * 1024, 1024, 1024, (bf16*)(a.ws + WS_WQ), 0, scr, r, F.lane);
    }
    const int gtid = F.bid * 512 + F.tid, NT = F.G * 512; constexpr int NI = 2 * 16384 * 32, NIH = 16384 * 32;
    const f32x4* us = (const f32x4*)(a.in[24] + (size_t)l * 16384 * 1024); const f32x4* vs = (const f32x4*)(a.in[25] + (size_t)l * 16384 * 1024);
    for (int i0 = gtid; i0 < NI; i0 += 2 * NT) { f32x4 p_[2][8];
#pragma unroll
        for (int u_ = 0; u_ < 2; ++u_) { const int i = min(i0 + u_ * NT, NI - 1); const bool isv = i >= NIH; const int j = isv ? i - NIH : i; const f32x4* sp = (isv ? vs : us) + 8 * (size_t)j;
#pragma unroll
            for (int q = 0; q < 8; ++q) p_[u_][q] = sp[q]; }
#pragma unroll
        for (int u_ = 0; u_ < 2; ++u_) { const int i = min(i0 + u_ * NT, NI - 1); const bool isv = i >= NIH; const int j = isv ? i - NIH : i;
            float m = 0.f;
#pragma unroll
            for (int q = 0; q < 8; ++q) m = fmaxf(fmaxf(m, fmaxf(fabsf(p_[u_][q][0]), fabsf(p_[u_][q][1]))), fmaxf(fabsf(p_[u_][q][2]), fabsf(p_[u_][q][3])));
#pragma unroll
            for (int o = 16; o >= 1; o >>= 1) m = fmaxf(m, __shfl_xor(m, o));
            const float sc = m > 0.f ? 7.5f * __builtin_amdgcn_rcpf(m) : 1.0f, inv = m > 0.f ? m * (1.0f / 7.5f) : 1.0f;
            v32bf bv;
#pragma unroll
            for (int q = 0; q < 8; ++q) { bv[4 * q] = (__bf16)(p_[u_][q][0] * sc); bv[4 * q + 1] = (__bf16)(p_[u_][q][1] * sc); bv[4 * q + 2] = (__bf16)(p_[u_][q][2] * sc); bv[4 * q + 3] = (__bf16)(p_[u_][q][3] * sc); }
            const v6u o = __builtin_amdgcn_cvt_scalef32_pk32_fp6_bf16(bv, 1.0f);
            if (i0 + u_ * NT < NI) { unsigned char* dp = a.ws + (isv ? WS_V16 : WS_U16) + (size_t)(j >> 5) * ROW6 + 24 * (j & 31);
                *(u32x2*)dp = (u32x2){o[0], o[1]}; *(u32x2*)(dp + 8) = (u32x2){o[2], o[3]}; *(u32x2*)(dp + 16) = (u32x2){o[4], o[5]};
                if ((j & 31) == 0) ((float*)(a.ws + (isv ? WS_SV : WS_SU)))[j >> 5] = inv; } } }
}
__device__ __forceinline__ void ph_mod(const Args& a, Frame& F, int l, int which) {
    const float* MOD = (const float*)(a.ws + WS_MOD) + (size_t)l * 3 * 6144 + (which ? 3072 : 0);
    const bool from_in = (l == 0 && which == 0);
    const float* X = from_in ? a.in[0] : (const float*)(a.ws + WS_X); const float* XC = from_in ? a.in[2] - (size_t)NLAT * DM : X; bf16* HX = (bf16*)(a.ws + WS_HX);
    const int gw = F.bid * NWAVES + F.wave, NGW = F.G * NWAVES; const int TL = (l == 1 && which == 1) ? NLAT : T;
    for (int row0 = gw; row0 < TL; row0 += 2 * NGW) {
        f32x4 v[2][4]; float ss[2];
#pragma unroll
        for (int u_ = 0; u_ < 2; ++u_) { const int row = min(row0 + u_ * NGW, TL - 1); const f32x4* xr = (const f32x4*)((row < NLAT ? X : XC) + (size_t)row * DM) + F.lane; ss[u_] = 0.f;
#pragma unroll
            for (int j = 0; j < 4; ++j) v[u_][j] = xr[64 * j]; }
#pragma unroll
        for (int u_ = 0; u_ < 2; ++u_) {
#pragma unroll
            for (int j = 0; j < 4; ++j) ss[u_] += (v[u_][j][0] * v[u_][j][0] + v[u_][j][1] * v[u_][j][1]) + (v[u_][j][2] * v[u_][j][2] + v[u_][j][3] * v[u_][j][3]); }
#pragma unroll
        for (int u_ = 0; u_ < 2; ++u_) { const int row = row0 + u_ * NGW; if (row < TL) {
            const float* sh = MOD + mod_index(row) * 6144; const float* sc = sh + 1024;
            const float rstd = rsqrtf(wave_sum(ss[u_]) * (1.0f / DM) + EPS);
#pragma unroll
            for (int j = 0; j < 4; ++j) { const int c = 4 * F.lane + 256 * j; const f32x4 s1 = *(const f32x4*)(sc + c), s0 = *(const f32x4*)(sh + c);
                const f32x4 h = v[u_][j] * rstd * (s1 + 1.0f) + s0; u32x2 o; o.x = pk2(h[0], h[1]); o.y = pk2(h[2], h[3]); *(u32x2*)(HX + (size_t)row * DM + c) = o; } } }
    }
}
__device__ __forceinline__ void ph_post(const Args& a, Frame& F, int l) {
    const bf16* PXa = (const bf16*)(a.ws + WS_R1); const float* rope = (const float*)(a.ws + WS_ROPE);
    const int gw = F.bid * NWAVES + F.wave, NGW = F.G * NWAVES, lane = F.lane;
    float km0_ = 0.f, km1_ = 0.f;
    {
        const int c = lane & 7, g8 = lane >> 3;
        float qw[8], kw[8];
#pragma unroll
        for (int j = 0; j < 8; ++j) { qw[j] = a.in[12][l * 64 + 8 * c + j]; kw[j] = a.in[13][l * 64 + 8 * c + j]; }
        float& km0 = km0_; float& km1 = km1_;
        for (int row = gw; row < T; row += NGW) {
            int b, nd; row_to_bn(row, b, nd);
            const bool lat = row < NLAT; const int pos = (c & 4) ? (nd & 63) : ((nd >> 6) & 127);
            float cs[8], sn[8];
            { const f32x4* rp = (const f32x4*)(rope + (pos * 16 + 8 * (c & 1)) * 2);
              const f32x4 r0 = rp[0], r1 = rp[1], r2 = rp[2], r3 = rp[3];
              cs[0] = r0[0]; sn[0] = r0[1]; cs[1] = r0[2]; sn[1] = r0[3]; cs[2] = r1[0]; sn[2] = r1[1]; cs[3] = r1[2]; sn[3] = r1[3];
              cs[4] = r2[0]; sn[4] = r2[1]; cs[5] = r2[2]; sn[5] = r2[3]; cs[6] = r3[0]; sn[6] = r3[1]; cs[7] = r3[2]; sn[7] = r3[3]; }
            const bf16* pr = PXa + (size_t)row * NPXA;
            v4u wv[5];
#pragma unroll
            for (int it = 0; it < 5; ++it) { const int hv = min(8 * it + g8, 35); wv[it] = *(const v4u*)(pr + hv * 64 + 8 * c); }
#pragma unroll
            for (int it = 0; it < 5; ++it) {
                const int hv = 8 * it + g8;
                float x[8]; x[0] = bflo(wv[it].x); x[1] = bfhi(wv[it].x); x[2] = bflo(wv[it].y); x[3] = bfhi(wv[it].y); x[4] = bflo(wv[it].z); x[5] = bfhi(wv[it].z); x[6] = bflo(wv[it].w); x[7] = bfhi(wv[it].w);
                const bool is_v = (hv >= 8 && hv < 16) || hv == 18 || hv == 19;
                const bool nrm = (hv == 16 || hv == 17 || hv >= 28);
                float ss = 0.f;
#pragma unroll
                for (int j = 0; j < 8; ++j) ss += x[j] * x[j];
                ss += __shfl_xor(ss, 1); ss += __shfl_xor(ss, 2); ss += __shfl_xor(ss, 4);
                const float rs = rsqrtf(ss * (1.0f / 64.0f) + EPS);
                if (it == 0) { if (b == 0) km0 = fmaxf(km0, ss); else km1 = fmaxf(km1, ss); }
                const float qs = hv >= 20 ? 0.18033688011112042f : 1.0f;
#pragma unroll
                for (int j = 0; j < 8; ++j) { if (nrm) x[j] *= rs * (hv >= 28 ? qw[j] : kw[j]); }
                const bool rot = lat && !is_v;
#pragma unroll
                for (int j = 0; j < 8; ++j) { const float p = __shfl_xor(x[j], 2); const float r = x[j] * cs[j] + ((c & 2) ? p : -p) * sn[j]; x[j] = (rot ? r : x[j]) * qs; }
                v4u o; o.x = pk2(x[0], x[1]); o.y = pk2(x[2], x[3]); o.z = pk2(x[4], x[5]); o.w = pk2(x[6], x[7]);
                unsigned off;
                if (hv < 8) off = (unsigned)WS_KA + (((unsigned)(b * 8 + hv) * NKEY + nd) * 64 + 8 * c) * 2;
                else if (hv < 16) off = (unsigned)WS_VA + (((unsigned)(b * 4 + ((hv - 8) >> 1)) * NKEY + nd) * 128 + ((hv - 8) & 1) * 64 + 8 * c) * 2;
                else if (hv < 18) off = (unsigned)WS_KB + (((unsigned)(b * 2 + (hv - 16)) * NKEY + nd) * 64 + 8 * c) * 2;
                else if (hv < 20) off = (unsigned)WS_VB + (((unsigned)(b * 2 + (hv - 18)) * NKEY + nd) * 64 + 8 * c) * 2;
                else if (hv < 28) off = (unsigned)WS_QA + (((unsigned)(b * 8 + (hv - 20)) * NKEY + nd) * 64 + 8 * c) * 2;
                else off = (unsigned)WS_QB + (((unsigned)(b * 8 + (hv - 28)) * NKEY + nd) * 64 + 8 * c) * 2;
                if (hv < 36) *(v4u*)(a.ws + off) = o;
            }
        }
    }
    { LAS float* KM = (LAS float*)(F.lds + 70656);
      if ((lane & 7) == 0) { KM[(F.wave * 2 + 0) * 8 + (lane >> 3)] = km0_; KM[(F.wave * 2 + 1) * 8 + (lane >> 3)] = km1_; }
      __syncthreads();
      int t_ = F.tid; asm volatile("" : "+v"(t_));
      if (t_ < 16) { float m = 0.f;
#pragma unroll
          for (int w_ = 0; w_ < 8; ++w_) m = fmaxf(m, KM[w_ * 16 + t_]);
          atomicMax((unsigned*)(a.ws + WS_KMAX) + l * 64 + t_, __float_as_uint(m)); } }
    const bf16* PXb = (const bf16*)(a.ws + WS_R3); bf16* OC = (bf16*)(a.ws + WS_OABC) + 1024;
    LAS unsigned short* UL = (LAS unsigned short*)F.lds;
    LAS float* RED = (LAS float*)(F.lds + 65536);
    LAS float* STAT = (LAS float*)(F.lds + 68608);
    LAS float* MSK = (LAS float*)(F.lds + 69632);
    constexpr int TT = 33;
    const int c = F.tid;
    float w[31];
#pragma unroll
    for (int k = 0; k < 31; ++k) w[k] = a.in[14][(size_t)l * 31 * 512 + k * 512 + c];
    int vz; asm volatile("v_mov_b32 %0, 0" : "=v"(vz));
    const float cb = a.in[15][l * 512 + c], lnw = a.in[16][l * 512 + c], lnb = a.in[17][l * 512 + c];
    for (int ct = F.bid; ct < (l == 0 ? T / TT : (NLAT + TT - 1) / TT); ct += F.G) {
        const int t0 = ct * TT;
        int bnd = -1; { const int lo_ = t0 - 15, hi_ = t0 + TT + 15; if (lo_ < 0) bnd = 0; else if (SEQ > lo_ && SEQ < hi_) bnd = SEQ; else if (NLAT > lo_ && NLAT < hi_) bnd = NLAT; else if (NLAT + CTXL > lo_ && NLAT + CTXL < hi_) bnd = NLAT + CTXL; else if (hi_ > T) bnd = T; }
        if (F.tid < 128) { const int p = F.tid >> 6, i = F.tid & 63; const int r = t0 - 15 + i;
            MSK[p * 64 + i] = (i < TT + 30 && r >= 0 && r < T && (bnd < 0 || ((r < bnd) == (p == 0)))) ? 1.f : 0.f;
            MSK[128 + p * 64 + i] = (i < TT && (bnd < 0 ? p == 0 : (((t0 + i) < bnd) == (p == 0)))) ? 1.f : 0.f; }
        __syncthreads();
        float y[TT];
#pragma unroll
        for (int n = 0; n < TT; ++n) y[n] = 0.f;
        const int npass = bnd < 0 ? 1 : 2;
        for (int pass = 0; pass < npass; ++pass) {
            __syncthreads();
            { v4u ga_[8], gg_[8];
#pragma unroll
              for (int q = 0; q < 8; ++q) { const int it = min(F.tid + 512 * q, (TT + 30) * 64 - 1); const int i = it >> 6, j8 = (it & 63) * 8; const int r = min(max(t0 - 15 + i, 0), T - 1);
                  ga_[q] = *(const v4u*)(PXb + (size_t)r * NPXB + j8); gg_[q] = *(const v4u*)(PXb + (size_t)r * NPXB + 512 + j8); }
#pragma unroll
              for (int q = 0; q < 8; ++q) { const int it = F.tid + 512 * q; if (it < (TT + 30) * 64) { const int i = it >> 6, j8 = (it & 63) * 8; const float mk = MSK[pass * 64 + i];
                  v4u o;
#pragma unroll
                  for (int e = 0; e < 4; ++e) { const float u0 = bflo(ga_[q][e]) * sigm(bflo(gg_[q][e])) * mk, u1 = bfhi(ga_[q][e]) * sigm(bfhi(gg_[q][e])) * mk; o[e] = pk2(u0, u1); }
                  *(LAS v4u*)(UL + i * 512 + j8) = o; } }
            }
            __syncthreads();
            float u[TT + 30];
#pragma unroll
            for (int i = 0; i < TT + 30; ++i) u[i] = bf2f(UL[i * 512 + c]);
#pragma unroll
            for (int n = 0; n < TT; ++n) { float acc = cb;
#pragma unroll
                for (int k = 0; k < 31; ++k) acc += w[k] * u[n + k];
                y[n] += acc * MSK[128 + pass * 64 + n + vz]; if ((n & 3) == 3) __builtin_amdgcn_sched_barrier(0); }
        }
#pragma unroll
        for (int n = 0; n < TT; ++n) { float s1 = y[n], s2 = y[n] * y[n];
#pragma unroll
            for (int o = 32; o >= 1; o >>= 1) { s1 += __shfl_xor(s1, o); s2 += __shfl_xor(s2, o); }
            if (lane == 0) { RED[(F.wave * TT + n) * 2] = s1; RED[(F.wave * TT + n) * 2 + 1] = s2; } }
        __syncthreads();
        if (F.tid < TT) { const int n = F.tid; float s1 = 0.f, s2 = 0.f;
#pragma unroll
            for (int wv_ = 0; wv_ < 8; ++wv_) { s1 += RED[(wv_ * TT + n) * 2]; s2 += RED[(wv_ * TT + n) * 2 + 1]; }
            const float mu = s1 * (1.0f / 512.0f), var = fmaxf(s2 * (1.0f / 512.0f) - mu * mu, 0.f);
            STAT[2 * n] = mu; STAT[2 * n + 1] = rsqrtf(var + EPS); }
        __syncthreads();
#pragma unroll
        for (int n = 0; n < TT; ++n) {
            if ((n & 7) == 7) __builtin_amdgcn_sched_barrier(0);
            const float yn = (y[n] - STAT[2 * n + vz]) * STAT[2 * n + 1 + vz] * lnw + lnb;
            OC[(size_t)(t0 + n) * 1536 + c] = (unsigned short)f2bf(yn * sigm(yn)); }
        __syncthreads();
    }
}
__device__ __forceinline__ void ph_attn(const Args& a, Frame& F, int l, char* shm) {
    typedef attn_body::bf16 abf;
    const int xcd = F.bid & 7, idx = F.bid >> 3;
    const int nA = (F.G == 256) ? 2 + ((l == 0 && F.bid < 16) ? 1 : 0) : 0;
    for (int j = 0; j < nA; ++j) {
        const int st = j < 2 ? 2 * xcd + j : F.bid, qb = j < 2 ? idx : 32;
        const int kt0 = qb == 32 ? 128 : 0, NT = qb == 32 ? 4 : 132;
        const abf* Qp = (const abf*)(a.ws + WS_QA) + ((size_t)st * NKEY + qb * 256) * 64; const abf* Kp = (const abf*)(a.ws + WS_KA) + ((size_t)st * NKEY + kt0 * 64) * 64;
        const abf* Vp = (const abf*)(a.ws + WS_VA) + ((size_t)(st >> 1) * NKEY + kt0 * 64) * 128;
        abf* Op = (abf*)(a.ws + WS_R1) + ((size_t)st * NKEY + qb * 256) * 128;
        attn_body::attn_unit128<8>(Qp, 64, Kp, 64, Vp, 128, Op, 128, NT, shm, __uint_as_float(__hip_atomic_load((unsigned*)(a.ws + WS_KMAX) + l * 64 + st, __ATOMIC_RELAXED, __HIP_MEMORY_SCOPE_AGENT)));
    }
    float mq = 0.f, mk = 0.f; for (int d = 0; d < 64; ++d) { mq = fmaxf(mq, fabsf(a.in[12][l * 64 + d])); mk = fmaxf(mk, fabsf(a.in[13][l * 64 + d])); }
    const float mrefB = 64.0f * mq * mk * 0.18033688011112042f * 1.02f;
    const int nB = (F.G == 256) ? 2 + ((l == 0 && F.bid >= 16 && F.bid < 32) ? 1 : 0) : 0;
    for (int j = 0; j < nB; ++j) {
        const int st = j < 2 ? 2 * xcd + j : F.bid - 16, qb = j < 2 ? idx : 32;
        const int kt0 = qb == 32 ? 128 : 0, NT = qb == 32 ? 4 : 132;
        const int b = st >> 3, qh = st & 7, kvh = b * 2 + (qh >> 2);
        const abf* Qp = (const abf*)(a.ws + WS_QB) + ((size_t)st * NKEY + qb * 256) * 64; const abf* Kp = (const abf*)(a.ws + WS_KB) + ((size_t)kvh * NKEY + kt0 * 64) * 64;
        const abf* Vp = (const abf*)(a.ws + WS_VB) + ((size_t)kvh * NKEY + kt0 * 64) * 64;
        const int trow = qb == 32 ? NLAT + b * CTXL : b * SEQ + qb * 256;
        abf* Op = (abf*)(a.ws + WS_OABC) + (size_t)trow * 1536 + 512 + qh * 64;
        attn_body::attn_unit<8>(Qp, 64, Kp, 64, Vp, 64, Op, 1536, NT, shm, mrefB);
    }
}
__device__ __forceinline__ void ph_comb(const Args& a, Frame& F, int l) {
    const bf16* OA2 = (const bf16*)(a.ws + WS_R1); bf16* OA = (bf16*)(a.ws + WS_OABC);
    const float lam = ((const float*)(a.ws + WS_LAM))[l * 2], oml = ((const float*)(a.ws + WS_LAM))[l * 2 + 1];
    const int gw = F.bid * NWAVES + F.wave, NGW = F.G * NWAVES, lane = F.lane;
    const float w0 = a.in[11][l * 128 + 2 * lane] * oml, w1 = a.in[11][l * 128 + 2 * lane + 1] * oml;
    const int NIT = (l == 0 ? T : NLAT) * 4;
    for (int it0 = gw; it0 < NIT; it0 += 4 * NGW) {
        unsigned p1[4], p2[4]; int rowv[4], hv_[4];
#pragma unroll
        for (int j = 0; j < 4; ++j) { const int it = min(it0 + j * NGW, NIT - 1); const int row = it >> 2, h = it & 3; int b, nd; row_to_bn(row, b, nd); rowv[j] = row; hv_[j] = h;
            p1[j] = *(const unsigned*)(OA2 + ((size_t)((b * 4 + h) * 2 + 0) * NKEY + nd) * 128 + 2 * lane); p2[j] = *(const unsigned*)(OA2 + ((size_t)((b * 4 + h) * 2 + 1) * NKEY + nd) * 128 + 2 * lane); }
#pragma unroll
        for (int j = 0; j < 4; ++j) { if (it0 + j * NGW < NIT) {
            const float x0 = bflo(p1[j]) - lam * bflo(p2[j]), x1 = bfhi(p1[j]) - lam * bfhi(p2[j]);
            const float rstd = rsqrtf(wave_sum(x0 * x0 + x1 * x1) * (1.0f / 128.0f) + EPS);
            *(unsigned*)(OA + (size_t)rowv[j] * 1536 + hv_[j] * 128 + 2 * lane) = pk2(x0 * rstd * w0, x1 * rstd * w1); } }
    }
}
__constant__ unsigned char PK_CAND[50] = {0,1,2,3,4,5,6,7,8,9,10,11,12,13,14,15, 16,17,18,19,20,21,22,23, 32,33,34,35,36, 48,49,50,51, 64,65,66, 80,81, 96,97, 112,113, 128, 144, 160, 176, 192, 208, 224, 240};
__device__ __forceinline__ void ce_desc(float& x, float& y) { float hi_, lo_; asm("v_max_f32_e32 %0, %1, %2" : "=v"(hi_) : "v"(x), "v"(y)); asm("v_min_f32_e32 %0, %1, %2" : "=v"(lo_) : "v"(x), "v"(y)); x = hi_; y = lo_; }
__device__ __forceinline__ void sort16_desc(float (&v)[16]) {
#pragma unroll
    for (int k = 2; k <= 16; k <<= 1)
#pragma unroll
        for (int j = k >> 1; j > 0; j >>= 1)
#pragma unroll
            for (int i = 0; i < 16; ++i) { const int p = i ^ j; if (p > i) { if ((i & k) == 0) ce_desc(v[i], v[p]); else ce_desc(v[p], v[i]); } }
}
__device__ __forceinline__ void merge16_desc(float (&t)[16], const float (&v)[16]) {
#pragma unroll
    for (int i = 0; i < 16; ++i) { float m; asm("v_max_f32_e32 %0, %1, %2" : "=v"(m) : "v"(t[i]), "v"(v[15 - i])); t[i] = m; }
#pragma unroll
    for (int j = 8; j > 0; j >>= 1)
#pragma unroll
        for (int i = 0; i < 16; ++i) { const int p = i ^ j; if (p > i) ce_desc(t[i], t[p]); }
}
__device__ __forceinline__ void ph_topk(const Args& a, Frame& F, int l) {
    const float* PQ = (const float*)(a.ws + WS_R1); int* EIDX = (int*)(a.ws + WS_EIDX); float* GW = (float*)(a.ws + WS_GW);
    LAS unsigned char* KH = F.lds; LAS unsigned char* KLo = F.lds + 32768;
    LAS unsigned* XV = (LAS unsigned*)(F.lds + 65536);
    const int tid = F.tid, lane = F.lane, wave = F.wave;
    int cur_h = -1;
    for (int u = F.bid; u < ((l == 0 ? T : NLAT) / 256) * 8; u += F.G) {
        const int h = u & 7, t0 = (u >> 3) * 256;
        if (h != cur_h) { __syncthreads(); const float* ks = a.in[23] + ((size_t)l * 8 + h) * 2 * 128 * 64;
#pragma unroll
            for (int i = 0; i < 4; ++i) { const int ch = tid + 512 * i, krow = ch >> 3, c8 = ch & 7;
                const f32x4 x0 = *(const f32x4*)(ks + (size_t)krow * 64 + c8 * 8), x1 = *(const f32x4*)(ks + (size_t)krow * 64 + c8 * 8 + 4);
                float xs[8] = {x0[0], x0[1], x0[2], x0[3], x1[0], x1[1], x1[2], x1[3]}; unsigned hw[8], lw[8];
#pragma unroll
                for (int j = 0; j < 8; ++j) { hw[j] = f2bf(xs[j]); lw[j] = f2bf(xs[j] - __uint_as_float(hw[j] << 16)); }
                const int off = krow * 128 + ((c8 * 16) ^ ((krow & 7) << 4));
                *(LAS v4u*)(KH + off) = (v4u){hw[0] | (hw[1] << 16), hw[2] | (hw[3] << 16), hw[4] | (hw[5] << 16), hw[6] | (hw[7] << 16)};
                *(LAS v4u*)(KLo + off) = (v4u){lw[0] | (lw[1] << 16), lw[2] | (lw[3] << 16), lw[4] | (lw[5] << 16), lw[6] | (lw[7] << 16)}; }
            cur_h = h; __syncthreads(); }
        {
            const int r32 = lane & 31, hp = lane >> 5; const float* qp = PQ + (size_t)(t0 + 32 * wave + r32) * 1024 + h * 128 + hp * 8;
#pragma unroll
            for (int half = 0; half < 2; ++half) {
                bf16x8 bqh[4], bql[4];
#pragma unroll
                for (int ks = 0; ks < 4; ++ks) { const f32x4 x0 = *(const f32x4*)(qp + half * 64 + ks * 16), x1 = *(const f32x4*)(qp + half * 64 + ks * 16 + 4);
                    float xs[8] = {x0[0], x0[1], x0[2], x0[3], x1[0], x1[1], x1[2], x1[3]}; unsigned hw[8], lw[8];
#pragma unroll
                    for (int j = 0; j < 8; ++j) { hw[j] = f2bf(xs[j]); lw[j] = f2bf(xs[j] - __uint_as_float(hw[j] << 16)); }
                    bqh[ks] = __builtin_bit_cast(bf16x8, (v4u){hw[0] | (hw[1] << 16), hw[2] | (hw[3] << 16), hw[4] | (hw[5] << 16), hw[6] | (hw[7] << 16)});
                    bql[ks] = __builtin_bit_cast(bf16x8, (v4u){lw[0] | (lw[1] << 16), lw[2] | (lw[3] << 16), lw[4] | (lw[5] << 16), lw[6] | (lw[7] << 16)}); }
                float tv[16];
#pragma unroll
                for (int kt = 0; kt < 4; ++kt) {
                    f32x16 acc;
#pragma unroll
                    for (int r = 0; r < 16; ++r) acc[r] = 0.f;
                    const int krow = half * 128 + kt * 32 + r32;
#pragma unroll
                    for (int ks = 0; ks < 4; ++ks) { const int off = krow * 128 + ((32 * ks + 16 * hp) ^ ((krow & 7) << 4));
                        const bf16x8 ah = *(const LAS bf16x8*)(KH + off), al = *(const LAS bf16x8*)(KLo + off);
                        acc = __builtin_amdgcn_mfma_f32_32x32x16_bf16(ah, bqh[ks], acc, 0, 0, 0);
                        acc = __builtin_amdgcn_mfma_f32_32x32x16_bf16(al, bqh[ks], acc, 0, 0, 0);
                        acc = __builtin_amdgcn_mfma_f32_32x32x16_bf16(ah, bql[ks], acc, 0, 0, 0); }
                    float v[16];
#pragma unroll
                    for (int r = 0; r < 16; ++r) { const unsigned key = (unsigned)(32 * kt + (r & 3) + 8 * (r >> 2)) | (unsigned)(4 * hp); v[r] = __uint_as_float((__float_as_uint(acc[r]) & 0xffffff80u) | (127u - key)); }
                    sort16_desc(v);
                    if (kt == 0) {
#pragma unroll
                        for (int r = 0; r < 16; ++r) tv[r] = v[r]; }
                    else merge16_desc(tv, v);
                }
                float pv[16];
#pragma unroll
                for (int r = 0; r < 16; ++r) pv[r] = __shfl_xor(tv[r], 32);
                merge16_desc(tv, pv);
                if (hp == 0) { LAS unsigned* xo = XV + ((32 * wave + r32) * 2 + half) * 16;
#pragma unroll
                    for (int j = 0; j < 16; j += 4) *(LAS v4u*)(xo + j) = (v4u){__float_as_uint(tv[j]), __float_as_uint(tv[j + 1]), __float_as_uint(tv[j + 2]), __float_as_uint(tv[j + 3])}; }
            }
        }
        __syncthreads();
        if (tid < 256) {
            const int tok = tid; const LAS unsigned* xa = XV + (tok * 2) * 16; const LAS unsigned* xb = xa + 16;
            float fv[16];
#pragma unroll
            for (int r = 0; r < 16; ++r) fv[r] = -INFINITY;
            for (int ci = 0; ci < 50; ++ci) {
                const unsigned c = PK_CAND[ci];
                const float sm = __uint_as_float(xa[c >> 4] & 0xffffff80u) + __uint_as_float(xb[c & 15] & 0xffffff80u);
                float v = __uint_as_float((__float_as_uint(sm) & 0xffffff00u) | (255u - c));
#pragma unroll
                for (int r = 0; r < 16; ++r) { float hi_, lo_; asm("v_max_f32_e32 %0, %1, %2" : "=v"(hi_) : "v"(fv[r]), "v"(v)); asm("v_min_f32_e32 %0, %1, %2" : "=v"(lo_) : "v"(fv[r]), "v"(v)); fv[r] = hi_; v = lo_; }
            }
            float val[16]; int ex[16]; float mx = -INFINITY;
#pragma unroll
            for (int r = 0; r < 16; ++r) { const unsigned c = 255u - (__float_as_uint(fv[r]) & 255u); const unsigned ia = xa[c >> 4], ib = xb[c & 15];
                val[r] = __uint_as_float(ia & 0xffffff80u) + __uint_as_float(ib & 0xffffff80u); ex[r] = (int)((127u - (ia & 127u)) * 128u + (127u - (ib & 127u))); mx = fmaxf(mx, val[r]); }
            float sum = 0.f;
#pragma unroll
            for (int r = 0; r < 16; ++r) { val[r] = __expf(val[r] - mx); sum += val[r]; }
            const float inv = 1.0f / sum;
            int* eo = EIDX + (size_t)(t0 + tok) * 128 + h * 16; float* go = GW + (size_t)(t0 + tok) * 128 + h * 16;
#pragma unroll
            for (int r = 0; r < 16; r += 4) { *(v4u*)(eo + r) = (v4u){(unsigned)ex[r], (unsigned)ex[r + 1], (unsigned)ex[r + 2], (unsigned)ex[r + 3]};
                *(f32x4*)(go + r) = (f32x4){val[r] * inv, val[r + 1] * inv, val[r + 2] * inv, val[r + 3] * inv}; }
        }
        __syncthreads();
    }
}
__device__ __forceinline__ void fp8x16_to_f32(const v4u w, float (&f)[16]) {
#pragma unroll
    for (int q = 0; q < 4; ++q) { const auto lo = __builtin_amdgcn_cvt_pk_f32_fp8((int)w[q], false); const auto hi = __builtin_amdgcn_cvt_pk_f32_fp8((int)w[q], true);
        f[4 * q] = lo[0]; f[4 * q + 1] = lo[1]; f[4 * q + 2] = hi[0]; f[4 * q + 3] = hi[1]; }
}
__device__ __forceinline__ void xp_sort128(int& e_a, int& e_b, float& g_a, float& g_b, int lane) {
    asm volatile("" : "+v"(lane));
    unsigned a0 = ((unsigned)e_a << 7) | (unsigned)lane, a1 = ((unsigned)e_b << 7) | (unsigned)(64 + lane);
#pragma unroll
    for (int k = 2; k <= 128; k <<= 1) {
#pragma unroll
        for (int j = k >> 1; j >= 1; j >>= 1) {
            if (j == 64) { const unsigned lo = min(a0, a1), hi = max(a0, a1); a0 = lo; a1 = hi; }
            else {
                const bool lower = (lane & j) == 0;
                const bool asc0 = k >= 64 ? true : ((lane & k) == 0), asc1 = k == 64 ? false : (k == 128 ? true : ((lane & k) == 0));
                const unsigned o0 = (unsigned)__shfl_xor((int)a0, j), o1 = (unsigned)__shfl_xor((int)a1, j);
                a0 = (lower == asc0) ? min(a0, o0) : max(a0, o0); a1 = (lower == asc1) ? min(a1, o1) : max(a1, o1);
            }
        }
    }
    const int i0 = (int)(a0 & 127u), i1 = (int)(a1 & 127u);
    const float ga0 = __shfl(g_a, i0 & 63), gb0 = __shfl(g_b, i0 & 63), ga1 = __shfl(g_a, i1 & 63), gb1 = __shfl(g_b, i1 & 63);
    e_a = (int)(a0 >> 7); e_b = (int)(a1 >> 7); g_a = i0 < 64 ? ga0 : gb0; g_b = i1 < 64 ? ga1 : gb1;
}
template <int CTRL> __device__ __forceinline__ float dpp_f(float v) { return __builtin_bit_cast(float, __builtin_amdgcn_update_dpp(0, __builtin_bit_cast(int, v), CTRL, 0xf, 0xf, false)); }
#define XP_PAIRS(KB, KE) do { for (int k0 = (KB); k0 < (KE); k0 += 8) { \
            v3u uw[8], vw[8]; const int kk = k0 & 63; const int esel = k0 < 64 ? e_a : e_b; const float gsel = k0 < 64 ? g_a : g_b, ssel = k0 < 64 ? su_a : su_b; \
            _Pragma("unroll") for (int j = 0; j < 8; ++j) { const int so_ = __builtin_amdgcn_readlane(esel, kk + j) * ROW6;     \
                uw[j] = __builtin_bit_cast(v3u, __builtin_amdgcn_raw_buffer_load_b96(rU, voff, so_, 0)); vw[j] = __builtin_bit_cast(v3u, __builtin_amdgcn_raw_buffer_load_b96(rV, voff, so_, 0)); } \
            const float gv = __shfl(gsel, kk + (lane >> 3)), suv = __shfl(ssel, kk + (lane >> 3)); \
            float d[8]; \
            _Pragma("unroll") for (int j = 0; j < 8; j += 2) { const v6u pk = {uw[j].x, uw[j].y, uw[j].z, uw[j + 1].x, uw[j + 1].y, uw[j + 1].z}; const v32f r = __builtin_amdgcn_cvt_scalef32_pk32_f32_fp6(pk, 1.0f); \
                f32x2 s0 = {0.f, 0.f}, s1 = {0.f, 0.f}; \
                _Pragma("unroll") for (int i = 0; i < 8; ++i) { s0 = __builtin_elementwise_fma((f32x2){r[2 * i], r[2 * i + 1]}, hx2[i], s0); s1 = __builtin_elementwise_fma((f32x2){r[16 + 2 * i], r[17 + 2 * i]}, hx2[i], s1); } \
                d[j] = s0.x + s0.y; d[j + 1] = s1.x + s1.y; __builtin_amdgcn_sched_barrier(0); } \
            float e4[4], f2[2]; \
            _Pragma("unroll") for (int j = 0; j < 4; ++j) { const auto r = __builtin_amdgcn_permlane32_swap(__float_as_uint(d[j]), __float_as_uint(d[j + 4]), false, false); e4[j] = __uint_as_float(r[0]) + __uint_as_float(r[1]); } \
            _Pragma("unroll") for (int j = 0; j < 2; ++j) { const auto r = __builtin_amdgcn_permlane16_swap(__float_as_uint(e4[j]), __float_as_uint(e4[j + 2]), false, false); f2[j] = __uint_as_float(r[0]) + __uint_as_float(r[1]); } \
            const bool b3 = (lane & 8) != 0; \
            float zs = (b3 ? f2[1] : f2[0]) + dpp_f<0x128>(b3 ? f2[0] : f2[1]);     \
            zs += dpp_f<0xB1>(zs); zs += dpp_f<0x4E>(zs); zs += dpp_f<0x141>(zs);     \
            const float z = zs * suv; const float actv = 0.5f * z * (1.0f + erff(z * 0.70710678118654752f)) * gv; \
            _Pragma("unroll") for (int j = 0; j < 8; j += 2) { const float act0 = __int_as_float(__builtin_amdgcn_readlane(__float_as_int(actv), 8 * j)), act1 = __int_as_float(__builtin_amdgcn_readlane(__float_as_int(actv), 8 * j + 8)); \
                const f32x2 a0 = {act0, act0}, a1 = {act1, act1}; \
                const v6u pk = {vw[j].x, vw[j].y, vw[j].z, vw[j + 1].x, vw[j + 1].y, vw[j + 1].z}; const v32f r = __builtin_amdgcn_cvt_scalef32_pk32_f32_fp6(pk, 1.0f); \
                _Pragma("unroll") for (int i = 0; i < 8; ++i) acc2[i] = __builtin_elementwise_fma((f32x2){r[2 * i], r[2 * i + 1]}, a0, acc2[i]); \
                __builtin_amdgcn_sched_barrier(0);     \
                _Pragma("unroll") for (int i = 0; i < 8; ++i) acc2[i] = __builtin_elementwise_fma((f32x2){r[16 + 2 * i], r[17 + 2 * i]}, a1, acc2[i]); \
                __builtin_amdgcn_sched_barrier(0); } } } while (0)
#define XP_UNPACK float acc[16]; _Pragma("unroll") for (int i = 0; i < 8; ++i) { acc[2 * i] = acc2[i].x; acc[2 * i + 1] = acc2[i].y; }
#define XP_LOAD_ROW(ROW) \
        f32x2 hx2[8]; f32x4 xrow[4];     \
        { const int mi_ = mod_index(ROW); const float* sh_ = MOD - 5120 + mi_ * 6144 + 3072; const float* sc_ = sh_ + 1024; float ss_ = 0.f; \
          _Pragma("unroll") for (int q = 0; q < 4; ++q) { xrow[q] = *(const f32x4*)(X + (size_t)(ROW) * DM + 16 * lane + 4 * q); ss_ += (xrow[q][0] * xrow[q][0] + xrow[q][1] * xrow[q][1]) + (xrow[q][2] * xrow[q][2] + xrow[q][3] * xrow[q][3]); } \
          const float rs_ = rsqrtf(wave_sum(ss_) * (1.0f / DM) + EPS); \
          _Pragma("unroll") for (int q = 0; q < 4; ++q) { const f32x4 s1_ = *(const f32x4*)(sc_ + 16 * lane + 4 * q), s0_ = *(const f32x4*)(sh_ + 16 * lane + 4 * q); const f32x4 h_ = xrow[q] * rs_ * (s1_ + 1.0f) + s0_; \
              hx2[2 * q] = (f32x2){h_[0], h_[1]}; hx2[2 * q + 1] = (f32x2){h_[2], h_[3]}; } } \
        int e_a = EIDX[(size_t)(ROW) * 128 + lane], e_b = EIDX[(size_t)(ROW) * 128 + 64 + lane]; \
        float g_a = GW[(size_t)(ROW) * 128 + lane], g_b = GW[(size_t)(ROW) * 128 + 64 + lane]; \
        xp_sort128(e_a, e_b, g_a, g_b, lane); \
        const float su_a = SU[e_a], su_b = SU[e_b]; g_a *= SV[e_a]; g_b *= SV[e_b];     \
        f32x2 acc2[8]; \
        _Pragma("unroll") for (int i = 0; i < 8; ++i) acc2[i] = (f32x2){0.f, 0.f};
#define XP_EPILOGUE(ROW) do { \
        const int mi = mod_index(ROW); const float* g2 = MOD + mi * 6144; float* xr = X + (size_t)(ROW) * DM + 16 * lane; \
        f32x4 xn[4]; float ss = 0.f; \
        _Pragma("unroll") for (int q = 0; q < 4; ++q) { const f32x4 g = *(const f32x4*)(g2 + 16 * lane + 4 * q); f32x4 x = xrow[q]; \
            x[0] += g[0] * acc[4 * q]; x[1] += g[1] * acc[4 * q + 1]; x[2] += g[2] * acc[4 * q + 2]; x[3] += g[3] * acc[4 * q + 3]; \
            xn[q] = x; ss += (x[0] * x[0] + x[1] * x[1]) + (x[2] * x[2] + x[3] * x[3]); } \
        const float rstd = rsqrtf(wave_sum(ss) * (1.0f / DM) + EPS); \
        if (l == 0) {     \
            const float* sh = (const float*)(a.ws + WS_MOD) + (size_t)(3 + mi) * 6144; const float* sc = sh + 1024; bf16* hxo = (bf16*)(a.ws + WS_HX) + (size_t)(ROW) * DM + 16 * lane; \
            _Pragma("unroll") for (int q = 0; q < 4; ++q) { *(f32x4*)(xr + 4 * q) = xn[q]; const f32x4 s1 = *(const f32x4*)(sc + 16 * lane + 4 * q), s0 = *(const f32x4*)(sh + 16 * lane + 4 * q); \
                const f32x4 hh = xn[q] * rstd * (s1 + 1.0f) + s0; u32x2 o; o.x = pk2(hh[0], hh[1]); o.y = pk2(hh[2], hh[3]); *(u32x2*)(hxo + 4 * q) = o; } \
        } else if ((ROW) < NLAT) {     \
            _Pragma("unroll") for (int q = 0; q < 4; ++q) *(f32x4*)(a.out + (size_t)(ROW) * DM + 16 * lane + 4 * q) = xn[q] * rstd * *(const f32x4*)(a.in[26] + 16 * lane + 4 * q); \
        } } while (0)
__device__ __forceinline__ void ph_expert(const Args& a, Frame& F, int l) {
    const __amdgpu_buffer_rsrc_t rU = __builtin_amdgcn_make_buffer_rsrc((void*)(a.ws + WS_U16), (short)0, 16384 * ROW6, 0x00020000), rV = __builtin_amdgcn_make_buffer_rsrc((void*)(a.ws + WS_V16), (short)0, 16384 * ROW6, 0x00020000);
    const float* SU = (const float*)(a.ws + WS_SU); const float* SV = (const float*)(a.ws + WS_SV);
    const int* EIDX = (const int*)(a.ws + WS_EIDX); const float* GW = (const float*)(a.ws + WS_GW); float* X = (float*)(a.ws + WS_X);
    const float* MOD = (const float*)(a.ws + WS_MOD) + (size_t)l * 3 * 6144 + 5120;
    const int gw = F.bid * NWAVES + F.wave, NGW = F.G * NWAVES, lane = F.lane; const int voff = 12 * lane;
    for (int row = gw; row < NLAT; row += NGW) {
        XP_LOAD_ROW(row)
        XP_PAIRS(0, 128);
        XP_UNPACK
        XP_EPILOGUE(row);
    }
    if (l == 0) {
        LAS float* PART = (LAS float*)F.lds;
        for (int r0 = NLAT + 2 * F.bid; r0 < T; r0 += 2 * F.G) {
            const int row = min(r0 + (F.wave >> 2), T - 1), qd = F.wave & 3;
            XP_LOAD_ROW(row)
            XP_PAIRS(32 * qd, 32 * qd + 32);
            XP_UNPACK
#pragma unroll
            for (int q = 0; q < 4; ++q) *(LAS f32x4*)(PART + F.wave * 1024 + 16 * lane + 4 * q) = (f32x4){acc[4 * q], acc[4 * q + 1], acc[4 * q + 2], acc[4 * q + 3]};
            __syncthreads();
            if (qd == 0 && r0 + (F.wave >> 2) < T) {
#pragma unroll
                for (int w_ = 1; w_ < 4; ++w_)
#pragma unroll
                    for (int q = 0; q < 4; ++q) { const f32x4 p = *(const LAS f32x4*)(PART + (F.wave + w_) * 1024 + 16 * lane + 4 * q); acc[4 * q] += p[0]; acc[4 * q + 1] += p[1]; acc[4 * q + 2] += p[2]; acc[4 * q + 3] += p[3]; }
                XP_EPILOGUE(row);
            }
            __syncthreads();
        }
    }
}
#undef XP_PAIRS
#undef XP_UNPACK
#undef XP_LOAD_ROW
#undef XP_EPILOGUE
__device__ __forceinline__ void ph_final(const Args& a, Frame& F) {
    const float* X = (const float*)(a.ws + WS_X); const float* fw = a.in[26];
    const int gw = F.bid * NWAVES + F.wave, NGW = F.G * NWAVES;
    for (int row = gw; row < NLAT; row += NGW) {
        const f32x4* xr = (const f32x4*)(X + (size_t)row * DM) + F.lane; f32x4 v[4]; float ss = 0.f;
#pragma unroll
        for (int j = 0; j < 4; ++j) { v[j] = xr[64 * j]; ss += (v[j][0] * v[j][0] + v[j][1] * v[j][1]) + (v[j][2] * v[j][2] + v[j][3] * v[j][3]); }
        const float rstd = rsqrtf(wave_sum(ss) * (1.0f / DM) + EPS);
#pragma unroll
        for (int j = 0; j < 4; ++j) { const int c = 4 * F.lane + 256 * j; *(f32x4*)(a.out + (size_t)row * DM + c) = v[j] * rstd * *(const f32x4*)(fw + c); }
    }
}
__device__ __forceinline__ f32x16 small_tile_mma(const bf16* A, int lda, const bf16* Bt, int ldb, int K, int lane) {
    const int r32 = lane & 31, hp = lane >> 5;
    const bf16* ap = A + (size_t)r32 * lda + 8 * hp; const bf16* bp = Bt + (size_t)r32 * ldb + 8 * hp;
    f32x16 acc;
#pragma unroll
    for (int r = 0; r < 16; ++r) acc[r] = 0.f;
#pragma unroll 1
    for (int k0 = 0; k0 < K; k0 += 128) {
        bf16x8 af[8], bfr[8];
#pragma unroll
        for (int s_ = 0; s_ < 8; ++s_) { af[s_] = *(const bf16x8*)(ap + k0 + 16 * s_); bfr[s_] = *(const bf16x8*)(bp + k0 + 16 * s_); }
#pragma unroll
        for (int s_ = 0; s_ < 8; ++s_) acc = __builtin_amdgcn_mfma_f32_32x32x16_bf16(af[s_], bfr[s_], acc, 0, 0, 0);
    }
    return acc;
}
__device__ __forceinline__ void ph_biasq(const Args& a, Frame& F, int l) {
    const bf16* Wq = (const bf16*)(a.ws + WS_WQ); const float* MOD = (const float*)(a.ws + WS_MOD) + (size_t)l * 3 * 6144 + 3072; float* BQ = (float*)(a.ws + WS_BQ) + l * 3 * 1024;
    const int gw = F.bid * NWAVES + F.wave, NGW = F.G * NWAVES, lane = F.lane;
    for (int it = gw; it < 3 * 1024; it += NGW) { const int mi = it >> 10, n = it & 1023;
        const v4u w0 = *(const v4u*)(Wq + (size_t)n * 1024 + 16 * lane), w1 = *(const v4u*)(Wq + (size_t)n * 1024 + 16 * lane + 8); const f32x4* sp = (const f32x4*)(MOD + mi * 6144 + 16 * lane);
        const f32x4 a0 = sp[0], a1 = sp[1], a2 = sp[2], a3 = sp[3];
        float v = (a0[0] * bflo(w0.x) + a0[1] * bfhi(w0.x)) + (a0[2] * bflo(w0.y) + a0[3] * bfhi(w0.y)) + (a1[0] * bflo(w0.z) + a1[1] * bfhi(w0.z)) + (a1[2] * bflo(w0.w) + a1[3] * bfhi(w0.w))
                + (a2[0] * bflo(w1.x) + a2[1] * bfhi(w1.x)) + (a2[2] * bflo(w1.y) + a2[3] * bfhi(w1.y)) + (a3[0] * bflo(w1.z) + a3[1] * bfhi(w1.z)) + (a3[2] * bflo(w1.w) + a3[3] * bfhi(w1.w));
        v = wave_sum(v); if (lane == 0) BQ[mi * 1024 + n] = v; }
}
__device__ __forceinline__ void ctx_small_q(const Args& a, Frame& F) {
    unsigned char* ws = a.ws; const int lane = F.lane, r32 = lane & 31, hp = lane >> 5; constexpr int AP = 1032;
    LAS unsigned short* A32 = (LAS unsigned short*)F.lds;
    const float* X = (const float*)(ws + WS_X); const float* sh = (const float*)(ws + WS_MOD) + 2 * 6144 + 3072; const float* sc = sh + 1024;
    for (int t0 = F.bid * 2; t0 < 512; t0 += F.G * 2) {
        const int row0 = NLAT + 32 * (t0 >> 5);
#pragma unroll
        for (int q = 0; q < 4; ++q) { const int rl = F.wave * 4 + q; const f32x4* xr = (const f32x4*)(X + (size_t)(row0 + rl) * DM) + lane; f32x4 v[4]; float ss = 0.f;
#pragma unroll
            for (int j = 0; j < 4; ++j) { v[j] = xr[64 * j]; ss += (v[j][0] * v[j][0] + v[j][1] * v[j][1]) + (v[j][2] * v[j][2] + v[j][3] * v[j][3]); }
            const float rstd = rsqrtf(wave_sum(ss) * (1.0f / DM) + EPS);
#pragma unroll
            for (int j = 0; j < 4; ++j) { const int c = 4 * lane + 256 * j; const f32x4 s1 = *(const f32x4*)(sc + c), s0 = *(const f32x4*)(sh + c); const f32x4 h = v[j] * rstd * (s1 + 1.0f) + s0;
                u32x2 o; o.x = pk2(h[0], h[1]); o.y = pk2(h[2], h[3]); *(LAS u32x2*)(A32 + rl * AP + c) = o; } }
        __syncthreads();
        if (F.wave < 2 && t0 + F.wave < 512) { const int col0 = 32 * ((t0 + F.wave) & 31);
            const LAS unsigned short* ap = A32 + r32 * AP + 8 * hp; const bf16* bp = (const bf16*)(ws + WS_WQ) + (size_t)(col0 + r32) * 1024 + 8 * hp;
            f32x16 acc;
#pragma unroll
            for (int r = 0; r < 16; ++r) acc[r] = 0.f;
#pragma unroll 1
            for (int k0 = 0; k0 < 1024; k0 += 128) { bf16x8 af[8], bfr[8];
#pragma unroll
                for (int s_ = 0; s_ < 8; ++s_) { af[s_] = *(const LAS bf16x8*)(ap + k0 + 16 * s_); bfr[s_] = *(const bf16x8*)(bp + k0 + 16 * s_); }
#pragma unroll
                for (int s_ = 0; s_ < 8; ++s_) acc = __builtin_amdgcn_mfma_f32_32x32x16_bf16(af[s_], bfr[s_], acc, 0, 0, 0); }
            float* PQ = (float*)(ws + WS_R1);
#pragma unroll
            for (int r = 0; r < 16; ++r) { const int row = row0 + (r & 3) + 8 * (r >> 2) + 4 * hp; PQ[(size_t)row * 1024 + col0 + r32] = acc[r]; } }
        __syncthreads();
    }
}
__device__ __forceinline__ void ctx_small(const Args& a, Frame& F, int which  ) {
    if (F.wave >= 2) return;
    unsigned char* ws = a.ws; const int lane = F.lane, r32 = lane & 31, hp = lane >> 5;
    for (int tile = F.bid * 2 + F.wave; tile < 512; tile += F.G * 2) {
        const int row0 = NLAT + 32 * (tile >> 5), col0 = 32 * (tile & 31);
        if (which == 2) {
            const bf16* OABC = (const bf16*)(ws + WS_OABC); const bf16* Wcat = (const bf16*)(ws + WS_WA); const bf16* gate = (const bf16*)(ws + WS_R3) + 1024; bf16* Mb = (bf16*)(ws + WS_MB);
            float macc[16];
#pragma unroll
            for (int r = 0; r < 16; ++r) macc[r] = 0.f;
            for (int br = 0; br < 3; ++br) {
                const f32x16 acc = small_tile_mma(OABC + (size_t)row0 * 1536 + 512 * br, 1536, Wcat + (size_t)col0 * 1536 + 512 * br, 1536, 512, lane);
#pragma unroll
                for (int r = 0; r < 16; ++r) { const int row = row0 + (r & 3) + 8 * (r >> 2) + 4 * hp; macc[r] += sigm(bf2f(gate[(size_t)row * NPXB + 1024 * br + col0 + r32])) * acc[r]; }
            }
#pragma unroll
            for (int r = 0; r < 16; ++r) { const int row = row0 + (r & 3) + 8 * (r >> 2) + 4 * hp; Mb[(size_t)row * 1024 + col0 + r32] = (unsigned short)f2bf(macc[r]); }
        } else if (which == 3) {
            const f32x16 acc = small_tile_mma((const bf16*)(ws + WS_MB) + (size_t)row0 * 1024, 1024, (const bf16*)(ws + WS_WO) + (size_t)col0 * 1024, 1024, 1024, lane);
            const float g1 = ((const float*)(ws + WS_MOD))[2 * 6144 + 2048 + col0 + r32]; float* X = (float*)(ws + WS_X);
#pragma unroll
            for (int r = 0; r < 16; ++r) { const int row = row0 + (r & 3) + 8 * (r >> 2) + 4 * hp; X[(size_t)row * 1024 + col0 + r32] = a.in[2][(size_t)(row - NLAT) * 1024 + col0 + r32] + g1 * acc[r]; }
        } else {
            const f32x16 acc = small_tile_mma((const bf16*)(ws + WS_HX) + (size_t)row0 * 1024, 1024, (const bf16*)(ws + WS_WQ) + (size_t)col0 * 1024, 1024, 1024, lane);
            float* PQ = (float*)(ws + WS_R1);
#pragma unroll
            for (int r = 0; r < 16; ++r) { const int row = row0 + (r & 3) + 8 * (r >> 2) + 4 * hp; PQ[(size_t)row * 1024 + col0 + r32] = acc[r]; }
        }
    }
}
#define GEMM_RUN(EPI, g, E) do { pg8::StaticOrder S_; S_.init((g).M, (g).N, F.G, F.bid); pg8::gemm_phase<EPI, pg8::StaticOrder, true, true>(F.lds, g, S_, E); } while (0)

constexpr int N_PHASES = 25;
#ifndef MK_ONE_LAUNCH
#define MK_ONE_LAUNCH 1
#endif
__global__ void __launch_bounds__(NWAVES * 64, 2) mk_fwd(Args args) {
    extern __shared__ __attribute__((aligned(16))) unsigned char lds_raw[];
    Frame F;
    F.lds = (LAS unsigned char*)lds_raw; F.MISC = (volatile LAS unsigned*)(F.lds + MISC_OFF);
    F.tid = threadIdx.x; F.lane = F.tid & 63; F.wave = __builtin_amdgcn_readfirstlane(F.tid >> 6); F.G = gridDim.x; F.bid = blockIdx.x;
    F.ctl = (gu32*)(args.ws + WS_CTL);
    for (int u = F.tid; u < (LDS_BYTES - LDSCTL_OFF) / 4; u += NWAVES * 64) ((LAS unsigned*)(F.lds + LDSCTL_OFF))[u] = 0u;
    __syncthreads();
    XcdBarrier bar; bar.bar = (unsigned*)(F.ctl + CW_BAR); bar.x = 0; bar.st = nullptr;
    const bool multi = (args.ph_hi - args.ph_lo) > 1;
    if (multi) bar = xcd_barrier_post((unsigned*)(F.ctl + CW_BAR), F.MISC + 8);
    unsigned char* ws = args.ws;
    const int lo = args.ph_lo, hi = args.ph_hi;
    if (PROBE_MASK != 0ull) { if (F.tid == 0) { const unsigned long long now_ = __builtin_amdgcn_s_memrealtime(); F.MISC[16] = (unsigned)now_; F.MISC[17] = (unsigned)(now_ >> 32); } __syncthreads(); }
#define IN(k) (lo <= (k) && (k) < hi)
#define SEAM(k) do { if (IN(k) && IN((k) + 1)) { xcd_barrier(bar); \
    if (PROBE_MASK != 0ull) { if (F.tid == 0) { unsigned long long now_ = __builtin_amdgcn_s_memrealtime(); const unsigned long long prev_ = ((unsigned long long)F.MISC[17] << 32) | F.MISC[16]; \
        if ((PROBE_MASK >> (k)) & 1ull) { const unsigned long long until_ = now_ + PROBE_AMP * (now_ - prev_); while (__builtin_amdgcn_s_memrealtime() < until_) __builtin_amdgcn_s_sleep(32); now_ = __builtin_amdgcn_s_memrealtime(); } \
        F.MISC[16] = (unsigned)now_; F.MISC[17] = (unsigned)(now_ >> 32); } __syncthreads(); } } } while (0)
#ifndef ONLY_PHASE
#define ONLY_PHASE(s) 1
#endif
#define LAYER(l, B) \
    if (ONLY_PHASE(1) && IN((B) + 1) && (l) == 0) { ph_mod(args, F, l, 0); } if ((l) == 0) SEAM((B) + 1); \
    if (ONLY_PHASE(2) && IN((B) + 2)) { pg8::Gemm g{(const pg8::bf16_t*)(ws + WS_HX), (const pg8::bf16_t*)(ws + WS_WIN), T, INC, DM}; pg8::EpiG1 E{(pg8::bf16_t*)(ws + WS_R1), (pg8::bf16_t*)(ws + WS_R3)}; GEMM_RUN(pg8::EpiG1, g, E); } SEAM((B) + 2); \
    if (ONLY_PHASE(3) && IN((B) + 3)) { ph_post(args, F, l); } SEAM((B) + 3); \
    if (ONLY_PHASE(4) && IN((B) + 4)) { ph_attn(args, F, l, (char*)lds_raw); } SEAM((B) + 4); \
    if (ONLY_PHASE(5) && IN((B) + 5)) { ph_comb(args, F, l); } SEAM((B) + 5); \
    if (ONLY_PHASE(6) && IN((B) + 6)) { const pg8::bf16_t* gate = (const pg8::bf16_t*)(ws + WS_R3) + 1024; \
        if ((l) == 0) ctx_small(args, F, 2); \
        pg8::Gemm g{(const pg8::bf16_t*)(ws + WS_OABC), (const pg8::bf16_t*)(ws + WS_WA), NLAT, DM, 1536}; pg8::EpiG2 E{gate + 2048, (pg8::bf16_t*)(ws + WS_MB)}; pg8::MidG2 Mh{gate}; \
        { pg8::StaticOrder S_; S_.init(g.M, g.N, F.G, F.bid); pg8::gemm_phase<pg8::EpiG2, pg8::StaticOrder, true, true, pg8::MidG2>(F.lds, g, S_, E, Mh); } } SEAM((B) + 6); \
    if (ONLY_PHASE(7) && IN((B) + 7)) { ph_biasq(args, F, l); if ((l) == 0) ctx_small(args, F, 3); pg8::Gemm g{(const pg8::bf16_t*)(ws + WS_MB), (const pg8::bf16_t*)(ws + WS_WO), NLAT, DM, DM}; pg8::EpiG3 E{(float*)(ws + WS_X), (l) == 0 ? args.in[0] : (const float*)(ws + WS_X), (const float*)(ws + WS_MOD) + (size_t)(l) * 3 * 6144 + 2048, (pg8::bf16_t*)(ws + WS_HX), (const float*)(ws + WS_MOD) + (size_t)(l) * 3 * 6144 + 4096, (float*)(ws + WS_SSQ)}; GEMM_RUN(pg8::EpiG3, g, E); } SEAM((B) + 7); \
    if (ONLY_PHASE(9) && IN((B) + 9)) { if ((l) == 0) ctx_small_q(args, F); pg8::Gemm g{(const pg8::bf16_t*)(ws + WS_HX), (const pg8::bf16_t*)(ws + WS_WQ), NLAT, DM, DM}; pg8::EpiG4 E{(float*)(ws + WS_R1), (const float*)(ws + WS_SSQ), (const float*)(ws + WS_BQ) + (l) * 3 * 1024}; GEMM_RUN(pg8::EpiG4, g, E); } SEAM((B) + 9); \
    if (ONLY_PHASE(10) && IN((B) + 10)) { ph_topk(args, F, l); } SEAM((B) + 10); \
    if (ONLY_PHASE(11) && IN((B) + 11)) { ph_expert(args, F, l); } if ((l) == 0) SEAM((B) + 11);

    if (ONLY_PHASE(0) && IN(0)) { ph_prep0(args, F); ph_convw(args, F, 0); } SEAM(0);
    LAYER(0, 0)
    if (ONLY_PHASE(12) && IN(12)) { ph_convw(args, F, 1); } SEAM(12);
    LAYER(1, 12)
    if (PROBE_MASK != 0ull && ((PROBE_MASK >> 23) & 1ull) && IN(23)) { __syncthreads(); if (F.tid == 0) { const unsigned long long now_ = __builtin_amdgcn_s_memrealtime(); const unsigned long long prev_ = ((unsigned long long)F.MISC[17] << 32) | F.MISC[16];
        const unsigned long long until_ = now_ + PROBE_AMP * (now_ - prev_); while (__builtin_amdgcn_s_memrealtime() < until_) __builtin_amdgcn_s_sleep(32); } __syncthreads(); }
#undef IN
#undef SEAM
}

extern "C" void kernel_launch(void* const* d_in, const int* in_sizes, int n_in, void* d_out, int out_size, void* d_ws, size_t ws_size, hipStream_t stream) {
    static int grid = 0;
    if (grid == 0) {
        if (n_in != 27 || out_size != NLAT * DM || ws_size < WS_END) { fprintf(stderr, "kernel_launch: unexpected shapes (n_in %d, out %d, ws %zu)\n", n_in, out_size, ws_size); grid = -1; return; }
        int dev = 0, cus = 0, per_cu = 0;
        if (hipGetDevice(&dev) != hipSuccess || hipDeviceGetAttribute(&cus, hipDeviceAttributeMultiprocessorCount, dev) != hipSuccess) { grid = -1; return; }
        if (hipFuncSetAttribute((const void*)mk_fwd, hipFuncAttributeMaxDynamicSharedMemorySize, LDS_BYTES) != hipSuccess) { fprintf(stderr, "kernel_launch: hipFuncSetAttribute failed\n"); grid = -1; return; }
        if (hipOccupancyMaxActiveBlocksPerMultiprocessor(&per_cu, (const void*)mk_fwd, NWAVES * 64, LDS_BYTES) != hipSuccess || per_cu < 1) { fprintf(stderr, "kernel_launch: occupancy query says %d blocks per CU\n", per_cu); (void)hipGetLastError(); grid = -1; return; }
        if (cus < 256) { fprintf(stderr, "kernel_launch: this kernel's phase maps are built for 256 workgroups (one per CU); the device reports %d CUs\n", cus); grid = -1; return; }
        grid = 256;
    }
    if (grid < 0) return;
    (void)hipMemsetAsync((char*)d_ws + WS_CTL, 0, CTL_ZERO_BYTES, stream);
    Args a{};
    for (int i = 0; i < 27; ++i) a.in[i] = (const float*)d_in[i];
    a.out = (float*)d_out; a.ws = (unsigned char*)d_ws;
#if MK_ONE_LAUNCH
    a.ph_lo = 0; a.ph_hi = N_PHASES;
    hipLaunchKernelGGL(mk_fwd, dim3(grid), dim3(NWAVES * 64), LDS_BYTES, stream, a);
#else
    for (int ph = 0; ph < N_PHASES; ++ph) { a.ph_lo = ph; a.ph_hi = ph + 1; hipLaunchKernelGGL(mk_fwd, dim3(grid), dim3(NWAVES * 64), LDS_BYTES, stream, a); }
#endif
}
```

```cpp
#include <hip/hip_runtime.h>
#include <cstdio>
#include <cstdint>
#include <cmath>
namespace pg8 {
#define PG8_LAS __attribute__((address_space(3)))
typedef unsigned short bf16_t;
typedef short bf16x8 __attribute__((ext_vector_type(8)));
typedef float f32x4 __attribute__((ext_vector_type(4)));
typedef unsigned u32x4 __attribute__((ext_vector_type(4)));
constexpr int BM = 256, BK = 64, HALF = 128, HTB = HALF * BK * 2  , STAGE_BYTES = 8 * HTB, NXCD = 8, WGM = 8;

__host__ __device__ __forceinline__ int lds_byte(int r, int c) { const int st = (r >> 4) * 2 + (c >> 5), rr = r & 15, cc = c & 31, ob = rr * 64 + cc * 2; return st * 1024 + (ob ^ (((ob >> 9) & 1) << 5)); }
__host__ __device__ __forceinline__ void stage_rc(int b, int& R, int& C) { const int st = b / 1024, sb = b % 1024, swz = sb ^ (((sb >> 9) & 1) << 5); R = (st >> 1) * 16 + swz / 64; C = (st & 1) * 32 + (swz % 64) / 2; }
__host__ __device__ __forceinline__ int perm32(int rho) { const int n = rho >> 4, i = rho & 15; return 8 * (i >> 2) + 4 * n + (i & 3); }

struct Unit { int pm, pn; };
struct Gemm { const bf16_t* A; const bf16_t* Bt; int M, N, K; };

struct StaticOrder {
    int nM, nN, nwg, G, c;
    __host__ __device__ void init(int M, int N, int G_, int c_) { nM = M / BM; nN = N / BM; nwg = nM * nN; G = G_; c = c_; }
    __host__ __device__ bool next(int i, Unit& u) const {
        const long L = (long)i * G + c; if (L >= nwg) return false;
        int wgid = (int)L; { const int q = nwg / NXCD, r = nwg % NXCD, xcd = wgid % NXCD, off = wgid / NXCD; wgid = (xcd < r ? xcd * (q + 1) : r * (q + 1) + (xcd - r) * q) + off; }
        const int nig = WGM * nN, gid = wgid / nig, fm = gid * WGM, gsz = (nM - fm) < WGM ? (nM - fm) : WGM;
        u.pm = fm + ((wgid % nig) % gsz); u.pn = (wgid % nig) / gsz; return true;
    }
    __device__ __forceinline__ void a_ready(const Unit&) const {}
    __device__ __forceinline__ void done(const Unit&) const {}
};

__device__ __forceinline__ unsigned cvt_pk_bf16(float lo, float hi) { unsigned r; asm volatile("v_cvt_pk_bf16_f32 %0, %1, %2" : "=v"(r) : "v"(lo), "v"(hi)); return r; }
typedef float f32x2 __attribute__((ext_vector_type(2)));
__device__ __forceinline__ float sigmoidf_(float x) { return __builtin_amdgcn_rcpf(1.0f + __expf(-x)); }
__device__ __forceinline__ float bf_lo(unsigned w) { return __uint_as_float(w << 16); }
__device__ __forceinline__ float bf_hi(unsigned w) { return __uint_as_float(w & 0xffff0000u); }
struct EpiG1 {
    static constexpr bool PERM = true, AFTER_DRAIN = false;
    bf16_t* Oa; bf16_t* Ob;
    __device__ __forceinline__ void operator()(const f32x4 (&acc)[2][2][4][2], const Unit& u, int wr, int wc, int fr, int fq) const {
        const int row0 = u.pm * BM + wr * 64 + fr; int colt = u.pn * BM; bf16_t* base = Oa; int ldc = 2304;
        if (colt >= 2304) { base = Ob; ldc = 4096; colt -= 2304; }
        const int col0 = colt + wc * 32 + 8 * fq;
#pragma unroll
        for (int ai = 0; ai < 2; ++ai)
#pragma unroll
            for (int m = 0; m < 4; ++m) { bf16_t* rowp = base + (size_t)(row0 + ai * HALF + m * 16) * ldc + col0;
#pragma unroll
                for (int bj = 0; bj < 2; ++bj) { const f32x4 v0 = acc[ai][bj][m][0], v1 = acc[ai][bj][m][1];
                    u32x4 w; w.x = cvt_pk_bf16(v0[0], v0[1]); w.y = cvt_pk_bf16(v0[2], v0[3]); w.z = cvt_pk_bf16(v1[0], v1[1]); w.w = cvt_pk_bf16(v1[2], v1[3]);
                    *(u32x4*)(rowp + bj * HALF) = w; } }
    }
};
struct MidG2 {
    static constexpr int SEG = 8;
    const bf16_t* gate;
    __device__ __forceinline__ void operator()(f32x4 (&acc)[2][2][4][2], const Unit& u, int wr, int wc, int fr, int fq, int seg) const {
        const int row0 = u.pm * BM + wr * 64 + fr; const int col0 = u.pn * BM + wc * 32 + 8 * fq; const bf16_t* gp = gate + (seg - 1) * 1024;
#define PG8_RATIO(N, D) ((1.0f + __expf(-(D))) * __builtin_amdgcn_rcpf(1.0f + __expf(-(N))))
#pragma unroll
        for (int ai = 0; ai < 2; ++ai)
          {
            u32x4 gn[4][2], gd[4][2];
#pragma unroll
            for (int mm = 0; mm < 4; ++mm)
#pragma unroll
                for (int bj = 0; bj < 2; ++bj) { const bf16_t* p = gp + (size_t)(row0 + ai * HALF + mm * 16) * 4096 + col0 + bj * HALF; gn[mm][bj] = *(const u32x4*)p; gd[mm][bj] = *(const u32x4*)(p + 1024); }
#pragma unroll
            for (int mm = 0; mm < 4; ++mm)
#pragma unroll
                for (int bj = 0; bj < 2; ++bj) { f32x4& v0 = acc[ai][bj][mm][0]; f32x4& v1 = acc[ai][bj][mm][1]; const u32x4 a_ = gn[mm][bj], b_ = gd[mm][bj];
                    v0[0] *= PG8_RATIO(bf_lo(a_.x), bf_lo(b_.x)); v0[1] *= PG8_RATIO(bf_hi(a_.x), bf_hi(b_.x)); v0[2] *= PG8_RATIO(bf_lo(a_.y), bf_lo(b_.y)); v0[3] *= PG8_RATIO(bf_hi(a_.y), bf_hi(b_.y));
                    v1[0] *= PG8_RATIO(bf_lo(a_.z), bf_lo(b_.z)); v1[1] *= PG8_RATIO(bf_hi(a_.z), bf_hi(b_.z)); v1[2] *= PG8_RATIO(bf_lo(a_.w), bf_lo(b_.w)); v1[3] *= PG8_RATIO(bf_hi(a_.w), bf_hi(b_.w)); }
            __builtin_amdgcn_sched_barrier(0);
          }
#undef PG8_RATIO
    }
};
struct EpiG2 {
    static constexpr bool PERM = true, AFTER_DRAIN = false;
    const bf16_t* gate;   bf16_t* Mb;
    __device__ __forceinline__ void operator()(const f32x4 (&acc)[2][2][4][2], const Unit& u, int wr, int wc, int fr, int fq) const {
        const int row0 = u.pm * BM + wr * 64 + fr; const int col0 = u.pn * BM + wc * 32 + 8 * fq;
        u32x4 gws[2][4][2];
#pragma unroll
        for (int ai = 0; ai < 2; ++ai)
#pragma unroll
            for (int m = 0; m < 4; ++m)
#pragma unroll
                for (int bj = 0; bj < 2; ++bj) gws[ai][m][bj] = *(const u32x4*)(gate + (size_t)(row0 + ai * HALF + m * 16) * 4096 + col0 + bj * HALF);
#pragma unroll
        for (int ai = 0; ai < 2; ++ai)
#pragma unroll
            for (int m = 0; m < 4; ++m) { const size_t row = (size_t)(row0 + ai * HALF + m * 16);
#pragma unroll
                for (int bj = 0; bj < 2; ++bj) { const int c = col0 + bj * HALF;
                    const u32x4 gw = gws[ai][m][bj];
                    f32x4 v0 = acc[ai][bj][m][0], v1 = acc[ai][bj][m][1];
                    v0[0] *= sigmoidf_(bf_lo(gw.x)); v0[1] *= sigmoidf_(bf_hi(gw.x)); v0[2] *= sigmoidf_(bf_lo(gw.y)); v0[3] *= sigmoidf_(bf_hi(gw.y));
                    v1[0] *= sigmoidf_(bf_lo(gw.z)); v1[1] *= sigmoidf_(bf_hi(gw.z)); v1[2] *= sigmoidf_(bf_lo(gw.w)); v1[3] *= sigmoidf_(bf_hi(gw.w));
                    u32x4 w; w.x = cvt_pk_bf16(v0[0], v0[1]); w.y = cvt_pk_bf16(v0[2], v0[3]); w.z = cvt_pk_bf16(v1[0], v1[1]); w.w = cvt_pk_bf16(v1[2], v1[3]);
                    *(u32x4*)(Mb + row * 1024 + c) = w; } }
    }
};
struct EpiG3 {
    static constexpr bool PERM = true, AFTER_DRAIN = false;
    float* X; const float* base;   const float* g1;
    bf16_t* Xs; const float* sc2;   float* SSQ;
    __device__ __forceinline__ void operator()(const f32x4 (&acc)[2][2][4][2], const Unit& u, int wr, int wc, int fr, int fq) const {
        const int row0 = u.pm * BM + wr * 64 + fr; const int col0 = u.pn * BM + wc * 32 + 8 * fq;
        const int rt = u.pm * BM; const int mi = rt < 8192 ? 0 : (rt < 16384 ? 1 : 2); const float* gp = g1 + mi * 6144; const float* sp = sc2 + mi * 6144;
        float ssq[2][4];
#pragma unroll
        for (int ai = 0; ai < 2; ++ai)
#pragma unroll
            for (int m = 0; m < 4; ++m) ssq[ai][m] = 0.f;
#pragma unroll
        for (int bj = 0; bj < 2; ++bj) { const int c = col0 + bj * HALF; const f32x4 ga = *(const f32x4*)(gp + c), gb = *(const f32x4*)(gp + c + 4);
            const f32x4 sa = *(const f32x4*)(sp + c) + 1.0f, sb = *(const f32x4*)(sp + c + 4) + 1.0f;
#pragma unroll
            for (int ai = 0; ai < 2; ++ai) {
                f32x4 b0[4], b1[4];
#pragma unroll
                for (int m = 0; m < 4; ++m) { const float* bp = base + (size_t)(row0 + ai * HALF + m * 16) * 1024 + c; b0[m] = *(const f32x4*)bp; b1[m] = *(const f32x4*)(bp + 4); }
#pragma unroll
                for (int m = 0; m < 4; ++m) { const size_t ro = (size_t)(row0 + ai * HALF + m * 16) * 1024 + c; float* xp = X + ro;
                    const f32x4 x0 = b0[m] + ga * acc[ai][bj][m][0], x1 = b1[m] + gb * acc[ai][bj][m][1];
                    *(f32x4*)xp = x0; *(f32x4*)(xp + 4) = x1;
                    ssq[ai][m] += (x0[0] * x0[0] + x0[1] * x0[1]) + (x0[2] * x0[2] + x0[3] * x0[3]) + (x1[0] * x1[0] + x1[1] * x1[1]) + (x1[2] * x1[2] + x1[3] * x1[3]);
                    const f32x4 y0 = x0 * sa, y1 = x1 * sb; u32x4 w; w.x = cvt_pk_bf16(y0[0], y0[1]); w.y = cvt_pk_bf16(y0[2], y0[3]); w.z = cvt_pk_bf16(y1[0], y1[1]); w.w = cvt_pk_bf16(y1[2], y1[3]);
                    *(u32x4*)(Xs + ro) = w; } } }
#pragma unroll
        for (int ai = 0; ai < 2; ++ai)
#pragma unroll
            for (int m = 0; m < 4; ++m) { float v = ssq[ai][m]; v += __shfl_xor(v, 16); v += __shfl_xor(v, 32);
                if (fq == 0) SSQ[(size_t)(row0 + ai * HALF + m * 16) * 16 + u.pn * 4 + wc] = v; }
    }
};
struct EpiG4 {
    static constexpr bool PERM = true, AFTER_DRAIN = false;
    float* O; const float* SSQ; const float* biasq;
    __device__ __forceinline__ void operator()(const f32x4 (&acc)[2][2][4][2], const Unit& u, int wr, int wc, int fr, int fq) const {
        const int row0 = u.pm * BM + wr * 64 + fr; const int col0 = u.pn * BM + wc * 32 + 8 * fq;
        const int rt = u.pm * BM; const int mi = rt < 8192 ? 0 : (rt < 16384 ? 1 : 2); const float* bq = biasq + mi * 1024;
        f32x4 ba[2], bb[2];
#pragma unroll
        for (int bj = 0; bj < 2; ++bj) { ba[bj] = *(const f32x4*)(bq + col0 + bj * HALF); bb[bj] = *(const f32x4*)(bq + col0 + bj * HALF + 4); }
        float rstds[2][4];
#pragma unroll
        for (int ai = 0; ai < 2; ++ai) { f32x4 q_[4][4];
#pragma unroll
            for (int m = 0; m < 4; ++m) { const f32x4* sq = (const f32x4*)(SSQ + (size_t)(row0 + ai * HALF + m * 16) * 16); q_[m][0] = sq[0]; q_[m][1] = sq[1]; q_[m][2] = sq[2]; q_[m][3] = sq[3]; }
#pragma unroll
            for (int m = 0; m < 4; ++m) { const f32x4 s = (q_[m][0] + q_[m][1]) + (q_[m][2] + q_[m][3]); rstds[ai][m] = rsqrtf(((s[0] + s[1]) + (s[2] + s[3])) * (1.0f / 1024.0f) + 1e-6f); } }
#pragma unroll
        for (int ai = 0; ai < 2; ++ai)
#pragma unroll
            for (int m = 0; m < 4; ++m) { const size_t row = (size_t)(row0 + ai * HALF + m * 16); const float rstd = rstds[ai][m];
                float* op = O + row * 1024 + col0;
#pragma unroll
                for (int bj = 0; bj < 2; ++bj) { *(f32x4*)(op + bj * HALF) = acc[ai][bj][m][0] * rstd + ba[bj]; *(f32x4*)(op + bj * HALF + 4) = acc[ai][bj][m][1] * rstd + bb[bj]; } }
    }
};
struct NoMid { static constexpr int SEG = 0; __device__ __forceinline__ void operator()(f32x4 (&)[2][2][4][2], const Unit&, int, int, int, int, int) const {} };
template <class Epi, class Sched, bool ALIGN_EPI = false, bool SP2 = false, class Mid = NoMid>
__device__ __forceinline__ void gemm_phase(PG8_LAS unsigned char* lds, const Gemm g, const Sched& S, const Epi& E, const Mid& Mh = Mid()) {
    const int tid = threadIdx.x, wid = __builtin_amdgcn_readfirstlane(tid >> 6), lane = tid & 63, wr = wid >> 2, wc = wid & 3, fr = lane & 15, fq = lane >> 4;
    const int K = g.K, nt = K / BK;
    unsigned voffA[2], voffB[2];
#pragma unroll
    for (int i = 0; i < 2; ++i) { int R, C; stage_rc(tid * 16 + i * 8192, R, C); const int Rb = Epi::PERM ? ((R & ~31) + perm32(R & 31)) : R;
        voffA[i] = (unsigned)(R * K + C) * 2u; voffB[i] = (unsigned)(Rb * K + C) * 2u; }
    const size_t kstep = (size_t)(BK * 2);
    const size_t hstep = (size_t)HALF * K * 2;
    const size_t tstep = 2 * hstep;
    const unsigned ldsw = (unsigned)wid * 1024u;
    const int aoff = lds_byte(wr * 64 + fr, fq * 8), boff = lds_byte(wc * 32 + fr, fq * 8);
#define PG8_SA(b, h) (((b) * 2 + (h)) * HTB)
#define PG8_SB(b, h) ((4 + (b) * 2 + (h)) * HTB)
#define PG8_STAGE(bufoff, gbase, voff) do { _Pragma("unroll") for (int _i = 0; _i < 2; ++_i) \
        __builtin_amdgcn_global_load_lds((const unsigned*)((const char*)(gbase) + (voff)[_i]), (PG8_LAS unsigned*)(lds + (bufoff) + ldsw + _i * 8192), 16, 0, 0); } while (0)
#define PG8_LDA(dst, b, h) do { _Pragma("unroll") for (int m = 0; m < 4; ++m) _Pragma("unroll") for (int k = 0; k < 2; ++k) dst[m][k] = *(const PG8_LAS bf16x8*)(lds + PG8_SA(b, h) + aoff + m * 2048 + k * 1024); } while (0)
#define PG8_LDB(dst, b, h) do { _Pragma("unroll") for (int n = 0; n < 2; ++n) _Pragma("unroll") for (int k = 0; k < 2; ++k) dst[n][k] = *(const PG8_LAS bf16x8*)(lds + PG8_SB(b, h) + boff + n * 2048 + k * 1024); } while (0)
#define PG8_MMA(ai, bj, At, Bt) do { __builtin_amdgcn_s_setprio(1); _Pragma("unroll") for (int m = 0; m < 4; ++m) _Pragma("unroll") for (int n = 0; n < 2; ++n) _Pragma("unroll") for (int k = 0; k < 2; ++k) \
        acc[ai][bj][m][n] = __builtin_amdgcn_mfma_f32_16x16x32_bf16(Bt[n][k], At[m][k], acc[ai][bj][m][n], 0, 0, 0); __builtin_amdgcn_s_setprio(0); } while (0)
#define PG8_WAIT_V(n) asm volatile("s_waitcnt vmcnt(" #n ")" ::: "memory")
#define PG8_WAIT_L(n) asm volatile("s_waitcnt lgkmcnt(" #n ")" ::: "memory")
#define PG8_BAR __builtin_amdgcn_s_barrier()
#define PG8_SCHED __builtin_amdgcn_sched_barrier(0)
    Unit cur, nxt; int ui = 0;
    if (!S.next(0, cur)) return;
    f32x4 acc[2][2][4][2];
#pragma unroll
    for (int a = 0; a < 2; ++a)
#pragma unroll
        for (int b = 0; b < 2; ++b)
#pragma unroll
            for (int m = 0; m < 4; ++m)
#pragma unroll
                for (int n = 0; n < 2; ++n) acc[a][b][m][n] = (f32x4){0.f, 0.f, 0.f, 0.f};
    bf16x8 At[4][2], B0[2][2], B1[2][2];
    const char* cA = (const char*)g.A + (size_t)cur.pm * tstep; const char* cB = (const char*)g.Bt + (size_t)cur.pn * tstep;
    S.a_ready(cur);
    if constexpr (SP2) {
        PG8_STAGE(PG8_SB(0, 0), cB, voffB); PG8_STAGE(PG8_SB(0, 1), cB + hstep, voffB); PG8_STAGE(PG8_SA(0, 0), cA, voffA); PG8_STAGE(PG8_SA(0, 1), cA + hstep, voffA);
        if (wr == 1) PG8_BAR;
        PG8_WAIT_V(2); PG8_BAR;
        PG8_STAGE(PG8_SB(1, 0), cB + kstep, voffB); PG8_STAGE(PG8_SA(1, 0), cA + kstep, voffA); PG8_STAGE(PG8_SB(1, 1), cB + hstep + kstep, voffB);
        PG8_WAIT_V(6); PG8_BAR;
    } else {
        PG8_STAGE(PG8_SB(0, 0), cB, voffB); PG8_STAGE(PG8_SA(0, 0), cA, voffA); PG8_STAGE(PG8_SB(0, 1), cB + hstep, voffB); PG8_STAGE(PG8_SA(0, 1), cA + hstep, voffA);
        if (wr == 1) PG8_BAR;
        PG8_WAIT_V(4); PG8_BAR;
        PG8_STAGE(PG8_SB(1, 0), cB + kstep, voffB); PG8_STAGE(PG8_SA(1, 0), cA + kstep, voffA); PG8_STAGE(PG8_SB(1, 1), cB + hstep + kstep, voffB);
        PG8_WAIT_V(6); PG8_BAR;
    }
    for (;;) {
        const bool has_next = S.next(ui + 1, nxt);
        const char* nA = has_next ? (const char*)g.A + (size_t)nxt.pm * tstep : cA; const char* nB = has_next ? (const char*)g.Bt + (size_t)nxt.pn * tstep : cB;
        for (int t = 0; t < nt; t += 2) {
            if constexpr (Mid::SEG > 0) { if (t != 0 && (t % Mid::SEG) == 0) Mh(acc, cur, wr, wc, fr, fq, t / Mid::SEG); }
            const bool last = (t == nt - 2);
            const char* a1 = cA + (size_t)(t + 1) * kstep;
            const char* a2 = last ? nA : cA + (size_t)(t + 2) * kstep; const char* b2 = last ? nB : cB + (size_t)(t + 2) * kstep;
            const char* a3 = a2 + kstep; const char* b3 = b2 + kstep;
            if (last && has_next) S.a_ready(nxt);
            if constexpr (SP2) {
            PG8_LDB(B0, 0, 0); PG8_LDB(B1, 0, 1); PG8_SCHED; PG8_LDA(At, 0, 0); PG8_STAGE(PG8_SA(1, 1), a1 + hstep, voffA);
            PG8_WAIT_V(8); PG8_WAIT_L(0); PG8_BAR; PG8_MMA(0, 0, At, B0); PG8_MMA(0, 1, At, B1); PG8_BAR; PG8_SCHED;
            PG8_LDA(At, 0, 1); PG8_STAGE(PG8_SB(0, 0), b2, voffB); PG8_STAGE(PG8_SB(0, 1), b2 + hstep, voffB); PG8_STAGE(PG8_SA(0, 0), a2, voffA);
            PG8_WAIT_V(8); PG8_WAIT_L(0); PG8_BAR; PG8_MMA(1, 0, At, B0); PG8_MMA(1, 1, At, B1); PG8_BAR; PG8_SCHED;
            PG8_LDB(B0, 1, 0); PG8_LDB(B1, 1, 1); PG8_SCHED; PG8_LDA(At, 1, 0); PG8_STAGE(PG8_SA(0, 1), a2 + hstep, voffA);
            PG8_WAIT_V(8); PG8_WAIT_L(0); PG8_BAR; PG8_MMA(0, 0, At, B0); PG8_MMA(0, 1, At, B1); PG8_BAR; PG8_SCHED;
            PG8_LDA(At, 1, 1); PG8_STAGE(PG8_SB(1, 0), b3, voffB); PG8_STAGE(PG8_SB(1, 1), b3 + hstep, voffB); PG8_STAGE(PG8_SA(1, 0), a3, voffA);
            PG8_WAIT_V(8); PG8_WAIT_L(0); PG8_BAR; PG8_MMA(1, 0, At, B0); PG8_MMA(1, 1, At, B1); PG8_BAR; PG8_SCHED;
            } else {
            PG8_LDB(B0, 0, 0); PG8_SCHED; PG8_LDA(At, 0, 0); PG8_STAGE(PG8_SA(1, 1), a1 + hstep, voffA);
            PG8_WAIT_L(8); PG8_BAR; PG8_WAIT_L(0); PG8_MMA(0, 0, At, B0); PG8_BAR; PG8_SCHED;
            PG8_LDB(B1, 0, 1); PG8_STAGE(PG8_SB(0, 0), b2, voffB);
            PG8_BAR; PG8_WAIT_L(0); PG8_MMA(0, 1, At, B1); PG8_BAR;
            PG8_LDA(At, 0, 1); PG8_STAGE(PG8_SA(0, 0), a2, voffA);
            PG8_BAR; PG8_WAIT_L(0); PG8_MMA(1, 0, At, B0); PG8_BAR; PG8_SCHED;
            PG8_STAGE(PG8_SB(0, 1), b2 + hstep, voffB);
            PG8_WAIT_V(6); PG8_BAR; PG8_MMA(1, 1, At, B1); PG8_BAR;
            PG8_LDB(B0, 1, 0); PG8_SCHED; PG8_LDA(At, 1, 0); PG8_STAGE(PG8_SA(0, 1), a2 + hstep, voffA);
            PG8_WAIT_L(8); PG8_BAR; PG8_WAIT_L(0); PG8_MMA(0, 0, At, B0); PG8_BAR; PG8_SCHED;
            PG8_LDB(B1, 1, 1); PG8_STAGE(PG8_SB(1, 0), b3, voffB);
            PG8_BAR; PG8_WAIT_L(0); PG8_MMA(0, 1, At, B1); PG8_BAR;
            PG8_LDA(At, 1, 1); PG8_STAGE(PG8_SA(1, 0), a3, voffA);
            PG8_BAR; PG8_WAIT_L(0); PG8_MMA(1, 0, At, B0); PG8_BAR; PG8_SCHED;
            PG8_STAGE(PG8_SB(1, 1), b3 + hstep, voffB);
            PG8_WAIT_V(6); PG8_BAR; PG8_MMA(1, 1, At, B1); PG8_BAR;
            }
        }
        if constexpr (ALIGN_EPI) { if (wr == 0) PG8_BAR; }
        if constexpr (!Epi::AFTER_DRAIN) { E(acc, cur, wr, wc, fr, fq); S.done(cur); }
        if (!has_next) break;
#pragma unroll
        for (int a = 0; a < 2; ++a)
#pragma unroll
            for (int b = 0; b < 2; ++b)
#pragma unroll
                for (int m = 0; m < 4; ++m)
#pragma unroll
                    for (int n = 0; n < 2; ++n) acc[a][b][m][n] = (f32x4){0.f, 0.f, 0.f, 0.f};
        cur = nxt; cA = nA; cB = nB; ++ui;
        if constexpr (ALIGN_EPI) { if (wr == 1) PG8_BAR; }
    }
    PG8_WAIT_V(0);
    if constexpr (!ALIGN_EPI) { if (wr == 0) PG8_BAR; }
    PG8_BAR;
    if constexpr (Epi::AFTER_DRAIN) { E.fused(acc, cur, wr, wc, fr, fq, lds, wid, lane); S.done(cur); }
#undef PG8_SA
#undef PG8_SB
#undef PG8_STAGE
#undef PG8_LDA
#undef PG8_LDB
#undef PG8_MMA
#undef PG8_WAIT_V
#undef PG8_WAIT_L
#undef PG8_BAR
#undef PG8_SCHED
}
}
#define GAS __attribute__((address_space(1)))
#define LAS __attribute__((address_space(3)))
typedef unsigned short bf16;
typedef unsigned v4u __attribute__((ext_vector_type(4)));
typedef float f32x4 __attribute__((ext_vector_type(4)));
typedef short bf16x8 __attribute__((ext_vector_type(8)));
typedef GAS unsigned gu32;
typedef GAS unsigned long long gu64;
#define RLX_AGENT __ATOMIC_RELAXED, __HIP_MEMORY_SCOPE_AGENT
#define LDS_WAIT() asm volatile("s_waitcnt lgkmcnt(0)" ::: "memory")
#define VM_WAIT() asm volatile("s_waitcnt vmcnt(0)" ::: "memory")
__device__ __forceinline__ unsigned long long rt() { return __builtin_amdgcn_s_memrealtime(); }
__device__ __forceinline__ unsigned f2bf(float f) { unsigned u = __builtin_bit_cast(unsigned, f); return (u + 0x7fffu + ((u >> 16) & 1u)) >> 16; }
__device__ __forceinline__ unsigned pk2(float lo, float hi) { return f2bf(lo) | (f2bf(hi) << 16); }
#define XB_TMO      128
#define XB_XCNT(j)  (256  + 64 * (j))
#define XB_XSUB(j)  (1280 + 64 * (j))
#define XB_XGEN(j)  (2304 + 64 * (j))
#define XB_TOP      3328
#define XB_TOPGEN   3392
#define XCD_BAR_WORDS 3456
#define XB_SPIN_CAP (1u << 24)

__device__ __forceinline__ unsigned xb_ld(unsigned* p)              { return __hip_atomic_load(p, __ATOMIC_RELAXED, __HIP_MEMORY_SCOPE_AGENT); }
__device__ __forceinline__ unsigned xb_add(unsigned* p, unsigned v) { return __hip_atomic_fetch_add(p, v, __ATOMIC_RELAXED, __HIP_MEMORY_SCOPE_AGENT); }
__device__ __forceinline__ unsigned xb_xcc_id() { return (unsigned)__builtin_amdgcn_s_getreg((3 << 11) | 20) & 0xFu; }
#define XB_SPIN(cond, bar) do { unsigned _sp = 0; while (cond) { __builtin_amdgcn_s_sleep(1); \
    if ((++_sp & 255u) == 0u) { if (xb_ld(&(bar)[XB_TMO])) break; if (_sp > XB_SPIN_CAP) { atomicAdd(&(bar)[XB_TMO], 1u); break; } } } } while (0)

struct XcdBarrier {
    unsigned* bar; unsigned x;
    volatile LAS unsigned* st;
};

__device__ __forceinline__ XcdBarrier xcd_barrier_post(unsigned* bar, volatile LAS unsigned* st) {
    XcdBarrier b; b.bar = bar; b.x = xb_xcc_id(); b.st = st;
    if (threadIdx.x == 0) (void)xb_add(&bar[XB_XCNT(b.x)], 1u);
    return b;
}
__device__ __forceinline__ void xcd_barrier_complete(unsigned* bar, unsigned x, unsigned& nloc, unsigned& nx) {
    const unsigned G = gridDim.x * gridDim.y * gridDim.z;
    unsigned sum, cnt, mine, sp = 0u;
    for (;;) {
        sum = 0u; cnt = 0u; mine = 0u;
#pragma unroll
        for (unsigned j = 0; j < 16; ++j) { const unsigned c = xb_ld(&bar[XB_XCNT(j)]); sum += c; cnt += (c > 0u) ? 1u : 0u; mine = (j == x) ? c : mine; }
        if (sum == G) break;
        __builtin_amdgcn_s_sleep(1);
        if ((++sp & 255u) == 0u) { if (xb_ld(&bar[XB_TMO])) break; if (sp > XB_SPIN_CAP) { atomicAdd(&bar[XB_TMO], 1u); break; } }
    }
    nloc = mine > 0u ? mine : 1u; nx = cnt > 0u ? cnt : 1u;
}

__device__ __forceinline__ void xcd_barrier(const XcdBarrier& b) {
    asm volatile("s_waitcnt vmcnt(0)" ::: "memory");
    __syncthreads();
    if (threadIdx.x == 0) {
        unsigned* bar = b.bar;
        __builtin_amdgcn_s_waitcnt(0);
        unsigned nloc = b.st[0], nx = b.st[1];
        if (nloc == 0u) { xcd_barrier_complete(bar, b.x, nloc, nx); b.st[0] = nloc; b.st[1] = nx; }
        const unsigned old = xb_add(&bar[XB_XSUB(b.x)], 1u);
        const unsigned gen = old / nloc;
        if (old + 1u == (gen + 1u) * nloc) {
            __builtin_amdgcn_fence(__ATOMIC_RELEASE, "agent");
            asm volatile("s_waitcnt vmcnt(0)" ::: "memory");
            const unsigned og = xb_add(&bar[XB_TOP], 1u);
            const unsigned tg = og / nx;
            if (og + 1u == (tg + 1u) * nx) xb_add(&bar[XB_TOPGEN], 1u);
            else XB_SPIN(xb_ld(&bar[XB_TOPGEN]) == tg, bar);
            __builtin_amdgcn_fence(__ATOMIC_ACQUIRE, "agent");
            xb_add(&bar[XB_XGEN(b.x)], 1u);
            asm volatile("s_waitcnt vmcnt(0)" ::: "memory");
        } else {
            XB_SPIN(xb_ld(&bar[XB_XGEN(b.x)]) == gen, bar);
            __builtin_amdgcn_fence(__ATOMIC_ACQUIRE, "agent");
            asm volatile("s_waitcnt vmcnt(0)" ::: "memory");
        }
    }
    __syncthreads();
}
__device__ __forceinline__ float wave_sum(float v) {
#pragma unroll
    for (int o = 1; o < 64; o <<= 1) v += __shfl_xor(v, o);
    return v;
}
__device__ __forceinline__ void p0_transpose_item(const float* W, int K, int N, bf16* WT, int row_off, LAS float* scr, int item, int lane) {
    const int nblk = N / 32, kb = item / nblk, nb = item % nblk, k0 = 64 * kb, n0 = 32 * nb;
#pragma unroll 8
    for (int i = 0; i < 32; ++i) { const int kk = 2 * i + (lane >> 5); scr[kk * 33 + (lane & 31)] = W[(size_t)(k0 + kk) * N + n0 + (lane & 31)]; }
    LDS_WAIT(); asm volatile("" ::: "memory");
    const int c = lane & 7;
#pragma unroll
    for (int j = 0; j < 4; ++j) { const int n = (lane >> 3) + 8 * j; const LAS float* s = scr + (8 * c) * 33 + n;
        v4u o; o.x = pk2(s[0 * 33], s[1 * 33]); o.y = pk2(s[2 * 33], s[3 * 33]); o.z = pk2(s[4 * 33], s[5 * 33]); o.w = pk2(s[6 * 33], s[7 * 33]);
        *(GAS v4u*)(WT + (size_t)(row_off + n0 + n) * K + k0 + 8 * c) = o; }
    LDS_WAIT(); asm volatile("" ::: "memory");
}
__device__ __forceinline__ void p0_transpose_item_p(const float* W, int K, int N, bf16* WT, int pitch, int col_off, LAS float* scr, int item, int lane) {
    const int nblk = N / 32, kb = item / nblk, nb = item % nblk, k0 = 64 * kb, n0 = 32 * nb;
#pragma unroll 8
    for (int i = 0; i < 32; ++i) { const int kk = 2 * i + (lane >> 5); scr[kk * 33 + (lane & 31)] = W[(size_t)(k0 + kk) * N + n0 + (lane & 31)]; }
    LDS_WAIT(); asm volatile("" ::: "memory");
    const int c = lane & 7;
#pragma unroll
    for (int j = 0; j < 4; ++j) { const int n = (lane >> 3) + 8 * j; const LAS float* s = scr + (8 * c) * 33 + n;
        v4u o; o.x = pk2(s[0 * 33], s[1 * 33]); o.y = pk2(s[2 * 33], s[3 * 33]); o.z = pk2(s[4 * 33], s[5 * 33]); o.w = pk2(s[6 * 33], s[7 * 33]);
        *(GAS v4u*)(WT + (size_t)(n0 + n) * pitch + col_off + k0 + 8 * c) = o; }
    LDS_WAIT(); asm volatile("" ::: "memory");
}
#include <hip/hip_bf16.h>
#include <cmath>
namespace attn_body {
using bf16=__hip_bfloat16;
using bf16x8=__attribute__((ext_vector_type(8)))short;
using s16x4=__attribute__((ext_vector_type(4)))short;
using f32x16=__attribute__((ext_vector_type(16)))float;
using u32x4=__attribute__((ext_vector_type(4)))unsigned;
constexpr int D=64;
constexpr int NW=8,QBLK=32,QB=QBLK*NW,KVBLK=64;
constexpr int ATTN_UNIT_ROWS=QB;
__device__ __forceinline__ int crow(int r,int hi){return (r&3)+8*(r>>2)+4*hi;}
#define SBAR() __builtin_amdgcn_sched_barrier(0)
constexpr int NSLOT=3, SLOTB=8192;
constexpr int LDS_K=0, LDS_V=NSLOT*SLOTB, LDS_WS=2*NSLOT*SLOTB, LDS_OST=LDS_WS+NW*64*4, LDS_BYTES=LDS_OST+NW*4096;
constexpr float C2=0.125f*1.4426950408889634f;
__device__ __forceinline__ void glds16(const void*gsrc,unsigned lds_dst){unsigned keep;
  asm volatile("s_mov_b32 %0, m0\n\ts_mov_b32 m0, %2\n\ts_nop 0\n\tglobal_load_lds_dwordx4 %1, off\n\ts_mov_b32 m0, %0":"=&s"(keep):"v"(gsrc),"s"(lds_dst):"memory");}
__device__ __forceinline__ float max3f(float a,float b,float c){float r;asm("v_max3_f32 %0, %1, %2, %3":"=v"(r):"v"(a),"v"(b),"v"(c));return r;}
__device__ __forceinline__ float max2f(float a,float b){float r;asm("v_max_f32_e32 %0, %1, %2":"=v"(r):"v"(a),"v"(b));return r;}
__device__ __forceinline__ float fadd_s(float a,float b){float r;asm("v_add_f32_e32 %0, %1, %2":"=v"(r):"v"(a),"v"(b));return r;}
__device__ __forceinline__ float fsub_s(float a,float b){float r;asm("v_sub_f32_e32 %0, %1, %2":"=v"(r):"v"(a),"v"(b));return r;}
typedef float f32x2_t __attribute__((ext_vector_type(2))); typedef __bf16 bf16x2_t __attribute__((ext_vector_type(2)));
__device__ __forceinline__ unsigned cvtpk_s(float lo,float hi){f32x2_t v={lo,hi};bf16x2_t b=__builtin_convertvector(v,bf16x2_t);return __builtin_bit_cast(unsigned,b);}
#define WAIT_BAR(N) asm volatile("s_waitcnt vmcnt(" #N ") lgkmcnt(0)\n\ts_barrier":::"memory")

__device__ __forceinline__ void qkt(f32x16&p0,f32x16&p1,const char*Kslot,const bf16x8*qr,const f32x16&negm,int r32,int hi){
  const char*kb=Kslot+hi*1024+r32*16;
  #pragma unroll
  for(int d0=0;d0<4;++d0){
    const bf16x8 b0=*reinterpret_cast<const bf16x8*>(kb+d0*2048);
    const bf16x8 b1=*reinterpret_cast<const bf16x8*>(kb+d0*2048+512);
    if(d0==0){p0=__builtin_amdgcn_mfma_f32_32x32x16_bf16(b0,qr[0],negm,0,0,0);p1=__builtin_amdgcn_mfma_f32_32x32x16_bf16(b1,qr[0],negm,0,0,0);}
    else{p0=__builtin_amdgcn_mfma_f32_32x32x16_bf16(b0,qr[d0],p0,0,0,0);p1=__builtin_amdgcn_mfma_f32_32x32x16_bf16(b1,qr[d0],p1,0,0,0);}}
}
typedef __attribute__((address_space(3))) const char* lds_cptr;
typedef short v4i16_t __attribute__((ext_vector_type(4)));
__device__ __forceinline__ void kload8(bf16x8*kf,lds_cptr kp){
  kf[0]=*(const __attribute__((address_space(3))) bf16x8*)(kp);      kf[1]=*(const __attribute__((address_space(3))) bf16x8*)(kp+512);
  kf[2]=*(const __attribute__((address_space(3))) bf16x8*)(kp+2048); kf[3]=*(const __attribute__((address_space(3))) bf16x8*)(kp+2560);
  kf[4]=*(const __attribute__((address_space(3))) bf16x8*)(kp+4096); kf[5]=*(const __attribute__((address_space(3))) bf16x8*)(kp+4608);
  kf[6]=*(const __attribute__((address_space(3))) bf16x8*)(kp+6144); kf[7]=*(const __attribute__((address_space(3))) bf16x8*)(kp+6656);
}
__device__ __forceinline__ void kload2(bf16x8*kf,lds_cptr kp,int j){ kf[2*j]=*(const __attribute__((address_space(3))) bf16x8*)(kp+j*2048); kf[2*j+1]=*(const __attribute__((address_space(3))) bf16x8*)(kp+j*2048+512); }
__device__ __forceinline__ s16x4 vtr(lds_cptr p){ return __builtin_bit_cast(s16x4,__builtin_amdgcn_ds_read_tr16_b64_v4i16((__attribute__((address_space(3))) v4i16_t*)p)); }
__device__ __forceinline__ float rowmax(const f32x16&p0,const f32x16&p1){
  float a=max3f(p0[0],p0[1],p1[0]),b=max3f(p0[2],p0[3],p1[1]);a=max3f(a,p1[2],p1[3]);
  #pragma unroll
  for(int r=4;r<16;r+=4){a=max3f(a,p0[r],p0[r+1]);b=max3f(b,p0[r+2],p0[r+3]);a=max3f(a,p1[r],p1[r+1]);b=max3f(b,p1[r+2],p1[r+3]);}
  const float m=max2f(a,b);
  auto rr=__builtin_amdgcn_permlane32_swap(__float_as_uint(m),__float_as_uint(m),false,false);
  return max2f(__uint_as_float(rr[0]),__uint_as_float(rr[1]));
}
__device__ __forceinline__ void pv(f32x16*o,int vb,bf16x8 pa0,bf16x8 pa1,bf16x8 pa2,bf16x8 pa3){
  #pragma unroll
  for(int d0=0;d0<2;++d0){s16x4 lo[4],hi[4];
    #pragma unroll
    for(int ks=0;ks<4;++ks){
      asm volatile("ds_read_b64_tr_b16 %0,%1 offset:%c2":"=&v"(lo[ks]):"v"(vb),"i"(d0*4096+ks*1024):"memory");
      asm volatile("ds_read_b64_tr_b16 %0,%1 offset:%c2":"=&v"(hi[ks]):"v"(vb),"i"(d0*4096+ks*1024+512):"memory");}
    asm volatile("s_waitcnt lgkmcnt(0)":::"memory");SBAR();
    #define PK(k) (bf16x8){lo[k][0],lo[k][1],lo[k][2],lo[k][3],hi[k][0],hi[k][1],hi[k][2],hi[k][3]}
    o[d0]=__builtin_amdgcn_mfma_f32_32x32x16_bf16(pa0,PK(0),o[d0],0,0,0);
    o[d0]=__builtin_amdgcn_mfma_f32_32x32x16_bf16(pa1,PK(1),o[d0],0,0,0);
    o[d0]=__builtin_amdgcn_mfma_f32_32x32x16_bf16(pa2,PK(2),o[d0],0,0,0);
    o[d0]=__builtin_amdgcn_mfma_f32_32x32x16_bf16(pa3,PK(3),o[d0],0,0,0);
    #undef PK
  }
}

#ifndef ATTN_STORE16
#define ATTN_STORE16(p,v) (*(u32x4*)(p)=(v))
#endif
template<int THRL> __device__ __forceinline__ void attn_unit(const bf16*Qw0,int QP,const bf16*Kh,int KP,const bf16*Vh,int VP,bf16*Ow0,int OP,int NT,char*shm,float mref){
  int tid=threadIdx.x; asm volatile("":"+v"(tid));
  const int lane=tid&63,r32=lane&31,hi=lane>>5; const int wid=__builtin_amdgcn_readfirstlane(tid>>6);
  const bf16*Qw=Qw0+(long)wid*QBLK*QP;
  const unsigned lds0=(unsigned)(uintptr_t)shm;
  float*wsf=(float*)(shm+LDS_WS)+wid*64;
  const bf16*ksrc=Kh+(long)lane*KP+wid*8;
  const bf16*vsrc=Vh+(long)(16*(wid&3)+(lane>>2))*VP+(wid>>2)*32+(lane&3)*8;
  const unsigned kdst=lds0+LDS_K+wid*1024, vdst=lds0+LDS_V+wid*1024;
  #define DMA_K(t,slot) glds16(ksrc+(long)(t)*KVBLK*KP,(unsigned)__builtin_amdgcn_readfirstlane(kdst+(slot)))
  #define DMA_V(t,slot) glds16(vsrc+(long)(t)*KVBLK*VP,(unsigned)__builtin_amdgcn_readfirstlane(vdst+(slot)))
  const int vb0=(int)(lds0+LDS_V)+((lane>>4)&1)*32+(lane&3)*8+(4*hi+((lane&15)>>2))*64;
  const char*Kbase=shm+LDS_K; bf16x8 kf[8];
  const lds_cptr shm3=(lds_cptr)shm; const lds_cptr kp0=shm3+LDS_K+hi*1024+r32*16; const lds_cptr vp0=shm3+LDS_V+((lane>>4)&1)*32+(lane&3)*8+(4*hi+((lane&15)>>2))*64;
  DMA_K(0,0);DMA_V(0,0);DMA_K(1,SLOTB);
  bf16x8 qr[4];
  #pragma unroll
  for(int d0=0;d0<4;++d0)qr[d0]=*reinterpret_cast<const bf16x8*>(&Qw[(long)r32*QP+d0*16+hi*8]);
  float l_reg=0.f;f32x16 o[2];o[0]=f32x16{};o[1]=f32x16{};f32x16 negm; _Pragma("unroll") for(int r=0;r<16;++r)negm[r]=-mref; asm volatile("":"+v"(negm));
  #define CMASK(P0,P1,t) do{}while(0)
  #define START(P0,P1) do{ _Pragma("unroll") for(int r=0;r<16;++r)P0[r]=__builtin_amdgcn_exp2f(P0[r]); }while(0)
  #define RESC() do{}while(0)
  f32x16 pA0,pA1,pB0,pB1;
  int sl_prev=0,sl_cur=0,sl_next=SLOTB;
  #define ROT() do{sl_prev=sl_cur;sl_cur=sl_next;sl_next=(sl_next==(NSLOT-1)*SLOTB)?0:sl_next+SLOTB;}while(0)
  DMA_K(2,2*SLOTB);
  WAIT_BAR(3);
  qkt(pA0,pA1,Kbase,qr,negm,r32,hi);asm volatile("s_nop 15\n\ts_nop 7":"+v"(pA0),"+v"(pA1));CMASK(pA0,pA1,0);
  START(pA0,pA1);
  _Pragma("unroll") for(int r=0;r<16;++r)pA1[r]=__builtin_amdgcn_exp2f(pA1[r]);
  WAIT_BAR(0);
  DMA_K(3,0);DMA_V(1,SLOTB);
  ROT();
  kload8(kf,kp0+sl_cur);
  WAIT_BAR(2);
  s16x4 vlo[8],vhi[8]; u32x4 pw0,pw1,pw2,pw3;
  #define PKW(P,B) cvtpk_s(P[B],P[B+1])
  #define PAF(k) __builtin_bit_cast(bf16x8,pw##k)
  #define VFR(i) (bf16x8){vlo[i][0],vlo[i][1],vlo[i][2],vlo[i][3],vhi[i][0],vhi[i][1],vhi[i][2],vhi[i][3]}
  #define PIN(x) asm volatile("":"+v"(x))
  #define MX3(a,b,c) __builtin_fmaxf(__builtin_fmaxf((a),(b)),(c))
  #define GAPA(MF,A0,A1,A2,A3,W0,W1,PW) do{ MF; sacc+=A0; sacc+=A1; sacc+=A2; sacc+=A3; PIN(sacc); W0; W1; PIN(PW); SBAR(); }while(0)
  #define EX(v) __builtin_amdgcn_exp2f(v)
  #define GAPB(MF,X,B) do{ MF; X[B]=EX(X[B]); X[B+1]=EX(X[B+1]); X[B+2]=EX(X[B+2]); X[B+3]=EX(X[B+3]); PIN(X); SBAR(); }while(0)
  #define VRD(i) do{ vlo[i]=vtr(vp_+(((i)>>2)*4096+((i)&3)*1024)); vhi[i]=vtr(vp_+(((i)>>2)*4096+((i)&3)*1024+512)); }while(0)
  #define KRD(G,j) do{ if(G){ kload2(kf,kp0+sl_next,j); SBAR(); } }while(0)
  #define STEP(C0,C1,P0,P1,t,GK,GV,GL) do{ SBAR(); \
    const lds_cptr vp_=vp0+sl_prev; \
    VRD(0); SBAR(); float sacc=(P0[0]+P0[1]); \
    GAPA(C0=__builtin_amdgcn_mfma_f32_32x32x16_bf16(kf[0],qr[0],negm,0,0,0), P0[2],P0[3],P0[4],P0[5],     pw0[0]=PKW(P0,0), pw0[1]=PKW(P0,2), pw0); \
    VRD(4); SBAR(); GAPA(C1=__builtin_amdgcn_mfma_f32_32x32x16_bf16(kf[1],qr[0],negm,0,0,0), P0[6],P0[7],P0[8],P0[9],     pw0[2]=PKW(P0,4), pw0[3]=PKW(P0,6), pw0); \
    VRD(1); SBAR(); GAPA(C0=__builtin_amdgcn_mfma_f32_32x32x16_bf16(kf[2],qr[1],C0,0,0,0),   P0[10],P0[11],P0[12],P0[13], pw1[0]=PKW(P0,8), pw1[1]=PKW(P0,10), pw1); \
    VRD(5); SBAR(); GAPA(C1=__builtin_amdgcn_mfma_f32_32x32x16_bf16(kf[3],qr[1],C1,0,0,0),   P0[14],P0[15],P1[0],P1[1],   pw1[2]=PKW(P0,12),pw1[3]=PKW(P0,14), pw1); \
    VRD(2); SBAR(); GAPA(C0=__builtin_amdgcn_mfma_f32_32x32x16_bf16(kf[4],qr[2],C0,0,0,0),   P1[2],P1[3],P1[4],P1[5],     pw2[0]=PKW(P1,0), pw2[1]=PKW(P1,2), pw2); \
    VRD(6); SBAR(); GAPA(C1=__builtin_amdgcn_mfma_f32_32x32x16_bf16(kf[5],qr[2],C1,0,0,0),   P1[6],P1[7],P1[8],P1[9],     pw2[2]=PKW(P1,4), pw2[3]=PKW(P1,6), pw2); \
    VRD(3); SBAR(); GAPA(C0=__builtin_amdgcn_mfma_f32_32x32x16_bf16(kf[6],qr[3],C0,0,0,0),   P1[10],P1[11],P1[12],P1[13], pw3[0]=PKW(P1,8), pw3[1]=PKW(P1,10), pw3); \
    VRD(7); SBAR(); GAPA(C1=__builtin_amdgcn_mfma_f32_32x32x16_bf16(kf[7],qr[3],C1,0,0,0),   P1[14],P1[15],0.f,0.f,       pw3[2]=PKW(P1,12),pw3[3]=PKW(P1,14), pw3); \
    l_reg+=sacc; \
    if(GK){DMA_K((t)+3,sl_cur);} if(GV){DMA_V((t)+1,sl_next);} \
    CMASK(C0,C1,t); \
    SBAR(); \
    GAPB(o[0]=__builtin_amdgcn_mfma_f32_32x32x16_bf16(PAF(0),VFR(0),o[0],0,0,0), C0,0); \
    GAPB(o[1]=__builtin_amdgcn_mfma_f32_32x32x16_bf16(PAF(0),VFR(4),o[1],0,0,0), C0,4); \
    KRD(GL,0); GAPB(o[0]=__builtin_amdgcn_mfma_f32_32x32x16_bf16(PAF(1),VFR(1),o[0],0,0,0), C0,8); \
    KRD(GL,1); GAPB(o[1]=__builtin_amdgcn_mfma_f32_32x32x16_bf16(PAF(1),VFR(5),o[1],0,0,0), C0,12); \
    KRD(GL,2); GAPB(o[0]=__builtin_amdgcn_mfma_f32_32x32x16_bf16(PAF(2),VFR(2),o[0],0,0,0), C1,0); \
    KRD(GL,3); GAPB(o[1]=__builtin_amdgcn_mfma_f32_32x32x16_bf16(PAF(2),VFR(6),o[1],0,0,0), C1,4); \
    GAPB(o[0]=__builtin_amdgcn_mfma_f32_32x32x16_bf16(PAF(3),VFR(3),o[0],0,0,0), C1,8); \
    GAPB(o[1]=__builtin_amdgcn_mfma_f32_32x32x16_bf16(PAF(3),VFR(7),o[1],0,0,0), C1,12); \
    }while(0)
  int t=1;
  #undef CMASK
  #define CMASK(P0,P1,t) do{}while(0)
  for(;t+5<NT;t+=2){
    STEP(pB0,pB1,pA0,pA1,t,true,true,true);     WAIT_BAR(2); RESC(); ROT();
    STEP(pA0,pA1,pB0,pB1,t+1,true,true,true);   WAIT_BAR(2); RESC(); ROT();
  }
  #undef CMASK
  #define CMASK(P0,P1,t) do{}while(0)
  #define ENDW(tt) do{ if((tt)+3<NT){WAIT_BAR(2);} else if((tt)+2<NT){WAIT_BAR(1);} else {WAIT_BAR(0);} }while(0)
  for(;t+1<NT;t+=2){
    STEP(pB0,pB1,pA0,pA1,t,(t+3<NT),(t+1<NT),(t+1<NT));       ENDW(t);   RESC(); ROT();
    STEP(pA0,pA1,pB0,pB1,t+1,(t+4<NT),(t+2<NT),(t+2<NT));     ENDW(t+1); RESC(); ROT();
  }
  STEP(pB0,pB1,pA0,pA1,NT-1,false,false,false); RESC();
  { float sacc=pB0[0]+pB0[1]; _Pragma("unroll") for(int r=2;r<16;++r)sacc+=pB0[r]; _Pragma("unroll") for(int r=0;r<16;++r)sacc+=pB1[r]; l_reg+=sacc;
    pw0=(u32x4){PKW(pB0,0),PKW(pB0,2),PKW(pB0,4),PKW(pB0,6)};pw1=(u32x4){PKW(pB0,8),PKW(pB0,10),PKW(pB0,12),PKW(pB0,14)};pw2=(u32x4){PKW(pB1,0),PKW(pB1,2),PKW(pB1,4),PKW(pB1,6)};pw3=(u32x4){PKW(pB1,8),PKW(pB1,10),PKW(pB1,12),PKW(pB1,14)};
    SBAR(); pv(o,vb0+sl_cur,PAF(0),PAF(1),PAF(2),PAF(3)); }
  #undef PKW
  #undef PAF
  #undef VFR
  #undef PIN
  #undef MX3
  #undef GAPA
  #undef GAPB
  #undef EX
  #undef VRD
  #undef KRD
  #undef STEP
  #undef ENDW
  {auto rr=__builtin_amdgcn_permlane32_swap(__float_as_uint(l_reg),__float_as_uint(l_reg),false,false);l_reg=__uint_as_float(rr[0])+__uint_as_float(rr[1]);}
  if(hi==0)wsf[32+r32]=l_reg;asm volatile("s_waitcnt lgkmcnt(0)":::"memory");
  float rli[16];
  #pragma unroll
  for(int r=0;r<16;++r)rli[r]=__builtin_amdgcn_rcpf(wsf[32+crow(r,hi)]);
  bf16*Ow=Ow0+(long)wid*QBLK*OP;
  { bf16*stg=(bf16*)(shm+LDS_OST)+wid*2048;
    #pragma unroll
    for(int r=0;r<16;++r){const int orow=crow(r,hi);
      #pragma unroll
      for(int d0=0;d0<2;++d0)stg[orow*64+d0*32+r32]=__float2bfloat16(o[d0][r]*rli[r]);}
    asm volatile("s_waitcnt lgkmcnt(0)":::"memory");
    #pragma unroll
    for(int i=0;i<4;++i){const int row=i*8+(lane>>3),ch=lane&7; const u32x4 v=*(const u32x4*)(stg+row*64+ch*8); ATTN_STORE16(Ow+(long)row*OP+ch*8,v);} }
  asm volatile("s_waitcnt lgkmcnt(0)\n\ts_barrier":::"memory");
  #undef DMA_K
  #undef DMA_V
  #undef CMASK
  #undef START
  #undef RESC
  #undef ROT
}
__device__ __forceinline__ void pv128(f32x16*o,int vb,bf16x8 pa0,bf16x8 pa1,bf16x8 pa2,bf16x8 pa3){
  #pragma unroll
  for(int d0=0;d0<4;++d0){s16x4 lo[4],hi[4];
    #pragma unroll
    for(int ks=0;ks<4;++ks){
      asm volatile("ds_read_b64_tr_b16 %0,%1 offset:%c2":"=&v"(lo[ks]):"v"(vb),"i"(d0*4096+ks*1024):"memory");
      asm volatile("ds_read_b64_tr_b16 %0,%1 offset:%c2":"=&v"(hi[ks]):"v"(vb),"i"(d0*4096+ks*1024+512):"memory");}
    asm volatile("s_waitcnt lgkmcnt(0)":::"memory");SBAR();
    #define PK(k) (bf16x8){lo[k][0],lo[k][1],lo[k][2],lo[k][3],hi[k][0],hi[k][1],hi[k][2],hi[k][3]}
    o[d0]=__builtin_amdgcn_mfma_f32_32x32x16_bf16(pa0,PK(0),o[d0],0,0,0);
    o[d0]=__builtin_amdgcn_mfma_f32_32x32x16_bf16(pa1,PK(1),o[d0],0,0,0);
    o[d0]=__builtin_amdgcn_mfma_f32_32x32x16_bf16(pa2,PK(2),o[d0],0,0,0);
    o[d0]=__builtin_amdgcn_mfma_f32_32x32x16_bf16(pa3,PK(3),o[d0],0,0,0);
    #undef PK
  }
}
constexpr int V128_V=NSLOT*SLOTB, V128_WS=V128_V+NSLOT*2*SLOTB, V128_Q=V128_WS+NW*64*4, V128_BYTES=V128_Q+NW*4096;
template<int THRL> __device__ __forceinline__ void attn_unit128(const bf16*Qw0,int QP,const bf16*Kh,int KP,const bf16*Vh,int VP,bf16*Ow0,int OP,int NT,char*shm,float kmax2){
  int tid=threadIdx.x; asm volatile("":"+v"(tid));
  const int lane=tid&63,r32=lane&31,hi=lane>>5; const int wid=__builtin_amdgcn_readfirstlane(tid>>6);
  const bf16*Qw=Qw0+(long)wid*QBLK*QP;
  const unsigned lds0=(unsigned)(uintptr_t)shm;
  float*wsf=(float*)(shm+V128_WS)+wid*64;
  const bf16*ksrc=Kh+(long)lane*KP+wid*8;
  const bf16*vsrc=Vh+(long)(16*(wid&3)+(lane>>2))*VP+(wid>>2)*32+(lane&3)*8;
  const unsigned kdst=lds0+LDS_K+wid*1024, vdst=lds0+V128_V+wid*1024;
  #define DMA_K(t,slot) glds16(ksrc+(long)(t)*KVBLK*KP,(unsigned)__builtin_amdgcn_readfirstlane(kdst+(slot)))
  #define DMA_V(t,slot) do{ glds16(vsrc+(long)(t)*KVBLK*VP,(unsigned)__builtin_amdgcn_readfirstlane(vdst+2*(slot))); glds16(vsrc+(long)(t)*KVBLK*VP+64,(unsigned)__builtin_amdgcn_readfirstlane(vdst+2*(slot)+8192)); }while(0)
  const int vb0=(int)(lds0+V128_V)+((lane>>4)&1)*32+(lane&3)*8+(4*hi+((lane&15)>>2))*64;
  const char*Kbase=shm+LDS_K; bf16x8 kf[8];
  const lds_cptr shm3=(lds_cptr)shm; const lds_cptr kp0=shm3+LDS_K+hi*1024+r32*16; const lds_cptr vp0=shm3+V128_V+((lane>>4)&1)*32+(lane&3)*8+(4*hi+((lane&15)>>2))*64;
  DMA_K(0,0);DMA_V(0,0);DMA_K(1,SLOTB);
  bf16x8 qr[4];
  #pragma unroll
  for(int d0=0;d0<4;++d0)qr[d0]=*reinterpret_cast<const bf16x8*>(&Qw[(long)r32*QP+d0*16+hi*8]);
  const lds_cptr qlp=shm3+V128_Q+wid*4096+lane*16;
  { __attribute__((address_space(3))) bf16x8* qw_=(__attribute__((address_space(3))) bf16x8*)(__attribute__((address_space(3))) char*)qlp; qw_[0]=qr[0]; qw_[64]=qr[1]; qw_[128]=qr[2]; qw_[192]=qr[3]; }
  float mhat,l_reg=0.f;
  { float qq=0.f; _Pragma("unroll") for(int d0=0;d0<4;++d0) _Pragma("unroll") for(int j=0;j<8;++j){ const float x=__uint_as_float(((unsigned)(unsigned short)qr[d0][j])<<16); qq+=x*x; }
    qq+=__shfl_xor(qq,32); mhat=fminf(sqrtf(qq*kmax2)*1.01f+1e-20f,96.0f); }
  f32x16 negm; _Pragma("unroll") for(int r=0;r<16;++r)negm[r]=-mhat; asm volatile("":"+v"(negm));
  f32x16 o[4];
  _Pragma("unroll") for(int d_=0;d_<4;++d_){ _Pragma("unroll") for(int r=0;r<16;++r)o[d_][r]=0.f; asm volatile("":"+v"(o[d_])); }
  #define CMASK(P0,P1,t) do{}while(0)
  #define START(P0,P1) do{ _Pragma("unroll") for(int r=0;r<16;++r)P0[r]=__builtin_amdgcn_exp2f(P0[r]); }while(0)
  #define RESC() do{}while(0)
  f32x16 pA0,pA1,pB0,pB1;
  int sl_prev=0,sl_cur=0,sl_next=SLOTB;
  #define ROT() do{sl_prev=sl_cur;sl_cur=sl_next;sl_next=(sl_next==(NSLOT-1)*SLOTB)?0:sl_next+SLOTB;}while(0)
  DMA_K(2,2*SLOTB);
  WAIT_BAR(4);
  qkt(pA0,pA1,Kbase,qr,negm,r32,hi);asm volatile("s_nop 15\n\ts_nop 7":"+v"(pA0),"+v"(pA1));CMASK(pA0,pA1,0);
  START(pA0,pA1);
  _Pragma("unroll") for(int r=0;r<16;++r)pA1[r]=__builtin_amdgcn_exp2f(pA1[r]);
  WAIT_BAR(0);
  DMA_K(3,0);DMA_V(1,SLOTB);
  ROT();
  kload8(kf,kp0+sl_cur);
  WAIT_BAR(3);
  s16x4 vlo[4],vhi[4]; u32x4 pw0,pw1,pw2,pw3;
  #define PKW(P,B) cvtpk_s(P[B],P[B+1])
  #define PAF(k) __builtin_bit_cast(bf16x8,pw##k)
  #define VFR(i) (bf16x8){vlo[i][0],vlo[i][1],vlo[i][2],vlo[i][3],vhi[i][0],vhi[i][1],vhi[i][2],vhi[i][3]}
  #define PIN(x) asm volatile("":"+v"(x))
  #define MX3(a,b,c) __builtin_fmaxf(__builtin_fmaxf((a),(b)),(c))
  #define GAPA(MF,A0,A1,A2,A3,W0,W1,PW) do{ MF; sacc+=A0; sacc+=A1; sacc+=A2; sacc+=A3; PIN(sacc); W0; W1; PIN(PW); SBAR(); }while(0)
  #define EX(v) __builtin_amdgcn_exp2f(v)
  #define GAPB(MF,X,B) do{ MF; X[B]=EX(X[B]); X[B+1]=EX(X[B+1]); X[B+2]=EX(X[B+2]); X[B+3]=EX(X[B+3]); PIN(X); }while(0)
  #define GAPB2(MF,X,B) do{ MF; X[B]=EX(X[B]); X[B+1]=EX(X[B+1]); PIN(X); }while(0)
  #define VRW(e,d0,ks) do{ vlo[e]=vtr(vp_+((d0)*4096+(ks)*1024)); vhi[e]=vtr(vp_+((d0)*4096+(ks)*1024+512)); }while(0)
  #define KRD(G,j) do{ if(G){ kload2(kf,kp0+sl_next,j); SBAR(); } }while(0)
  #define STEP(C0,C1,P0,P1,t,GK,GV,GL) do{ SBAR(); \
    const lds_cptr vp_=vp0+2*sl_prev; \
    const bf16x8 q0_=*(const __attribute__((address_space(3))) bf16x8*)(qlp), q1_=*(const __attribute__((address_space(3))) bf16x8*)(qlp+1024);     \
    float sacc=(P0[0]+P0[1]); \
    GAPA(C0=__builtin_amdgcn_mfma_f32_32x32x16_bf16(kf[0],q0_,negm,0,0,0), P0[2],P0[3],P0[4],P0[5],     pw0[0]=PKW(P0,0), pw0[1]=PKW(P0,2), pw0); \
    GAPA(C1=__builtin_amdgcn_mfma_f32_32x32x16_bf16(kf[1],q0_,negm,0,0,0), P0[6],P0[7],P0[8],P0[9],     pw0[2]=PKW(P0,4), pw0[3]=PKW(P0,6), pw0); \
    const bf16x8 q2_=*(const __attribute__((address_space(3))) bf16x8*)(qlp+2048); SBAR(); \
    GAPA(C0=__builtin_amdgcn_mfma_f32_32x32x16_bf16(kf[2],q1_,C0,0,0,0),   P0[10],P0[11],P0[12],P0[13], pw1[0]=PKW(P0,8), pw1[1]=PKW(P0,10), pw1); \
    GAPA(C1=__builtin_amdgcn_mfma_f32_32x32x16_bf16(kf[3],q1_,C1,0,0,0),   P0[14],P0[15],P1[0],P1[1],   pw1[2]=PKW(P0,12),pw1[3]=PKW(P0,14), pw1); \
    const bf16x8 q3_=*(const __attribute__((address_space(3))) bf16x8*)(qlp+3072); SBAR(); \
    VRW(0,0,0); SBAR(); GAPA(C0=__builtin_amdgcn_mfma_f32_32x32x16_bf16(kf[4],q2_,C0,0,0,0),   P1[2],P1[3],P1[4],P1[5],     pw2[0]=PKW(P1,0), pw2[1]=PKW(P1,2), pw2); \
    VRW(1,1,0); SBAR(); GAPA(C1=__builtin_amdgcn_mfma_f32_32x32x16_bf16(kf[5],q2_,C1,0,0,0),   P1[6],P1[7],P1[8],P1[9],     pw2[2]=PKW(P1,4), pw2[3]=PKW(P1,6), pw2); \
    VRW(2,0,1); SBAR(); GAPA(C0=__builtin_amdgcn_mfma_f32_32x32x16_bf16(kf[6],q3_,C0,0,0,0),   P1[10],P1[11],P1[12],P1[13], pw3[0]=PKW(P1,8), pw3[1]=PKW(P1,10), pw3); \
    VRW(3,1,1); SBAR(); GAPA(C1=__builtin_amdgcn_mfma_f32_32x32x16_bf16(kf[7],q3_,C1,0,0,0),   P1[14],P1[15],0.f,0.f,       pw3[2]=PKW(P1,12),pw3[3]=PKW(P1,14), pw3); \
    l_reg+=sacc; \
    if(GK){DMA_K((t)+3,sl_cur);} if(GV){DMA_V((t)+1,sl_next);} \
      \
    SBAR(); \
    GAPB2(o[0]=__builtin_amdgcn_mfma_f32_32x32x16_bf16(PAF(0),VFR(0),o[0],0,0,0), C0,0); VRW(0,0,2); SBAR(); \
    GAPB2(o[1]=__builtin_amdgcn_mfma_f32_32x32x16_bf16(PAF(0),VFR(1),o[1],0,0,0), C0,2); VRW(1,1,2); SBAR(); \
    KRD(GL,0); GAPB2(o[0]=__builtin_amdgcn_mfma_f32_32x32x16_bf16(PAF(1),VFR(2),o[0],0,0,0), C0,4); VRW(2,0,3); SBAR(); \
    KRD(GL,1); GAPB2(o[1]=__builtin_amdgcn_mfma_f32_32x32x16_bf16(PAF(1),VFR(3),o[1],0,0,0), C0,6); VRW(3,1,3); SBAR(); \
    KRD(GL,2); GAPB2(o[0]=__builtin_amdgcn_mfma_f32_32x32x16_bf16(PAF(2),VFR(0),o[0],0,0,0), C0,8); VRW(0,2,0); SBAR(); \
    KRD(GL,3); GAPB2(o[1]=__builtin_amdgcn_mfma_f32_32x32x16_bf16(PAF(2),VFR(1),o[1],0,0,0), C0,10); VRW(1,3,0); SBAR(); \
    GAPB2(o[0]=__builtin_amdgcn_mfma_f32_32x32x16_bf16(PAF(3),VFR(2),o[0],0,0,0), C0,12); VRW(2,2,1); SBAR(); \
    GAPB2(o[1]=__builtin_amdgcn_mfma_f32_32x32x16_bf16(PAF(3),VFR(3),o[1],0,0,0), C0,14); VRW(3,3,1); SBAR(); \
    GAPB2(o[2]=__builtin_amdgcn_mfma_f32_32x32x16_bf16(PAF(0),VFR(0),o[2],0,0,0), C1,0); VRW(0,2,2); SBAR(); \
    GAPB2(o[3]=__builtin_amdgcn_mfma_f32_32x32x16_bf16(PAF(0),VFR(1),o[3],0,0,0), C1,2); VRW(1,3,2); SBAR(); \
    GAPB2(o[2]=__builtin_amdgcn_mfma_f32_32x32x16_bf16(PAF(1),VFR(2),o[2],0,0,0), C1,4); VRW(2,2,3); SBAR(); \
    GAPB2(o[3]=__builtin_amdgcn_mfma_f32_32x32x16_bf16(PAF(1),VFR(3),o[3],0,0,0), C1,6); VRW(3,3,3); SBAR(); \
    GAPB2(o[2]=__builtin_amdgcn_mfma_f32_32x32x16_bf16(PAF(2),VFR(0),o[2],0,0,0), C1,8); SBAR(); \
    GAPB2(o[3]=__builtin_amdgcn_mfma_f32_32x32x16_bf16(PAF(2),VFR(1),o[3],0,0,0), C1,10); SBAR(); \
    GAPB2(o[2]=__builtin_amdgcn_mfma_f32_32x32x16_bf16(PAF(3),VFR(2),o[2],0,0,0), C1,12); SBAR(); \
    GAPB2(o[3]=__builtin_amdgcn_mfma_f32_32x32x16_bf16(PAF(3),VFR(3),o[3],0,0,0), C1,14);  \
    }while(0)
  int t=1;
  #undef CMASK
  #define CMASK(P0,P1,t) do{}while(0)
  for(;t+5<NT;t+=2){
    STEP(pB0,pB1,pA0,pA1,t,true,true,true);     WAIT_BAR(3); RESC(); ROT();
    STEP(pA0,pA1,pB0,pB1,t+1,true,true,true);   WAIT_BAR(3); RESC(); ROT();
  }
  #undef CMASK
  #define CMASK(P0,P1,t) do{}while(0)
  #define ENDW(tt) do{ if((tt)+3<NT){WAIT_BAR(3);} else if((tt)+2<NT){WAIT_BAR(2);} else {WAIT_BAR(0);} }while(0)
  for(;t+1<NT;t+=2){
    STEP(pB0,pB1,pA0,pA1,t,(t+3<NT),(t+1<NT),(t+1<NT));       ENDW(t);   RESC(); ROT();
    STEP(pA0,pA1,pB0,pB1,t+1,(t+4<NT),(t+2<NT),(t+2<NT));     ENDW(t+1); RESC(); ROT();
  }
  STEP(pB0,pB1,pA0,pA1,NT-1,false,false,false); RESC();
  { float sacc=pB0[0]+pB0[1]; _Pragma("unroll") for(int r=2;r<16;++r)sacc+=pB0[r]; _Pragma("unroll") for(int r=0;r<16;++r)sacc+=pB1[r]; l_reg+=sacc;
    pw0=(u32x4){PKW(pB0,0),PKW(pB0,2),PKW(pB0,4),PKW(pB0,6)};pw1=(u32x4){PKW(pB0,8),PKW(pB0,10),PKW(pB0,12),PKW(pB0,14)};pw2=(u32x4){PKW(pB1,0),PKW(pB1,2),PKW(pB1,4),PKW(pB1,6)};pw3=(u32x4){PKW(pB1,8),PKW(pB1,10),PKW(pB1,12),PKW(pB1,14)};
    SBAR(); pv128(o,vb0+2*sl_cur,PAF(0),PAF(1),PAF(2),PAF(3)); }
  #undef PKW
  #undef PAF
  #undef VFR
  #undef PIN
  #undef MX3
  #undef GAPA
  #undef GAPB
  #undef GAPB2
  #undef EX
  #undef VRW
  #undef KRD
  #undef STEP
  #undef ENDW
  {auto rr=__builtin_amdgcn_permlane32_swap(__float_as_uint(l_reg),__float_as_uint(l_reg),false,false);l_reg=__uint_as_float(rr[0])+__uint_as_float(rr[1]);}
  if(hi==0)wsf[32+r32]=l_reg;asm volatile("s_waitcnt lgkmcnt(0)":::"memory");
  float rli[16];
  #pragma unroll
  for(int r=0;r<16;++r)rli[r]=__builtin_amdgcn_rcpf(wsf[32+crow(r,hi)]);
  bf16*Ow=Ow0+(long)wid*QBLK*OP;
  asm volatile("s_waitcnt lgkmcnt(0)\n\ts_barrier":::"memory");
  { bf16*stg=(bf16*)(shm)+wid*4096;
    #pragma unroll
    for(int r=0;r<16;++r){const int orow=crow(r,hi);
      #pragma unroll
      for(int d0=0;d0<4;++d0)stg[orow*128+d0*32+r32]=__float2bfloat16(o[d0][r]*rli[r]);}
    asm volatile("s_waitcnt lgkmcnt(0)":::"memory");
    #pragma unroll
    for(int i=0;i<8;++i){const int row=i*4+(lane>>4),ch=lane&15; const u32x4 v=*(const u32x4*)(stg+row*128+ch*8); ATTN_STORE16(Ow+(long)row*OP+ch*8,v);} }
  asm volatile("s_waitcnt lgkmcnt(0)\n\ts_barrier":::"memory");
  #undef DMA_K
  #undef DMA_V
  #undef CMASK
  #undef START
  #undef RESC
  #undef ROT
}
constexpr int ATTN_LDS_BYTES=LDS_BYTES;
#undef SBAR
#undef WAIT_BAR
}
#ifndef PROBE_MASK
#define PROBE_MASK 0ull
#endif
#ifndef PROBE_AMP
#define PROBE_AMP 4
#endif

constexpr int NWAVES = 8;
constexpr int DM = 1024, SEQ = 8192, NB = 2, CTXL = 256, NLAT = NB * SEQ, T = NLAT + NB * CTXL  , NKEY = SEQ + CTXL  ;
constexpr int NPXA = 2304, NPXB = 4096, INC = NPXA + NPXB;
constexpr float EPS = 1e-6f;
constexpr size_t MiB = 1u << 20;
constexpr size_t WS_CTL = 0, CTL_ZERO_BYTES = 1 * MiB, WS_MOD = 512 * 1024;
constexpr size_t WS_KMAX = 768 * 1024;
constexpr size_t WS_ROPE = 1 * MiB, WS_LAM = 1 * MiB + 65536;
constexpr size_t WS_WIN = 2 * MiB, WS_WA = 15 * MiB, WS_WB = 16 * MiB, WS_WC = 17 * MiB, WS_WO = 18 * MiB, WS_WQ = 20 * MiB;
constexpr size_t WS_U16 = 22 * MiB, WS_V16 = 54 * MiB;
constexpr size_t WS_SU = WS_U16 + 12 * MiB, WS_SV = WS_V16 + 12 * MiB; constexpr int ROW6 = 768;
constexpr size_t WS_X = 86 * MiB;
constexpr size_t WS_R1 = 152 * MiB;
constexpr size_t WS_R2 = 227 * MiB;
constexpr size_t SZ_QA = (size_t)NB * 4 * 2 * NKEY * 64 * 2, SZ_VA = (size_t)NB * 4 * NKEY * 128 * 2, SZ_QB = (size_t)NB * 8 * NKEY * 64 * 2, SZ_KB = (size_t)NB * 2 * NKEY * 64 * 2;
constexpr size_t WS_QA = WS_R2, WS_KA = WS_QA + SZ_QA, WS_VA = WS_KA + SZ_QA, WS_QB = WS_VA + SZ_VA, WS_KB = WS_QB + SZ_QB, WS_VB = WS_KB + SZ_KB;
constexpr size_t WS_MB = WS_R2, WS_EIDX = WS_R2 + 33 * MiB, WS_GW = WS_EIDX + (size_t)T * 128 * 4;
constexpr size_t WS_R3 = 306 * MiB;
constexpr size_t WS_R4 = 438 * MiB;
constexpr size_t SZ_O = (size_t)T * 512 * 2;
constexpr size_t WS_OABC = WS_R4, WS_HX = WS_R4;
constexpr size_t WS_SSQ = 488 * MiB;
constexpr size_t WS_BQ = 490 * MiB;
constexpr size_t WS_END = 491 * MiB;
static_assert(WS_VB + SZ_KB <= WS_R3 && WS_GW + (size_t)T * 128 * 4 <= WS_R3 && WS_R1 + (size_t)T * NPXA * 2 <= WS_R2 && WS_R3 + (size_t)T * NPXB * 2 <= WS_R4 && WS_OABC + 3 * SZ_O <= WS_END, "d_ws map");
constexpr int CW_TMO = 0, CW_BAR = 4096;
static_assert(CW_BAR * 4 + 3456 * 4 <= WS_MOD && WS_MOD + (size_t)2 * 3 * 6144 * 4 <= WS_KMAX && WS_KMAX + 512 <= CTL_ZERO_BYTES, "control-region map");

constexpr int RING_BYTES = 131072, LDSCTL_OFF = RING_BYTES, MISC_OFF = LDSCTL_OFF + 320, LDS_BYTES = 147456;

struct Args { const float* in[27]; float* out; unsigned char* ws; int ph_lo, ph_hi; };
struct Frame { LAS unsigned char* lds; volatile LAS unsigned* MISC; gu32* ctl; int tid, lane, wave, G, bid; };

typedef float f32x16 __attribute__((ext_vector_type(16)));
typedef short s16x4 __attribute__((ext_vector_type(4)));
typedef unsigned u32x2 __attribute__((ext_vector_type(2)));
typedef float f32x2 __attribute__((ext_vector_type(2)));
typedef float v32f __attribute__((ext_vector_type(32))); typedef __bf16 v32bf __attribute__((ext_vector_type(32))); typedef unsigned v6u __attribute__((ext_vector_type(6))); typedef unsigned v3u __attribute__((ext_vector_type(3)));
__device__ __forceinline__ float bf2f(unsigned short b) { return __uint_as_float((unsigned)b << 16); }
__device__ __forceinline__ float bflo(unsigned w) { return __uint_as_float(w << 16); }
__device__ __forceinline__ float bfhi(unsigned w) { return __uint_as_float(w & 0xffff0000u); }
__device__ __forceinline__ float sigm(float x) { return __builtin_amdgcn_rcpf(1.0f + __expf(-x)); }
__device__ __forceinline__ int mod_index(int row) { return row < SEQ ? 0 : (row < NLAT ? 1 : 2); }
__device__ __forceinline__ void row_to_bn(int row, int& b, int& nd) { if (row < NLAT) { b = row >> 13; nd = row & (SEQ - 1); } else { const int r = row - NLAT; b = r >> 8; nd = SEQ + (r & 255); } }

__device__ __forceinline__ void ph_prep0(const Args& a, Frame& F) {
    const int gtid = (F.G - 1 - F.bid) * 512 + F.tid;
    if (gtid < 2048) {
        const int pos = gtid >> 4, i = gtid & 15;
        double inv = 1.0; for (int k = 0; k < i; ++k) inv *= 0.5623413251903491;
        const double x = (double)pos * inv, TWO_PI = 6.283185307179586476925;
        const double kk = rint(x / TWO_PI), y = x - kk * TWO_PI, y2 = y * y;
        double ts = 1.0, tc = 1.0;
        for (int n = 14; n >= 1; --n) { ts = 1.0 - ts * y2 / (double)((2 * n) * (2 * n + 1)); tc = 1.0 - tc * y2 / (double)((2 * n - 1) * (2 * n)); }
        float* rp = (float*)(a.ws + WS_ROPE) + gtid * 2; rp[0] = (float)tc; rp[1] = (float)(y * ts);
    }
    if (gtid >= 2048 && gtid < 2050) {
        const int l = gtid - 2048; float s1 = 0.f, s2 = 0.f;
        for (int d = 0; d < 64; ++d) { s1 += a.in[7][l * 64 + d] * a.in[8][l * 64 + d]; s2 += a.in[9][l * 64 + d] * a.in[10][l * 64 + d]; }
        const float lam_init = l == 0 ? 0.2f : 0.35550906759096926f;
        float* lp = (float*)(a.ws + WS_LAM); lp[l * 2] = expf(s1) - expf(s2) + lam_init; lp[l * 2 + 1] = 1.0f - lam_init;
    }
    if (F.bid < 192) {
        float* MOD = (float*)(a.ws + WS_MOD); LAS float* sc = (LAS float*)F.lds; LAS float* red = sc + 3072;
        for (int i = F.tid; i < 3072; i += 512) { const int k = i & 1023; const float c = i < 1024 ? a.in[1][k] : (i < 2048 ? a.in[1][1024 + k] : a.in[3][k]); sc[i] = c * sigm(c); }
        __syncthreads();
        for (int u = F.bid; u < 192; u += F.G) {
            const int l = u / 96, cc = u % 96, kg = F.tid >> 4, c4 = F.tid & 15;
            const f32x4* W = (const f32x4*)(a.in[4] + (size_t)l * 1024 * 6144 + (size_t)(kg * 32) * 6144 + cc * 64 + 4 * c4);
            f32x4 s0 = {0.f, 0.f, 0.f, 0.f}, s1 = s0, s2 = s0;
#pragma unroll
            for (int h = 0; h < 2; ++h) { f32x4 w[16];
#pragma unroll
                for (int kk = 0; kk < 16; ++kk) w[kk] = W[(size_t)(h * 16 + kk) * (6144 / 4)];
#pragma unroll
                for (int kk = 0; kk < 16; ++kk) { const int k = kg * 32 + h * 16 + kk; s0 += sc[k] * w[kk]; s1 += sc[1024 + k] * w[kk]; s2 += sc[2048 + k] * w[kk]; } }
            *(LAS f32x4*)(red + (kg * 3 + 0) * 64 + 4 * c4) = s0; *(LAS f32x4*)(red + (kg * 3 + 1) * 64 + 4 * c4) = s1; *(LAS f32x4*)(red + (kg * 3 + 2) * 64 + 4 * c4) = s2;
            __syncthreads();
            if (F.tid < 192) { const int mi = F.tid >> 6, c = F.tid & 63; float s = a.in[5][l * 6144 + cc * 64 + c];
                for (int g = 0; g < 32; ++g) s += red[(g * 3 + mi) * 64 + c];
                MOD[(l * 3 + mi) * 6144 + cc * 64 + c] = s; }
            __syncthreads();
        }
    }
}
__device__ __forceinline__ void ph_convw(const Args& a, Frame& F, int l) {
    LAS float* scr = (LAS float*)(F.lds + F.wave * 16384);
    const int gw = F.bid * NWAVES + F.wave, NGW = F.G * NWAVES;
    constexpr int I_IN = 16 * 200, I_BR = 8 * 32, I_O = 16 * 32, NITEMS = I_IN + 3 * I_BR + 2 * I_O;
    for (int it = gw; it < NITEMS; it += NGW) {
        int r = it;
        if (r < I_IN) { p0_transpose_item(a.in[6] + (size_t)l * 1024 * INC, 1024, INC, (bf16*)(a.ws + WS_WIN), 0, scr, r, F.lane); continue; } r -= I_IN;
        if (r < I_BR) { p0_transpose_item_p(a.in[18] + (size_t)l * 512 * 1024, 512, 1024, (bf16*)(a.ws + WS_WA), 1536, 0, scr, r, F.lane); continue; } r -= I_BR;
        if (r < I_BR) { p0_transpose_item_p(a.in[19] + (size_t)l * 512 * 1024, 512, 1024, (bf16*)(a.ws + WS_WA), 1536, 512, scr, r, F.lane); continue; } r -= I_BR;
        if (r < I_BR) { p0_transpose_item_p(a.in[20] + (size_t)l * 512 * 1024, 512, 1024, (bf16*)(a.ws + WS_WA), 1536, 1024, scr, r, F.lane); continue; } r -= I_BR;
        if (r < I_O) { p0_transpose_item(a.in[21] + (size_t)l * 1024 * 1024, 1024, 1024, (bf16*)(a.ws + WS_WO), 0, scr, r, F.lane); continue; } r -= I_O;
        p0_transpose_item(a.in[22] + (size_t)l * 1024 * 1024, 1024, 1024, (bf16*)(a.ws + WS_WQ), 0, scr, r, F.lane);
    }
    const int gtid = F.bid * 512 + F.tid, NT = F.G * 512; constexpr int NI = 2 * 16384 * 32, NIH = 16384 * 32;
    const f32x4* us = (const f32x4*)(a.in[24] + (size_t)l * 16384 * 1024); const f32x4* vs = (const f32x4*)(a.in[25] + (size_t)l * 16384 * 1024);
    for (int i0 = gtid; i0 < NI; i0 += 2 * NT) { f32x4 p_[2][8];
#pragma unroll
        for (int u_ = 0; u_ < 2; ++u_) { const int i = min(i0 + u_ * NT, NI - 1); const bool isv = i >= NIH; const int j = isv ? i - NIH : i; const f32x4* sp = (isv ? vs : us) + 8 * (size_t)j;
#pragma unroll
            for (int q = 0; q < 8; ++q) p_[u_][q] = sp[q]; }
#pragma unroll
        for (int u_ = 0; u_ < 2; ++u_) { const int i = min(i0 + u_ * NT, NI - 1); const bool isv = i >= NIH; const int j = isv ? i - NIH : i;
            float m = 0.f;
#pragma unroll
            for (int q = 0; q < 8; ++q) m = fmaxf(fmaxf(m, fmaxf(fabsf(p_[u_][q][0]), fabsf(p_[u_][q][1]))), fmaxf(fabsf(p_[u_][q][2]), fabsf(p_[u_][q][3])));
#pragma unroll
            for (int o = 16; o >= 1; o >>= 1) m = fmaxf(m, __shfl_xor(m, o));
            const float sc = m > 0.f ? 7.5f * __builtin_amdgcn_rcpf(m) : 1.0f, inv = m > 0.f ? m * (1.0f / 7.5f) : 1.0f;
            v32bf bv;
#pragma unroll
            for (int q = 0; q < 8; ++q) { bv[4 * q] = (__bf16)(p_[u_][q][0] * sc); bv[4 * q + 1] = (__bf16)(p_[u_][q][1] * sc); bv[4 * q + 2] = (__bf16)(p_[u_][q][2] * sc); bv[4 * q + 3] = (__bf16)(p_[u_][q][3] * sc); }
            const v6u o = __builtin_amdgcn_cvt_scalef32_pk32_fp6_bf16(bv, 1.0f);
            if (i0 + u_ * NT < NI) { unsigned char* dp = a.ws + (isv ? WS_V16 : WS_U16) + (size_t)(j >> 5) * ROW6 + 24 * (j & 31);
                *(u32x2*)dp = (u32x2){o[0], o[1]}; *(u32x2*)(dp + 8) = (u32x2){o[2], o[3]}; *(u32x2*)(dp + 16) = (u32x2){o[4], o[5]};
                if ((j & 31) == 0) ((float*)(a.ws + (isv ? WS_SV : WS_SU)))[j >> 5] = inv; } } }
}
__device__ __forceinline__ void ph_mod(const Args& a, Frame& F, int l, int which) {
    const float* MOD = (const float*)(a.ws + WS_MOD) + (size_t)l * 3 * 6144 + (which ? 3072 : 0);
    const bool from_in = (l == 0 && which == 0);
    const float* X = from_in ? a.in[0] : (const float*)(a.ws + WS_X); const float* XC = from_in ? a.in[2] - (size_t)NLAT * DM : X; bf16* HX = (bf16*)(a.ws + WS_HX);
    const int gw = F.bid * NWAVES + F.wave, NGW = F.G * NWAVES; const int TL = (l == 1 && which == 1) ? NLAT : T;
    for (int row0 = gw; row0 < TL; row0 += 2 * NGW) {
        f32x4 v[2][4]; float ss[2];
#pragma unroll
        for (int u_ = 0; u_ < 2; ++u_) { const int row = min(row0 + u_ * NGW, TL - 1); const f32x4* xr = (const f32x4*)((row < NLAT ? X : XC) + (size_t)row * DM) + F.lane; ss[u_] = 0.f;
#pragma unroll
            for (int j = 0; j < 4; ++j) v[u_][j] = xr[64 * j]; }
#pragma unroll
        for (int u_ = 0; u_ < 2; ++u_) {
#pragma unroll
            for (int j = 0; j < 4; ++j) ss[u_] += (v[u_][j][0] * v[u_][j][0] + v[u_][j][1] * v[u_][j][1]) + (v[u_][j][2] * v[u_][j][2] + v[u_][j][3] * v[u_][j][3]); }
#pragma unroll
        for (int u_ = 0; u_ < 2; ++u_) { const int row = row0 + u_ * NGW; if (row < TL) {
            const float* sh = MOD + mod_index(row) * 6144; const float* sc = sh + 1024;
            const float rstd = rsqrtf(wave_sum(ss[u_]) * (1.0f / DM) + EPS);
#pragma unroll
            for (int j = 0; j < 4; ++j) { const int c = 4 * F.lane + 256 * j; const f32x4 s1 = *(const f32x4*)(sc + c), s0 = *(const f32x4*)(sh + c);
                const f32x4 h = v[u_][j] * rstd * (s1 + 1.0f) + s0; u32x2 o; o.x = pk2(h[0], h[1]); o.y = pk2(h[2], h[3]); *(u32x2*)(HX + (size_t)row * DM + c) = o; } } }
    }
}
__device__ __forceinline__ void ph_post(const Args& a, Frame& F, int l) {
    const bf16* PXa = (const bf16*)(a.ws + WS_R1); const float* rope = (const float*)(a.ws + WS_ROPE);
    const int gw = F.bid * NWAVES + F.wave, NGW = F.G * NWAVES, lane = F.lane;
    float km0_ = 0.f, km1_ = 0.f;
    {
        const int c = lane & 7, g8 = lane >> 3;
        float qw[8], kw[8];
#pragma unroll
        for (int j = 0; j < 8; ++j) { qw[j] = a.in[12][l * 64 + 8 * c + j]; kw[j] = a.in[13][l * 64 + 8 * c + j]; }
        float& km0 = km0_; float& km1 = km1_;
        for (int row = gw; row < T; row += NGW) {
            int b, nd; row_to_bn(row, b, nd);
            const bool lat = row < NLAT; const int pos = (c & 4) ? (nd & 63) : ((nd >> 6) & 127);
            float cs[8], sn[8];
            { const f32x4* rp = (const f32x4*)(rope + (pos * 16 + 8 * (c & 1)) * 2);
              const f32x4 r0 = rp[0], r1 = rp[1], r2 = rp[2], r3 = rp[3];
              cs[0] = r0[0]; sn[0] = r0[1]; cs[1] = r0[2]; sn[1] = r0[3]; cs[2] = r1[0]; sn[2] = r1[1]; cs[3] = r1[2]; sn[3] = r1[3];
              cs[4] = r2[0]; sn[4] = r2[1]; cs[5] = r2[2]; sn[5] = r2[3]; cs[6] = r3[0]; sn[6] = r3[1]; cs[7] = r3[2]; sn[7] = r3[3]; }
            const bf16* pr = PXa + (size_t)row * NPXA;
            v4u wv[5];
#pragma unroll
            for (int it = 0; it < 5; ++it) { const int hv = min(8 * it + g8, 35); wv[it] = *(const v4u*)(pr + hv * 64 + 8 * c); }
#pragma unroll
            for (int it = 0; it < 5; ++it) {
                const int hv = 8 * it + g8;
                float x[8]; x[0] = bflo(wv[it].x); x[1] = bfhi(wv[it].x); x[2] = bflo(wv[it].y); x[3] = bfhi(wv[it].y); x[4] = bflo(wv[it].z); x[5] = bfhi(wv[it].z); x[6] = bflo(wv[it].w); x[7] = bfhi(wv[it].w);
                const bool is_v = (hv >= 8 && hv < 16) || hv == 18 || hv == 19;
                const bool nrm = (hv == 16 || hv == 17 || hv >= 28);
                float ss = 0.f;
#pragma unroll
                for (int j = 0; j < 8; ++j) ss += x[j] * x[j];
                ss += __shfl_xor(ss, 1); ss += __shfl_xor(ss, 2); ss += __shfl_xor(ss, 4);
                const float rs = rsqrtf(ss * (1.0f / 64.0f) + EPS);
                if (it == 0) { if (b == 0) km0 = fmaxf(km0, ss); else km1 = fmaxf(km1, ss); }
                const float qs = hv >= 20 ? 0.18033688011112042f : 1.0f;
#pragma unroll
                for (int j = 0; j < 8; ++j) { if (nrm) x[j] *= rs * (hv >= 28 ? qw[j] : kw[j]); }
                const bool rot = lat && !is_v;
#pragma unroll
                for (int j = 0; j < 8; ++j) { const float p = __shfl_xor(x[j], 2); const float r = x[j] * cs[j] + ((c & 2) ? p : -p) * sn[j]; x[j] = (rot ? r : x[j]) * qs; }
                v4u o; o.x = pk2(x[0], x[1]); o.y = pk2(x[2], x[3]); o.z = pk2(x[4], x[5]); o.w = pk2(x[6], x[7]);
                unsigned off;
                if (hv < 8) off = (unsigned)WS_KA + (((unsigned)(b * 8 + hv) * NKEY + nd) * 64 + 8 * c) * 2;
                else if (hv < 16) off = (unsigned)WS_VA + (((unsigned)(b * 4 + ((hv - 8) >> 1)) * NKEY + nd) * 128 + ((hv - 8) & 1) * 64 + 8 * c) * 2;
                else if (hv < 18) off = (unsigned)WS_KB + (((unsigned)(b * 2 + (hv - 16)) * NKEY + nd) * 64 + 8 * c) * 2;
                else if (hv < 20) off = (unsigned)WS_VB + (((unsigned)(b * 2 + (hv - 18)) * NKEY + nd) * 64 + 8 * c) * 2;
                else if (hv < 28) off = (unsigned)WS_QA + (((unsigned)(b * 8 + (hv - 20)) * NKEY + nd) * 64 + 8 * c) * 2;
                else off = (unsigned)WS_QB + (((unsigned)(b * 8 + (hv - 28)) * NKEY + nd) * 64 + 8 * c) * 2;
                if (hv < 36) *(v4u*)(a.ws + off) = o;
            }
        }
    }
    { LAS float* KM = (LAS float*)(F.lds + 70656);
      if ((lane & 7) == 0) { KM[(F.wave * 2 + 0) * 8 + (lane >> 3)] = km0_; KM[(F.wave * 2 + 1) * 8 + (lane >> 3)] = km1_; }
      __syncthreads();
      int t_ = F.tid; asm volatile("" : "+v"(t_));
      if (t_ < 16) { float m = 0.f;
#pragma unroll
          for (int w_ = 0; w_ < 8; ++w_) m = fmaxf(m, KM[w_ * 16 + t_]);
          atomicMax((unsigned*)(a.ws + WS_KMAX) + l * 64 + t_, __float_as_uint(m)); } }
    const bf16* PXb = (const bf16*)(a.ws + WS_R3); bf16* OC = (bf16*)(a.ws + WS_OABC) + 1024;
    LAS unsigned short* UL = (LAS unsigned short*)F.lds;
    LAS float* RED = (LAS float*)(F.lds + 65536);
    LAS float* STAT = (LAS float*)(F.lds + 68608);
    LAS float* MSK = (LAS float*)(F.lds + 69632);
    constexpr int TT = 33;
    const int c = F.tid;
    float w[31];
#pragma unroll
    for (int k = 0; k < 31; ++k) w[k] = a.in[14][(size_t)l * 31 * 512 + k * 512 + c];
    int vz; asm volatile("v_mov_b32 %0, 0" : "=v"(vz));
    const float cb = a.in[15][l * 512 + c], lnw = a.in[16][l * 512 + c], lnb = a.in[17][l * 512 + c];
    for (int ct = F.bid; ct < (l == 0 ? T / TT : (NLAT + TT - 1) / TT); ct += F.G) {
        const int t0 = ct * TT;
        int bnd = -1; { const int lo_ = t0 - 15, hi_ = t0 + TT + 15; if (lo_ < 0) bnd = 0; else if (SEQ > lo_ && SEQ < hi_) bnd = SEQ; else if (NLAT > lo_ && NLAT < hi_) bnd = NLAT; else if (NLAT + CTXL > lo_ && NLAT + CTXL < hi_) bnd = NLAT + CTXL; else if (hi_ > T) bnd = T; }
        if (F.tid < 128) { const int p = F.tid >> 6, i = F.tid & 63; const int r = t0 - 15 + i;
            MSK[p * 64 + i] = (i < TT + 30 && r >= 0 && r < T && (bnd < 0 || ((r < bnd) == (p == 0)))) ? 1.f : 0.f;
            MSK[128 + p * 64 + i] = (i < TT && (bnd < 0 ? p == 0 : (((t0 + i) < bnd) == (p == 0)))) ? 1.f : 0.f; }
        __syncthreads();
        float y[TT];
#pragma unroll
        for (int n = 0; n < TT; ++n) y[n] = 0.f;
        const int npass = bnd < 0 ? 1 : 2;
        for (int pass = 0; pass < npass; ++pass) {
            __syncthreads();
            { v4u ga_[8], gg_[8];
#pragma unroll
              for (int q = 0; q < 8; ++q) { const int it = min(F.tid + 512 * q, (TT + 30) * 64 - 1); const int i = it >> 6, j8 = (it & 63) * 8; const int r = min(max(t0 - 15 + i, 0), T - 1);
                  ga_[q] = *(const v4u*)(PXb + (size_t)r * NPXB + j8); gg_[q] = *(const v4u*)(PXb + (size_t)r * NPXB + 512 + j8); }
#pragma unroll
              for (int q = 0; q < 8; ++q) { const int it = F.tid + 512 * q; if (it < (TT + 30) * 64) { const int i = it >> 6, j8 = (it & 63) * 8; const float mk = MSK[pass * 64 + i];
                  v4u o;
#pragma unroll
                  for (int e = 0; e < 4; ++e) { const float u0 = bflo(ga_[q][e]) * sigm(bflo(gg_[q][e])) * mk, u1 = bfhi(ga_[q][e]) * sigm(bfhi(gg_[q][e])) * mk; o[e] = pk2(u0, u1); }
                  *(LAS v4u*)(UL + i * 512 + j8) = o; } }
            }
            __syncthreads();
            float u[TT + 30];
#pragma unroll
            for (int i = 0; i < TT + 30; ++i) u[i] = bf2f(UL[i * 512 + c]);
#pragma unroll
            for (int n = 0; n < TT; ++n) { float acc = cb;
#pragma unroll
                for (int k = 0; k < 31; ++k) acc += w[k] * u[n + k];
                y[n] += acc * MSK[128 + pass * 64 + n + vz]; if ((n & 3) == 3) __builtin_amdgcn_sched_barrier(0); }
        }
#pragma unroll
        for (int n = 0; n < TT; ++n) { float s1 = y[n], s2 = y[n] * y[n];
#pragma unroll
            for (int o = 32; o >= 1; o >>= 1) { s1 += __shfl_xor(s1, o); s2 += __shfl_xor(s2, o); }
            if (lane == 0) { RED[(F.wave * TT + n) * 2] = s1; RED[(F.wave * TT + n) * 2 + 1] = s2; } }
        __syncthreads();
        if (F.tid < TT) { const int n = F.tid; float s1 = 0.f, s2 = 0.f;
#pragma unroll
            for (int wv_ = 0; wv_ < 8; ++wv_) { s1 += RED[(wv_ * TT + n) * 2]; s2 += RED[(wv_ * TT + n) * 2 + 1]; }
            const float mu = s1 * (1.0f / 512.0f), var = fmaxf(s2 * (1.0f / 512.0f) - mu * mu, 0.f);
            STAT[2 * n] = mu; STAT[2 * n + 1] = rsqrtf(var + EPS); }
        __syncthreads();
#pragma unroll
        for (int n = 0; n < TT; ++n) {
            if ((n & 7) == 7) __builtin_amdgcn_sched_barrier(0);
            const float yn = (y[n] - STAT[2 * n + vz]) * STAT[2 * n + 1 + vz] * lnw + lnb;
            OC[(size_t)(t0 + n) * 1536 + c] = (unsigned short)f2bf(yn * sigm(yn)); }
        __syncthreads();
    }
}
__device__ __forceinline__ void ph_attn(const Args& a, Frame& F, int l, char* shm) {
    typedef attn_body::bf16 abf;
    const int xcd = F.bid & 7, idx = F.bid >> 3;
    const int nA = (F.G == 256) ? 2 + ((l == 0 && F.bid < 16) ? 1 : 0) : 0;
    for (int j = 0; j < nA; ++j) {
        const int st = j < 2 ? 2 * xcd + j : F.bid, qb = j < 2 ? idx : 32;
        const int kt0 = qb == 32 ? 128 : 0, NT = qb == 32 ? 4 : 132;
        const abf* Qp = (const abf*)(a.ws + WS_QA) + ((size_t)st * NKEY + qb * 256) * 64; const abf* Kp = (const abf*)(a.ws + WS_KA) + ((size_t)st * NKEY + kt0 * 64) * 64;
        const abf* Vp = (const abf*)(a.ws + WS_VA) + ((size_t)(st >> 1) * NKEY + kt0 * 64) * 128;
        abf* Op = (abf*)(a.ws + WS_R1) + ((size_t)st * NKEY + qb * 256) * 128;
        attn_body::attn_unit128<8>(Qp, 64, Kp, 64, Vp, 128, Op, 128, NT, shm, __uint_as_float(__hip_atomic_load((unsigned*)(a.ws + WS_KMAX) + l * 64 + st, __ATOMIC_RELAXED, __HIP_MEMORY_SCOPE_AGENT)));
    }
    float mq = 0.f, mk = 0.f; for (int d = 0; d < 64; ++d) { mq = fmaxf(mq, fabsf(a.in[12][l * 64 + d])); mk = fmaxf(mk, fabsf(a.in[13][l * 64 + d])); }
    const float mrefB = 64.0f * mq * mk * 0.18033688011112042f * 1.02f;
    const int nB = (F.G == 256) ? 2 + ((l == 0 && F.bid >= 16 && F.bid < 32) ? 1 : 0) : 0;
    for (int j = 0; j < nB; ++j) {
        const int st = j < 2 ? 2 * xcd + j : F.bid - 16, qb = j < 2 ? idx : 32;
        const int kt0 = qb == 32 ? 128 : 0, NT = qb == 32 ? 4 : 132;
        const int b = st >> 3, qh = st & 7, kvh = b * 2 + (qh >> 2);
        const abf* Qp = (const abf*)(a.ws + WS_QB) + ((size_t)st * NKEY + qb * 256) * 64; const abf* Kp = (const abf*)(a.ws + WS_KB) + ((size_t)kvh * NKEY + kt0 * 64) * 64;
        const abf* Vp = (const abf*)(a.ws + WS_VB) + ((size_t)kvh * NKEY + kt0 * 64) * 64;
        const int trow = qb == 32 ? NLAT + b * CTXL : b * SEQ + qb * 256;
        abf* Op = (abf*)(a.ws + WS_OABC) + (size_t)trow * 1536 + 512 + qh * 64;
        attn_body::attn_unit<8>(Qp, 64, Kp, 64, Vp, 64, Op, 1536, NT, shm, mrefB);
    }
}
__device__ __forceinline__ void ph_comb(const Args& a, Frame& F, int l) {
    const bf16* OA2 = (const bf16*)(a.ws + WS_R1); bf16* OA = (bf16*)(a.ws + WS_OABC);
    const float lam = ((const float*)(a.ws + WS_LAM))[l * 2], oml = ((const float*)(a.ws + WS_LAM))[l * 2 + 1];
    const int gw = F.bid * NWAVES + F.wave, NGW = F.G * NWAVES, lane = F.lane;
    const float w0 = a.in[11][l * 128 + 2 * lane] * oml, w1 = a.in[11][l * 128 + 2 * lane + 1] * oml;
    const int NIT = (l == 0 ? T : NLAT) * 4;
    for (int it0 = gw; it0 < NIT; it0 += 4 * NGW) {
        unsigned p1[4], p2[4]; int rowv[4], hv_[4];
#pragma unroll
        for (int j = 0; j < 4; ++j) { const int it = min(it0 + j * NGW, NIT - 1); const int row = it >> 2, h = it & 3; int b, nd; row_to_bn(row, b, nd); rowv[j] = row; hv_[j] = h;
            p1[j] = *(const unsigned*)(OA2 + ((size_t)((b * 4 + h) * 2 + 0) * NKEY + nd) * 128 + 2 * lane); p2[j] = *(const unsigned*)(OA2 + ((size_t)((b * 4 + h) * 2 + 1) * NKEY + nd) * 128 + 2 * lane); }
#pragma unroll
        for (int j = 0; j < 4; ++j) { if (it0 + j * NGW < NIT) {
            const float x0 = bflo(p1[j]) - lam * bflo(p2[j]), x1 = bfhi(p1[j]) - lam * bfhi(p2[j]);
            const float rstd = rsqrtf(wave_sum(x0 * x0 + x1 * x1) * (1.0f / 128.0f) + EPS);
            *(unsigned*)(OA + (size_t)rowv[j] * 1536 + hv_[j] * 128 + 2 * lane) = pk2(x0 * rstd * w0, x1 * rstd * w1); } }
    }
}
__constant__ unsigned char PK_CAND[50] = {0,1,2,3,4,5,6,7,8,9,10,11,12,13,14,15, 16,17,18,19,20,21,22,23, 32,33,34,35,36, 48,49,50,51, 64,65,66, 80,81, 96,97, 112,113, 128, 144, 160, 176, 192, 208, 224, 240};
__device__ __forceinline__ void ce_desc(float& x, float& y) { float hi_, lo_; asm("v_max_f32_e32 %0, %1, %2" : "=v"(hi_) : "v"(x), "v"(y)); asm("v_min_f32_e32 %0, %1, %2" : "=v"(lo_) : "v"(x), "v"(y)); x = hi_; y = lo_; }
__device__ __forceinline__ void sort16_desc(float (&v)[16]) {
#pragma unroll
    for (int k = 2; k <= 16; k <<= 1)
#pragma unroll
        for (int j = k >> 1; j > 0; j >>= 1)
#pragma unroll
            for (int i = 0; i < 16; ++i) { const int p = i ^ j; if (p > i) { if ((i & k) == 0) ce_desc(v[i], v[p]); else ce_desc(v[p], v[i]); } }
}
__device__ __forceinline__ void merge16_desc(float (&t)[16], const float (&v)[16]) {
#pragma unroll
    for (int i = 0; i < 16; ++i) { float m; asm("v_max_f32_e32 %0, %1, %2" : "=v"(m) : "v"(t[i]), "v"(v[15 - i])); t[i] = m; }
#pragma unroll
    for (int j = 8; j > 0; j >>= 1)
#pragma unroll
        for (int i = 0; i < 16; ++i) { const int p = i ^ j; if (p > i) ce_desc(t[i], t[p]); }
}
__device__ __forceinline__ void ph_topk(const Args& a, Frame& F, int l) {
    const float* PQ = (const float*)(a.ws + WS_R1); int* EIDX = (int*)(a.ws + WS_EIDX); float* GW = (float*)(a.ws + WS_GW);
    LAS unsigned char* KH = F.lds; LAS unsigned char* KLo = F.lds + 32768;
    LAS unsigned* XV = (LAS unsigned*)(F.lds + 65536);
    const int tid = F.tid, lane = F.lane, wave = F.wave;
    int cur_h = -1;
    for (int u = F.bid; u < ((l == 0 ? T : NLAT) / 256) * 8; u += F.G) {
        const int h = u & 7, t0 = (u >> 3) * 256;
        if (h != cur_h) { __syncthreads(); const float* ks = a.in[23] + ((size_t)l * 8 + h) * 2 * 128 * 64;
#pragma unroll
            for (int i = 0; i < 4; ++i) { const int ch = tid + 512 * i, krow = ch >> 3, c8 = ch & 7;
                const f32x4 x0 = *(const f32x4*)(ks + (size_t)krow * 64 + c8 * 8), x1 = *(const f32x4*)(ks + (size_t)krow * 64 + c8 * 8 + 4);
                float xs[8] = {x0[0], x0[1], x0[2], x0[3], x1[0], x1[1], x1[2], x1[3]}; unsigned hw[8], lw[8];
#pragma unroll
                for (int j = 0; j < 8; ++j) { hw[j] = f2bf(xs[j]); lw[j] = f2bf(xs[j] - __uint_as_float(hw[j] << 16)); }
                const int off = krow * 128 + ((c8 * 16) ^ ((krow & 7) << 4));
                *(LAS v4u*)(KH + off) = (v4u){hw[0] | (hw[1] << 16), hw[2] | (hw[3] << 16), hw[4] | (hw[5] << 16), hw[6] | (hw[7] << 16)};
                *(LAS v4u*)(KLo + off) = (v4u){lw[0] | (lw[1] << 16), lw[2] | (lw[3] << 16), lw[4] | (lw[5] << 16), lw[6] | (lw[7] << 16)}; }
            cur_h = h; __syncthreads(); }
        {
            const int r32 = lane & 31, hp = lane >> 5; const float* qp = PQ + (size_t)(t0 + 32 * wave + r32) * 1024 + h * 128 + hp * 8;
#pragma unroll
            for (int half = 0; half < 2; ++half) {
                bf16x8 bqh[4], bql[4];
#pragma unroll
                for (int ks = 0; ks < 4; ++ks) { const f32x4 x0 = *(const f32x4*)(qp + half * 64 + ks * 16), x1 = *(const f32x4*)(qp + half * 64 + ks * 16 + 4);
                    float xs[8] = {x0[0], x0[1], x0[2], x0[3], x1[0], x1[1], x1[2], x1[3]}; unsigned hw[8], lw[8];
#pragma unroll
                    for (int j = 0; j < 8; ++j) { hw[j] = f2bf(xs[j]); lw[j] = f2bf(xs[j] - __uint_as_float(hw[j] << 16)); }
                    bqh[ks] = __builtin_bit_cast(bf16x8, (v4u){hw[0] | (hw[1] << 16), hw[2] | (hw[3] << 16), hw[4] | (hw[5] << 16), hw[6] | (hw[7] << 16)});
                    bql[ks] = __builtin_bit_cast(bf16x8, (v4u){lw[0] | (lw[1] << 16), lw[2] | (lw[3] << 16), lw[4] | (lw[5] << 16), lw[6] | (lw[7] << 16)}); }
                float tv[16];
#pragma unroll
                for (int kt = 0; kt < 4; ++kt) {
                    f32x16 acc;
#pragma unroll
                    for (int r = 0; r < 16; ++r) acc[r] = 0.f;
                    const int krow = half * 128 + kt * 32 + r32;
#pragma unroll
                    for (int ks = 0; ks < 4; ++ks) { const int off = krow * 128 + ((32 * ks + 16 * hp) ^ ((krow & 7) << 4));
                        const bf16x8 ah = *(const LAS bf16x8*)(KH + off), al = *(const LAS bf16x8*)(KLo + off);
                        acc = __builtin_amdgcn_mfma_f32_32x32x16_bf16(ah, bqh[ks], acc, 0, 0, 0);
                        acc = __builtin_amdgcn_mfma_f32_32x32x16_bf16(al, bqh[ks], acc, 0, 0, 0);
                        acc = __builtin_amdgcn_mfma_f32_32x32x16_bf16(ah, bql[ks], acc, 0, 0, 0); }
                    float v[16];
#pragma unroll
                    for (int r = 0; r < 16; ++r) { const unsigned key = (unsigned)(32 * kt + (r & 3) + 8 * (r >> 2)) | (unsigned)(4 * hp); v[r] = __uint_as_float((__float_as_uint(acc[r]) & 0xffffff80u) | (127u - key)); }
                    sort16_desc(v);
                    if (kt == 0) {
#pragma unroll
                        for (int r = 0; r < 16; ++r) tv[r] = v[r]; }
                    else merge16_desc(tv, v);
                }
                float pv[16];
#pragma unroll
                for (int r = 0; r < 16; ++r) pv[r] = __shfl_xor(tv[r], 32);
                merge16_desc(tv, pv);
                if (hp == 0) { LAS unsigned* xo = XV + ((32 * wave + r32) * 2 + half) * 16;
#pragma unroll
                    for (int j = 0; j < 16; j += 4) *(LAS v4u*)(xo + j) = (v4u){__float_as_uint(tv[j]), __float_as_uint(tv[j + 1]), __float_as_uint(tv[j + 2]), __float_as_uint(tv[j + 3])}; }
            }
        }
        __syncthreads();
        if (tid < 256) {
            const int tok = tid; const LAS unsigned* xa = XV + (tok * 2) * 16; const LAS unsigned* xb = xa + 16;
            float fv[16];
#pragma unroll
            for (int r = 0; r < 16; ++r) fv[r] = -INFINITY;
            for (int ci = 0; ci < 50; ++ci) {
                const unsigned c = PK_CAND[ci];
                const float sm = __uint_as_float(xa[c >> 4] & 0xffffff80u) + __uint_as_float(xb[c & 15] & 0xffffff80u);
                float v = __uint_as_float((__float_as_uint(sm) & 0xffffff00u) | (255u - c));
#pragma unroll
                for (int r = 0; r < 16; ++r) { float hi_, lo_; asm("v_max_f32_e32 %0, %1, %2" : "=v"(hi_) : "v"(fv[r]), "v"(v)); asm("v_min_f32_e32 %0, %1, %2" : "=v"(lo_) : "v"(fv[r]), "v"(v)); fv[r] = hi_; v = lo_; }
            }
            float val[16]; int ex[16]; float mx = -INFINITY;
#pragma unroll
            for (int r = 0; r < 16; ++r) { const unsigned c = 255u - (__float_as_uint(fv[r]) & 255u); const unsigned ia = xa[c >> 4], ib = xb[c & 15];
                val[r] = __uint_as_float(ia & 0xffffff80u) + __uint_as_float(ib & 0xffffff80u); ex[r] = (int)((127u - (ia & 127u)) * 128u + (127u - (ib & 127u))); mx = fmaxf(mx, val[r]); }
            float sum = 0.f;
#pragma unroll
            for (int r = 0; r < 16; ++r) { val[r] = __expf(val[r] - mx); sum += val[r]; }
            const float inv = 1.0f / sum;
            int* eo = EIDX + (size_t)(t0 + tok) * 128 + h * 16; float* go = GW + (size_t)(t0 + tok) * 128 + h * 16;
#pragma unroll
            for (int r = 0; r < 16; r += 4) { *(v4u*)(eo + r) = (v4u){(unsigned)ex[r], (unsigned)ex[r + 1], (unsigned)ex[r + 2], (unsigned)ex[r + 3]};
                *(f32x4*)(go + r) = (f32x4){val[r] * inv, val[r + 1] * inv, val[r + 2] * inv, val[r + 3] * inv}; }
        }
        __syncthreads();
    }
}
__device__ __forceinline__ void fp8x16_to_f32(const v4u w, float (&f)[16]) {
#pragma unroll
    for (int q = 0; q < 4; ++q) { const auto lo = __builtin_amdgcn_cvt_pk_f32_fp8((int)w[q], false); const auto hi = __builtin_amdgcn_cvt_pk_f32_fp8((int)w[q], true);
        f[4 * q] = lo[0]; f[4 * q + 1] = lo[1]; f[4 * q + 2] = hi[0]; f[4 * q + 3] = hi[1]; }
}
__device__ __forceinline__ void xp_sort128(int& e_a, int& e_b, float& g_a, float& g_b, int lane) {
    asm volatile("" : "+v"(lane));
    unsigned a0 = ((unsigned)e_a << 7) | (unsigned)lane, a1 = ((unsigned)e_b << 7) | (unsigned)(64 + lane);
#pragma unroll
    for (int k = 2; k <= 128; k <<= 1) {
#pragma unroll
        for (int j = k >> 1; j >= 1; j >>= 1) {
            if (j == 64) { const unsigned lo = min(a0, a1), hi = max(a0, a1); a0 = lo; a1 = hi; }
            else {
                const bool lower = (lane & j) == 0;
                const bool asc0 = k >= 64 ? true : ((lane & k) == 0), asc1 = k == 64 ? false : (k == 128 ? true : ((lane & k) == 0));
                const unsigned o0 = (unsigned)__shfl_xor((int)a0, j), o1 = (unsigned)__shfl_xor((int)a1, j);
                a0 = (lower == asc0) ? min(a0, o0) : max(a0, o0); a1 = (lower == asc1) ? min(a1, o1) : max(a1, o1);
            }
        }
    }
    const int i0 = (int)(a0 & 127u), i1 = (int)(a1 & 127u);
    const float ga0 = __shfl(g_a, i0 & 63), gb0 = __shfl(g_b, i0 & 63), ga1 = __shfl(g_a, i1 & 63), gb1 = __shfl(g_b, i1 & 63);
    e_a = (int)(a0 >> 7); e_b = (int)(a1 >> 7); g_a = i0 < 64 ? ga0 : gb0; g_b = i1 < 64 ? ga1 : gb1;
}
template <int CTRL> __device__ __forceinline__ float dpp_f(float v) { return __builtin_bit_cast(float, __builtin_amdgcn_update_dpp(0, __builtin_bit_cast(int, v), CTRL, 0xf, 0xf, false)); }
#define XP_PAIRS(KB, KE) do { for (int k0 = (KB); k0 < (KE); k0 += 8) { \
            v3u uw[8], vw[8]; const int kk = k0 & 63; const int esel = k0 < 64 ? e_a : e_b; const float gsel = k0 < 64 ? g_a : g_b, ssel = k0 < 64 ? su_a : su_b; \
            _Pragma("unroll") for (int j = 0; j < 8; ++j) { const int so_ = __builtin_amdgcn_readlane(esel, kk + j) * ROW6;     \
                uw[j] = __builtin_bit_cast(v3u, __builtin_amdgcn_raw_buffer_load_b96(rU, voff, so_, 0)); vw[j] = __builtin_bit_cast(v3u, __builtin_amdgcn_raw_buffer_load_b96(rV, voff, so_, 0)); } \
            const float gv = __shfl(gsel, kk + (lane >> 3)), suv = __shfl(ssel, kk + (lane >> 3)); \
            float d[8]; \
            _Pragma("unroll") for (int j = 0; j < 8; j += 2) { const v6u pk = {uw[j].x, uw[j].y, uw[j].z, uw[j + 1].x, uw[j + 1].y, uw[j + 1].z}; const v32f r = __builtin_amdgcn_cvt_scalef32_pk32_f32_fp6(pk, 1.0f); \
                f32x2 s0 = {0.f, 0.f}, s1 = {0.f, 0.f}; \
                _Pragma("unroll") for (int i = 0; i < 8; ++i) { s0 = __builtin_elementwise_fma((f32x2){r[2 * i], r[2 * i + 1]}, hx2[i], s0); s1 = __builtin_elementwise_fma((f32x2){r[16 + 2 * i], r[17 + 2 * i]}, hx2[i], s1); } \
                d[j] = s0.x + s0.y; d[j + 1] = s1.x + s1.y; __builtin_amdgcn_sched_barrier(0); } \
            float e4[4], f2[2]; \
            _Pragma("unroll") for (int j = 0; j < 4; ++j) { const auto r = __builtin_amdgcn_permlane32_swap(__float_as_uint(d[j]), __float_as_uint(d[j + 4]), false, false); e4[j] = __uint_as_float(r[0]) + __uint_as_float(r[1]); } \
            _Pragma("unroll") for (int j = 0; j < 2; ++j) { const auto r = __builtin_amdgcn_permlane16_swap(__float_as_uint(e4[j]), __float_as_uint(e4[j + 2]), false, false); f2[j] = __uint_as_float(r[0]) + __uint_as_float(r[1]); } \
            const bool b3 = (lane & 8) != 0; \
            float zs = (b3 ? f2[1] : f2[0]) + dpp_f<0x128>(b3 ? f2[0] : f2[1]);     \
            zs += dpp_f<0xB1>(zs); zs += dpp_f<0x4E>(zs); zs += dpp_f<0x141>(zs);     \
            const float z = zs * suv; const float actv = 0.5f * z * (1.0f + erff(z * 0.70710678118654752f)) * gv; \
            _Pragma("unroll") for (int j = 0; j < 8; j += 2) { const float act0 = __int_as_float(__builtin_amdgcn_readlane(__float_as_int(actv), 8 * j)), act1 = __int_as_float(__builtin_amdgcn_readlane(__float_as_int(actv), 8 * j + 8)); \
                const f32x2 a0 = {act0, act0}, a1 = {act1, act1}; \
                const v6u pk = {vw[j].x, vw[j].y, vw[j].z, vw[j + 1].x, vw[j + 1].y, vw[j + 1].z}; const v32f r = __builtin_amdgcn_cvt_scalef32_pk32_f32_fp6(pk, 1.0f); \
                _Pragma("unroll") for (int i = 0; i < 8; ++i) acc2[i] = __builtin_elementwise_fma((f32x2){r[2 * i], r[2 * i + 1]}, a0, acc2[i]); \
                __builtin_amdgcn_sched_barrier(0);     \
                _Pragma("unroll") for (int i = 0; i < 8; ++i) acc2[i] = __builtin_elementwise_fma((f32x2){r[16 + 2 * i], r[17 + 2 * i]}, a1, acc2[i]); \
                __builtin_amdgcn_sched_barrier(0); } } } while (0)
#define XP_UNPACK float acc[16]; _Pragma("unroll") for (int i = 0; i < 8; ++i) { acc[2 * i] = acc2[i].x; acc[2 * i + 1] = acc2[i].y; }
#define XP_LOAD_ROW(ROW) \
        f32x2 hx2[8]; f32x4 xrow[4];     \
        { const int mi_ = mod_index(ROW); const float* sh_ = MOD - 5120 + mi_ * 6144 + 3072; const float* sc_ = sh_ + 1024; float ss_ = 0.f; \
          _Pragma("unroll") for (int q = 0; q < 4; ++q) { xrow[q] = *(const f32x4*)(X + (size_t)(ROW) * DM + 16 * lane + 4 * q); ss_ += (xrow[q][0] * xrow[q][0] + xrow[q][1] * xrow[q][1]) + (xrow[q][2] * xrow[q][2] + xrow[q][3] * xrow[q][3]); } \
          const float rs_ = rsqrtf(wave_sum(ss_) * (1.0f / DM) + EPS); \
          _Pragma("unroll") for (int q = 0; q < 4; ++q) { const f32x4 s1_ = *(const f32x4*)(sc_ + 16 * lane + 4 * q), s0_ = *(const f32x4*)(sh_ + 16 * lane + 4 * q); const f32x4 h_ = xrow[q] * rs_ * (s1_ + 1.0f) + s0_; \
              hx2[2 * q] = (f32x2){h_[0], h_[1]}; hx2[2 * q + 1] = (f32x2){h_[2], h_[3]}; } } \
        int e_a = EIDX[(size_t)(ROW) * 128 + lane], e_b = EIDX[(size_t)(ROW) * 128 + 64 + lane]; \
        float g_a = GW[(size_t)(ROW) * 128 + lane], g_b = GW[(size_t)(ROW) * 128 + 64 + lane]; \
        xp_sort128(e_a, e_b, g_a, g_b, lane); \
        const float su_a = SU[e_a], su_b = SU[e_b]; g_a *= SV[e_a]; g_b *= SV[e_b];     \
        f32x2 acc2[8]; \
        _Pragma("unroll") for (int i = 0; i < 8; ++i) acc2[i] = (f32x2){0.f, 0.f};
#define XP_EPILOGUE(ROW) do { \
        const int mi = mod_index(ROW); const float* g2 = MOD + mi * 6144; float* xr = X + (size_t)(ROW) * DM + 16 * lane; \
        f32x4 xn[4]; float ss = 0.f; \
        _Pragma("unroll") for (int q = 0; q < 4; ++q) { const f32x4 g = *(const f32x4*)(g2 + 16 * lane + 4 * q); f32x4 x = xrow[q]; \
            x[0] += g[0] * acc[4 * q]; x[1] += g[1] * acc[4 * q + 1]; x[2] += g[2] * acc[4 * q + 2]; x[3] += g[3] * acc[4 * q + 3]; \
            xn[q] = x; ss += (x[0] * x[0] + x[1] * x[1]) + (x[2] * x[2] + x[3] * x[3]); } \
        const float rstd = rsqrtf(wave_sum(ss) * (1.0f / DM) + EPS); \
        if (l == 0) {     \
            const float* sh = (const float*)(a.ws + WS_MOD) + (size_t)(3 + mi) * 6144; const float* sc = sh + 1024; bf16* hxo = (bf16*)(a.ws + WS_HX) + (size_t)(ROW) * DM + 16 * lane; \
            _Pragma("unroll") for (int q = 0; q < 4; ++q) { *(f32x4*)(xr + 4 * q) = xn[q]; const f32x4 s1 = *(const f32x4*)(sc + 16 * lane + 4 * q), s0 = *(const f32x4*)(sh + 16 * lane + 4 * q); \
                const f32x4 hh = xn[q] * rstd * (s1 + 1.0f) + s0; u32x2 o; o.x = pk2(hh[0], hh[1]); o.y = pk2(hh[2], hh[3]); *(u32x2*)(hxo + 4 * q) = o; } \
        } else if ((ROW) < NLAT) {     \
            _Pragma("unroll") for (int q = 0; q < 4; ++q) *(f32x4*)(a.out + (size_t)(ROW) * DM + 16 * lane + 4 * q) = xn[q] * rstd * *(const f32x4*)(a.in[26] + 16 * lane + 4 * q); \
        } } while (0)
__device__ __forceinline__ void ph_expert(const Args& a, Frame& F, int l) {
    const __amdgpu_buffer_rsrc_t rU = __builtin_amdgcn_make_buffer_rsrc((void*)(a.ws + WS_U16), (short)0, 16384 * ROW6, 0x00020000), rV = __builtin_amdgcn_make_buffer_rsrc((void*)(a.ws + WS_V16), (short)0, 16384 * ROW6, 0x00020000);
    const float* SU = (const float*)(a.ws + WS_SU); const float* SV = (const float*)(a.ws + WS_SV);
    const int* EIDX = (const int*)(a.ws + WS_EIDX); const float* GW = (const float*)(a.ws + WS_GW); float* X = (float*)(a.ws + WS_X);
    const float* MOD = (const float*)(a.ws + WS_MOD) + (size_t)l * 3 * 6144 + 5120;
    const int gw = F.bid * NWAVES + F.wave, NGW = F.G * NWAVES, lane = F.lane; const int voff = 12 * lane;
    for (int row = gw; row < NLAT; row += NGW) {
        XP_LOAD_ROW(row)
        XP_PAIRS(0, 128);
        XP_UNPACK
        XP_EPILOGUE(row);
    }
    if (l == 0) {
        LAS float* PART = (LAS float*)F.lds;
        for (int r0 = NLAT + 2 * F.bid; r0 < T; r0 += 2 * F.G) {
            const int row = min(r0 + (F.wave >> 2), T - 1), qd = F.wave & 3;
            XP_LOAD_ROW(row)
            XP_PAIRS(32 * qd, 32 * qd + 32);
            XP_UNPACK
#pragma unroll
            for (int q = 0; q < 4; ++q) *(LAS f32x4*)(PART + F.wave * 1024 + 16 * lane + 4 * q) = (f32x4){acc[4 * q], acc[4 * q + 1], acc[4 * q + 2], acc[4 * q + 3]};
            __syncthreads();
            if (qd == 0 && r0 + (F.wave >> 2) < T) {
#pragma unroll
                for (int w_ = 1; w_ < 4; ++w_)
#pragma unroll
                    for (int q = 0; q < 4; ++q) { const f32x4 p = *(const LAS f32x4*)(PART + (F.wave + w_) * 1024 + 16 * lane + 4 * q); acc[4 * q] += p[0]; acc[4 * q + 1] += p[1]; acc[4 * q + 2] += p[2]; acc[4 * q + 3] += p[3]; }
                XP_EPILOGUE(row);
            }
            __syncthreads();
        }
    }
}
#undef XP_PAIRS
#undef XP_UNPACK
#undef XP_LOAD_ROW
#undef XP_EPILOGUE
__device__ __forceinline__ void ph_final(const Args& a, Frame& F) {
    const float* X = (const float*)(a.ws + WS_X); const float* fw = a.in[26];
    const int gw = F.bid * NWAVES + F.wave, NGW = F.G * NWAVES;
    for (int row = gw; row < NLAT; row += NGW) {
        const f32x4* xr = (const f32x4*)(X + (size_t)row * DM) + F.lane; f32x4 v[4]; float ss = 0.f;
#pragma unroll
        for (int j = 0; j < 4; ++j) { v[j] = xr[64 * j]; ss += (v[j][0] * v[j][0] + v[j][1] * v[j][1]) + (v[j][2] * v[j][2] + v[j][3] * v[j][3]); }
        const float rstd = rsqrtf(wave_sum(ss) * (1.0f / DM) + EPS);
#pragma unroll
        for (int j = 0; j < 4; ++j) { const int c = 4 * F.lane + 256 * j; *(f32x4*)(a.out + (size_t)row * DM + c) = v[j] * rstd * *(const f32x4*)(fw + c); }
    }
}
__device__ __forceinline__ f32x16 small_tile_mma(const bf16* A, int lda, const bf16* Bt, int ldb, int K, int lane) {
    const int r32 = lane & 31, hp = lane >> 5;
    const bf16* ap = A + (size_t)r32 * lda + 8 * hp; const bf16* bp = Bt + (size_t)r32 * ldb + 8 * hp;
    f32x16 acc;
#pragma unroll
    for (int r = 0; r < 16; ++r) acc[r] = 0.f;
#pragma unroll 1
    for (int k0 = 0; k0 < K; k0 += 128) {
        bf16x8 af[8], bfr[8];
#pragma unroll
        for (int s_ = 0; s_ < 8; ++s_) { af[s_] = *(const bf16x8*)(ap + k0 + 16 * s_); bfr[s_] = *(const bf16x8*)(bp + k0 + 16 * s_); }
#pragma unroll
        for (int s_ = 0; s_ < 8; ++s_) acc = __builtin_amdgcn_mfma_f32_32x32x16_bf16(af[s_], bfr[s_], acc, 0, 0, 0);
    }
    return acc;
}
__device__ __forceinline__ void ph_biasq(const Args& a, Frame& F, int l) {
    const bf16* Wq = (const bf16*)(a.ws + WS_WQ); const float* MOD = (const float*)(a.ws + WS_MOD) + (size_t)l * 3 * 6144 + 3072; float* BQ = (float*)(a.ws + WS_BQ) + l * 3 * 1024;
    const int gw = F.bid * NWAVES + F.wave, NGW = F.G * NWAVES, lane = F.lane;
    for (int it = gw; it < 3 * 1024; it += NGW) { const int mi = it >> 10, n = it & 1023;
        const v4u w0 = *(const v4u*)(Wq + (size_t)n * 1024 + 16 * lane), w1 = *(const v4u*)(Wq + (size_t)n * 1024 + 16 * lane + 8); const f32x4* sp = (const f32x4*)(MOD + mi * 6144 + 16 * lane);
        const f32x4 a0 = sp[0], a1 = sp[1], a2 = sp[2], a3 = sp[3];
        float v = (a0[0] * bflo(w0.x) + a0[1] * bfhi(w0.x)) + (a0[2] * bflo(w0.y) + a0[3] * bfhi(w0.y)) + (a1[0] * bflo(w0.z) + a1[1] * bfhi(w0.z)) + (a1[2] * bflo(w0.w) + a1[3] * bfhi(w0.w))
                + (a2[0] * bflo(w1.x) + a2[1] * bfhi(w1.x)) + (a2[2] * bflo(w1.y) + a2[3] * bfhi(w1.y)) + (a3[0] * bflo(w1.z) + a3[1] * bfhi(w1.z)) + (a3[2] * bflo(w1.w) + a3[3] * bfhi(w1.w));
        v = wave_sum(v); if (lane == 0) BQ[mi * 1024 + n] = v; }
}
__device__ __forceinline__ void ctx_small_q(const Args& a, Frame& F) {
    unsigned char* ws = a.ws; const int lane = F.lane, r32 = lane & 31, hp = lane >> 5; constexpr int AP = 1032;
    LAS unsigned short* A32 = (LAS unsigned short*)F.lds;
    const float* X = (const float*)(ws + WS_X); const float* sh = (const float*)(ws + WS_MOD) + 2 * 6144 + 3072; const float* sc = sh + 1024;
    for (int t0 = F.bid * 2; t0 < 512; t0 += F.G * 2) {
        const int row0 = NLAT + 32 * (t0 >> 5);
#pragma unroll
        for (int q = 0; q < 4; ++q) { const int rl = F.wave * 4 + q; const f32x4* xr = (const f32x4*)(X + (size_t)(row0 + rl) * DM) + lane; f32x4 v[4]; float ss = 0.f;
#pragma unroll
            for (int j = 0; j < 4; ++j) { v[j] = xr[64 * j]; ss += (v[j][0] * v[j][0] + v[j][1] * v[j][1]) + (v[j][2] * v[j][2] + v[j][3] * v[j][3]); }
            const float rstd = rsqrtf(wave_sum(ss) * (1.0f / DM) + EPS);
#pragma unroll
            for (int j = 0; j < 4; ++j) { const int c = 4 * lane + 256 * j; const f32x4 s1 = *(const f32x4*)(sc + c), s0 = *(const f32x4*)(sh + c); const f32x4 h = v[j] * rstd * (s1 + 1.0f) + s0;
                u32x2 o; o.x = pk2(h[0], h[1]); o.y = pk2(h[2], h[3]); *(LAS u32x2*)(A32 + rl * AP + c) = o; } }
        __syncthreads();
        if (F.wave < 2 && t0 + F.wave < 512) { const int col0 = 32 * ((t0 + F.wave) & 31);
            const LAS unsigned short* ap = A32 + r32 * AP + 8 * hp; const bf16* bp = (const bf16*)(ws + WS_WQ) + (size_t)(col0 + r32) * 1024 + 8 * hp;
            f32x16 acc;
#pragma unroll
            for (int r = 0; r < 16; ++r) acc[r] = 0.f;
#pragma unroll 1
            for (int k0 = 0; k0 < 1024; k0 += 128) { bf16x8 af[8], bfr[8];
#pragma unroll
                for (int s_ = 0; s_ < 8; ++s_) { af[s_] = *(const LAS bf16x8*)(ap + k0 + 16 * s_); bfr[s_] = *(const bf16x8*)(bp + k0 + 16 * s_); }
#pragma unroll
                for (int s_ = 0; s_ < 8; ++s_) acc = __builtin_amdgcn_mfma_f32_32x32x16_bf16(af[s_], bfr[s_], acc, 0, 0, 0); }
            float* PQ = (float*)(ws + WS_R1);
#pragma unroll
            for (int r = 0; r < 16; ++r) { const int row = row0 + (r & 3) + 8 * (r >> 2) + 4 * hp; PQ[(size_t)row * 1024 + col0 + r32] = acc[r]; } }
        __syncthreads();
    }
}
__device__ __forceinline__ void ctx_small(const Args& a, Frame& F, int which  ) {
    if (F.wave >= 2) return;
    unsigned char* ws = a.ws; const int lane = F.lane, r32 = lane & 31, hp = lane >> 5;
    for (int tile = F.bid * 2 + F.wave; tile < 512; tile += F.G * 2) {
        const int row0 = NLAT + 32 * (tile >> 5), col0 = 32 * (tile & 31);
        if (which == 2) {
            const bf16* OABC = (const bf16*)(ws + WS_OABC); const bf16* Wcat = (const bf16*)(ws + WS_WA); const bf16* gate = (const bf16*)(ws + WS_R3) + 1024; bf16* Mb = (bf16*)(ws + WS_MB);
            float macc[16];
#pragma unroll
            for (int r = 0; r < 16; ++r) macc[r] = 0.f;
            for (int br = 0; br < 3; ++br) {
                const f32x16 acc = small_tile_mma(OABC + (size_t)row0 * 1536 + 512 * br, 1536, Wcat + (size_t)col0 * 1536 + 512 * br, 1536, 512, lane);
#pragma unroll
                for (int r = 0; r < 16; ++r) { const int row = row0 + (r & 3) + 8 * (r >> 2) + 4 * hp; macc[r] += sigm(bf2f(gate[(size_t)row * NPXB + 1024 * br + col0 + r32])) * acc[r]; }
            }
#pragma unroll
            for (int r = 0; r < 16; ++r) { const int row = row0 + (r & 3) + 8 * (r >> 2) + 4 * hp; Mb[(size_t)row * 1024 + col0 + r32] = (unsigned short)f2bf(macc[r]); }
        } else if (which == 3) {
            const f32x16 acc = small_tile_mma((const bf16*)(ws + WS_MB) + (size_t)row0 * 1024, 1024, (const bf16*)(ws + WS_WO) + (size_t)col0 * 1024, 1024, 1024, lane);
            const float g1 = ((const float*)(ws + WS_MOD))[2 * 6144 + 2048 + col0 + r32]; float* X = (float*)(ws + WS_X);
#pragma unroll
            for (int r = 0; r < 16; ++r) { const int row = row0 + (r & 3) + 8 * (r >> 2) + 4 * hp; X[(size_t)row * 1024 + col0 + r32] = a.in[2][(size_t)(row - NLAT) * 1024 + col0 + r32] + g1 * acc[r]; }
        } else {
            const f32x16 acc = small_tile_mma((const bf16*)(ws + WS_HX) + (size_t)row0 * 1024, 1024, (const bf16*)(ws + WS_WQ) + (size_t)col0 * 1024, 1024, 1024, lane);
            float* PQ = (float*)(ws + WS_R1);
#pragma unroll
            for (int r = 0; r < 16; ++r) { const int row = row0 + (r & 3) + 8 * (r >> 2) + 4 * hp; PQ[(size_t)row * 1024 + col0 + r32] = acc[r]; }
        }
    }
}
#define GEMM_RUN(EPI, g, E) do { pg8::StaticOrder S_; S_.init((g).M, (g).N, F.G, F.bid); pg8::gemm_phase<EPI, pg8::StaticOrder, true, true>(F.lds, g, S_, E); } while (0)

constexpr int N_PHASES = 25;
#ifndef MK_ONE_LAUNCH
#define MK_ONE_LAUNCH 1
#endif
__global__ void __launch_bounds__(NWAVES * 64, 2) mk_fwd(Args args) {
    extern __shared__ __attribute__((aligned(16))) unsigned char lds_raw[];
    Frame F;
    F.lds = (LAS unsigned char*)lds_raw; F.MISC = (volatile LAS unsigned*)(F.lds + MISC_OFF);
    F.tid = threadIdx.x; F.lane = F.tid & 63; F.wave = __builtin_amdgcn_readfirstlane(F.tid >> 6); F.G = gridDim.x; F.bid = blockIdx.x;
    F.ctl = (gu32*)(args.ws + WS_CTL);
    for (int u = F.tid; u < (LDS_BYTES - LDSCTL_OFF) / 4; u += NWAVES * 64) ((LAS unsigned*)(F.lds + LDSCTL_OFF))[u] = 0u;
    __syncthreads();
    XcdBarrier bar; bar.bar = (unsigned*)(F.ctl + CW_BAR); bar.x = 0; bar.st = nullptr;
    const bool multi = (args.ph_hi - args.ph_lo) > 1;
    if (multi) bar = xcd_barrier_post((unsigned*)(F.ctl + CW_BAR), F.MISC + 8);
    unsigned char* ws = args.ws;
    const int lo = args.ph_lo, hi = args.ph_hi;
    if (PROBE_MASK != 0ull) { if (F.tid == 0) { const unsigned long long now_ = __builtin_amdgcn_s_memrealtime(); F.MISC[16] = (unsigned)now_; F.MISC[17] = (unsigned)(now_ >> 32); } __syncthreads(); }
#define IN(k) (lo <= (k) && (k) < hi)
#define SEAM(k) do { if (IN(k) && IN((k) + 1)) { xcd_barrier(bar); \
    if (PROBE_MASK != 0ull) { if (F.tid == 0) { unsigned long long now_ = __builtin_amdgcn_s_memrealtime(); const unsigned long long prev_ = ((unsigned long long)F.MISC[17] << 32) | F.MISC[16]; \
        if ((PROBE_MASK >> (k)) & 1ull) { const unsigned long long until_ = now_ + PROBE_AMP * (now_ - prev_); while (__builtin_amdgcn_s_memrealtime() < until_) __builtin_amdgcn_s_sleep(32); now_ = __builtin_amdgcn_s_memrealtime(); } \
        F.MISC[16] = (unsigned)now_; F.MISC[17] = (unsigned)(now_ >> 32); } __syncthreads(); } } } while (0)
#ifndef ONLY_PHASE
#define ONLY_PHASE(s) 1
#endif
#define LAYER(l, B) \
    if (ONLY_PHASE(1) && IN((B) + 1) && (l) == 0) { ph_mod(args, F, l, 0); } if ((l) == 0) SEAM((B) + 1); \
    if (ONLY_PHASE(2) && IN((B) + 2)) { pg8::Gemm g{(const pg8::bf16_t*)(ws + WS_HX), (const pg8::bf16_t*)(ws + WS_WIN), T, INC, DM}; pg8::EpiG1 E{(pg8::bf16_t*)(ws + WS_R1), (pg8::bf16_t*)(ws + WS_R3)}; GEMM_RUN(pg8::EpiG1, g, E); } SEAM((B) + 2); \
    if (ONLY_PHASE(3) && IN((B) + 3)) { ph_post(args, F, l); } SEAM((B) + 3); \
    if (ONLY_PHASE(4) && IN((B) + 4)) { ph_attn(args, F, l, (char*)lds_raw); } SEAM((B) + 4); \
    if (ONLY_PHASE(5) && IN((B) + 5)) { ph_comb(args, F, l); } SEAM((B) + 5); \
    if (ONLY_PHASE(6) && IN((B) + 6)) { const pg8::bf16_t* gate = (const pg8::bf16_t*)(ws + WS_R3) + 1024; \
        if ((l) == 0) ctx_small(args, F, 2); \
        pg8::Gemm g{(const pg8::bf16_t*)(ws + WS_OABC), (const pg8::bf16_t*)(ws + WS_WA), NLAT, DM, 1536}; pg8::EpiG2 E{gate + 2048, (pg8::bf16_t*)(ws + WS_MB)}; pg8::MidG2 Mh{gate}; \
        { pg8::StaticOrder S_; S_.init(g.M, g.N, F.G, F.bid); pg8::gemm_phase<pg8::EpiG2, pg8::StaticOrder, true, true, pg8::MidG2>(F.lds, g, S_, E, Mh); } } SEAM((B) + 6); \
    if (ONLY_PHASE(7) && IN((B) + 7)) { ph_biasq(args, F, l); if ((l) == 0) ctx_small(args, F, 3); pg8::Gemm g{(const pg8::bf16_t*)(ws + WS_MB), (const pg8::bf16_t*)(ws + WS_WO), NLAT, DM, DM}; pg8::EpiG3 E{(float*)(ws + WS_X), (l) == 0 ? args.in[0] : (const float*)(ws + WS_X), (const float*)(ws + WS_MOD) + (size_t)(l) * 3 * 6144 + 2048, (pg8::bf16_t*)(ws + WS_HX), (const float*)(ws + WS_MOD) + (size_t)(l) * 3 * 6144 + 4096, (float*)(ws + WS_SSQ)}; GEMM_RUN(pg8::EpiG3, g, E); } SEAM((B) + 7); \
    if (ONLY_PHASE(9) && IN((B) + 9)) { if ((l) == 0) ctx_small_q(args, F); pg8::Gemm g{(const pg8::bf16_t*)(ws + WS_HX), (const pg8::bf16_t*)(ws + WS_WQ), NLAT, DM, DM}; pg8::EpiG4 E{(float*)(ws + WS_R1), (const float*)(ws + WS_SSQ), (const float*)(ws + WS_BQ) + (l) * 3 * 1024}; GEMM_RUN(pg8::EpiG4, g, E); } SEAM((B) + 9); \
    if (ONLY_PHASE(10) && IN((B) + 10)) { ph_topk(args, F, l); } SEAM((B) + 10); \
    if (ONLY_PHASE(11) && IN((B) + 11)) { ph_expert(args, F, l); } if ((l) == 0) SEAM((B) + 11);

    if (ONLY_PHASE(0) && IN(0)) { ph_prep0(args, F); ph_convw(args, F, 0); } SEAM(0);
    LAYER(0, 0)
    if (ONLY_PHASE(12) && IN(12)) { ph_convw(args, F, 1); } SEAM(12);
    LAYER(1, 12)
    if (PROBE_MASK != 0ull && ((PROBE_MASK >> 23) & 1ull) && IN(23)) { __syncthreads(); if (F.tid == 0) { const unsigned long long now_ = __builtin_amdgcn_s_memrealtime(); const unsigned long long prev_ = ((unsigned long long)F.MISC[17] << 32) | F.MISC[16];
        const unsigned long long until_ = now_ + PROBE_AMP * (now_ - prev_); while (__builtin_amdgcn_s_memrealtime() < until_) __builtin_amdgcn_s_sleep(32); } __syncthreads(); }
#undef IN
#undef SEAM
}

extern "C" void kernel_launch(void* const* d_in, const int* in_sizes, int n_in, void* d_out, int out_size, void* d_ws, size_t ws_size, hipStream_t stream) {
    static int grid = 0;
    if (grid == 0) {
        if (n_in != 27 || out_size != NLAT * DM || ws_size < WS_END) { fprintf(stderr, "kernel_launch: unexpected shapes (n_in %d, out %d, ws %zu)\n", n_in, out_size, ws_size); grid = -1; return; }
        int dev = 0, cus = 0, per_cu = 0;
        if (hipGetDevice(&dev) != hipSuccess || hipDeviceGetAttribute(&cus, hipDeviceAttributeMultiprocessorCount, dev) != hipSuccess) { grid = -1; return; }
        if (hipFuncSetAttribute((const void*)mk_fwd, hipFuncAttributeMaxDynamicSharedMemorySize, LDS_BYTES) != hipSuccess) { fprintf(stderr, "kernel_launch: hipFuncSetAttribute failed\n"); grid = -1; return; }
        if (hipOccupancyMaxActiveBlocksPerMultiprocessor(&per_cu, (const void*)mk_fwd, NWAVES * 64, LDS_BYTES) != hipSuccess || per_cu < 1) { fprintf(stderr, "kernel_launch: occupancy query says %d blocks per CU\n", per_cu); (void)hipGetLastError(); grid = -1; return; }
        if (cus < 256) { fprintf(stderr, "kernel_launch: this kernel's phase maps are built for 256 workgroups (one per CU); the device reports %d CUs\n", cus); grid = -1; return; }
        grid = 256;
    }
    if (grid < 0) return;
    (void)hipMemsetAsync((char*)d_ws + WS_CTL, 0, CTL_ZERO_BYTES, stream);
    Args a{};
    for (int i = 0; i < 27; ++i) a.in[i] = (const float*)d_in[i];
    a.out = (float*)d_out; a.ws = (unsigned char*)d_ws;
#if MK_ONE_LAUNCH
    a.ph_lo = 0; a.ph_hi = N_PHASES;
    hipLaunchKernelGGL(mk_fwd, dim3(grid), dim3(NWAVES * 64), LDS_BYTES, stream, a);
#else
    for (int ph = 0; ph < N_PHASES; ++ph) { a.ph_lo = ph; a.ph_hi = ph + 1; hipLaunchKernelGGL(mk_fwd, dim3(grid), dim3(NWAVES * 64), LDS_BYTES, stream, a); }
#endif
}
```

```cpp
#include <hip/hip_runtime.h>
#include <cstdio>
#include <cstdint>
#include <cmath>
namespace pg8 {
#define PG8_LAS __attribute__((address_space(3)))
typedef unsigned short bf16_t;
typedef short bf16x8 __attribute__((ext_vector_type(8)));
typedef float f32x4 __attribute__((ext_vector_type(4)));
typedef unsigned u32x4 __attribute__((ext_vector_type(4)));
constexpr int BM = 256, BK = 64, HALF = 128, HTB = HALF * BK * 2  , STAGE_BYTES = 8 * HTB, NXCD = 8, WGM = 8;

__host__ __device__ __forceinline__ int lds_byte(int r, int c) { const int st = (r >> 4) * 2 + (c >> 5), rr = r & 15, cc = c & 31, ob = rr * 64 + cc * 2; return st * 1024 + (ob ^ (((ob >> 9) & 1) << 5)); }
__host__ __device__ __forceinline__ void stage_rc(int b, int& R, int& C) { const int st = b / 1024, sb = b % 1024, swz = sb ^ (((sb >> 9) & 1) << 5); R = (st >> 1) * 16 + swz / 64; C = (st & 1) * 32 + (swz % 64) / 2; }
__host__ __device__ __forceinline__ int perm32(int rho) { const int n = rho >> 4, i = rho & 15; return 8 * (i >> 2) + 4 * n + (i & 3); }

struct Unit { int pm, pn; };
struct Gemm { const bf16_t* A; const bf16_t* Bt; int M, N, K; };

struct StaticOrder {
    int nM, nN, nwg, G, c;
    __host__ __device__ void init(int M, int N, int G_, int c_) { nM = M / BM; nN = N / BM; nwg = nM * nN; G = G_; c = c_; }
    __host__ __device__ bool next(int i, Unit& u) const {
        const long L = (long)i * G + c; if (L >= nwg) return false;
        int wgid = (int)L; { const int q = nwg / NXCD, r = nwg % NXCD, xcd = wgid % NXCD, off = wgid / NXCD; wgid = (xcd < r ? xcd * (q + 1) : r * (q + 1) + (xcd - r) * q) + off; }
        const int nig = WGM * nN, gid = wgid / nig, fm = gid * WGM, gsz = (nM - fm) < WGM ? (nM - fm) : WGM;
        u.pm = fm + ((wgid % nig) % gsz); u.pn = (wgid % nig) / gsz; return true;
    }
    __device__ __forceinline__ void a_ready(const Unit&) const {}
    __device__ __forceinline__ void done(const Unit&) const {}
};

__device__ __forceinline__ unsigned cvt_pk_bf16(float lo, float hi) { unsigned r; asm volatile("v_cvt_pk_bf16_f32 %0, %1, %2" : "=v"(r) : "v"(lo), "v"(hi)); return r; }
typedef float f32x2 __attribute__((ext_vector_type(2)));
__device__ __forceinline__ float sigmoidf_(float x) { return __builtin_amdgcn_rcpf(1.0f + __expf(-x)); }
__device__ __forceinline__ float bf_lo(unsigned w) { return __uint_as_float(w << 16); }
__device__ __forceinline__ float bf_hi(unsigned w) { return __uint_as_float(w & 0xffff0000u); }
struct EpiG1 {
    static constexpr bool PERM = true, AFTER_DRAIN = false;
    bf16_t* Oa; bf16_t* Ob;
    __device__ __forceinline__ void operator()(const f32x4 (&acc)[2][2][4][2], const Unit& u, int wr, int wc, int fr, int fq) const {
        const int row0 = u.pm * BM + wr * 64 + fr; int colt = u.pn * BM; bf16_t* base = Oa; int ldc = 2304;
        if (colt >= 2304) { base = Ob; ldc = 4096; colt -= 2304; }
        const int col0 = colt + wc * 32 + 8 * fq;
#pragma unroll
        for (int ai = 0; ai < 2; ++ai)
#pragma unroll
            for (int m = 0; m < 4; ++m) { bf16_t* rowp = base + (size_t)(row0 + ai * HALF + m * 16) * ldc + col0;
#pragma unroll
                for (int bj = 0; bj < 2; ++bj) { const f32x4 v0 = acc[ai][bj][m][0], v1 = acc[ai][bj][m][1];
                    u32x4 w; w.x = cvt_pk_bf16(v0[0], v0[1]); w.y = cvt_pk_bf16(v0[2], v0[3]); w.z = cvt_pk_bf16(v1[0], v1[1]); w.w = cvt_pk_bf16(v1[2], v1[3]);
                    *(u32x4*)(rowp + bj * HALF) = w; } }
    }
};
struct MidG2 {
    static constexpr int SEG = 8;
    const bf16_t* gate;
    __device__ __forceinline__ void operator()(f32x4 (&acc)[2][2][4][2], const Unit& u, int wr, int wc, int fr, int fq, int seg) const {
        const int row0 = u.pm * BM + wr * 64 + fr; const int col0 = u.pn * BM + wc * 32 + 8 * fq; const bf16_t* gp = gate + (seg - 1) * 1024;
#define PG8_RATIO(N, D) ((1.0f + __expf(-(D))) * __builtin_amdgcn_rcpf(1.0f + __expf(-(N))))
#pragma unroll
        for (int ai = 0; ai < 2; ++ai)
#pragma unroll
          for (int mh = 0; mh < 2; ++mh) {
            u32x4 gn[2][2], gd[2][2];
#pragma unroll
            for (int mm = 0; mm < 2; ++mm)
#pragma unroll
                for (int bj = 0; bj < 2; ++bj) { const bf16_t* p = gp + (size_t)(row0 + ai * HALF + (2 * mh + mm) * 16) * 4096 + col0 + bj * HALF; gn[mm][bj] = *(const u32x4*)p; gd[mm][bj] = *(const u32x4*)(p + 1024); }
#pragma unroll
            for (int mm = 0; mm < 2; ++mm)
#pragma unroll
                for (int bj = 0; bj < 2; ++bj) { f32x4& v0 = acc[ai][bj][2 * mh + mm][0]; f32x4& v1 = acc[ai][bj][2 * mh + mm][1]; const u32x4 a_ = gn[mm][bj], b_ = gd[mm][bj];
                    v0[0] *= PG8_RATIO(bf_lo(a_.x), bf_lo(b_.x)); v0[1] *= PG8_RATIO(bf_hi(a_.x), bf_hi(b_.x)); v0[2] *= PG8_RATIO(bf_lo(a_.y), bf_lo(b_.y)); v0[3] *= PG8_RATIO(bf_hi(a_.y), bf_hi(b_.y));
                    v1[0] *= PG8_RATIO(bf_lo(a_.z), bf_lo(b_.z)); v1[1] *= PG8_RATIO(bf_hi(a_.z), bf_hi(b_.z)); v1[2] *= PG8_RATIO(bf_lo(a_.w), bf_lo(b_.w)); v1[3] *= PG8_RATIO(bf_hi(a_.w), bf_hi(b_.w)); }
            __builtin_amdgcn_sched_barrier(0);
          }
#undef PG8_RATIO
    }
};
struct EpiG2 {
    static constexpr bool PERM = true, AFTER_DRAIN = false;
    const bf16_t* gate;   bf16_t* Mb;
    __device__ __forceinline__ void operator()(const f32x4 (&acc)[2][2][4][2], const Unit& u, int wr, int wc, int fr, int fq) const {
        const int row0 = u.pm * BM + wr * 64 + fr; const int col0 = u.pn * BM + wc * 32 + 8 * fq;
#pragma unroll
        for (int ai = 0; ai < 2; ++ai)
#pragma unroll
            for (int m = 0; m < 4; ++m) { const size_t row = (size_t)(row0 + ai * HALF + m * 16);
#pragma unroll
                for (int bj = 0; bj < 2; ++bj) { const int c = col0 + bj * HALF;
                    const u32x4 gw = *(const u32x4*)(gate + row * 4096 + c);
                    f32x4 v0 = acc[ai][bj][m][0], v1 = acc[ai][bj][m][1];
                    v0[0] *= sigmoidf_(bf_lo(gw.x)); v0[1] *= sigmoidf_(bf_hi(gw.x)); v0[2] *= sigmoidf_(bf_lo(gw.y)); v0[3] *= sigmoidf_(bf_hi(gw.y));
                    v1[0] *= sigmoidf_(bf_lo(gw.z)); v1[1] *= sigmoidf_(bf_hi(gw.z)); v1[2] *= sigmoidf_(bf_lo(gw.w)); v1[3] *= sigmoidf_(bf_hi(gw.w));
                    u32x4 w; w.x = cvt_pk_bf16(v0[0], v0[1]); w.y = cvt_pk_bf16(v0[2], v0[3]); w.z = cvt_pk_bf16(v1[0], v1[1]); w.w = cvt_pk_bf16(v1[2], v1[3]);
                    *(u32x4*)(Mb + row * 1024 + c) = w; } }
    }
};
struct EpiG3 {
    static constexpr bool PERM = true, AFTER_DRAIN = false;
    float* X; const float* base;   const float* g1;
    bf16_t* Xs; const float* sc2;   float* SSQ;
    __device__ __forceinline__ void operator()(const f32x4 (&acc)[2][2][4][2], const Unit& u, int wr, int wc, int fr, int fq) const {
        const int row0 = u.pm * BM + wr * 64 + fr; const int col0 = u.pn * BM + wc * 32 + 8 * fq;
        const int rt = u.pm * BM; const int mi = rt < 8192 ? 0 : (rt < 16384 ? 1 : 2); const float* gp = g1 + mi * 6144; const float* sp = sc2 + mi * 6144;
        float ssq[2][4];
#pragma unroll
        for (int ai = 0; ai < 2; ++ai)
#pragma unroll
            for (int m = 0; m < 4; ++m) ssq[ai][m] = 0.f;
#pragma unroll
        for (int bj = 0; bj < 2; ++bj) { const int c = col0 + bj * HALF; const f32x4 ga = *(const f32x4*)(gp + c), gb = *(const f32x4*)(gp + c + 4);
            const f32x4 sa = *(const f32x4*)(sp + c) + 1.0f, sb = *(const f32x4*)(sp + c + 4) + 1.0f;
#pragma unroll
            for (int ai = 0; ai < 2; ++ai)
#pragma unroll
                for (int m = 0; m < 4; ++m) { const size_t ro = (size_t)(row0 + ai * HALF + m * 16) * 1024 + c; float* xp = X + ro; const float* bp = base + ro;
                    const f32x4 x0 = *(const f32x4*)bp + ga * acc[ai][bj][m][0], x1 = *(const f32x4*)(bp + 4) + gb * acc[ai][bj][m][1];
                    *(f32x4*)xp = x0; *(f32x4*)(xp + 4) = x1;
                    ssq[ai][m] += (x0[0] * x0[0] + x0[1] * x0[1]) + (x0[2] * x0[2] + x0[3] * x0[3]) + (x1[0] * x1[0] + x1[1] * x1[1]) + (x1[2] * x1[2] + x1[3] * x1[3]);
                    const f32x4 y0 = x0 * sa, y1 = x1 * sb; u32x4 w; w.x = cvt_pk_bf16(y0[0], y0[1]); w.y = cvt_pk_bf16(y0[2], y0[3]); w.z = cvt_pk_bf16(y1[0], y1[1]); w.w = cvt_pk_bf16(y1[2], y1[3]);
                    *(u32x4*)(Xs + ro) = w; } }
#pragma unroll
        for (int ai = 0; ai < 2; ++ai)
#pragma unroll
            for (int m = 0; m < 4; ++m) { float v = ssq[ai][m]; v += __shfl_xor(v, 16); v += __shfl_xor(v, 32);
                if (fq == 0) SSQ[(size_t)(row0 + ai * HALF + m * 16) * 16 + u.pn * 4 + wc] = v; }
    }
};
struct EpiG4 {
    static constexpr bool PERM = true, AFTER_DRAIN = false;
    float* O; const float* SSQ; const float* biasq;
    __device__ __forceinline__ void operator()(const f32x4 (&acc)[2][2][4][2], const Unit& u, int wr, int wc, int fr, int fq) const {
        const int row0 = u.pm * BM + wr * 64 + fr; const int col0 = u.pn * BM + wc * 32 + 8 * fq;
        const int rt = u.pm * BM; const int mi = rt < 8192 ? 0 : (rt < 16384 ? 1 : 2); const float* bq = biasq + mi * 1024;
        f32x4 ba[2], bb[2];
#pragma unroll
        for (int bj = 0; bj < 2; ++bj) { ba[bj] = *(const f32x4*)(bq + col0 + bj * HALF); bb[bj] = *(const f32x4*)(bq + col0 + bj * HALF + 4); }
#pragma unroll
        for (int ai = 0; ai < 2; ++ai)
#pragma unroll
            for (int m = 0; m < 4; ++m) { const size_t row = (size_t)(row0 + ai * HALF + m * 16); const f32x4* sq = (const f32x4*)(SSQ + row * 16);
                const f32x4 s = (sq[0] + sq[1]) + (sq[2] + sq[3]); const float rstd = rsqrtf(((s[0] + s[1]) + (s[2] + s[3])) * (1.0f / 1024.0f) + 1e-6f);
                float* op = O + row * 1024 + col0;
#pragma unroll
                for (int bj = 0; bj < 2; ++bj) { *(f32x4*)(op + bj * HALF) = acc[ai][bj][m][0] * rstd + ba[bj]; *(f32x4*)(op + bj * HALF + 4) = acc[ai][bj][m][1] * rstd + bb[bj]; } }
    }
};
struct NoMid { static constexpr int SEG = 0; __device__ __forceinline__ void operator()(f32x4 (&)[2][2][4][2], const Unit&, int, int, int, int, int) const {} };
template <class Epi, class Sched, bool ALIGN_EPI = false, bool SP2 = false, class Mid = NoMid>
__device__ __forceinline__ void gemm_phase(PG8_LAS unsigned char* lds, const Gemm g, const Sched& S, const Epi& E, const Mid& Mh = Mid()) {
    const int tid = threadIdx.x, wid = __builtin_amdgcn_readfirstlane(tid >> 6), lane = tid & 63, wr = wid >> 2, wc = wid & 3, fr = lane & 15, fq = lane >> 4;
    const int K = g.K, nt = K / BK;
    unsigned voffA[2], voffB[2];
#pragma unroll
    for (int i = 0; i < 2; ++i) { int R, C; stage_rc(tid * 16 + i * 8192, R, C); const int Rb = Epi::PERM ? ((R & ~31) + perm32(R & 31)) : R;
        voffA[i] = (unsigned)(R * K + C) * 2u; voffB[i] = (unsigned)(Rb * K + C) * 2u; }
    const size_t kstep = (size_t)(BK * 2);
    const size_t hstep = (size_t)HALF * K * 2;
    const size_t tstep = 2 * hstep;
    const unsigned ldsw = (unsigned)wid * 1024u;
    const int aoff = lds_byte(wr * 64 + fr, fq * 8), boff = lds_byte(wc * 32 + fr, fq * 8);
#define PG8_SA(b, h) (((b) * 2 + (h)) * HTB)
#define PG8_SB(b, h) ((4 + (b) * 2 + (h)) * HTB)
#define PG8_STAGE(bufoff, gbase, voff) do { _Pragma("unroll") for (int _i = 0; _i < 2; ++_i) \
        __builtin_amdgcn_global_load_lds((const unsigned*)((const char*)(gbase) + (voff)[_i]), (PG8_LAS unsigned*)(lds + (bufoff) + ldsw + _i * 8192), 16, 0, 0); } while (0)
#define PG8_LDA(dst, b, h) do { _Pragma("unroll") for (int m = 0; m < 4; ++m) _Pragma("unroll") for (int k = 0; k < 2; ++k) dst[m][k] = *(const PG8_LAS bf16x8*)(lds + PG8_SA(b, h) + aoff + m * 2048 + k * 1024); } while (0)
#define PG8_LDB(dst, b, h) do { _Pragma("unroll") for (int n = 0; n < 2; ++n) _Pragma("unroll") for (int k = 0; k < 2; ++k) dst[n][k] = *(const PG8_LAS bf16x8*)(lds + PG8_SB(b, h) + boff + n * 2048 + k * 1024); } while (0)
#define PG8_MMA(ai, bj, At, Bt) do { __builtin_amdgcn_s_setprio(1); _Pragma("unroll") for (int m = 0; m < 4; ++m) _Pragma("unroll") for (int n = 0; n < 2; ++n) _Pragma("unroll") for (int k = 0; k < 2; ++k) \
        acc[ai][bj][m][n] = __builtin_amdgcn_mfma_f32_16x16x32_bf16(Bt[n][k], At[m][k], acc[ai][bj][m][n], 0, 0, 0); __builtin_amdgcn_s_setprio(0); } while (0)
#define PG8_WAIT_V(n) asm volatile("s_waitcnt vmcnt(" #n ")" ::: "memory")
#define PG8_WAIT_L(n) asm volatile("s_waitcnt lgkmcnt(" #n ")" ::: "memory")
#define PG8_BAR __builtin_amdgcn_s_barrier()
#define PG8_SCHED __builtin_amdgcn_sched_barrier(0)
    Unit cur, nxt; int ui = 0;
    if (!S.next(0, cur)) return;
    f32x4 acc[2][2][4][2];
#pragma unroll
    for (int a = 0; a < 2; ++a)
#pragma unroll
        for (int b = 0; b < 2; ++b)
#pragma unroll
            for (int m = 0; m < 4; ++m)
#pragma unroll
                for (int n = 0; n < 2; ++n) acc[a][b][m][n] = (f32x4){0.f, 0.f, 0.f, 0.f};
    bf16x8 At[4][2], B0[2][2], B1[2][2];
    const char* cA = (const char*)g.A + (size_t)cur.pm * tstep; const char* cB = (const char*)g.Bt + (size_t)cur.pn * tstep;
    S.a_ready(cur);
    if constexpr (SP2) {
        PG8_STAGE(PG8_SB(0, 0), cB, voffB); PG8_STAGE(PG8_SB(0, 1), cB + hstep, voffB); PG8_STAGE(PG8_SA(0, 0), cA, voffA); PG8_STAGE(PG8_SA(0, 1), cA + hstep, voffA);
        if (wr == 1) PG8_BAR;
        PG8_WAIT_V(2); PG8_BAR;
        PG8_STAGE(PG8_SB(1, 0), cB + kstep, voffB); PG8_STAGE(PG8_SA(1, 0), cA + kstep, voffA); PG8_STAGE(PG8_SB(1, 1), cB + hstep + kstep, voffB);
        PG8_WAIT_V(6); PG8_BAR;
    } else {
        PG8_STAGE(PG8_SB(0, 0), cB, voffB); PG8_STAGE(PG8_SA(0, 0), cA, voffA); PG8_STAGE(PG8_SB(0, 1), cB + hstep, voffB); PG8_STAGE(PG8_SA(0, 1), cA + hstep, voffA);
        if (wr == 1) PG8_BAR;
        PG8_WAIT_V(4); PG8_BAR;
        PG8_STAGE(PG8_SB(1, 0), cB + kstep, voffB); PG8_STAGE(PG8_SA(1, 0), cA + kstep, voffA); PG8_STAGE(PG8_SB(1, 1), cB + hstep + kstep, voffB);
        PG8_WAIT_V(6); PG8_BAR;
    }
    for (;;) {
        const bool has_next = S.next(ui + 1, nxt);
        const char* nA = has_next ? (const char*)g.A + (size_t)nxt.pm * tstep : cA; const char* nB = has_next ? (const char*)g.Bt + (size_t)nxt.pn * tstep : cB;
        for (int t = 0; t < nt; t += 2) {
            if constexpr (Mid::SEG > 0) { if (t != 0 && (t % Mid::SEG) == 0) Mh(acc, cur, wr, wc, fr, fq, t / Mid::SEG); }
            const bool last = (t == nt - 2);
            const char* a1 = cA + (size_t)(t + 1) * kstep;
            const char* a2 = last ? nA : cA + (size_t)(t + 2) * kstep; const char* b2 = last ? nB : cB + (size_t)(t + 2) * kstep;
            const char* a3 = a2 + kstep; const char* b3 = b2 + kstep;
            if (last && has_next) S.a_ready(nxt);
            if constexpr (SP2) {
            PG8_LDB(B0, 0, 0); PG8_LDB(B1, 0, 1); PG8_SCHED; PG8_LDA(At, 0, 0); PG8_STAGE(PG8_SA(1, 1), a1 + hstep, voffA);
            PG8_WAIT_V(8); PG8_WAIT_L(0); PG8_BAR; PG8_MMA(0, 0, At, B0); PG8_MMA(0, 1, At, B1); PG8_BAR; PG8_SCHED;
            PG8_LDA(At, 0, 1); PG8_STAGE(PG8_SB(0, 0), b2, voffB); PG8_STAGE(PG8_SB(0, 1), b2 + hstep, voffB); PG8_STAGE(PG8_SA(0, 0), a2, voffA);
            PG8_WAIT_V(8); PG8_WAIT_L(0); PG8_BAR; PG8_MMA(1, 0, At, B0); PG8_MMA(1, 1, At, B1); PG8_BAR; PG8_SCHED;
            PG8_LDB(B0, 1, 0); PG8_LDB(B1, 1, 1); PG8_SCHED; PG8_LDA(At, 1, 0); PG8_STAGE(PG8_SA(0, 1), a2 + hstep, voffA);
            PG8_WAIT_V(8); PG8_WAIT_L(0); PG8_BAR; PG8_MMA(0, 0, At, B0); PG8_MMA(0, 1, At, B1); PG8_BAR; PG8_SCHED;
            PG8_LDA(At, 1, 1); PG8_STAGE(PG8_SB(1, 0), b3, voffB); PG8_STAGE(PG8_SB(1, 1), b3 + hstep, voffB); PG8_STAGE(PG8_SA(1, 0), a3, voffA);
            PG8_WAIT_V(8); PG8_WAIT_L(0); PG8_BAR; PG8_MMA(1, 0, At, B0); PG8_MMA(1, 1, At, B1); PG8_BAR; PG8_SCHED;
            } else {
            PG8_LDB(B0, 0, 0); PG8_SCHED; PG8_LDA(At, 0, 0); PG8_STAGE(PG8_SA(1, 1), a1 + hstep, voffA);
            PG8_WAIT_L(8); PG8_BAR; PG8_WAIT_L(0); PG8_MMA(0, 0, At, B0); PG8_BAR; PG8_SCHED;
            PG8_LDB(B1, 0, 1); PG8_STAGE(PG8_SB(0, 0), b2, voffB);
            PG8_BAR; PG8_WAIT_L(0); PG8_MMA(0, 1, At, B1); PG8_BAR;
            PG8_LDA(At, 0, 1); PG8_STAGE(PG8_SA(0, 0), a2, voffA);
            PG8_BAR; PG8_WAIT_L(0); PG8_MMA(1, 0, At, B0); PG8_BAR; PG8_SCHED;
            PG8_STAGE(PG8_SB(0, 1), b2 + hstep, voffB);
            PG8_WAIT_V(6); PG8_BAR; PG8_MMA(1, 1, At, B1); PG8_BAR;
            PG8_LDB(B0, 1, 0); PG8_SCHED; PG8_LDA(At, 1, 0); PG8_STAGE(PG8_SA(0, 1), a2 + hstep, voffA);
            PG8_WAIT_L(8); PG8_BAR; PG8_WAIT_L(0); PG8_MMA(0, 0, At, B0); PG8_BAR; PG8_SCHED;
            PG8_LDB(B1, 1, 1); PG8_STAGE(PG8_SB(1, 0), b3, voffB);
            PG8_BAR; PG8_WAIT_L(0); PG8_MMA(0, 1, At, B1); PG8_BAR;
            PG8_LDA(At, 1, 1); PG8_STAGE(PG8_SA(1, 0), a3, voffA);
            PG8_BAR; PG8_WAIT_L(0); PG8_MMA(1, 0, At, B0); PG8_BAR; PG8_SCHED;
            PG8_STAGE(PG8_SB(1, 1), b3 + hstep, voffB);
            PG8_WAIT_V(6); PG8_BAR; PG8_MMA(1, 1, At, B1); PG8_BAR;
            }
        }
        if constexpr (ALIGN_EPI) { if (wr == 0) PG8_BAR; }
        if constexpr (!Epi::AFTER_DRAIN) { E(acc, cur, wr, wc, fr, fq); S.done(cur); }
        if (!has_next) break;
#pragma unroll
        for (int a = 0; a < 2; ++a)
#pragma unroll
            for (int b = 0; b < 2; ++b)
#pragma unroll
                for (int m = 0; m < 4; ++m)
#pragma unroll
                    for (int n = 0; n < 2; ++n) acc[a][b][m][n] = (f32x4){0.f, 0.f, 0.f, 0.f};
        cur = nxt; cA = nA; cB = nB; ++ui;
        if constexpr (ALIGN_EPI) { if (wr == 1) PG8_BAR; }
    }
    PG8_WAIT_V(0);
    if constexpr (!ALIGN_EPI) { if (wr == 0) PG8_BAR; }
    PG8_BAR;
    if constexpr (Epi::AFTER_DRAIN) { E.fused(acc, cur, wr, wc, fr, fq, lds, wid, lane); S.done(cur); }
#undef PG8_SA
#undef PG8_SB
#undef PG8_STAGE
#undef PG8_LDA
#undef PG8_LDB
#undef PG8_MMA
#undef PG8_WAIT_V
#undef PG8_WAIT_L
#undef PG8_BAR
#undef PG8_SCHED
}
}
#define GAS __attribute__((address_space(1)))
#define LAS __attribute__((address_space(3)))
typedef unsigned short bf16;
typedef unsigned v4u __attribute__((ext_vector_type(4)));
typedef float f32x4 __attribute__((ext_vector_type(4)));
typedef short bf16x8 __attribute__((ext_vector_type(8)));
typedef GAS unsigned gu32;
typedef GAS unsigned long long gu64;
#define RLX_AGENT __ATOMIC_RELAXED, __HIP_MEMORY_SCOPE_AGENT
#define LDS_WAIT() asm volatile("s_waitcnt lgkmcnt(0)" ::: "memory")
#define VM_WAIT() asm volatile("s_waitcnt vmcnt(0)" ::: "memory")
__device__ __forceinline__ unsigned long long rt() { return __builtin_amdgcn_s_memrealtime(); }
__device__ __forceinline__ unsigned f2bf(float f) { unsigned u = __builtin_bit_cast(unsigned, f); return (u + 0x7fffu + ((u >> 16) & 1u)) >> 16; }
__device__ __forceinline__ unsigned pk2(float lo, float hi) { return f2bf(lo) | (f2bf(hi) << 16); }
#define XB_TMO      128
#define XB_XCNT(j)  (256  + 64 * (j))
#define XB_XSUB(j)  (1280 + 64 * (j))
#define XB_XGEN(j)  (2304 + 64 * (j))
#define XB_TOP      3328
#define XB_TOPGEN   3392
#define XCD_BAR_WORDS 3456
#define XB_SPIN_CAP (1u << 24)

__device__ __forceinline__ unsigned xb_ld(unsigned* p)              { return __hip_atomic_load(p, __ATOMIC_RELAXED, __HIP_MEMORY_SCOPE_AGENT); }
__device__ __forceinline__ unsigned xb_add(unsigned* p, unsigned v) { return __hip_atomic_fetch_add(p, v, __ATOMIC_RELAXED, __HIP_MEMORY_SCOPE_AGENT); }
__device__ __forceinline__ unsigned xb_xcc_id() { return (unsigned)__builtin_amdgcn_s_getreg((3 << 11) | 20) & 0xFu; }
#define XB_SPIN(cond, bar) do { unsigned _sp = 0; while (cond) { __builtin_amdgcn_s_sleep(1); \
    if ((++_sp & 255u) == 0u) { if (xb_ld(&(bar)[XB_TMO])) break; if (_sp > XB_SPIN_CAP) { atomicAdd(&(bar)[XB_TMO], 1u); break; } } } } while (0)

struct XcdBarrier {
    unsigned* bar; unsigned x;
    volatile LAS unsigned* st;
};

__device__ __forceinline__ XcdBarrier xcd_barrier_post(unsigned* bar, volatile LAS unsigned* st) {
    XcdBarrier b; b.bar = bar; b.x = xb_xcc_id(); b.st = st;
    if (threadIdx.x == 0) (void)xb_add(&bar[XB_XCNT(b.x)], 1u);
    return b;
}
__device__ __forceinline__ void xcd_barrier_complete(unsigned* bar, unsigned x, unsigned& nloc, unsigned& nx) {
    const unsigned G = gridDim.x * gridDim.y * gridDim.z;
    unsigned sum, cnt, mine, sp = 0u;
    for (;;) {
        sum = 0u; cnt = 0u; mine = 0u;
#pragma unroll
        for (unsigned j = 0; j < 16; ++j) { const unsigned c = xb_ld(&bar[XB_XCNT(j)]); sum += c; cnt += (c > 0u) ? 1u : 0u; mine = (j == x) ? c : mine; }
        if (sum == G) break;
        __builtin_amdgcn_s_sleep(1);
        if ((++sp & 255u) == 0u) { if (xb_ld(&bar[XB_TMO])) break; if (sp > XB_SPIN_CAP) { atomicAdd(&bar[XB_TMO], 1u); break; } }
    }
    nloc = mine > 0u ? mine : 1u; nx = cnt > 0u ? cnt : 1u;
}

__device__ __forceinline__ void xcd_barrier(const XcdBarrier& b) {
    asm volatile("s_waitcnt vmcnt(0)" ::: "memory");
    __syncthreads();
    if (threadIdx.x == 0) {
        unsigned* bar = b.bar;
        __builtin_amdgcn_s_waitcnt(0);
        unsigned nloc = b.st[0], nx = b.st[1];
        if (nloc == 0u) { xcd_barrier_complete(bar, b.x, nloc, nx); b.st[0] = nloc; b.st[1] = nx; }
        const unsigned old = xb_add(&bar[XB_XSUB(b.x)], 1u);
        const unsigned gen = old / nloc;
        if (old + 1u == (gen + 1u) * nloc) {
            __builtin_amdgcn_fence(__ATOMIC_RELEASE, "agent");
            asm volatile("s_waitcnt vmcnt(0)" ::: "memory");
            const unsigned og = xb_add(&bar[XB_TOP], 1u);
            const unsigned tg = og / nx;
            if (og + 1u == (tg + 1u) * nx) xb_add(&bar[XB_TOPGEN], 1u);
            else XB_SPIN(xb_ld(&bar[XB_TOPGEN]) == tg, bar);
            __builtin_amdgcn_fence(__ATOMIC_ACQUIRE, "agent");
            xb_add(&bar[XB_XGEN(b.x)], 1u);
            asm volatile("s_waitcnt vmcnt(0)" ::: "memory");
        } else {
            XB_SPIN(xb_ld(&bar[XB_XGEN(b.x)]) == gen, bar);
            __builtin_amdgcn_fence(__ATOMIC_ACQUIRE, "agent");
            asm volatile("s_waitcnt vmcnt(0)" ::: "memory");
        }
    }
    __syncthreads();
}
__device__ __forceinline__ float wave_sum(float v) {
#pragma unroll
    for (int o = 1; o < 64; o <<= 1) v += __shfl_xor(v, o);
    return v;
}
__device__ __forceinline__ void p0_transpose_item(const float* W, int K, int N, bf16* WT, int row_off, LAS float* scr, int item, int lane) {
    const int nblk = N / 32, kb = item / nblk, nb = item % nblk, k0 = 64 * kb, n0 = 32 * nb;
#pragma unroll 8
    for (int i = 0; i < 32; ++i) { const int kk = 2 * i + (lane >> 5); scr[kk * 33 + (lane & 31)] = W[(size_t)(k0 + kk) * N + n0 + (lane & 31)]; }
    LDS_WAIT(); asm volatile("" ::: "memory");
    const int c = lane & 7;
#pragma unroll
    for (int j = 0; j < 4; ++j) { const int n = (lane >> 3) + 8 * j; const LAS float* s = scr + (8 * c) * 33 + n;
        v4u o; o.x = pk2(s[0 * 33], s[1 * 33]); o.y = pk2(s[2 * 33], s[3 * 33]); o.z = pk2(s[4 * 33], s[5 * 33]); o.w = pk2(s[6 * 33], s[7 * 33]);
        *(GAS v4u*)(WT + (size_t)(row_off + n0 + n) * K + k0 + 8 * c) = o; }
    LDS_WAIT(); asm volatile("" ::: "memory");
}
__device__ __forceinline__ void p0_transpose_item_p(const float* W, int K, int N, bf16* WT, int pitch, int col_off, LAS float* scr, int item, int lane) {
    const int nblk = N / 32, kb = item / nblk, nb = item % nblk, k0 = 64 * kb, n0 = 32 * nb;
#pragma unroll 8
    for (int i = 0; i < 32; ++i) { const int kk = 2 * i + (lane >> 5); scr[kk * 33 + (lane & 31)] = W[(size_t)(k0 + kk) * N + n0 + (lane & 31)]; }
    LDS_WAIT(); asm volatile("" ::: "memory");
    const int c = lane & 7;
#pragma unroll
    for (int j = 0; j < 4; ++j) { const int n = (lane >> 3) + 8 * j; const LAS float* s = scr + (8 * c) * 33 + n;
        v4u o; o.x = pk2(s[0 * 33], s[1 * 33]); o.y = pk2(s[2 * 33], s[3 * 33]); o.z = pk2(s[4 * 33], s[5 * 33]); o.w = pk2(s[6 * 33], s[7 * 33]);
        *(GAS v4u*)(WT + (size_t)(n0 + n) * pitch + col_off + k0 + 8 * c) = o; }
    LDS_WAIT(); asm volatile("" ::: "memory");
}
#include <hip/hip_bf16.h>
#include <cmath>
namespace attn_body {
using bf16=__hip_bfloat16;
using bf16x8=__attribute__((ext_vector_type(8)))short;
using s16x4=__attribute__((ext_vector_type(4)))short;
using f32x16=__attribute__((ext_vector_type(16)))float;
using u32x4=__attribute__((ext_vector_type(4)))unsigned;
constexpr int D=64;
constexpr int NW=8,QBLK=32,QB=QBLK*NW,KVBLK=64;
constexpr int ATTN_UNIT_ROWS=QB;
__device__ __forceinline__ int crow(int r,int hi){return (r&3)+8*(r>>2)+4*hi;}
#define SBAR() __builtin_amdgcn_sched_barrier(0)
constexpr int NSLOT=3, SLOTB=8192;
constexpr int LDS_K=0, LDS_V=NSLOT*SLOTB, LDS_WS=2*NSLOT*SLOTB, LDS_OST=LDS_WS+NW*64*4, LDS_BYTES=LDS_OST+NW*4096;
constexpr float C2=0.125f*1.4426950408889634f;
__device__ __forceinline__ void glds16(const void*gsrc,unsigned lds_dst){unsigned keep;
  asm volatile("s_mov_b32 %0, m0\n\ts_mov_b32 m0, %2\n\ts_nop 0\n\tglobal_load_lds_dwordx4 %1, off\n\ts_mov_b32 m0, %0":"=&s"(keep):"v"(gsrc),"s"(lds_dst):"memory");}
__device__ __forceinline__ float max3f(float a,float b,float c){float r;asm("v_max3_f32 %0, %1, %2, %3":"=v"(r):"v"(a),"v"(b),"v"(c));return r;}
__device__ __forceinline__ float max2f(float a,float b){float r;asm("v_max_f32_e32 %0, %1, %2":"=v"(r):"v"(a),"v"(b));return r;}
__device__ __forceinline__ float fadd_s(float a,float b){float r;asm("v_add_f32_e32 %0, %1, %2":"=v"(r):"v"(a),"v"(b));return r;}
__device__ __forceinline__ float fsub_s(float a,float b){float r;asm("v_sub_f32_e32 %0, %1, %2":"=v"(r):"v"(a),"v"(b));return r;}
typedef float f32x2_t __attribute__((ext_vector_type(2))); typedef __bf16 bf16x2_t __attribute__((ext_vector_type(2)));
__device__ __forceinline__ unsigned cvtpk_s(float lo,float hi){f32x2_t v={lo,hi};bf16x2_t b=__builtin_convertvector(v,bf16x2_t);return __builtin_bit_cast(unsigned,b);}
#define WAIT_BAR(N) asm volatile("s_waitcnt vmcnt(" #N ") lgkmcnt(0)\n\ts_barrier":::"memory")

__device__ __forceinline__ void qkt(f32x16&p0,f32x16&p1,const char*Kslot,const bf16x8*qr,const f32x16&negm,int r32,int hi){
  const char*kb=Kslot+hi*1024+r32*16;
  #pragma unroll
  for(int d0=0;d0<4;++d0){
    const bf16x8 b0=*reinterpret_cast<const bf16x8*>(kb+d0*2048);
    const bf16x8 b1=*reinterpret_cast<const bf16x8*>(kb+d0*2048+512);
    if(d0==0){p0=__builtin_amdgcn_mfma_f32_32x32x16_bf16(b0,qr[0],negm,0,0,0);p1=__builtin_amdgcn_mfma_f32_32x32x16_bf16(b1,qr[0],negm,0,0,0);}
    else{p0=__builtin_amdgcn_mfma_f32_32x32x16_bf16(b0,qr[d0],p0,0,0,0);p1=__builtin_amdgcn_mfma_f32_32x32x16_bf16(b1,qr[d0],p1,0,0,0);}}
}
typedef __attribute__((address_space(3))) const char* lds_cptr;
typedef short v4i16_t __attribute__((ext_vector_type(4)));
__device__ __forceinline__ void kload8(bf16x8*kf,lds_cptr kp){
  kf[0]=*(const __attribute__((address_space(3))) bf16x8*)(kp);      kf[1]=*(const __attribute__((address_space(3))) bf16x8*)(kp+512);
  kf[2]=*(const __attribute__((address_space(3))) bf16x8*)(kp+2048); kf[3]=*(const __attribute__((address_space(3))) bf16x8*)(kp+2560);
  kf[4]=*(const __attribute__((address_space(3))) bf16x8*)(kp+4096); kf[5]=*(const __attribute__((address_space(3))) bf16x8*)(kp+4608);
  kf[6]=*(const __attribute__((address_space(3))) bf16x8*)(kp+6144); kf[7]=*(const __attribute__((address_space(3))) bf16x8*)(kp+6656);
}
__device__ __forceinline__ void kload2(bf16x8*kf,lds_cptr kp,int j){ kf[2*j]=*(const __attribute__((address_space(3))) bf16x8*)(kp+j*2048); kf[2*j+1]=*(const __attribute__((address_space(3))) bf16x8*)(kp+j*2048+512); }
__device__ __forceinline__ s16x4 vtr(lds_cptr p){ return __builtin_bit_cast(s16x4,__builtin_amdgcn_ds_read_tr16_b64_v4i16((__attribute__((address_space(3))) v4i16_t*)p)); }
__device__ __forceinline__ float rowmax(const f32x16&p0,const f32x16&p1){
  float a=max3f(p0[0],p0[1],p1[0]),b=max3f(p0[2],p0[3],p1[1]);a=max3f(a,p1[2],p1[3]);
  #pragma unroll
  for(int r=4;r<16;r+=4){a=max3f(a,p0[r],p0[r+1]);b=max3f(b,p0[r+2],p0[r+3]);a=max3f(a,p1[r],p1[r+1]);b=max3f(b,p1[r+2],p1[r+3]);}
  const float m=max2f(a,b);
  auto rr=__builtin_amdgcn_permlane32_swap(__float_as_uint(m),__float_as_uint(m),false,false);
  return max2f(__uint_as_float(rr[0]),__uint_as_float(rr[1]));
}
__device__ __forceinline__ void pv(f32x16*o,int vb,bf16x8 pa0,bf16x8 pa1,bf16x8 pa2,bf16x8 pa3){
  #pragma unroll
  for(int d0=0;d0<2;++d0){s16x4 lo[4],hi[4];
    #pragma unroll
    for(int ks=0;ks<4;++ks){
      asm volatile("ds_read_b64_tr_b16 %0,%1 offset:%c2":"=&v"(lo[ks]):"v"(vb),"i"(d0*4096+ks*1024):"memory");
      asm volatile("ds_read_b64_tr_b16 %0,%1 offset:%c2":"=&v"(hi[ks]):"v"(vb),"i"(d0*4096+ks*1024+512):"memory");}
    asm volatile("s_waitcnt lgkmcnt(0)":::"memory");SBAR();
    #define PK(k) (bf16x8){lo[k][0],lo[k][1],lo[k][2],lo[k][3],hi[k][0],hi[k][1],hi[k][2],hi[k][3]}
    o[d0]=__builtin_amdgcn_mfma_f32_32x32x16_bf16(pa0,PK(0),o[d0],0,0,0);
    o[d0]=__builtin_amdgcn_mfma_f32_32x32x16_bf16(pa1,PK(1),o[d0],0,0,0);
    o[d0]=__builtin_amdgcn_mfma_f32_32x32x16_bf16(pa2,PK(2),o[d0],0,0,0);
    o[d0]=__builtin_amdgcn_mfma_f32_32x32x16_bf16(pa3,PK(3),o[d0],0,0,0);
    #undef PK
  }
}

#ifndef ATTN_STORE16
#define ATTN_STORE16(p,v) (*(u32x4*)(p)=(v))
#endif
template<int THRL> __device__ __forceinline__ void attn_unit(const bf16*Qw0,int QP,const bf16*Kh,int KP,const bf16*Vh,int VP,bf16*Ow0,int OP,int NT,char*shm,float mref){
  int tid=threadIdx.x; asm volatile("":"+v"(tid));
  const int lane=tid&63,r32=lane&31,hi=lane>>5; const int wid=__builtin_amdgcn_readfirstlane(tid>>6);
  const bf16*Qw=Qw0+(long)wid*QBLK*QP;
  const unsigned lds0=(unsigned)(uintptr_t)shm;
  float*wsf=(float*)(shm+LDS_WS)+wid*64;
  const bf16*ksrc=Kh+(long)lane*KP+wid*8;
  const bf16*vsrc=Vh+(long)(16*(wid&3)+(lane>>2))*VP+(wid>>2)*32+(lane&3)*8;
  const unsigned kdst=lds0+LDS_K+wid*1024, vdst=lds0+LDS_V+wid*1024;
  #define DMA_K(t,slot) glds16(ksrc+(long)(t)*KVBLK*KP,(unsigned)__builtin_amdgcn_readfirstlane(kdst+(slot)))
  #define DMA_V(t,slot) glds16(vsrc+(long)(t)*KVBLK*VP,(unsigned)__builtin_amdgcn_readfirstlane(vdst+(slot)))
  const int vb0=(int)(lds0+LDS_V)+((lane>>4)&1)*32+(lane&3)*8+(4*hi+((lane&15)>>2))*64;
  const char*Kbase=shm+LDS_K; bf16x8 kf[8];
  const lds_cptr shm3=(lds_cptr)shm; const lds_cptr kp0=shm3+LDS_K+hi*1024+r32*16; const lds_cptr vp0=shm3+LDS_V+((lane>>4)&1)*32+(lane&3)*8+(4*hi+((lane&15)>>2))*64;
  DMA_K(0,0);DMA_V(0,0);DMA_K(1,SLOTB);
  bf16x8 qr[4];
  #pragma unroll
  for(int d0=0;d0<4;++d0)qr[d0]=*reinterpret_cast<const bf16x8*>(&Qw[(long)r32*QP+d0*16+hi*8]);
  float l_reg=0.f;f32x16 o[2];o[0]=f32x16{};o[1]=f32x16{};f32x16 negm; _Pragma("unroll") for(int r=0;r<16;++r)negm[r]=-mref; asm volatile("":"+v"(negm));
  #define CMASK(P0,P1,t) do{}while(0)
  #define START(P0,P1) do{ _Pragma("unroll") for(int r=0;r<16;++r)P0[r]=__builtin_amdgcn_exp2f(P0[r]); }while(0)
  #define RESC() do{}while(0)
  f32x16 pA0,pA1,pB0,pB1;
  int sl_prev=0,sl_cur=0,sl_next=SLOTB;
  #define ROT() do{sl_prev=sl_cur;sl_cur=sl_next;sl_next=(sl_next==(NSLOT-1)*SLOTB)?0:sl_next+SLOTB;}while(0)
  DMA_K(2,2*SLOTB);
  WAIT_BAR(3);
  qkt(pA0,pA1,Kbase,qr,negm,r32,hi);asm volatile("s_nop 15\n\ts_nop 7":"+v"(pA0),"+v"(pA1));CMASK(pA0,pA1,0);
  START(pA0,pA1);
  _Pragma("unroll") for(int r=0;r<16;++r)pA1[r]=__builtin_amdgcn_exp2f(pA1[r]);
  WAIT_BAR(0);
  DMA_K(3,0);DMA_V(1,SLOTB);
  ROT();
  kload8(kf,kp0+sl_cur);
  WAIT_BAR(2);
  s16x4 vlo[8],vhi[8]; u32x4 pw0,pw1,pw2,pw3;
  #define PKW(P,B) cvtpk_s(P[B],P[B+1])
  #define PAF(k) __builtin_bit_cast(bf16x8,pw##k)
  #define VFR(i) (bf16x8){vlo[i][0],vlo[i][1],vlo[i][2],vlo[i][3],vhi[i][0],vhi[i][1],vhi[i][2],vhi[i][3]}
  #define PIN(x) asm volatile("":"+v"(x))
  #define MX3(a,b,c) __builtin_fmaxf(__builtin_fmaxf((a),(b)),(c))
  #define GAPA(MF,A0,A1,A2,A3,W0,W1,PW) do{ MF; sacc+=A0; sacc+=A1; sacc+=A2; sacc+=A3; PIN(sacc); W0; W1; PIN(PW); SBAR(); }while(0)
  #define EX(v) __builtin_amdgcn_exp2f(v)
  #define GAPB(MF,X,B) do{ MF; X[B]=EX(X[B]); X[B+1]=EX(X[B+1]); X[B+2]=EX(X[B+2]); X[B+3]=EX(X[B+3]); PIN(X); SBAR(); }while(0)
  #define VRD(i) do{ vlo[i]=vtr(vp_+(((i)>>2)*4096+((i)&3)*1024)); vhi[i]=vtr(vp_+(((i)>>2)*4096+((i)&3)*1024+512)); }while(0)
  #define KRD(G,j) do{ if(G){ kload2(kf,kp0+sl_next,j); SBAR(); } }while(0)
  #define STEP(C0,C1,P0,P1,t,GK,GV,GL) do{ SBAR(); \
    const lds_cptr vp_=vp0+sl_prev; \
    VRD(0); SBAR(); float sacc=(P0[0]+P0[1]); \
    GAPA(C0=__builtin_amdgcn_mfma_f32_32x32x16_bf16(kf[0],qr[0],negm,0,0,0), P0[2],P0[3],P0[4],P0[5],     pw0[0]=PKW(P0,0), pw0[1]=PKW(P0,2), pw0); \
    VRD(4); SBAR(); GAPA(C1=__builtin_amdgcn_mfma_f32_32x32x16_bf16(kf[1],qr[0],negm,0,0,0), P0[6],P0[7],P0[8],P0[9],     pw0[2]=PKW(P0,4), pw0[3]=PKW(P0,6), pw0); \
    VRD(1); SBAR(); GAPA(C0=__builtin_amdgcn_mfma_f32_32x32x16_bf16(kf[2],qr[1],C0,0,0,0),   P0[10],P0[11],P0[12],P0[13], pw1[0]=PKW(P0,8), pw1[1]=PKW(P0,10), pw1); \
    VRD(5); SBAR(); GAPA(C1=__builtin_amdgcn_mfma_f32_32x32x16_bf16(kf[3],qr[1],C1,0,0,0),   P0[14],P0[15],P1[0],P1[1],   pw1[2]=PKW(P0,12),pw1[3]=PKW(P0,14), pw1); \
    VRD(2); SBAR(); GAPA(C0=__builtin_amdgcn_mfma_f32_32x32x16_bf16(kf[4],qr[2],C0,0,0,0),   P1[2],P1[3],P1[4],P1[5],     pw2[0]=PKW(P1,0), pw2[1]=PKW(P1,2), pw2); \
    VRD(6); SBAR(); GAPA(C1=__builtin_amdgcn_mfma_f32_32x32x16_bf16(kf[5],qr[2],C1,0,0,0),   P1[6],P1[7],P1[8],P1[9],     pw2[2]=PKW(P1,4), pw2[3]=PKW(P1,6), pw2); \
    VRD(3); SBAR(); GAPA(C0=__builtin_amdgcn_mfma_f32_32x32x16_bf16(kf[6],qr[3],C0,0,0,0),   P1[10],P1[11],P1[12],P1[13], pw3[0]=PKW(P1,8), pw3[1]=PKW(P1,10), pw3); \
    VRD(7); SBAR(); GAPA(C1=__builtin_amdgcn_mfma_f32_32x32x16_bf16(kf[7],qr[3],C1,0,0,0),   P1[14],P1[15],0.f,0.f,       pw3[2]=PKW(P1,12),pw3[3]=PKW(P1,14), pw3); \
    l_reg+=sacc; \
    if(GK){DMA_K((t)+3,sl_cur);} if(GV){DMA_V((t)+1,sl_next);} \
    CMASK(C0,C1,t); \
    SBAR(); \
    GAPB(o[0]=__builtin_amdgcn_mfma_f32_32x32x16_bf16(PAF(0),VFR(0),o[0],0,0,0), C0,0); \
    GAPB(o[1]=__builtin_amdgcn_mfma_f32_32x32x16_bf16(PAF(0),VFR(4),o[1],0,0,0), C0,4); \
    KRD(GL,0); GAPB(o[0]=__builtin_amdgcn_mfma_f32_32x32x16_bf16(PAF(1),VFR(1),o[0],0,0,0), C0,8); \
    KRD(GL,1); GAPB(o[1]=__builtin_amdgcn_mfma_f32_32x32x16_bf16(PAF(1),VFR(5),o[1],0,0,0), C0,12); \
    KRD(GL,2); GAPB(o[0]=__builtin_amdgcn_mfma_f32_32x32x16_bf16(PAF(2),VFR(2),o[0],0,0,0), C1,0); \
    KRD(GL,3); GAPB(o[1]=__builtin_amdgcn_mfma_f32_32x32x16_bf16(PAF(2),VFR(6),o[1],0,0,0), C1,4); \
    GAPB(o[0]=__builtin_amdgcn_mfma_f32_32x32x16_bf16(PAF(3),VFR(3),o[0],0,0,0), C1,8); \
    GAPB(o[1]=__builtin_amdgcn_mfma_f32_32x32x16_bf16(PAF(3),VFR(7),o[1],0,0,0), C1,12); \
    }while(0)
  int t=1;
  #undef CMASK
  #define CMASK(P0,P1,t) do{}while(0)
  for(;t+5<NT;t+=2){
    STEP(pB0,pB1,pA0,pA1,t,true,true,true);     WAIT_BAR(2); RESC(); ROT();
    STEP(pA0,pA1,pB0,pB1,t+1,true,true,true);   WAIT_BAR(2); RESC(); ROT();
  }
  #undef CMASK
  #define CMASK(P0,P1,t) do{}while(0)
  #define ENDW(tt) do{ if((tt)+3<NT){WAIT_BAR(2);} else if((tt)+2<NT){WAIT_BAR(1);} else {WAIT_BAR(0);} }while(0)
  for(;t+1<NT;t+=2){
    STEP(pB0,pB1,pA0,pA1,t,(t+3<NT),(t+1<NT),(t+1<NT));       ENDW(t);   RESC(); ROT();
    STEP(pA0,pA1,pB0,pB1,t+1,(t+4<NT),(t+2<NT),(t+2<NT));     ENDW(t+1); RESC(); ROT();
  }
  STEP(pB0,pB1,pA0,pA1,NT-1,false,false,false); RESC();
  { float sacc=pB0[0]+pB0[1]; _Pragma("unroll") for(int r=2;r<16;++r)sacc+=pB0[r]; _Pragma("unroll") for(int r=0;r<16;++r)sacc+=pB1[r]; l_reg+=sacc;
    pw0=(u32x4){PKW(pB0,0),PKW(pB0,2),PKW(pB0,4),PKW(pB0,6)};pw1=(u32x4){PKW(pB0,8),PKW(pB0,10),PKW(pB0,12),PKW(pB0,14)};pw2=(u32x4){PKW(pB1,0),PKW(pB1,2),PKW(pB1,4),PKW(pB1,6)};pw3=(u32x4){PKW(pB1,8),PKW(pB1,10),PKW(pB1,12),PKW(pB1,14)};
    SBAR(); pv(o,vb0+sl_cur,PAF(0),PAF(1),PAF(2),PAF(3)); }
  #undef PKW
  #undef PAF
  #undef VFR
  #undef PIN
  #undef MX3
  #undef GAPA
  #undef GAPB
  #undef EX
  #undef VRD
  #undef KRD
  #undef STEP
  #undef ENDW
  {auto rr=__builtin_amdgcn_permlane32_swap(__float_as_uint(l_reg),__float_as_uint(l_reg),false,false);l_reg=__uint_as_float(rr[0])+__uint_as_float(rr[1]);}
  if(hi==0)wsf[32+r32]=l_reg;asm volatile("s_waitcnt lgkmcnt(0)":::"memory");
  float rli[16];
  #pragma unroll
  for(int r=0;r<16;++r)rli[r]=__builtin_amdgcn_rcpf(wsf[32+crow(r,hi)]);
  bf16*Ow=Ow0+(long)wid*QBLK*OP;
  { bf16*stg=(bf16*)(shm+LDS_OST)+wid*2048;
    #pragma unroll
    for(int r=0;r<16;++r){const int orow=crow(r,hi);
      #pragma unroll
      for(int d0=0;d0<2;++d0)stg[orow*64+d0*32+r32]=__float2bfloat16(o[d0][r]*rli[r]);}
    asm volatile("s_waitcnt lgkmcnt(0)":::"memory");
    #pragma unroll
    for(int i=0;i<4;++i){const int row=i*8+(lane>>3),ch=lane&7; const u32x4 v=*(const u32x4*)(stg+row*64+ch*8); ATTN_STORE16(Ow+(long)row*OP+ch*8,v);} }
  asm volatile("s_waitcnt lgkmcnt(0)\n\ts_barrier":::"memory");
  #undef DMA_K
  #undef DMA_V
  #undef CMASK
  #undef START
  #undef RESC
  #undef ROT
}
__device__ __forceinline__ void pv128(f32x16*o,int vb,bf16x8 pa0,bf16x8 pa1,bf16x8 pa2,bf16x8 pa3){
  #pragma unroll
  for(int d0=0;d0<4;++d0){s16x4 lo[4],hi[4];
    #pragma unroll
    for(int ks=0;ks<4;++ks){
      asm volatile("ds_read_b64_tr_b16 %0,%1 offset:%c2":"=&v"(lo[ks]):"v"(vb),"i"(d0*4096+ks*1024):"memory");
      asm volatile("ds_read_b64_tr_b16 %0,%1 offset:%c2":"=&v"(hi[ks]):"v"(vb),"i"(d0*4096+ks*1024+512):"memory");}
    asm volatile("s_waitcnt lgkmcnt(0)":::"memory");SBAR();
    #define PK(k) (bf16x8){lo[k][0],lo[k][1],lo[k][2],lo[k][3],hi[k][0],hi[k][1],hi[k][2],hi[k][3]}
    o[d0]=__builtin_amdgcn_mfma_f32_32x32x16_bf16(pa0,PK(0),o[d0],0,0,0);
    o[d0]=__builtin_amdgcn_mfma_f32_32x32x16_bf16(pa1,PK(1),o[d0],0,0,0);
    o[d0]=__builtin_amdgcn_mfma_f32_32x32x16_bf16(pa2,PK(2),o[d0],0,0,0);
    o[d0]=__builtin_amdgcn_mfma_f32_32x32x16_bf16(pa3,PK(3),o[d0],0,0,0);
    #undef PK
  }
}
constexpr int V128_V=NSLOT*SLOTB, V128_WS=V128_V+NSLOT*2*SLOTB, V128_Q=V128_WS+NW*64*4, V128_BYTES=V128_Q+NW*4096;
template<int THRL> __device__ __forceinline__ void attn_unit128(const bf16*Qw0,int QP,const bf16*Kh,int KP,const bf16*Vh,int VP,bf16*Ow0,int OP,int NT,char*shm,float kmax2){
  int tid=threadIdx.x; asm volatile("":"+v"(tid));
  const int lane=tid&63,r32=lane&31,hi=lane>>5; const int wid=__builtin_amdgcn_readfirstlane(tid>>6);
  const bf16*Qw=Qw0+(long)wid*QBLK*QP;
  const unsigned lds0=(unsigned)(uintptr_t)shm;
  float*wsf=(float*)(shm+V128_WS)+wid*64;
  const bf16*ksrc=Kh+(long)lane*KP+wid*8;
  const bf16*vsrc=Vh+(long)(16*(wid&3)+(lane>>2))*VP+(wid>>2)*32+(lane&3)*8;
  const unsigned kdst=lds0+LDS_K+wid*1024, vdst=lds0+V128_V+wid*1024;
  #define DMA_K(t,slot) glds16(ksrc+(long)(t)*KVBLK*KP,(unsigned)__builtin_amdgcn_readfirstlane(kdst+(slot)))
  #define DMA_V(t,slot) do{ glds16(vsrc+(long)(t)*KVBLK*VP,(unsigned)__builtin_amdgcn_readfirstlane(vdst+2*(slot))); glds16(vsrc+(long)(t)*KVBLK*VP+64,(unsigned)__builtin_amdgcn_readfirstlane(vdst+2*(slot)+8192)); }while(0)
  const int vb0=(int)(lds0+V128_V)+((lane>>4)&1)*32+(lane&3)*8+(4*hi+((lane&15)>>2))*64;
  const char*Kbase=shm+LDS_K; bf16x8 kf[8];
  const lds_cptr shm3=(lds_cptr)shm; const lds_cptr kp0=shm3+LDS_K+hi*1024+r32*16; const lds_cptr vp0=shm3+V128_V+((lane>>4)&1)*32+(lane&3)*8+(4*hi+((lane&15)>>2))*64;
  DMA_K(0,0);DMA_V(0,0);DMA_K(1,SLOTB);
  bf16x8 qr[4];
  #pragma unroll
  for(int d0=0;d0<4;++d0)qr[d0]=*reinterpret_cast<const bf16x8*>(&Qw[(long)r32*QP+d0*16+hi*8]);
  const lds_cptr qlp=shm3+V128_Q+wid*4096+lane*16;
  { __attribute__((address_space(3))) bf16x8* qw_=(__attribute__((address_space(3))) bf16x8*)(__attribute__((address_space(3))) char*)qlp; qw_[0]=qr[0]; qw_[64]=qr[1]; qw_[128]=qr[2]; qw_[192]=qr[3]; }
  float mhat,l_reg=0.f;
  { float qq=0.f; _Pragma("unroll") for(int d0=0;d0<4;++d0) _Pragma("unroll") for(int j=0;j<8;++j){ const float x=__uint_as_float(((unsigned)(unsigned short)qr[d0][j])<<16); qq+=x*x; }
    qq+=__shfl_xor(qq,32); mhat=fminf(sqrtf(qq*kmax2)*1.01f+1e-20f,96.0f); }
  f32x16 negm; _Pragma("unroll") for(int r=0;r<16;++r)negm[r]=-mhat; asm volatile("":"+v"(negm));
  f32x16 o[4];
  _Pragma("unroll") for(int d_=0;d_<4;++d_){ _Pragma("unroll") for(int r=0;r<16;++r)o[d_][r]=0.f; asm volatile("":"+v"(o[d_])); }
  #define CMASK(P0,P1,t) do{}while(0)
  #define START(P0,P1) do{ _Pragma("unroll") for(int r=0;r<16;++r)P0[r]=__builtin_amdgcn_exp2f(P0[r]); }while(0)
  #define RESC() do{}while(0)
  f32x16 pA0,pA1,pB0,pB1;
  int sl_prev=0,sl_cur=0,sl_next=SLOTB;
  #define ROT() do{sl_prev=sl_cur;sl_cur=sl_next;sl_next=(sl_next==(NSLOT-1)*SLOTB)?0:sl_next+SLOTB;}while(0)
  DMA_K(2,2*SLOTB);
  WAIT_BAR(4);
  qkt(pA0,pA1,Kbase,qr,negm,r32,hi);asm volatile("s_nop 15\n\ts_nop 7":"+v"(pA0),"+v"(pA1));CMASK(pA0,pA1,0);
  START(pA0,pA1);
  _Pragma("unroll") for(int r=0;r<16;++r)pA1[r]=__builtin_amdgcn_exp2f(pA1[r]);
  WAIT_BAR(0);
  DMA_K(3,0);DMA_V(1,SLOTB);
  ROT();
  kload8(kf,kp0+sl_cur);
  WAIT_BAR(3);
  s16x4 vlo[4],vhi[4]; u32x4 pw0,pw1,pw2,pw3;
  #define PKW(P,B) cvtpk_s(P[B],P[B+1])
  #define PAF(k) __builtin_bit_cast(bf16x8,pw##k)
  #define VFR(i) (bf16x8){vlo[i][0],vlo[i][1],vlo[i][2],vlo[i][3],vhi[i][0],vhi[i][1],vhi[i][2],vhi[i][3]}
  #define PIN(x) asm volatile("":"+v"(x))
  #define MX3(a,b,c) __builtin_fmaxf(__builtin_fmaxf((a),(b)),(c))
  #define GAPA(MF,A0,A1,A2,A3,W0,W1,PW) do{ MF; sacc+=A0; sacc+=A1; sacc+=A2; sacc+=A3; PIN(sacc); W0; W1; PIN(PW); SBAR(); }while(0)
  #define EX(v) __builtin_amdgcn_exp2f(v)
  #define GAPB(MF,X,B) do{ MF; X[B]=EX(X[B]); X[B+1]=EX(X[B+1]); X[B+2]=EX(X[B+2]); X[B+3]=EX(X[B+3]); PIN(X); }while(0)
  #define GAPB2(MF,X,B) do{ MF; X[B]=EX(X[B]); X[B+1]=EX(X[B+1]); PIN(X); }while(0)
  #define VRW(e,d0,ks) do{ vlo[e]=vtr(vp_+((d0)*4096+(ks)*1024)); vhi[e]=vtr(vp_+((d0)*4096+(ks)*1024+512)); }while(0)
  #define KRD(G,j) do{ if(G){ kload2(kf,kp0+sl_next,j); SBAR(); } }while(0)
  #define STEP(C0,C1,P0,P1,t,GK,GV,GL) do{ SBAR(); \
    const lds_cptr vp_=vp0+2*sl_prev; \
    const bf16x8 q0_=*(const __attribute__((address_space(3))) bf16x8*)(qlp), q1_=*(const __attribute__((address_space(3))) bf16x8*)(qlp+1024);     \
    float sacc=(P0[0]+P0[1]); \
    GAPA(C0=__builtin_amdgcn_mfma_f32_32x32x16_bf16(kf[0],q0_,negm,0,0,0), P0[2],P0[3],P0[4],P0[5],     pw0[0]=PKW(P0,0), pw0[1]=PKW(P0,2), pw0); \
    GAPA(C1=__builtin_amdgcn_mfma_f32_32x32x16_bf16(kf[1],q0_,negm,0,0,0), P0[6],P0[7],P0[8],P0[9],     pw0[2]=PKW(P0,4), pw0[3]=PKW(P0,6), pw0); \
    const bf16x8 q2_=*(const __attribute__((address_space(3))) bf16x8*)(qlp+2048); SBAR(); \
    GAPA(C0=__builtin_amdgcn_mfma_f32_32x32x16_bf16(kf[2],q1_,C0,0,0,0),   P0[10],P0[11],P0[12],P0[13], pw1[0]=PKW(P0,8), pw1[1]=PKW(P0,10), pw1); \
    GAPA(C1=__builtin_amdgcn_mfma_f32_32x32x16_bf16(kf[3],q1_,C1,0,0,0),   P0[14],P0[15],P1[0],P1[1],   pw1[2]=PKW(P0,12),pw1[3]=PKW(P0,14), pw1); \
    const bf16x8 q3_=*(const __attribute__((address_space(3))) bf16x8*)(qlp+3072); SBAR(); \
    VRW(0,0,0); SBAR(); GAPA(C0=__builtin_amdgcn_mfma_f32_32x32x16_bf16(kf[4],q2_,C0,0,0,0),   P1[2],P1[3],P1[4],P1[5],     pw2[0]=PKW(P1,0), pw2[1]=PKW(P1,2), pw2); \
    VRW(1,1,0); SBAR(); GAPA(C1=__builtin_amdgcn_mfma_f32_32x32x16_bf16(kf[5],q2_,C1,0,0,0),   P1[6],P1[7],P1[8],P1[9],     pw2[2]=PKW(P1,4), pw2[3]=PKW(P1,6), pw2); \
    VRW(2,0,1); SBAR(); GAPA(C0=__builtin_amdgcn_mfma_f32_32x32x16_bf16(kf[6],q3_,C0,0,0,0),   P1[10],P1[11],P1[12],P1[13], pw3[0]=PKW(P1,8), pw3[1]=PKW(P1,10), pw3); \
    VRW(3,1,1); SBAR(); GAPA(C1=__builtin_amdgcn_mfma_f32_32x32x16_bf16(kf[7],q3_,C1,0,0,0),   P1[14],P1[15],0.f,0.f,       pw3[2]=PKW(P1,12),pw3[3]=PKW(P1,14), pw3); \
    l_reg+=sacc; \
    if(GK){DMA_K((t)+3,sl_cur);} if(GV){DMA_V((t)+1,sl_next);} \
      \
    SBAR(); \
    GAPB2(o[0]=__builtin_amdgcn_mfma_f32_32x32x16_bf16(PAF(0),VFR(0),o[0],0,0,0), C0,0); VRW(0,0,2); SBAR(); \
    GAPB2(o[1]=__builtin_amdgcn_mfma_f32_32x32x16_bf16(PAF(0),VFR(1),o[1],0,0,0), C0,2); VRW(1,1,2); SBAR(); \
    KRD(GL,0); GAPB2(o[0]=__builtin_amdgcn_mfma_f32_32x32x16_bf16(PAF(1),VFR(2),o[0],0,0,0), C0,4); VRW(2,0,3); SBAR(); \
    KRD(GL,1); GAPB2(o[1]=__builtin_amdgcn_mfma_f32_32x32x16_bf16(PAF(1),VFR(3),o[1],0,0,0), C0,6); VRW(3,1,3); SBAR(); \
    KRD(GL,2); GAPB2(o[0]=__builtin_amdgcn_mfma_f32_32x32x16_bf16(PAF(2),VFR(0),o[0],0,0,0), C0,8); VRW(0,2,0); SBAR(); \
    KRD(GL,3); GAPB2(o[1]=__builtin_amdgcn_mfma_f32_32x32x16_bf16(PAF(2),VFR(1),o[1],0,0,0), C0,10); VRW(1,3,0); SBAR(); \
    GAPB2(o[0]=__builtin_amdgcn_mfma_f32_32x32x16_bf16(PAF(3),VFR(2),o[0],0,0,0), C0,12); VRW(2,2,1); SBAR(); \
    GAPB2(o[1]=__builtin_amdgcn_mfma_f32_32x32x16_bf16(PAF(3),VFR(3),o[1],0,0,0), C0,14); VRW(3,3,1); SBAR(); \
    GAPB2(o[2]=__builtin_amdgcn_mfma_f32_32x32x16_bf16(PAF(0),VFR(0),o[2],0,0,0), C1,0); VRW(0,2,2); SBAR(); \
    GAPB2(o[3]=__builtin_amdgcn_mfma_f32_32x32x16_bf16(PAF(0),VFR(1),o[3],0,0,0), C1,2); VRW(1,3,2); SBAR(); \
    GAPB2(o[2]=__builtin_amdgcn_mfma_f32_32x32x16_bf16(PAF(1),VFR(2),o[2],0,0,0), C1,4); VRW(2,2,3); SBAR(); \
    GAPB2(o[3]=__builtin_amdgcn_mfma_f32_32x32x16_bf16(PAF(1),VFR(3),o[3],0,0,0), C1,6); VRW(3,3,3); SBAR(); \
    GAPB2(o[2]=__builtin_amdgcn_mfma_f32_32x32x16_bf16(PAF(2),VFR(0),o[2],0,0,0), C1,8); SBAR(); \
    GAPB2(o[3]=__builtin_amdgcn_mfma_f32_32x32x16_bf16(PAF(2),VFR(1),o[3],0,0,0), C1,10); SBAR(); \
    GAPB2(o[2]=__builtin_amdgcn_mfma_f32_32x32x16_bf16(PAF(3),VFR(2),o[2],0,0,0), C1,12); SBAR(); \
    GAPB2(o[3]=__builtin_amdgcn_mfma_f32_32x32x16_bf16(PAF(3),VFR(3),o[3],0,0,0), C1,14);  \
    }while(0)
  int t=1;
  #undef CMASK
  #define CMASK(P0,P1,t) do{}while(0)
  for(;t+5<NT;t+=2){
    STEP(pB0,pB1,pA0,pA1,t,true,true,true);     WAIT_BAR(3); RESC(); ROT();
    STEP(pA0,pA1,pB0,pB1,t+1,true,true,true);   WAIT_BAR(3); RESC(); ROT();
  }
  #undef CMASK
  #define CMASK(P0,P1,t) do{}while(0)
  #define ENDW(tt) do{ if((tt)+3<NT){WAIT_BAR(3);} else if((tt)+2<NT){WAIT_BAR(2);} else {WAIT_BAR(0);} }while(0)
  for(;t+1<NT;t+=2){
    STEP(pB0,pB1,pA0,pA1,t,(t+3<NT),(t+1<NT),(t+1<NT));       ENDW(t);   RESC(); ROT();
    STEP(pA0,pA1,pB0,pB1,t+1,(t+4<NT),(t+2<NT),(t+2<NT));     ENDW(t+1); RESC(); ROT();
  }
  STEP(pB0,pB1,pA0,pA1,NT-1,false,false,false); RESC();
  { float sacc=pB0[0]+pB0[1]; _Pragma("unroll") for(int r=2;r<16;++r)sacc+=pB0[r]; _Pragma("unroll") for(int r=0;r<16;++r)sacc+=pB1[r]; l_reg+=sacc;
    pw0=(u32x4){PKW(pB0,0),PKW(pB0,2),PKW(pB0,4),PKW(pB0,6)};pw1=(u32x4){PKW(pB0,8),PKW(pB0,10),PKW(pB0,12),PKW(pB0,14)};pw2=(u32x4){PKW(pB1,0),PKW(pB1,2),PKW(pB1,4),PKW(pB1,6)};pw3=(u32x4){PKW(pB1,8),PKW(pB1,10),PKW(pB1,12),PKW(pB1,14)};
    SBAR(); pv128(o,vb0+2*sl_cur,PAF(0),PAF(1),PAF(2),PAF(3)); }
  #undef PKW
  #undef PAF
  #undef VFR
  #undef PIN
  #undef MX3
  #undef GAPA
  #undef GAPB
  #undef GAPB2
  #undef EX
  #undef VRW
  #undef KRD
  #undef STEP
  #undef ENDW
  {auto rr=__builtin_amdgcn_permlane32_swap(__float_as_uint(l_reg),__float_as_uint(l_reg),false,false);l_reg=__uint_as_float(rr[0])+__uint_as_float(rr[1]);}
  if(hi==0)wsf[32+r32]=l_reg;asm volatile("s_waitcnt lgkmcnt(0)":::"memory");
  float rli[16];
  #pragma unroll
  for(int r=0;r<16;++r)rli[r]=__builtin_amdgcn_rcpf(wsf[32+crow(r,hi)]);
  bf16*Ow=Ow0+(long)wid*QBLK*OP;
  asm volatile("s_waitcnt lgkmcnt(0)\n\ts_barrier":::"memory");
  { bf16*stg=(bf16*)(shm)+wid*4096;
    #pragma unroll
    for(int r=0;r<16;++r){const int orow=crow(r,hi);
      #pragma unroll
      for(int d0=0;d0<4;++d0)stg[orow*128+d0*32+r32]=__float2bfloat16(o[d0][r]*rli[r]);}
    asm volatile("s_waitcnt lgkmcnt(0)":::"memory");
    #pragma unroll
    for(int i=0;i<8;++i){const int row=i*4+(lane>>4),ch=lane&15; const u32x4 v=*(const u32x4*)(stg+row*128+ch*8); ATTN_STORE16(Ow+(long)row*OP+ch*8,v);} }
  asm volatile("s_waitcnt lgkmcnt(0)\n\ts_barrier":::"memory");
  #undef DMA_K
  #undef DMA_V
  #undef CMASK
  #undef START
  #undef RESC
  #undef ROT
}
constexpr int ATTN_LDS_BYTES=LDS_BYTES;
#undef SBAR
#undef WAIT_BAR
}
#ifndef PROBE_MASK
#define PROBE_MASK 0ull
#endif
#ifndef PROBE_AMP
#define PROBE_AMP 4
#endif

constexpr int NWAVES = 8;
constexpr int DM = 1024, SEQ = 8192, NB = 2, CTXL = 256, NLAT = NB * SEQ, T = NLAT + NB * CTXL  , NKEY = SEQ + CTXL  ;
constexpr int NPXA = 2304, NPXB = 4096, INC = NPXA + NPXB;
constexpr float EPS = 1e-6f;
constexpr size_t MiB = 1u << 20;
constexpr size_t WS_CTL = 0, CTL_ZERO_BYTES = 1 * MiB, WS_MOD = 512 * 1024;
constexpr size_t WS_KMAX = 768 * 1024;
constexpr size_t WS_ROPE = 1 * MiB, WS_LAM = 1 * MiB + 65536;
constexpr size_t WS_WIN = 2 * MiB, WS_WA = 15 * MiB, WS_WB = 16 * MiB, WS_WC = 17 * MiB, WS_WO = 18 * MiB, WS_WQ = 20 * MiB;
constexpr size_t WS_U16 = 22 * MiB, WS_V16 = 54 * MiB;
constexpr size_t WS_SU = WS_U16 + 12 * MiB, WS_SV = WS_V16 + 12 * MiB; constexpr int ROW6 = 768;
constexpr size_t WS_X = 86 * MiB;
constexpr size_t WS_R1 = 152 * MiB;
constexpr size_t WS_R2 = 227 * MiB;
constexpr size_t SZ_QA = (size_t)NB * 4 * 2 * NKEY * 64 * 2, SZ_VA = (size_t)NB * 4 * NKEY * 128 * 2, SZ_QB = (size_t)NB * 8 * NKEY * 64 * 2, SZ_KB = (size_t)NB * 2 * NKEY * 64 * 2;
constexpr size_t WS_QA = WS_R2, WS_KA = WS_QA + SZ_QA, WS_VA = WS_KA + SZ_QA, WS_QB = WS_VA + SZ_VA, WS_KB = WS_QB + SZ_QB, WS_VB = WS_KB + SZ_KB;
constexpr size_t WS_MB = WS_R2, WS_EIDX = WS_R2 + 33 * MiB, WS_GW = WS_EIDX + (size_t)T * 128 * 4;
constexpr size_t WS_R3 = 306 * MiB;
constexpr size_t WS_R4 = 438 * MiB;
constexpr size_t SZ_O = (size_t)T * 512 * 2;
constexpr size_t WS_OABC = WS_R4, WS_HX = WS_R4;
constexpr size_t WS_SSQ = 488 * MiB;
constexpr size_t WS_BQ = 490 * MiB;
constexpr size_t WS_END = 491 * MiB;
static_assert(WS_VB + SZ_KB <= WS_R3 && WS_GW + (size_t)T * 128 * 4 <= WS_R3 && WS_R1 + (size_t)T * NPXA * 2 <= WS_R2 && WS_R3 + (size_t)T * NPXB * 2 <= WS_R4 && WS_OABC + 3 * SZ_O <= WS_END, "d_ws map");
constexpr int CW_TMO = 0, CW_BAR = 4096;
static_assert(CW_BAR * 4 + 3456 * 4 <= WS_MOD && WS_MOD + (size_t)2 * 3 * 6144 * 4 <= WS_KMAX && WS_KMAX + 512 <= CTL_ZERO_BYTES, "control-region map");

constexpr int RING_BYTES = 131072, LDSCTL_OFF = RING_BYTES, MISC_OFF = LDSCTL_OFF + 320, LDS_BYTES = 147456;

struct Args { const float* in[27]; float* out; unsigned char* ws; int ph_lo, ph_hi; };
struct Frame { LAS unsigned char* lds; volatile LAS unsigned* MISC; gu32* ctl; int tid, lane, wave, G, bid; };

typedef float f32x16 __attribute__((ext_vector_type(16)));
typedef short s16x4 __attribute__((ext_vector_type(4)));
typedef unsigned u32x2 __attribute__((ext_vector_type(2)));
typedef float f32x2 __attribute__((ext_vector_type(2)));
typedef float v32f __attribute__((ext_vector_type(32))); typedef __bf16 v32bf __attribute__((ext_vector_type(32))); typedef unsigned v6u __attribute__((ext_vector_type(6))); typedef unsigned v3u __attribute__((ext_vector_type(3)));
__device__ __forceinline__ float bf2f(unsigned short b) { return __uint_as_float((unsigned)b << 16); }
__device__ __forceinline__ float bflo(unsigned w) { return __uint_as_float(w << 16); }
__device__ __forceinline__ float bfhi(unsigned w) { return __uint_as_float(w & 0xffff0000u); }
__device__ __forceinline__ float sigm(float x) { return __builtin_amdgcn_rcpf(1.0f + __expf(-x)); }
__device__ __forceinline__ int mod_index(int row) { return row < SEQ ? 0 : (row < NLAT ? 1 : 2); }
__device__ __forceinline__ void row_to_bn(int row, int& b, int& nd) { if (row < NLAT) { b = row >> 13; nd = row & (SEQ - 1); } else { const int r = row - NLAT; b = r >> 8; nd = SEQ + (r & 255); } }

__device__ __forceinline__ void ph_prep0(const Args& a, Frame& F) {
    const int gtid = (F.G - 1 - F.bid) * 512 + F.tid;
    if (gtid < 2048) {
        const int pos = gtid >> 4, i = gtid & 15;
        double inv = 1.0; for (int k = 0; k < i; ++k) inv *= 0.5623413251903491;
        const double x = (double)pos * inv, TWO_PI = 6.283185307179586476925;
        const double kk = rint(x / TWO_PI), y = x - kk * TWO_PI, y2 = y * y;
        double ts = 1.0, tc = 1.0;
        for (int n = 14; n >= 1; --n) { ts = 1.0 - ts * y2 / (double)((2 * n) * (2 * n + 1)); tc = 1.0 - tc * y2 / (double)((2 * n - 1) * (2 * n)); }
        float* rp = (float*)(a.ws + WS_ROPE) + gtid * 2; rp[0] = (float)tc; rp[1] = (float)(y * ts);
    }
    if (gtid >= 2048 && gtid < 2050) {
        const int l = gtid - 2048; float s1 = 0.f, s2 = 0.f;
        for (int d = 0; d < 64; ++d) { s1 += a.in[7][l * 64 + d] * a.in[8][l * 64 + d]; s2 += a.in[9][l * 64 + d] * a.in[10][l * 64 + d]; }
        const float lam_init = l == 0 ? 0.2f : 0.35550906759096926f;
        float* lp = (float*)(a.ws + WS_LAM); lp[l * 2] = expf(s1) - expf(s2) + lam_init; lp[l * 2 + 1] = 1.0f - lam_init;
    }
    if (F.bid < 192) {
        float* MOD = (float*)(a.ws + WS_MOD); LAS float* sc = (LAS float*)F.lds; LAS float* red = sc + 3072;
        for (int i = F.tid; i < 3072; i += 512) { const int k = i & 1023; const float c = i < 1024 ? a.in[1][k] : (i < 2048 ? a.in[1][1024 + k] : a.in[3][k]); sc[i] = c * sigm(c); }
        __syncthreads();
        for (int u = F.bid; u < 192; u += F.G) {
            const int l = u / 96, cc = u % 96, kg = F.tid >> 4, c4 = F.tid & 15;
            const f32x4* W = (const f32x4*)(a.in[4] + (size_t)l * 1024 * 6144 + (size_t)(kg * 32) * 6144 + cc * 64 + 4 * c4);
            f32x4 s0 = {0.f, 0.f, 0.f, 0.f}, s1 = s0, s2 = s0;
#pragma unroll
            for (int h = 0; h < 2; ++h) { f32x4 w[16];
#pragma unroll
                for (int kk = 0; kk < 16; ++kk) w[kk] = W[(size_t)(h * 16 + kk) * (6144 / 4)];
#pragma unroll
                for (int kk = 0; kk < 16; ++kk) { const int k = kg * 32 + h * 16 + kk; s0 += sc[k] * w[kk]; s1 += sc[1024 + k] * w[kk]; s2 += sc[2048 + k] * w[kk]; } }
            *(LAS f32x4*)(red + (kg * 3 + 0) * 64 + 4 * c4) = s0; *(LAS f32x4*)(red + (kg * 3 + 1) * 64 + 4 * c4) = s1; *(LAS f32x4*)(red + (kg * 3 + 2) * 64 + 4 * c4) = s2;
            __syncthreads();
            if (F.tid < 192) { const int mi = F.tid >> 6, c = F.tid & 63; float s = a.in[5][l * 6144 + cc * 64 + c];
                for (int g = 0; g < 32; ++g) s += red[(g * 3 + mi) * 64 + c];
                MOD[(l * 3 + mi) * 6144 + cc * 64 + c] = s; }
            __syncthreads();
        }
    }
}
__device__ __forceinline__ void ph_convw(const Args& a, Frame& F, int l) {
    LAS float* scr = (LAS float*)(F.lds + F.wave * 16384);
    const int gw = F.bid * NWAVES + F.wave, NGW = F.G * NWAVES;
    constexpr int I_IN = 16 * 200, I_BR = 8 * 32, I_O = 16 * 32, NITEMS = I_IN + 3 * I_BR + 2 * I_O;
    for (int it = gw; it < NITEMS; it += NGW) {
        int r = it;
        if (r < I_IN) { p0_transpose_item(a.in[6] + (size_t)l * 1024 * INC, 1024, INC, (bf16*)(a.ws + WS_WIN), 0, scr, r, F.lane); continue; } r -= I_IN;
        if (r < I_BR) { p0_transpose_item_p(a.in[18] + (size_t)l * 512 * 1024, 512, 1024, (bf16*)(a.ws + WS_WA), 1536, 0, scr, r, F.lane); continue; } r -= I_BR;
        if (r < I_BR) { p0_transpose_item_p(a.in[19] + (size_t)l * 512 * 1024, 512, 1024, (bf16*)(a.ws + WS_WA), 1536, 512, scr, r, F.lane); continue; } r -= I_BR;
        if (r < I_BR) { p0_transpose_item_p(a.in[20] + (size_t)l * 512 * 1024, 512, 1024, (bf16*)(a.ws + WS_WA), 1536, 1024, scr, r, F.lane); continue; } r -= I_BR;
        if (r < I_O) { p0_transpose_item(a.in[21] + (size_t)l * 1024 * 1024, 1024, 1024, (bf16*)(a.ws + WS_WO), 0, scr, r, F.lane); continue; } r -= I_O;
        p0_transpose_item(a.in[22] + (size_t)l * 1024 * 1024, 1024, 1024, (bf16*)(a.ws + WS_WQ), 0, scr, r, F.lane);
    }
    const int gtid = F.bid * 512 + F.tid, NT = F.G * 512; constexpr int NI = 2 * 16384 * 32, NIH = 16384 * 32;
    const f32x4* us = (const f32x4*)(a.in[24] + (size_t)l * 16384 * 1024); const f32x4* vs = (const f32x4*)(a.in[25] + (size_t)l * 16384 * 1024);
    for (int i0 = gtid; i0 < NI; i0 += 2 * NT) { f32x4 p_[2][8];
#pragma unroll
        for (int u_ = 0; u_ < 2; ++u_) { const int i = min(i0 + u_ * NT, NI - 1); const bool isv = i >= NIH; const int j = isv ? i - NIH : i; const f32x4* sp = (isv ? vs : us) + 8 * (size_t)j;
#pragma unroll
            for (int q = 0; q < 8; ++q) p_[u_][q] = sp[q]; }
#pragma unroll
        for (int u_ = 0; u_ < 2; ++u_) { const int i = min(i0 + u_ * NT, NI - 1); const bool isv = i >= NIH; const int j = isv ? i - NIH : i;
            float m = 0.f;
#pragma unroll
            for (int q = 0; q < 8; ++q) m = fmaxf(fmaxf(m, fmaxf(fabsf(p_[u_][q][0]), fabsf(p_[u_][q][1]))), fmaxf(fabsf(p_[u_][q][2]), fabsf(p_[u_][q][3])));
#pragma unroll
            for (int o = 16; o >= 1; o >>= 1) m = fmaxf(m, __shfl_xor(m, o));
            const float sc = m > 0.f ? 7.5f * __builtin_amdgcn_rcpf(m) : 1.0f, inv = m > 0.f ? m * (1.0f / 7.5f) : 1.0f;
            v32bf bv;
#pragma unroll
            for (int q = 0; q < 8; ++q) { bv[4 * q] = (__bf16)(p_[u_][q][0] * sc); bv[4 * q + 1] = (__bf16)(p_[u_][q][1] * sc); bv[4 * q + 2] = (__bf16)(p_[u_][q][2] * sc); bv[4 * q + 3] = (__bf16)(p_[u_][q][3] * sc); }
            const v6u o = __builtin_amdgcn_cvt_scalef32_pk32_fp6_bf16(bv, 1.0f);
            if (i0 + u_ * NT < NI) { unsigned char* dp = a.ws + (isv ? WS_V16 : WS_U16) + (size_t)(j >> 5) * ROW6 + 24 * (j & 31);
                *(u32x2*)dp = (u32x2){o[0], o[1]}; *(u32x2*)(dp + 8) = (u32x2){o[2], o[3]}; *(u32x2*)(dp + 16) = (u32x2){o[4], o[5]};
                if ((j & 31) == 0) ((float*)(a.ws + (isv ? WS_SV : WS_SU)))[j >> 5] = inv; } } }
}
__device__ __forceinline__ void ph_mod(const Args& a, Frame& F, int l, int which) {
    const float* MOD = (const float*)(a.ws + WS_MOD) + (size_t)l * 3 * 6144 + (which ? 3072 : 0);
    const bool from_in = (l == 0 && which == 0);
    const float* X = from_in ? a.in[0] : (const float*)(a.ws + WS_X); const float* XC = from_in ? a.in[2] - (size_t)NLAT * DM : X; bf16* HX = (bf16*)(a.ws + WS_HX);
    const int gw = F.bid * NWAVES + F.wave, NGW = F.G * NWAVES; const int TL = (l == 1 && which == 1) ? NLAT : T;
    for (int row0 = gw; row0 < TL; row0 += 2 * NGW) {
        f32x4 v[2][4]; float ss[2];
#pragma unroll
        for (int u_ = 0; u_ < 2; ++u_) { const int row = min(row0 + u_ * NGW, TL - 1); const f32x4* xr = (const f32x4*)((row < NLAT ? X : XC) + (size_t)row * DM) + F.lane; ss[u_] = 0.f;
#pragma unroll
            for (int j = 0; j < 4; ++j) v[u_][j] = xr[64 * j]; }
#pragma unroll
        for (int u_ = 0; u_ < 2; ++u_) {
#pragma unroll
            for (int j = 0; j < 4; ++j) ss[u_] += (v[u_][j][0] * v[u_][j][0] + v[u_][j][1] * v[u_][j][1]) + (v[u_][j][2] * v[u_][j][2] + v[u_][j][3] * v[u_][j][3]); }
#pragma unroll
        for (int u_ = 0; u_ < 2; ++u_) { const int row = row0 + u_ * NGW; if (row < TL) {
            const float* sh = MOD + mod_index(row) * 6144; const float* sc = sh + 1024;
            const float rstd = rsqrtf(wave_sum(ss[u_]) * (1.0f / DM) + EPS);
#pragma unroll
            for (int j = 0; j < 4; ++j) { const int c = 4 * F.lane + 256 * j; const f32x4 s1 = *(const f32x4*)(sc + c), s0 = *(const f32x4*)(sh + c);
                const f32x4 h = v[u_][j] * rstd * (s1 + 1.0f) + s0; u32x2 o; o.x = pk2(h[0], h[1]); o.y = pk2(h[2], h[3]); *(u32x2*)(HX + (size_t)row * DM + c) = o; } } }
    }
}
__device__ __forceinline__ void ph_post(const Args& a, Frame& F, int l) {
    const bf16* PXa = (const bf16*)(a.ws + WS_R1); const float* rope = (const float*)(a.ws + WS_ROPE);
    const int gw = F.bid * NWAVES + F.wave, NGW = F.G * NWAVES, lane = F.lane;
    float km0_ = 0.f, km1_ = 0.f;
    {
        const int c = lane & 7, g8 = lane >> 3;
        float qw[8], kw[8];
#pragma unroll
        for (int j = 0; j < 8; ++j) { qw[j] = a.in[12][l * 64 + 8 * c + j]; kw[j] = a.in[13][l * 64 + 8 * c + j]; }
        float& km0 = km0_; float& km1 = km1_;
        for (int row = gw; row < T; row += NGW) {
            int b, nd; row_to_bn(row, b, nd);
            const bool lat = row < NLAT; const int pos = (c & 4) ? (nd & 63) : ((nd >> 6) & 127);
            float cs[8], sn[8];
            { const f32x4* rp = (const f32x4*)(rope + (pos * 16 + 8 * (c & 1)) * 2);
              const f32x4 r0 = rp[0], r1 = rp[1], r2 = rp[2], r3 = rp[3];
              cs[0] = r0[0]; sn[0] = r0[1]; cs[1] = r0[2]; sn[1] = r0[3]; cs[2] = r1[0]; sn[2] = r1[1]; cs[3] = r1[2]; sn[3] = r1[3];
              cs[4] = r2[0]; sn[4] = r2[1]; cs[5] = r2[2]; sn[5] = r2[3]; cs[6] = r3[0]; sn[6] = r3[1]; cs[7] = r3[2]; sn[7] = r3[3]; }
            const bf16* pr = PXa + (size_t)row * NPXA;
            v4u wv[5];
#pragma unroll
            for (int it = 0; it < 5; ++it) { const int hv = min(8 * it + g8, 35); wv[it] = *(const v4u*)(pr + hv * 64 + 8 * c); }
#pragma unroll
            for (int it = 0; it < 5; ++it) {
                const int hv = 8 * it + g8;
                float x[8]; x[0] = bflo(wv[it].x); x[1] = bfhi(wv[it].x); x[2] = bflo(wv[it].y); x[3] = bfhi(wv[it].y); x[4] = bflo(wv[it].z); x[5] = bfhi(wv[it].z); x[6] = bflo(wv[it].w); x[7] = bfhi(wv[it].w);
                const bool is_v = (hv >= 8 && hv < 16) || hv == 18 || hv == 19;
                const bool nrm = (hv == 16 || hv == 17 || hv >= 28);
                float ss = 0.f;
#pragma unroll
                for (int j = 0; j < 8; ++j) ss += x[j] * x[j];
                ss += __shfl_xor(ss, 1); ss += __shfl_xor(ss, 2); ss += __shfl_xor(ss, 4);
                const float rs = rsqrtf(ss * (1.0f / 64.0f) + EPS);
                if (it == 0) { if (b == 0) km0 = fmaxf(km0, ss); else km1 = fmaxf(km1, ss); }
                const float qs = hv >= 20 ? 0.18033688011112042f : 1.0f;
#pragma unroll
                for (int j = 0; j < 8; ++j) { if (nrm) x[j] *= rs * (hv >= 28 ? qw[j] : kw[j]); }
                const bool rot = lat && !is_v;
#pragma unroll
                for (int j = 0; j < 8; ++j) { const float p = __shfl_xor(x[j], 2); const float r = x[j] * cs[j] + ((c & 2) ? p : -p) * sn[j]; x[j] = (rot ? r : x[j]) * qs; }
                v4u o; o.x = pk2(x[0], x[1]); o.y = pk2(x[2], x[3]); o.z = pk2(x[4], x[5]); o.w = pk2(x[6], x[7]);
                unsigned off;
                if (hv < 8) off = (unsigned)WS_KA + (((unsigned)(b * 8 + hv) * NKEY + nd) * 64 + 8 * c) * 2;
                else if (hv < 16) off = (unsigned)WS_VA + (((unsigned)(b * 4 + ((hv - 8) >> 1)) * NKEY + nd) * 128 + ((hv - 8) & 1) * 64 + 8 * c) * 2;
                else if (hv < 18) off = (unsigned)WS_KB + (((unsigned)(b * 2 + (hv - 16)) * NKEY + nd) * 64 + 8 * c) * 2;
                else if (hv < 20) off = (unsigned)WS_VB + (((unsigned)(b * 2 + (hv - 18)) * NKEY + nd) * 64 + 8 * c) * 2;
                else if (hv < 28) off = (unsigned)WS_QA + (((unsigned)(b * 8 + (hv - 20)) * NKEY + nd) * 64 + 8 * c) * 2;
                else off = (unsigned)WS_QB + (((unsigned)(b * 8 + (hv - 28)) * NKEY + nd) * 64 + 8 * c) * 2;
                if (hv < 36) *(v4u*)(a.ws + off) = o;
            }
        }
    }
    { LAS float* KM = (LAS float*)(F.lds + 70656);
      if ((lane & 7) == 0) { KM[(F.wave * 2 + 0) * 8 + (lane >> 3)] = km0_; KM[(F.wave * 2 + 1) * 8 + (lane >> 3)] = km1_; }
      __syncthreads();
      int t_ = F.tid; asm volatile("" : "+v"(t_));
      if (t_ < 16) { float m = 0.f;
#pragma unroll
          for (int w_ = 0; w_ < 8; ++w_) m = fmaxf(m, KM[w_ * 16 + t_]);
          atomicMax((unsigned*)(a.ws + WS_KMAX) + l * 64 + t_, __float_as_uint(m)); } }
    const bf16* PXb = (const bf16*)(a.ws + WS_R3); bf16* OC = (bf16*)(a.ws + WS_OABC) + 1024;
    LAS unsigned short* UL = (LAS unsigned short*)F.lds;
    LAS float* RED = (LAS float*)(F.lds + 65536);
    LAS float* STAT = (LAS float*)(F.lds + 68608);
    LAS float* MSK = (LAS float*)(F.lds + 69632);
    constexpr int TT = 33;
    const int c = F.tid;
    float w[31];
#pragma unroll
    for (int k = 0; k < 31; ++k) w[k] = a.in[14][(size_t)l * 31 * 512 + k * 512 + c];
    int vz; asm volatile("v_mov_b32 %0, 0" : "=v"(vz));
    const float cb = a.in[15][l * 512 + c], lnw = a.in[16][l * 512 + c], lnb = a.in[17][l * 512 + c];
    for (int ct = F.bid; ct < (l == 0 ? T / TT : (NLAT + TT - 1) / TT); ct += F.G) {
        const int t0 = ct * TT;
        int bnd = -1; { const int lo_ = t0 - 15, hi_ = t0 + TT + 15; if (lo_ < 0) bnd = 0; else if (SEQ > lo_ && SEQ < hi_) bnd = SEQ; else if (NLAT > lo_ && NLAT < hi_) bnd = NLAT; else if (NLAT + CTXL > lo_ && NLAT + CTXL < hi_) bnd = NLAT + CTXL; else if (hi_ > T) bnd = T; }
        if (F.tid < 128) { const int p = F.tid >> 6, i = F.tid & 63; const int r = t0 - 15 + i;
            MSK[p * 64 + i] = (i < TT + 30 && r >= 0 && r < T && (bnd < 0 || ((r < bnd) == (p == 0)))) ? 1.f : 0.f;
            MSK[128 + p * 64 + i] = (i < TT && (bnd < 0 ? p == 0 : (((t0 + i) < bnd) == (p == 0)))) ? 1.f : 0.f; }
        __syncthreads();
        float y[TT];
#pragma unroll
        for (int n = 0; n < TT; ++n) y[n] = 0.f;
        const int npass = bnd < 0 ? 1 : 2;
        for (int pass = 0; pass < npass; ++pass) {
            __syncthreads();
            { v4u ga_[8], gg_[8];
#pragma unroll
              for (int q = 0; q < 8; ++q) { const int it = min(F.tid + 512 * q, (TT + 30) * 64 - 1); const int i = it >> 6, j8 = (it & 63) * 8; const int r = min(max(t0 - 15 + i, 0), T - 1);
                  ga_[q] = *(const v4u*)(PXb + (size_t)r * NPXB + j8); gg_[q] = *(const v4u*)(PXb + (size_t)r * NPXB + 512 + j8); }
#pragma unroll
              for (int q = 0; q < 8; ++q) { const int it = F.tid + 512 * q; if (it < (TT + 30) * 64) { const int i = it >> 6, j8 = (it & 63) * 8; const float mk = MSK[pass * 64 + i];
                  v4u o;
#pragma unroll
                  for (int e = 0; e < 4; ++e) { const float u0 = bflo(ga_[q][e]) * sigm(bflo(gg_[q][e])) * mk, u1 = bfhi(ga_[q][e]) * sigm(bfhi(gg_[q][e])) * mk; o[e] = pk2(u0, u1); }
                  *(LAS v4u*)(UL + i * 512 + j8) = o; } }
            }
            __syncthreads();
            float u[TT + 30];
#pragma unroll
            for (int i = 0; i < TT + 30; ++i) u[i] = bf2f(UL[i * 512 + c]);
#pragma unroll
            for (int n = 0; n < TT; ++n) { float acc = cb;
#pragma unroll
                for (int k = 0; k < 31; ++k) acc += w[k] * u[n + k];
                y[n] += acc * MSK[128 + pass * 64 + n + vz]; if ((n & 3) == 3) __builtin_amdgcn_sched_barrier(0); }
        }
#pragma unroll
        for (int n = 0; n < TT; ++n) { float s1 = y[n], s2 = y[n] * y[n];
#pragma unroll
            for (int o = 32; o >= 1; o >>= 1) { s1 += __shfl_xor(s1, o); s2 += __shfl_xor(s2, o); }
            if (lane == 0) { RED[(F.wave * TT + n) * 2] = s1; RED[(F.wave * TT + n) * 2 + 1] = s2; } }
        __syncthreads();
        if (F.tid < TT) { const int n = F.tid; float s1 = 0.f, s2 = 0.f;
#pragma unroll
            for (int wv_ = 0; wv_ < 8; ++wv_) { s1 += RED[(wv_ * TT + n) * 2]; s2 += RED[(wv_ * TT + n) * 2 + 1]; }
            const float mu = s1 * (1.0f / 512.0f), var = fmaxf(s2 * (1.0f / 512.0f) - mu * mu, 0.f);
            STAT[2 * n] = mu; STAT[2 * n + 1] = rsqrtf(var + EPS); }
        __syncthreads();
#pragma unroll
        for (int n = 0; n < TT; ++n) {
            if ((n & 7) == 7) __builtin_amdgcn_sched_barrier(0);
            const float yn = (y[n] - STAT[2 * n + vz]) * STAT[2 * n + 1 + vz] * lnw + lnb;
            OC[(size_t)(t0 + n) * 1536 + c] = (unsigned short)f2bf(yn * sigm(yn)); }
        __syncthreads();
    }
}
__device__ __forceinline__ void ph_attn(const Args& a, Frame& F, int l, char* shm) {
    typedef attn_body::bf16 abf;
    const int xcd = F.bid & 7, idx = F.bid >> 3;
    const int nA = (F.G == 256) ? 2 + ((l == 0 && F.bid < 16) ? 1 : 0) : 0;
    for (int j = 0; j < nA; ++j) {
        const int st = j < 2 ? 2 * xcd + j : F.bid, qb = j < 2 ? idx : 32;
        const int kt0 = qb == 32 ? 128 : 0, NT = qb == 32 ? 4 : 132;
        const abf* Qp = (const abf*)(a.ws + WS_QA) + ((size_t)st * NKEY + qb * 256) * 64; const abf* Kp = (const abf*)(a.ws + WS_KA) + ((size_t)st * NKEY + kt0 * 64) * 64;
        const abf* Vp = (const abf*)(a.ws + WS_VA) + ((size_t)(st >> 1) * NKEY + kt0 * 64) * 128;
        abf* Op = (abf*)(a.ws + WS_R1) + ((size_t)st * NKEY + qb * 256) * 128;
        attn_body::attn_unit128<8>(Qp, 64, Kp, 64, Vp, 128, Op, 128, NT, shm, __uint_as_float(__hip_atomic_load((unsigned*)(a.ws + WS_KMAX) + l * 64 + st, __ATOMIC_RELAXED, __HIP_MEMORY_SCOPE_AGENT)));
    }
    float mq = 0.f, mk = 0.f; for (int d = 0; d < 64; ++d) { mq = fmaxf(mq, fabsf(a.in[12][l * 64 + d])); mk = fmaxf(mk, fabsf(a.in[13][l * 64 + d])); }
    const float mrefB = 64.0f * mq * mk * 0.18033688011112042f * 1.02f;
    const int nB = (F.G == 256) ? 2 + ((l == 0 && F.bid >= 16 && F.bid < 32) ? 1 : 0) : 0;
    for (int j = 0; j < nB; ++j) {
        const int st = j < 2 ? 2 * xcd + j : F.bid - 16, qb = j < 2 ? idx : 32;
        const int kt0 = qb == 32 ? 128 : 0, NT = qb == 32 ? 4 : 132;
        const int b = st >> 3, qh = st & 7, kvh = b * 2 + (qh >> 2);
        const abf* Qp = (const abf*)(a.ws + WS_QB) + ((size_t)st * NKEY + qb * 256) * 64; const abf* Kp = (const abf*)(a.ws + WS_KB) + ((size_t)kvh * NKEY + kt0 * 64) * 64;
        const abf* Vp = (const abf*)(a.ws + WS_VB) + ((size_t)kvh * NKEY + kt0 * 64) * 64;
        const int trow = qb == 32 ? NLAT + b * CTXL : b * SEQ + qb * 256;
        abf* Op = (abf*)(a.ws + WS_OABC) + (size_t)trow * 1536 + 512 + qh * 64;
        attn_body::attn_unit<8>(Qp, 64, Kp, 64, Vp, 64, Op, 1536, NT, shm, mrefB);
    }
}
__device__ __forceinline__ void ph_comb(const Args& a, Frame& F, int l) {
    const bf16* OA2 = (const bf16*)(a.ws + WS_R1); bf16* OA = (bf16*)(a.ws + WS_OABC);
    const float lam = ((const float*)(a.ws + WS_LAM))[l * 2], oml = ((const float*)(a.ws + WS_LAM))[l * 2 + 1];
    const int gw = F.bid * NWAVES + F.wave, NGW = F.G * NWAVES, lane = F.lane;
    const float w0 = a.in[11][l * 128 + 2 * lane] * oml, w1 = a.in[11][l * 128 + 2 * lane + 1] * oml;
    const int NIT = (l == 0 ? T : NLAT) * 4;
    for (int it0 = gw; it0 < NIT; it0 += 4 * NGW) {
        unsigned p1[4], p2[4]; int rowv[4], hv_[4];
#pragma unroll
        for (int j = 0; j < 4; ++j) { const int it = min(it0 + j * NGW, NIT - 1); const int row = it >> 2, h = it & 3; int b, nd; row_to_bn(row, b, nd); rowv[j] = row; hv_[j] = h;
            p1[j] = *(const unsigned*)(OA2 + ((size_t)((b * 4 + h) * 2 + 0) * NKEY + nd) * 128 + 2 * lane); p2[j] = *(const unsigned*)(OA2 + ((size_t)((b * 4 + h) * 2 + 1) * NKEY + nd) * 128 + 2 * lane); }
#pragma unroll
        for (int j = 0; j < 4; ++j) { if (it0 + j * NGW < NIT) {
            const float x0 = bflo(p1[j]) - lam * bflo(p2[j]), x1 = bfhi(p1[j]) - lam * bfhi(p2[j]);
            const float rstd = rsqrtf(wave_sum(x0 * x0 + x1 * x1) * (1.0f / 128.0f) + EPS);
            *(unsigned*)(OA + (size_t)rowv[j] * 1536 + hv_[j] * 128 + 2 * lane) = pk2(x0 * rstd * w0, x1 * rstd * w1); } }
    }
}
__constant__ unsigned char PK_CAND[50] = {0,1,2,3,4,5,6,7,8,9,10,11,12,13,14,15, 16,17,18,19,20,21,22,23, 32,33,34,35,36, 48,49,50,51, 64,65,66, 80,81, 96,97, 112,113, 128, 144, 160, 176, 192, 208, 224, 240};
__device__ __forceinline__ void ce_desc(float& x, float& y) { float hi_, lo_; asm("v_max_f32_e32 %0, %1, %2" : "=v"(hi_) : "v"(x), "v"(y)); asm("v_min_f32_e32 %0, %1, %2" : "=v"(lo_) : "v"(x), "v"(y)); x = hi_; y = lo_; }
__device__ __forceinline__ void sort16_desc(float (&v)[16]) {
#pragma unroll
    for (int k = 2; k <= 16; k <<= 1)
#pragma unroll
        for (int j = k >> 1; j > 0; j >>= 1)
#pragma unroll
            for (int i = 0; i < 16; ++i) { const int p = i ^ j; if (p > i) { if ((i & k) == 0) ce_desc(v[i], v[p]); else ce_desc(v[p], v[i]); } }
}
__device__ __forceinline__ void merge16_desc(float (&t)[16], const float (&v)[16]) {
#pragma unroll
    for (int i = 0; i < 16; ++i) { float m; asm("v_max_f32_e32 %0, %1, %2" : "=v"(m) : "v"(t[i]), "v"(v[15 - i])); t[i] = m; }
#pragma unroll
    for (int j = 8; j > 0; j >>= 1)
#pragma unroll
        for (int i = 0; i < 16; ++i) { const int p = i ^ j; if (p > i) ce_desc(t[i], t[p]); }
}
__device__ __forceinline__ void ph_topk(const Args& a, Frame& F, int l) {
    const float* PQ = (const float*)(a.ws + WS_R1); int* EIDX = (int*)(a.ws + WS_EIDX); float* GW = (float*)(a.ws + WS_GW);
    LAS unsigned char* KH = F.lds; LAS unsigned char* KLo = F.lds + 32768;
    LAS unsigned* XV = (LAS unsigned*)(F.lds + 65536);
    const int tid = F.tid, lane = F.lane, wave = F.wave;
    int cur_h = -1;
    for (int u = F.bid; u < ((l == 0 ? T : NLAT) / 256) * 8; u += F.G) {
        const int h = u & 7, t0 = (u >> 3) * 256;
        if (h != cur_h) { __syncthreads(); const float* ks = a.in[23] + ((size_t)l * 8 + h) * 2 * 128 * 64;
#pragma unroll
            for (int i = 0; i < 4; ++i) { const int ch = tid + 512 * i, krow = ch >> 3, c8 = ch & 7;
                const f32x4 x0 = *(const f32x4*)(ks + (size_t)krow * 64 + c8 * 8), x1 = *(const f32x4*)(ks + (size_t)krow * 64 + c8 * 8 + 4);
                float xs[8] = {x0[0], x0[1], x0[2], x0[3], x1[0], x1[1], x1[2], x1[3]}; unsigned hw[8], lw[8];
#pragma unroll
                for (int j = 0; j < 8; ++j) { hw[j] = f2bf(xs[j]); lw[j] = f2bf(xs[j] - __uint_as_float(hw[j] << 16)); }
                const int off = krow * 128 + ((c8 * 16) ^ ((krow & 7) << 4));
                *(LAS v4u*)(KH + off) = (v4u){hw[0] | (hw[1] << 16), hw[2] | (hw[3] << 16), hw[4] | (hw[5] << 16), hw[6] | (hw[7] << 16)};
                *(LAS v4u*)(KLo + off) = (v4u){lw[0] | (lw[1] << 16), lw[2] | (lw[3] << 16), lw[4] | (lw[5] << 16), lw[6] | (lw[7] << 16)}; }
            cur_h = h; __syncthreads(); }
        {
            const int r32 = lane & 31, hp = lane >> 5; const float* qp = PQ + (size_t)(t0 + 32 * wave + r32) * 1024 + h * 128 + hp * 8;
#pragma unroll
            for (int half = 0; half < 2; ++half) {
                bf16x8 bqh[4], bql[4];
#pragma unroll
                for (int ks = 0; ks < 4; ++ks) { const f32x4 x0 = *(const f32x4*)(qp + half * 64 + ks * 16), x1 = *(const f32x4*)(qp + half * 64 + ks * 16 + 4);
                    float xs[8] = {x0[0], x0[1], x0[2], x0[3], x1[0], x1[1], x1[2], x1[3]}; unsigned hw[8], lw[8];
#pragma unroll
                    for (int j = 0; j < 8; ++j) { hw[j] = f2bf(xs[j]); lw[j] = f2bf(xs[j] - __uint_as_float(hw[j] << 16)); }
                    bqh[ks] = __builtin_bit_cast(bf16x8, (v4u){hw[0] | (hw[1] << 16), hw[2] | (hw[3] << 16), hw[4] | (hw[5] << 16), hw[6] | (hw[7] << 16)});
                    bql[ks] = __builtin_bit_cast(bf16x8, (v4u){lw[0] | (lw[1] << 16), lw[2] | (lw[3] << 16), lw[4] | (lw[5] << 16), lw[6] | (lw[7] << 16)}); }
                float tv[16];
#pragma unroll
                for (int kt = 0; kt < 4; ++kt) {
                    f32x16 acc;
#pragma unroll
                    for (int r = 0; r < 16; ++r) acc[r] = 0.f;
                    const int krow = half * 128 + kt * 32 + r32;
#pragma unroll
                    for (int ks = 0; ks < 4; ++ks) { const int off = krow * 128 + ((32 * ks + 16 * hp) ^ ((krow & 7) << 4));
                        const bf16x8 ah = *(const LAS bf16x8*)(KH + off), al = *(const LAS bf16x8*)(KLo + off);
                        acc = __builtin_amdgcn_mfma_f32_32x32x16_bf16(ah, bqh[ks], acc, 0, 0, 0);
                        acc = __builtin_amdgcn_mfma_f32_32x32x16_bf16(al, bqh[ks], acc, 0, 0, 0);
                        acc = __builtin_amdgcn_mfma_f32_32x32x16_bf16(ah, bql[ks], acc, 0, 0, 0); }
                    float v[16];
#pragma unroll
                    for (int r = 0; r < 16; ++r) { const unsigned key = (unsigned)(32 * kt + (r & 3) + 8 * (r >> 2)) | (unsigned)(4 * hp); v[r] = __uint_as_float((__float_as_uint(acc[r]) & 0xffffff80u) | (127u - key)); }
                    sort16_desc(v);
                    if (kt == 0) {
#pragma unroll
                        for (int r = 0; r < 16; ++r) tv[r] = v[r]; }
                    else merge16_desc(tv, v);
                }
                float pv[16];
#pragma unroll
                for (int r = 0; r < 16; ++r) pv[r] = __shfl_xor(tv[r], 32);
                merge16_desc(tv, pv);
                if (hp == 0) { LAS unsigned* xo = XV + ((32 * wave + r32) * 2 + half) * 16;
#pragma unroll
                    for (int j = 0; j < 16; j += 4) *(LAS v4u*)(xo + j) = (v4u){__float_as_uint(tv[j]), __float_as_uint(tv[j + 1]), __float_as_uint(tv[j + 2]), __float_as_uint(tv[j + 3])}; }
            }
        }
        __syncthreads();
        if (tid < 256) {
            const int tok = tid; const LAS unsigned* xa = XV + (tok * 2) * 16; const LAS unsigned* xb = xa + 16;
            float fv[16];
#pragma unroll
            for (int r = 0; r < 16; ++r) fv[r] = -INFINITY;
            for (int ci = 0; ci < 50; ++ci) {
                const unsigned c = PK_CAND[ci];
                const float sm = __uint_as_float(xa[c >> 4] & 0xffffff80u) + __uint_as_float(xb[c & 15] & 0xffffff80u);
                float v = __uint_as_float((__float_as_uint(sm) & 0xffffff00u) | (255u - c));
#pragma unroll
                for (int r = 0; r < 16; ++r) { float hi_, lo_; asm("v_max_f32_e32 %0, %1, %2" : "=v"(hi_) : "v"(fv[r]), "v"(v)); asm("v_min_f32_e32 %0, %1, %2" : "=v"(lo_) : "v"(fv[r]), "v"(v)); fv[r] = hi_; v = lo_; }
            }
            float val[16]; int ex[16]; float mx = -INFINITY;
#pragma unroll
            for (int r = 0; r < 16; ++r) { const unsigned c = 255u - (__float_as_uint(fv[r]) & 255u); const unsigned ia = xa[c >> 4], ib = xb[c & 15];
                val[r] = __uint_as_float(ia & 0xffffff80u) + __uint_as_float(ib & 0xffffff80u); ex[r] = (int)((127u - (ia & 127u)) * 128u + (127u - (ib & 127u))); mx = fmaxf(mx, val[r]); }
            float sum = 0.f;
#pragma unroll
            for (int r = 0; r < 16; ++r) { val[r] = __expf(val[r] - mx); sum += val[r]; }
            const float inv = 1.0f / sum;
            int* eo = EIDX + (size_t)(t0 + tok) * 128 + h * 16; float* go = GW + (size_t)(t0 + tok) * 128 + h * 16;
#pragma unroll
            for (int r = 0; r < 16; r += 4) { *(v4u*)(eo + r) = (v4u){(unsigned)ex[r], (unsigned)ex[r + 1], (unsigned)ex[r + 2], (unsigned)ex[r + 3]};
                *(f32x4*)(go + r) = (f32x4){val[r] * inv, val[r + 1] * inv, val[r + 2] * inv, val[r + 3] * inv}; }
        }
        __syncthreads();
    }
}
__device__ __forceinline__ void fp8x16_to_f32(const v4u w, float (&f)[16]) {
#pragma unroll
    for (int q = 0; q < 4; ++q) { const auto lo = __builtin_amdgcn_cvt_pk_f32_fp8((int)w[q], false); const auto hi = __builtin_amdgcn_cvt_pk_f32_fp8((int)w[q], true);
        f[4 * q] = lo[0]; f[4 * q + 1] = lo[1]; f[4 * q + 2] = hi[0]; f[4 * q + 3] = hi[1]; }
}
__device__ __forceinline__ void xp_sort128(int& e_a, int& e_b, float& g_a, float& g_b, int lane) {
    asm volatile("" : "+v"(lane));
    unsigned a0 = ((unsigned)e_a << 7) | (unsigned)lane, a1 = ((unsigned)e_b << 7) | (unsigned)(64 + lane);
#pragma unroll
    for (int k = 2; k <= 128; k <<= 1) {
#pragma unroll
        for (int j = k >> 1; j >= 1; j >>= 1) {
            if (j == 64) { const unsigned lo = min(a0, a1), hi = max(a0, a1); a0 = lo; a1 = hi; }
            else {
                const bool lower = (lane & j) == 0;
                const bool asc0 = k >= 64 ? true : ((lane & k) == 0), asc1 = k == 64 ? false : (k == 128 ? true : ((lane & k) == 0));
                const unsigned o0 = (unsigned)__shfl_xor((int)a0, j), o1 = (unsigned)__shfl_xor((int)a1, j);
                a0 = (lower == asc0) ? min(a0, o0) : max(a0, o0); a1 = (lower == asc1) ? min(a1, o1) : max(a1, o1);
            }
        }
    }
    const int i0 = (int)(a0 & 127u), i1 = (int)(a1 & 127u);
    const float ga0 = __shfl(g_a, i0 & 63), gb0 = __shfl(g_b, i0 & 63), ga1 = __shfl(g_a, i1 & 63), gb1 = __shfl(g_b, i1 & 63);
    e_a = (int)(a0 >> 7); e_b = (int)(a1 >> 7); g_a = i0 < 64 ? ga0 : gb0; g_b = i1 < 64 ? ga1 : gb1;
}
template <int CTRL> __device__ __forceinline__ float dpp_f(float v) { return __builtin_bit_cast(float, __builtin_amdgcn_update_dpp(0, __builtin_bit_cast(int, v), CTRL, 0xf, 0xf, false)); }
#define XP_REDUCE8(D0, ZS) do { float e4[4], f2[2]; \
            _Pragma("unroll") for (int j = 0; j < 4; ++j) { const auto r = __builtin_amdgcn_permlane32_swap(__float_as_uint(d[(D0) + j]), __float_as_uint(d[(D0) + j + 4]), false, false); e4[j] = __uint_as_float(r[0]) + __uint_as_float(r[1]); } \
            _Pragma("unroll") for (int j = 0; j < 2; ++j) { const auto r = __builtin_amdgcn_permlane16_swap(__float_as_uint(e4[j]), __float_as_uint(e4[j + 2]), false, false); f2[j] = __uint_as_float(r[0]) + __uint_as_float(r[1]); } \
            const bool b3 = (lane & 8) != 0; \
            float zs = (b3 ? f2[1] : f2[0]) + dpp_f<0x128>(b3 ? f2[0] : f2[1]);     \
            zs += dpp_f<0xB1>(zs); zs += dpp_f<0x4E>(zs); zs += dpp_f<0x141>(zs);     \
            ZS = zs; } while (0)
#define XP_PAIRS(KB, KE) do { float z_a = 0.f, z_b = 0.f; \
        for (int k0 = (KB); k0 < (KE); k0 += 16) {     \
            v3u uw[16]; const int kk = k0 & 63; const int esel = k0 < 64 ? e_a : e_b; \
            _Pragma("unroll") for (int j = 0; j < 16; ++j) { const int so_ = __builtin_amdgcn_readlane(esel, kk + j) * ROW6; uw[j] = __builtin_bit_cast(v3u, __builtin_amdgcn_raw_buffer_load_b96(rU, voff, so_, 0)); } \
            float d[16]; \
            _Pragma("unroll") for (int j = 0; j < 16; j += 2) { const v6u pk = {uw[j].x, uw[j].y, uw[j].z, uw[j + 1].x, uw[j + 1].y, uw[j + 1].z}; const v32f r = __builtin_amdgcn_cvt_scalef32_pk32_f32_fp6(pk, 1.0f); \
                f32x2 s0 = {0.f, 0.f}, s1 = {0.f, 0.f}; \
                _Pragma("unroll") for (int i = 0; i < 8; ++i) { s0 = __builtin_elementwise_fma((f32x2){r[2 * i], r[2 * i + 1]}, hx2[i], s0); s1 = __builtin_elementwise_fma((f32x2){r[16 + 2 * i], r[17 + 2 * i]}, hx2[i], s1); } \
                d[j] = s0.x + s0.y; d[j + 1] = s1.x + s1.y; __builtin_amdgcn_sched_barrier(0); } \
            float zs0, zs1; XP_REDUCE8(0, zs0); XP_REDUCE8(8, zs1); \
              \
            const float t0 = __shfl(zs0, 8 * (lane & 7)), t1 = __shfl(zs1, 8 * (lane & 7)); \
            const int rel = lane - kk; const float tz = (rel & 8) ? t1 : t0; const bool mine = rel >= 0 && rel < 16; \
            if (k0 < 64) z_a = mine ? tz : z_a; else z_b = mine ? tz : z_b; } \
        float act_a, act_b; \
        { const float za = z_a * su_a, zb = z_b * su_b; act_a = 0.5f * za * (1.0f + erff(za * 0.70710678118654752f)) * g_a; act_b = 0.5f * zb * (1.0f + erff(zb * 0.70710678118654752f)) * g_b; } \
        for (int k0 = (KB); k0 < (KE); k0 += 16) {     \
            v3u vw[16]; const int kk = k0 & 63; const int esel = k0 < 64 ? e_a : e_b; const float asel = k0 < 64 ? act_a : act_b; \
            _Pragma("unroll") for (int j = 0; j < 16; ++j) { const int so_ = __builtin_amdgcn_readlane(esel, kk + j) * ROW6; vw[j] = __builtin_bit_cast(v3u, __builtin_amdgcn_raw_buffer_load_b96(rV, voff, so_, 0)); } \
            _Pragma("unroll") for (int j = 0; j < 16; j += 2) { const float act0 = __int_as_float(__builtin_amdgcn_readlane(__float_as_int(asel), kk + j)), act1 = __int_as_float(__builtin_amdgcn_readlane(__float_as_int(asel), kk + j + 1)); \
                const f32x2 a0 = {act0, act0}, a1 = {act1, act1}; \
                const v6u pk = {vw[j].x, vw[j].y, vw[j].z, vw[j + 1].x, vw[j + 1].y, vw[j + 1].z}; const v32f r = __builtin_amdgcn_cvt_scalef32_pk32_f32_fp6(pk, 1.0f); \
                _Pragma("unroll") for (int i = 0; i < 8; ++i) acc2[i] = __builtin_elementwise_fma((f32x2){r[2 * i], r[2 * i + 1]}, a0, acc2[i]); \
                __builtin_amdgcn_sched_barrier(0);     \
                _Pragma("unroll") for (int i = 0; i < 8; ++i) acc2[i] = __builtin_elementwise_fma((f32x2){r[16 + 2 * i], r[17 + 2 * i]}, a1, acc2[i]); \
                __builtin_amdgcn_sched_barrier(0); } } } while (0)
#define XP_UNPACK float acc[16]; _Pragma("unroll") for (int i = 0; i < 8; ++i) { acc[2 * i] = acc2[i].x; acc[2 * i + 1] = acc2[i].y; }
#define XP_LOAD_ROW(ROW) \
        f32x2 hx2[8]; f32x4 xrow[4];     \
        { const int mi_ = mod_index(ROW); const float* sh_ = MOD - 5120 + mi_ * 6144 + 3072; const float* sc_ = sh_ + 1024; float ss_ = 0.f; \
          _Pragma("unroll") for (int q = 0; q < 4; ++q) { xrow[q] = *(const f32x4*)(X + (size_t)(ROW) * DM + 16 * lane + 4 * q); ss_ += (xrow[q][0] * xrow[q][0] + xrow[q][1] * xrow[q][1]) + (xrow[q][2] * xrow[q][2] + xrow[q][3] * xrow[q][3]); } \
          const float rs_ = rsqrtf(wave_sum(ss_) * (1.0f / DM) + EPS); \
          _Pragma("unroll") for (int q = 0; q < 4; ++q) { const f32x4 s1_ = *(const f32x4*)(sc_ + 16 * lane + 4 * q), s0_ = *(const f32x4*)(sh_ + 16 * lane + 4 * q); const f32x4 h_ = xrow[q] * rs_ * (s1_ + 1.0f) + s0_; \
              hx2[2 * q] = (f32x2){h_[0], h_[1]}; hx2[2 * q + 1] = (f32x2){h_[2], h_[3]}; } } \
        int e_a = EIDX[(size_t)(ROW) * 128 + lane], e_b = EIDX[(size_t)(ROW) * 128 + 64 + lane]; \
        float g_a = GW[(size_t)(ROW) * 128 + lane], g_b = GW[(size_t)(ROW) * 128 + 64 + lane]; \
        xp_sort128(e_a, e_b, g_a, g_b, lane); \
        const float su_a = SU[e_a], su_b = SU[e_b]; g_a *= SV[e_a]; g_b *= SV[e_b];     \
        f32x2 acc2[8]; \
        _Pragma("unroll") for (int i = 0; i < 8; ++i) acc2[i] = (f32x2){0.f, 0.f};
#define XP_EPILOGUE(ROW) do { \
        const int mi = mod_index(ROW); const float* g2 = MOD + mi * 6144; float* xr = X + (size_t)(ROW) * DM + 16 * lane; \
        f32x4 xn[4]; float ss = 0.f; \
        _Pragma("unroll") for (int q = 0; q < 4; ++q) { const f32x4 g = *(const f32x4*)(g2 + 16 * lane + 4 * q); f32x4 x = xrow[q]; \
            x[0] += g[0] * acc[4 * q]; x[1] += g[1] * acc[4 * q + 1]; x[2] += g[2] * acc[4 * q + 2]; x[3] += g[3] * acc[4 * q + 3]; \
            xn[q] = x; ss += (x[0] * x[0] + x[1] * x[1]) + (x[2] * x[2] + x[3] * x[3]); } \
        const float rstd = rsqrtf(wave_sum(ss) * (1.0f / DM) + EPS); \
        if (l == 0) {     \
            const float* sh = (const float*)(a.ws + WS_MOD) + (size_t)(3 + mi) * 6144; const float* sc = sh + 1024; bf16* hxo = (bf16*)(a.ws + WS_HX) + (size_t)(ROW) * DM + 16 * lane; \
            _Pragma("unroll") for (int q = 0; q < 4; ++q) { *(f32x4*)(xr + 4 * q) = xn[q]; const f32x4 s1 = *(const f32x4*)(sc + 16 * lane + 4 * q), s0 = *(const f32x4*)(sh + 16 * lane + 4 * q); \
                const f32x4 hh = xn[q] * rstd * (s1 + 1.0f) + s0; u32x2 o; o.x = pk2(hh[0], hh[1]); o.y = pk2(hh[2], hh[3]); *(u32x2*)(hxo + 4 * q) = o; } \
        } else if ((ROW) < NLAT) {     \
            _Pragma("unroll") for (int q = 0; q < 4; ++q) *(f32x4*)(a.out + (size_t)(ROW) * DM + 16 * lane + 4 * q) = xn[q] * rstd * *(const f32x4*)(a.in[26] + 16 * lane + 4 * q); \
        } } while (0)
__device__ __forceinline__ void ph_expert(const Args& a, Frame& F, int l) {
    const __amdgpu_buffer_rsrc_t rU = __builtin_amdgcn_make_buffer_rsrc((void*)(a.ws + WS_U16), (short)0, 16384 * ROW6, 0x00020000), rV = __builtin_amdgcn_make_buffer_rsrc((void*)(a.ws + WS_V16), (short)0, 16384 * ROW6, 0x00020000);
    const float* SU = (const float*)(a.ws + WS_SU); const float* SV = (const float*)(a.ws + WS_SV);
    const int* EIDX = (const int*)(a.ws + WS_EIDX); const float* GW = (const float*)(a.ws + WS_GW); float* X = (float*)(a.ws + WS_X);
    const float* MOD = (const float*)(a.ws + WS_MOD) + (size_t)l * 3 * 6144 + 5120;
    const int gw = F.bid * NWAVES + F.wave, NGW = F.G * NWAVES, lane = F.lane; const int voff = 12 * lane;
    for (int row = gw; row < NLAT; row += NGW) {
        XP_LOAD_ROW(row)
        XP_PAIRS(0, 128);
        XP_UNPACK
        XP_EPILOGUE(row);
    }
    if (l == 0) {
        LAS float* PART = (LAS float*)F.lds;
        for (int r0 = NLAT + 2 * F.bid; r0 < T; r0 += 2 * F.G) {
            const int row = min(r0 + (F.wave >> 2), T - 1), qd = F.wave & 3;
            XP_LOAD_ROW(row)
            XP_PAIRS(32 * qd, 32 * qd + 32);
            XP_UNPACK
#pragma unroll
            for (int q = 0; q < 4; ++q) *(LAS f32x4*)(PART + F.wave * 1024 + 16 * lane + 4 * q) = (f32x4){acc[4 * q], acc[4 * q + 1], acc[4 * q + 2], acc[4 * q + 3]};
            __syncthreads();
            if (qd == 0 && r0 + (F.wave >> 2) < T) {
#pragma unroll
                for (int w_ = 1; w_ < 4; ++w_)
#pragma unroll
                    for (int q = 0; q < 4; ++q) { const f32x4 p = *(const LAS f32x4*)(PART + (F.wave + w_) * 1024 + 16 * lane + 4 * q); acc[4 * q] += p[0]; acc[4 * q + 1] += p[1]; acc[4 * q + 2] += p[2]; acc[4 * q + 3] += p[3]; }
                XP_EPILOGUE(row);
            }
            __syncthreads();
        }
    }
}
#undef XP_PAIRS
#undef XP_REDUCE8
#undef XP_UNPACK
#undef XP_LOAD_ROW
#undef XP_EPILOGUE
__device__ __forceinline__ void ph_final(const Args& a, Frame& F) {
    const float* X = (const float*)(a.ws + WS_X); const float* fw = a.in[26];
    const int gw = F.bid * NWAVES + F.wave, NGW = F.G * NWAVES;
    for (int row = gw; row < NLAT; row += NGW) {
        const f32x4* xr = (const f32x4*)(X + (size_t)row * DM) + F.lane; f32x4 v[4]; float ss = 0.f;
#pragma unroll
        for (int j = 0; j < 4; ++j) { v[j] = xr[64 * j]; ss += (v[j][0] * v[j][0] + v[j][1] * v[j][1]) + (v[j][2] * v[j][2] + v[j][3] * v[j][3]); }
        const float rstd = rsqrtf(wave_sum(ss) * (1.0f / DM) + EPS);
#pragma unroll
        for (int j = 0; j < 4; ++j) { const int c = 4 * F.lane + 256 * j; *(f32x4*)(a.out + (size_t)row * DM + c) = v[j] * rstd * *(const f32x4*)(fw + c); }
    }
}
__device__ __forceinline__ f32x16 small_tile_mma(const bf16* A, int lda, const bf16* Bt, int ldb, int K, int lane) {
    const int r32 = lane & 31, hp = lane >> 5;
    const bf16* ap = A + (size_t)r32 * lda + 8 * hp; const bf16* bp = Bt + (size_t)r32 * ldb + 8 * hp;
    f32x16 acc;
#pragma unroll
    for (int r = 0; r < 16; ++r) acc[r] = 0.f;
#pragma unroll 1
    for (int k0 = 0; k0 < K; k0 += 128) {
        bf16x8 af[8], bfr[8];
#pragma unroll
        for (int s_ = 0; s_ < 8; ++s_) { af[s_] = *(const bf16x8*)(ap + k0 + 16 * s_); bfr[s_] = *(const bf16x8*)(bp + k0 + 16 * s_); }
#pragma unroll
        for (int s_ = 0; s_ < 8; ++s_) acc = __builtin_amdgcn_mfma_f32_32x32x16_bf16(af[s_], bfr[s_], acc, 0, 0, 0);
    }
    return acc;
}
__device__ __forceinline__ void ph_biasq(const Args& a, Frame& F, int l) {
    const bf16* Wq = (const bf16*)(a.ws + WS_WQ); const float* MOD = (const float*)(a.ws + WS_MOD) + (size_t)l * 3 * 6144 + 3072; float* BQ = (float*)(a.ws + WS_BQ) + l * 3 * 1024;
    const int gw = F.bid * NWAVES + F.wave, NGW = F.G * NWAVES, lane = F.lane;
    for (int it = gw; it < 3 * 1024; it += NGW) { const int mi = it >> 10, n = it & 1023;
        const v4u w0 = *(const v4u*)(Wq + (size_t)n * 1024 + 16 * lane), w1 = *(const v4u*)(Wq + (size_t)n * 1024 + 16 * lane + 8); const f32x4* sp = (const f32x4*)(MOD + mi * 6144 + 16 * lane);
        const f32x4 a0 = sp[0], a1 = sp[1], a2 = sp[2], a3 = sp[3];
        float v = (a0[0] * bflo(w0.x) + a0[1] * bfhi(w0.x)) + (a0[2] * bflo(w0.y) + a0[3] * bfhi(w0.y)) + (a1[0] * bflo(w0.z) + a1[1] * bfhi(w0.z)) + (a1[2] * bflo(w0.w) + a1[3] * bfhi(w0.w))
                + (a2[0] * bflo(w1.x) + a2[1] * bfhi(w1.x)) + (a2[2] * bflo(w1.y) + a2[3] * bfhi(w1.y)) + (a3[0] * bflo(w1.z) + a3[1] * bfhi(w1.z)) + (a3[2] * bflo(w1.w) + a3[3] * bfhi(w1.w));
        v = wave_sum(v); if (lane == 0) BQ[mi * 1024 + n] = v; }
}
__device__ __forceinline__ void ctx_small_q(const Args& a, Frame& F) {
    unsigned char* ws = a.ws; const int lane = F.lane, r32 = lane & 31, hp = lane >> 5; constexpr int AP = 1032;
    LAS unsigned short* A32 = (LAS unsigned short*)F.lds;
    const float* X = (const float*)(ws + WS_X); const float* sh = (const float*)(ws + WS_MOD) + 2 * 6144 + 3072; const float* sc = sh + 1024;
    for (int t0 = F.bid * 2; t0 < 512; t0 += F.G * 2) {
        const int row0 = NLAT + 32 * (t0 >> 5);
#pragma unroll
        for (int q = 0; q < 4; ++q) { const int rl = F.wave * 4 + q; const f32x4* xr = (const f32x4*)(X + (size_t)(row0 + rl) * DM) + lane; f32x4 v[4]; float ss = 0.f;
#pragma unroll
            for (int j = 0; j < 4; ++j) { v[j] = xr[64 * j]; ss += (v[j][0] * v[j][0] + v[j][1] * v[j][1]) + (v[j][2] * v[j][2] + v[j][3] * v[j][3]); }
            const float rstd = rsqrtf(wave_sum(ss) * (1.0f / DM) + EPS);
#pragma unroll
            for (int j = 0; j < 4; ++j) { const int c = 4 * lane + 256 * j; const f32x4 s1 = *(const f32x4*)(sc + c), s0 = *(const f32x4*)(sh + c); const f32x4 h = v[j] * rstd * (s1 + 1.0f) + s0;
                u32x2 o; o.x = pk2(h[0], h[1]); o.y = pk2(h[2], h[3]); *(LAS u32x2*)(A32 + rl * AP + c) = o; } }
        __syncthreads();
        if (F.wave < 2 && t0 + F.wave < 512) { const int col0 = 32 * ((t0 + F.wave) & 31);
            const LAS unsigned short* ap = A32 + r32 * AP + 8 * hp; const bf16* bp = (const bf16*)(ws + WS_WQ) + (size_t)(col0 + r32) * 1024 + 8 * hp;
            f32x16 acc;
#pragma unroll
            for (int r = 0; r < 16; ++r) acc[r] = 0.f;
#pragma unroll 1
            for (int k0 = 0; k0 < 1024; k0 += 128) { bf16x8 af[8], bfr[8];
#pragma unroll
                for (int s_ = 0; s_ < 8; ++s_) { af[s_] = *(const LAS bf16x8*)(ap + k0 + 16 * s_); bfr[s_] = *(const bf16x8*)(bp + k0 + 16 * s_); }
#pragma unroll
                for (int s_ = 0; s_ < 8; ++s_) acc = __builtin_amdgcn_mfma_f32_32x32x16_bf16(af[s_], bfr[s_], acc, 0, 0, 0); }
            float* PQ = (float*)(ws + WS_R1);
#pragma unroll
            for (int r = 0; r < 16; ++r) { const int row = row0 + (r & 3) + 8 * (r >> 2) + 4 * hp; PQ[(size_t)row * 1024 + col0 + r32] = acc[r]; } }
        __syncthreads();
    }
}
__device__ __forceinline__ void ctx_small(const Args& a, Frame& F, int which  ) {
    if (F.wave >= 2) return;
    unsigned char* ws = a.ws; const int lane = F.lane, r32 = lane & 31, hp = lane >> 5;
    for (int tile = F.bid * 2 + F.wave; tile < 512; tile += F.G * 2) {
        const int row0 = NLAT + 32 * (tile >> 5), col0 = 32 * (tile & 31);
        if (which == 2) {
            const bf16* OABC = (const bf16*)(ws + WS_OABC); const bf16* Wcat = (const bf16*)(ws + WS_WA); const bf16* gate = (const bf16*)(ws + WS_R3) + 1024; bf16* Mb = (bf16*)(ws + WS_MB);
            float macc[16];
#pragma unroll
            for (int r = 0; r < 16; ++r) macc[r] = 0.f;
            for (int br = 0; br < 3; ++br) {
                const f32x16 acc = small_tile_mma(OABC + (size_t)row0 * 1536 + 512 * br, 1536, Wcat + (size_t)col0 * 1536 + 512 * br, 1536, 512, lane);
#pragma unroll
                for (int r = 0; r < 16; ++r) { const int row = row0 + (r & 3) + 8 * (r >> 2) + 4 * hp; macc[r] += sigm(bf2f(gate[(size_t)row * NPXB + 1024 * br + col0 + r32])) * acc[r]; }
            }
#pragma unroll
            for (int r = 0; r < 16; ++r) { const int row = row0 + (r & 3) + 8 * (r >> 2) + 4 * hp; Mb[(size_t)row * 1024 + col0 + r32] = (unsigned short)f2bf(macc[r]); }
        } else if (which == 3) {
            const f32x16 acc = small_tile_mma((const bf16*)(ws + WS_MB) + (size_t)row0 * 1024, 1024, (const bf16*)(ws + WS_WO) + (size_t)col0 * 1024, 1024, 1024, lane);
            const float g1 = ((const float*)(ws + WS_MOD))[2 * 6144 + 2048 + col0 + r32]; float* X = (float*)(ws + WS_X);
#pragma unroll
            for (int r = 0; r < 16; ++r) { const int row = row0 + (r & 3) + 8 * (r >> 2) + 4 * hp; X[(size_t)row * 1024 + col0 + r32] = a.in[2][(size_t)(row - NLAT) * 1024 + col0 + r32] + g1 * acc[r]; }
        } else {
            const f32x16 acc = small_tile_mma((const bf16*)(ws + WS_HX) + (size_t)row0 * 1024, 1024, (const bf16*)(ws + WS_WQ) + (size_t)col0 * 1024, 1024, 1024, lane);
            float* PQ = (float*)(ws + WS_R1);
#pragma unroll
            for (int r = 0; r < 16; ++r) { const int row = row0 + (r & 3) + 8 * (r >> 2) + 4 * hp; PQ[(size_t)row * 1024 + col0 + r32] = acc[r]; }
        }
    }
}
#define GEMM_RUN(EPI, g, E) do { pg8::StaticOrder S_; S_.init((g).M, (g).N, F.G, F.bid); pg8::gemm_phase<EPI, pg8::StaticOrder, true, true>(F.lds, g, S_, E); } while (0)

constexpr int N_PHASES = 25;
#ifndef MK_ONE_LAUNCH
#define MK_ONE_LAUNCH 1
#endif
__global__ void __launch_bounds__(NWAVES * 64, 2) mk_fwd(Args args) {
    extern __shared__ __attribute__((aligned(16))) unsigned char lds_raw[];
    Frame F;
    F.lds = (LAS unsigned char*)lds_raw; F.MISC = (volatile LAS unsigned*)(F.lds + MISC_OFF);
    F.tid = threadIdx.x; F.lane = F.tid & 63; F.wave = __builtin_amdgcn_readfirstlane(F.tid >> 6); F.G = gridDim.x; F.bid = blockIdx.x;
    F.ctl = (gu32*)(args.ws + WS_CTL);
    for (int u = F.tid; u < (LDS_BYTES - LDSCTL_OFF) / 4; u += NWAVES * 64) ((LAS unsigned*)(F.lds + LDSCTL_OFF))[u] = 0u;
    __syncthreads();
    XcdBarrier bar; bar.bar = (unsigned*)(F.ctl + CW_BAR); bar.x = 0; bar.st = nullptr;
    const bool multi = (args.ph_hi - args.ph_lo) > 1;
    if (multi) bar = xcd_barrier_post((unsigned*)(F.ctl + CW_BAR), F.MISC + 8);
    unsigned char* ws = args.ws;
    const int lo = args.ph_lo, hi = args.ph_hi;
    if (PROBE_MASK != 0ull) { if (F.tid == 0) { const unsigned long long now_ = __builtin_amdgcn_s_memrealtime(); F.MISC[16] = (unsigned)now_; F.MISC[17] = (unsigned)(now_ >> 32); } __syncthreads(); }
#define IN(k) (lo <= (k) && (k) < hi)
#define SEAM(k) do { if (IN(k) && IN((k) + 1)) { xcd_barrier(bar); \
    if (PROBE_MASK != 0ull) { if (F.tid == 0) { unsigned long long now_ = __builtin_amdgcn_s_memrealtime(); const unsigned long long prev_ = ((unsigned long long)F.MISC[17] << 32) | F.MISC[16]; \
        if ((PROBE_MASK >> (k)) & 1ull) { const unsigned long long until_ = now_ + PROBE_AMP * (now_ - prev_); while (__builtin_amdgcn_s_memrealtime() < until_) __builtin_amdgcn_s_sleep(32); now_ = __builtin_amdgcn_s_memrealtime(); } \
        F.MISC[16] = (unsigned)now_; F.MISC[17] = (unsigned)(now_ >> 32); } __syncthreads(); } } } while (0)
#ifndef ONLY_PHASE
#define ONLY_PHASE(s) 1
#endif
#define LAYER(l, B) \
    if (ONLY_PHASE(1) && IN((B) + 1) && (l) == 0) { ph_mod(args, F, l, 0); } if ((l) == 0) SEAM((B) + 1); \
    if (ONLY_PHASE(2) && IN((B) + 2)) { pg8::Gemm g{(const pg8::bf16_t*)(ws + WS_HX), (const pg8::bf16_t*)(ws + WS_WIN), T, INC, DM}; pg8::EpiG1 E{(pg8::bf16_t*)(ws + WS_R1), (pg8::bf16_t*)(ws + WS_R3)}; GEMM_RUN(pg8::EpiG1, g, E); } SEAM((B) + 2); \
    if (ONLY_PHASE(3) && IN((B) + 3)) { ph_post(args, F, l); } SEAM((B) + 3); \
    if (ONLY_PHASE(4) && IN((B) + 4)) { ph_attn(args, F, l, (char*)lds_raw); } SEAM((B) + 4); \
    if (ONLY_PHASE(5) && IN((B) + 5)) { ph_comb(args, F, l); } SEAM((B) + 5); \
    if (ONLY_PHASE(6) && IN((B) + 6)) { const pg8::bf16_t* gate = (const pg8::bf16_t*)(ws + WS_R3) + 1024; \
        if ((l) == 0) ctx_small(args, F, 2); \
        pg8::Gemm g{(const pg8::bf16_t*)(ws + WS_OABC), (const pg8::bf16_t*)(ws + WS_WA), NLAT, DM, 1536}; pg8::EpiG2 E{gate + 2048, (pg8::bf16_t*)(ws + WS_MB)}; pg8::MidG2 Mh{gate}; \
        { pg8::StaticOrder S_; S_.init(g.M, g.N, F.G, F.bid); pg8::gemm_phase<pg8::EpiG2, pg8::StaticOrder, true, true, pg8::MidG2>(F.lds, g, S_, E, Mh); } } SEAM((B) + 6); \
    if (ONLY_PHASE(7) && IN((B) + 7)) { ph_biasq(args, F, l); if ((l) == 0) ctx_small(args, F, 3); pg8::Gemm g{(const pg8::bf16_t*)(ws + WS_MB), (const pg8::bf16_t*)(ws + WS_WO), NLAT, DM, DM}; pg8::EpiG3 E{(float*)(ws + WS_X), (l) == 0 ? args.in[0] : (const float*)(ws + WS_X), (const float*)(ws + WS_MOD) + (size_t)(l) * 3 * 6144 + 2048, (pg8::bf16_t*)(ws + WS_HX), (const float*)(ws + WS_MOD) + (size_t)(l) * 3 * 6144 + 4096, (float*)(ws + WS_SSQ)}; GEMM_RUN(pg8::EpiG3, g, E); } SEAM((B) + 7); \
    if (ONLY_PHASE(9) && IN((B) + 9)) { if ((l) == 0) ctx_small_q(args, F); pg8::Gemm g{(const pg8::bf16_t*)(ws + WS_HX), (const pg8::bf16_t*)(ws + WS_WQ), NLAT, DM, DM}; pg8::EpiG4 E{(float*)(ws + WS_R1), (const float*)(ws + WS_SSQ), (const float*)(ws + WS_BQ) + (l) * 3 * 1024}; GEMM_RUN(pg8::EpiG4, g, E); } SEAM((B) + 9); \
    if (ONLY_PHASE(10) && IN((B) + 10)) { ph_topk(args, F, l); } SEAM((B) + 10); \
    if (ONLY_PHASE(11) && IN((B) + 11)) { ph_expert(args, F, l); } if ((l) == 0) SEAM((B) + 11);

    if (ONLY_PHASE(0) && IN(0)) { ph_prep0(args, F); ph_convw(args, F, 0); } SEAM(0);
    LAYER(0, 0)
    if (ONLY_PHASE(12) && IN(12)) { ph_convw(args, F, 1); } SEAM(12);
    LAYER(1, 12)
    if (PROBE_MASK != 0ull && ((PROBE_MASK >> 23) & 1ull) && IN(23)) { __syncthreads(); if (F.tid == 0) { const unsigned long long now_ = __builtin_amdgcn_s_memrealtime(); const unsigned long long prev_ = ((unsigned long long)F.MISC[17] << 32) | F.MISC[16];
        const unsigned long long until_ = now_ + PROBE_AMP * (now_ - prev_); while (__builtin_amdgcn_s_memrealtime() < until_) __builtin_amdgcn_s_sleep(32); } __syncthreads(); }
#undef IN
#undef SEAM
}

extern "C" void kernel_launch(void* const* d_in, const int* in_sizes, int n_in, void* d_out, int out_size, void* d_ws, size_t ws_size, hipStream_t stream) {
    static int grid = 0;
    if (grid == 0) {
        if (n_in != 27 || out_size != NLAT * DM || ws_size < WS_END) { fprintf(stderr, "kernel_launch: unexpected shapes (n_in %d, out %d, ws %zu)\n", n_in, out_size, ws_size); grid = -1; return; }
        int dev = 0, cus = 0, per_cu = 0;
        if (hipGetDevice(&dev) != hipSuccess || hipDeviceGetAttribute(&cus, hipDeviceAttributeMultiprocessorCount, dev) != hipSuccess) { grid = -1; return; }
        if (hipFuncSetAttribute((const void*)mk_fwd, hipFuncAttributeMaxDynamicSharedMemorySize, LDS_BYTES) != hipSuccess) { fprintf(stderr, "kernel_launch: hipFuncSetAttribute failed\n"); grid = -1; return; }
        if (hipOccupancyMaxActiveBlocksPerMultiprocessor(&per_cu, (const void*)mk_fwd, NWAVES * 64, LDS_BYTES) != hipSuccess || per_cu < 1) { fprintf(stderr, "kernel_launch: occupancy query says %d blocks per CU\n", per_cu); (void)hipGetLastError(); grid = -1; return; }
        if (cus < 256) { fprintf(stderr, "kernel_launch: this kernel's phase maps are built for 256 workgroups (one per CU); the device reports %d CUs\n", cus); grid = -1; return; }
        grid = 256;
    }
    if (grid < 0) return;
    (void)hipMemsetAsync((char*)d_ws + WS_CTL, 0, CTL_ZERO_BYTES, stream);
    Args a{};
    for (int i = 0; i < 27; ++i) a.in[i] = (const float*)d_in[i];
    a.out = (float*)d_out; a.ws = (unsigned char*)d_ws;
#if MK_ONE_LAUNCH
    a.ph_lo = 0; a.ph_hi = N_PHASES;
    hipLaunchKernelGGL(mk_fwd, dim3(grid), dim3(NWAVES * 64), LDS_BYTES, stream, a);
#else
    for (int ph = 0; ph < N_PHASES; ++ph) { a.ph_lo = ph; a.ph_hi = ph + 1; hipLaunchKernelGGL(mk_fwd, dim3(grid), dim3(NWAVES * 64), LDS_BYTES, stream, a); }
#endif
}
```

```cpp
#include <hip/hip_runtime.h>
#include <cstdio>
#include <cstdint>
#include <cmath>
namespace pg8 {
#define PG8_LAS __attribute__((address_space(3)))
typedef unsigned short bf16_t;
typedef short bf16x8 __attribute__((ext_vector_type(8)));
typedef float f32x4 __attribute__((ext_vector_type(4)));
typedef unsigned u32x4 __attribute__((ext_vector_type(4)));
constexpr int BM = 256, BK = 64, HALF = 128, HTB = HALF * BK * 2  , STAGE_BYTES = 8 * HTB, NXCD = 8, WGM = 8;

__host__ __device__ __forceinline__ int lds_byte(int r, int c) { const int st = (r >> 4) * 2 + (c >> 5), rr = r & 15, cc = c & 31, ob = rr * 64 + cc * 2; return st * 1024 + (ob ^ (((ob >> 9) & 1) << 5)); }
__host__ __device__ __forceinline__ void stage_rc(int b, int& R, int& C) { const int st = b / 1024, sb = b % 1024, swz = sb ^ (((sb >> 9) & 1) << 5); R = (st >> 1) * 16 + swz / 64; C = (st & 1) * 32 + (swz % 64) / 2; }
__host__ __device__ __forceinline__ int perm32(int rho) { const int n = rho >> 4, i = rho & 15; return 8 * (i >> 2) + 4 * n + (i & 3); }

struct Unit { int pm, pn; };
struct Gemm { const bf16_t* A; const bf16_t* Bt; int M, N, K; };

struct StaticOrder {
    int nM, nN, nwg, G, c;
    __host__ __device__ void init(int M, int N, int G_, int c_) { nM = M / BM; nN = N / BM; nwg = nM * nN; G = G_; c = c_; }
    __host__ __device__ bool next(int i, Unit& u) const {
        const long L = (long)i * G + c; if (L >= nwg) return false;
        int wgid = (int)L; { const int q = nwg / NXCD, r = nwg % NXCD, xcd = wgid % NXCD, off = wgid / NXCD; wgid = (xcd < r ? xcd * (q + 1) : r * (q + 1) + (xcd - r) * q) + off; }
        const int nig = WGM * nN, gid = wgid / nig, fm = gid * WGM, gsz = (nM - fm) < WGM ? (nM - fm) : WGM;
        u.pm = fm + ((wgid % nig) % gsz); u.pn = (wgid % nig) / gsz; return true;
    }
    __device__ __forceinline__ void a_ready(const Unit&) const {}
    __device__ __forceinline__ void done(const Unit&) const {}
};

__device__ __forceinline__ unsigned cvt_pk_bf16(float lo, float hi) { unsigned r; asm volatile("v_cvt_pk_bf16_f32 %0, %1, %2" : "=v"(r) : "v"(lo), "v"(hi)); return r; }
typedef float f32x2 __attribute__((ext_vector_type(2)));
__device__ __forceinline__ float sigmoidf_(float x) { return __builtin_amdgcn_rcpf(1.0f + __expf(-x)); }
__device__ __forceinline__ float bf_lo(unsigned w) { return __uint_as_float(w << 16); }
__device__ __forceinline__ float bf_hi(unsigned w) { return __uint_as_float(w & 0xffff0000u); }
struct EpiG1 {
    static constexpr bool PERM = true, AFTER_DRAIN = false;
    bf16_t* Oa; bf16_t* Ob;
    __device__ __forceinline__ void operator()(const f32x4 (&acc)[2][2][4][2], const Unit& u, int wr, int wc, int fr, int fq) const {
        const int row0 = u.pm * BM + wr * 64 + fr; int colt = u.pn * BM; bf16_t* base = Oa; int ldc = 2304;
        if (colt >= 2304) { base = Ob; ldc = 4096; colt -= 2304; }
        const int col0 = colt + wc * 32 + 8 * fq;
#pragma unroll
        for (int ai = 0; ai < 2; ++ai)
#pragma unroll
            for (int m = 0; m < 4; ++m) { bf16_t* rowp = base + (size_t)(row0 + ai * HALF + m * 16) * ldc + col0;
#pragma unroll
                for (int bj = 0; bj < 2; ++bj) { const f32x4 v0 = acc[ai][bj][m][0], v1 = acc[ai][bj][m][1];
                    u32x4 w; w.x = cvt_pk_bf16(v0[0], v0[1]); w.y = cvt_pk_bf16(v0[2], v0[3]); w.z = cvt_pk_bf16(v1[0], v1[1]); w.w = cvt_pk_bf16(v1[2], v1[3]);
                    *(u32x4*)(rowp + bj * HALF) = w; } }
    }
};
struct MidG2 {
    static constexpr int SEG = 8;
    const bf16_t* gate;
    __device__ __forceinline__ void operator()(f32x4 (&acc)[2][2][4][2], const Unit& u, int wr, int wc, int fr, int fq, int seg) const {
        const int row0 = u.pm * BM + wr * 64 + fr; const int col0 = u.pn * BM + wc * 32 + 8 * fq; const bf16_t* gp = gate + (seg - 1) * 1024;
#define PG8_RATIO(N, D) ((1.0f + __expf(-(D))) * __builtin_amdgcn_rcpf(1.0f + __expf(-(N))))
#pragma unroll
        for (int ai = 0; ai < 2; ++ai)
#pragma unroll
          for (int mh = 0; mh < 2; ++mh) {
            u32x4 gn[2][2], gd[2][2];
#pragma unroll
            for (int mm = 0; mm < 2; ++mm)
#pragma unroll
                for (int bj = 0; bj < 2; ++bj) { const bf16_t* p = gp + (size_t)(row0 + ai * HALF + (2 * mh + mm) * 16) * 4096 + col0 + bj * HALF; gn[mm][bj] = *(const u32x4*)p; gd[mm][bj] = *(const u32x4*)(p + 1024); }
#pragma unroll
            for (int mm = 0; mm < 2; ++mm)
#pragma unroll
                for (int bj = 0; bj < 2; ++bj) { f32x4& v0 = acc[ai][bj][2 * mh + mm][0]; f32x4& v1 = acc[ai][bj][2 * mh + mm][1]; const u32x4 a_ = gn[mm][bj], b_ = gd[mm][bj];
                    v0[0] *= PG8_RATIO(bf_lo(a_.x), bf_lo(b_.x)); v0[1] *= PG8_RATIO(bf_hi(a_.x), bf_hi(b_.x)); v0[2] *= PG8_RATIO(bf_lo(a_.y), bf_lo(b_.y)); v0[3] *= PG8_RATIO(bf_hi(a_.y), bf_hi(b_.y));
                    v1[0] *= PG8_RATIO(bf_lo(a_.z), bf_lo(b_.z)); v1[1] *= PG8_RATIO(bf_hi(a_.z), bf_hi(b_.z)); v1[2] *= PG8_RATIO(bf_lo(a_.w), bf_lo(b_.w)); v1[3] *= PG8_RATIO(bf_hi(a_.w), bf_hi(b_.w)); }
            __builtin_amdgcn_sched_barrier(0);
          }
#undef PG8_RATIO
    }
};
struct EpiG2 {
    static constexpr bool PERM = true, AFTER_DRAIN = false;
    const bf16_t* gate;   bf16_t* Mb;
    __device__ __forceinline__ void operator()(const f32x4 (&acc)[2][2][4][2], const Unit& u, int wr, int wc, int fr, int fq) const {
        const int row0 = u.pm * BM + wr * 64 + fr; const int col0 = u.pn * BM + wc * 32 + 8 * fq;
#pragma unroll
        for (int ai = 0; ai < 2; ++ai)
#pragma unroll
            for (int m = 0; m < 4; ++m) { const size_t row = (size_t)(row0 + ai * HALF + m * 16);
#pragma unroll
                for (int bj = 0; bj < 2; ++bj) { const int c = col0 + bj * HALF;
                    const u32x4 gw = *(const u32x4*)(gate + row * 4096 + c);
                    f32x4 v0 = acc[ai][bj][m][0], v1 = acc[ai][bj][m][1];
                    v0[0] *= sigmoidf_(bf_lo(gw.x)); v0[1] *= sigmoidf_(bf_hi(gw.x)); v0[2] *= sigmoidf_(bf_lo(gw.y)); v0[3] *= sigmoidf_(bf_hi(gw.y));
                    v1[0] *= sigmoidf_(bf_lo(gw.z)); v1[1] *= sigmoidf_(bf_hi(gw.z)); v1[2] *= sigmoidf_(bf_lo(gw.w)); v1[3] *= sigmoidf_(bf_hi(gw.w));
                    u32x4 w; w.x = cvt_pk_bf16(v0[0], v0[1]); w.y = cvt_pk_bf16(v0[2], v0[3]); w.z = cvt_pk_bf16(v1[0], v1[1]); w.w = cvt_pk_bf16(v1[2], v1[3]);
                    *(u32x4*)(Mb + row * 1024 + c) = w; } }
    }
};
struct EpiG3 {
    static constexpr bool PERM = true, AFTER_DRAIN = false;
    float* X; const float* base;   const float* g1;
    bf16_t* Xs; const float* sc2;   float* SSQ;
    __device__ __forceinline__ void operator()(const f32x4 (&acc)[2][2][4][2], const Unit& u, int wr, int wc, int fr, int fq) const {
        const int row0 = u.pm * BM + wr * 64 + fr; const int col0 = u.pn * BM + wc * 32 + 8 * fq;
        const int rt = u.pm * BM; const int mi = rt < 8192 ? 0 : (rt < 16384 ? 1 : 2); const float* gp = g1 + mi * 6144; const float* sp = sc2 + mi * 6144;
        float ssq[2][4];
#pragma unroll
        for (int ai = 0; ai < 2; ++ai)
#pragma unroll
            for (int m = 0; m < 4; ++m) ssq[ai][m] = 0.f;
#pragma unroll
        for (int bj = 0; bj < 2; ++bj) { const int c = col0 + bj * HALF; const f32x4 ga = *(const f32x4*)(gp + c), gb = *(const f32x4*)(gp + c + 4);
            const f32x4 sa = *(const f32x4*)(sp + c) + 1.0f, sb = *(const f32x4*)(sp + c + 4) + 1.0f;
#pragma unroll
            for (int ai = 0; ai < 2; ++ai)
#pragma unroll
                for (int m = 0; m < 4; ++m) { const size_t ro = (size_t)(row0 + ai * HALF + m * 16) * 1024 + c; float* xp = X + ro; const float* bp = base + ro;
                    const f32x4 x0 = *(const f32x4*)bp + ga * acc[ai][bj][m][0], x1 = *(const f32x4*)(bp + 4) + gb * acc[ai][bj][m][1];
                    *(f32x4*)xp = x0; *(f32x4*)(xp + 4) = x1;
                    ssq[ai][m] += (x0[0] * x0[0] + x0[1] * x0[1]) + (x0[2] * x0[2] + x0[3] * x0[3]) + (x1[0] * x1[0] + x1[1] * x1[1]) + (x1[2] * x1[2] + x1[3] * x1[3]);
                    const f32x4 y0 = x0 * sa, y1 = x1 * sb; u32x4 w; w.x = cvt_pk_bf16(y0[0], y0[1]); w.y = cvt_pk_bf16(y0[2], y0[3]); w.z = cvt_pk_bf16(y1[0], y1[1]); w.w = cvt_pk_bf16(y1[2], y1[3]);
                    *(u32x4*)(Xs + ro) = w; } }
#pragma unroll
        for (int ai = 0; ai < 2; ++ai)
#pragma unroll
            for (int m = 0; m < 4; ++m) { float v = ssq[ai][m]; v += __shfl_xor(v, 16); v += __shfl_xor(v, 32);
                if (fq == 0) SSQ[(size_t)(row0 + ai * HALF + m * 16) * 16 + u.pn * 4 + wc] = v; }
    }
};
struct EpiG4 {
    static constexpr bool PERM = true, AFTER_DRAIN = false;
    float* O; const float* SSQ; const float* biasq;
    __device__ __forceinline__ void operator()(const f32x4 (&acc)[2][2][4][2], const Unit& u, int wr, int wc, int fr, int fq) const {
        const int row0 = u.pm * BM + wr * 64 + fr; const int col0 = u.pn * BM + wc * 32 + 8 * fq;
        const int rt = u.pm * BM; const int mi = rt < 8192 ? 0 : (rt < 16384 ? 1 : 2); const float* bq = biasq + mi * 1024;
        f32x4 ba[2], bb[2];
#pragma unroll
        for (int bj = 0; bj < 2; ++bj) { ba[bj] = *(const f32x4*)(bq + col0 + bj * HALF); bb[bj] = *(const f32x4*)(bq + col0 + bj * HALF + 4); }
#pragma unroll
        for (int ai = 0; ai < 2; ++ai)
#pragma unroll
            for (int m = 0; m < 4; ++m) { const size_t row = (size_t)(row0 + ai * HALF + m * 16); const f32x4* sq = (const f32x4*)(SSQ + row * 16);
                const f32x4 s = (sq[0] + sq[1]) + (sq[2] + sq[3]); const float rstd = rsqrtf(((s[0] + s[1]) + (s[2] + s[3])) * (1.0f / 1024.0f) + 1e-6f);
                float* op = O + row * 1024 + col0;
#pragma unroll
                for (int bj = 0; bj < 2; ++bj) { *(f32x4*)(op + bj * HALF) = acc[ai][bj][m][0] * rstd + ba[bj]; *(f32x4*)(op + bj * HALF + 4) = acc[ai][bj][m][1] * rstd + bb[bj]; } }
    }
};
struct NoMid { static constexpr int SEG = 0; __device__ __forceinline__ void operator()(f32x4 (&)[2][2][4][2], const Unit&, int, int, int, int, int) const {} };
template <class Epi, class Sched, bool ALIGN_EPI = false, bool SP2 = false, class Mid = NoMid>
__device__ __forceinline__ void gemm_phase(PG8_LAS unsigned char* lds, const Gemm g, const Sched& S, const Epi& E, const Mid& Mh = Mid()) {
    const int tid = threadIdx.x, wid = __builtin_amdgcn_readfirstlane(tid >> 6), lane = tid & 63, wr = wid >> 2, wc = wid & 3, fr = lane & 15, fq = lane >> 4;
    const int K = g.K, nt = K / BK;
    unsigned voffA[2], voffB[2];
#pragma unroll
    for (int i = 0; i < 2; ++i) { int R, C; stage_rc(tid * 16 + i * 8192, R, C); const int Rb = Epi::PERM ? ((R & ~31) + perm32(R & 31)) : R;
        voffA[i] = (unsigned)(R * K + C) * 2u; voffB[i] = (unsigned)(Rb * K + C) * 2u; }
    const size_t kstep = (size_t)(BK * 2);
    const size_t hstep = (size_t)HALF * K * 2;
    const size_t tstep = 2 * hstep;
    const unsigned ldsw = (unsigned)wid * 1024u;
    const int aoff = lds_byte(wr * 64 + fr, fq * 8), boff = lds_byte(wc * 32 + fr, fq * 8);
#define PG8_SA(b, h) (((b) * 2 + (h)) * HTB)
#define PG8_SB(b, h) ((4 + (b) * 2 + (h)) * HTB)
#define PG8_STAGE(bufoff, gbase, voff) do { _Pragma("unroll") for (int _i = 0; _i < 2; ++_i) \
        __builtin_amdgcn_global_load_lds((const unsigned*)((const char*)(gbase) + (voff)[_i]), (PG8_LAS unsigned*)(lds + (bufoff) + ldsw + _i * 8192), 16, 0, 0); } while (0)
#define PG8_LDA(dst, b, h) do { _Pragma("unroll") for (int m = 0; m < 4; ++m) _Pragma("unroll") for (int k = 0; k < 2; ++k) dst[m][k] = *(const PG8_LAS bf16x8*)(lds + PG8_SA(b, h) + aoff + m * 2048 + k * 1024); } while (0)
#define PG8_LDB(dst, b, h) do { _Pragma("unroll") for (int n = 0; n < 2; ++n) _Pragma("unroll") for (int k = 0; k < 2; ++k) dst[n][k] = *(const PG8_LAS bf16x8*)(lds + PG8_SB(b, h) + boff + n * 2048 + k * 1024); } while (0)
#define PG8_MMA(ai, bj, At, Bt) do { __builtin_amdgcn_s_setprio(1); _Pragma("unroll") for (int m = 0; m < 4; ++m) _Pragma("unroll") for (int n = 0; n < 2; ++n) _Pragma("unroll") for (int k = 0; k < 2; ++k) \
        acc[ai][bj][m][n] = __builtin_amdgcn_mfma_f32_16x16x32_bf16(Bt[n][k], At[m][k], acc[ai][bj][m][n], 0, 0, 0); __builtin_amdgcn_s_setprio(0); } while (0)
#define PG8_WAIT_V(n) asm volatile("s_waitcnt vmcnt(" #n ")" ::: "memory")
#define PG8_WAIT_L(n) asm volatile("s_waitcnt lgkmcnt(" #n ")" ::: "memory")
#define PG8_BAR __builtin_amdgcn_s_barrier()
#define PG8_SCHED __builtin_amdgcn_sched_barrier(0)
    Unit cur, nxt; int ui = 0;
    if (!S.next(0, cur)) return;
    f32x4 acc[2][2][4][2];
#pragma unroll
    for (int a = 0; a < 2; ++a)
#pragma unroll
        for (int b = 0; b < 2; ++b)
#pragma unroll
            for (int m = 0; m < 4; ++m)
#pragma unroll
                for (int n = 0; n < 2; ++n) acc[a][b][m][n] = (f32x4){0.f, 0.f, 0.f, 0.f};
    bf16x8 At[4][2], B0[2][2], B1[2][2];
    const char* cA = (const char*)g.A + (size_t)cur.pm * tstep; const char* cB = (const char*)g.Bt + (size_t)cur.pn * tstep;
    S.a_ready(cur);
    if constexpr (SP2) {
        PG8_STAGE(PG8_SB(0, 0), cB, voffB); PG8_STAGE(PG8_SB(0, 1), cB + hstep, voffB); PG8_STAGE(PG8_SA(0, 0), cA, voffA); PG8_STAGE(PG8_SA(0, 1), cA + hstep, voffA);
        if (wr == 1) PG8_BAR;
        PG8_WAIT_V(2); PG8_BAR;
        PG8_STAGE(PG8_SB(1, 0), cB + kstep, voffB); PG8_STAGE(PG8_SA(1, 0), cA + kstep, voffA); PG8_STAGE(PG8_SB(1, 1), cB + hstep + kstep, voffB);
        PG8_WAIT_V(6); PG8_BAR;
    } else {
        PG8_STAGE(PG8_SB(0, 0), cB, voffB); PG8_STAGE(PG8_SA(0, 0), cA, voffA); PG8_STAGE(PG8_SB(0, 1), cB + hstep, voffB); PG8_STAGE(PG8_SA(0, 1), cA + hstep, voffA);
        if (wr == 1) PG8_BAR;
        PG8_WAIT_V(4); PG8_BAR;
        PG8_STAGE(PG8_SB(1, 0), cB + kstep, voffB); PG8_STAGE(PG8_SA(1, 0), cA + kstep, voffA); PG8_STAGE(PG8_SB(1, 1), cB + hstep + kstep, voffB);
        PG8_WAIT_V(6); PG8_BAR;
    }
    for (;;) {
        const bool has_next = S.next(ui + 1, nxt);
        const char* nA = has_next ? (const char*)g.A + (size_t)nxt.pm * tstep : cA; const char* nB = has_next ? (const char*)g.Bt + (size_t)nxt.pn * tstep : cB;
        for (int t = 0; t < nt; t += 2) {
            if constexpr (Mid::SEG > 0) { if (t != 0 && (t % Mid::SEG) == 0) Mh(acc, cur, wr, wc, fr, fq, t / Mid::SEG); }
            const bool last = (t == nt - 2);
            const char* a1 = cA + (size_t)(t + 1) * kstep;
            const char* a2 = last ? nA : cA + (size_t)(t + 2) * kstep; const char* b2 = last ? nB : cB + (size_t)(t + 2) * kstep;
            const char* a3 = a2 + kstep; const char* b3 = b2 + kstep;
            if (last && has_next) S.a_ready(nxt);
            if constexpr (SP2) {
            PG8_LDB(B0, 0, 0); PG8_LDB(B1, 0, 1); PG8_SCHED; PG8_LDA(At, 0, 0); PG8_STAGE(PG8_SA(1, 1), a1 + hstep, voffA);
            PG8_WAIT_V(8); PG8_WAIT_L(0); PG8_BAR; PG8_MMA(0, 0, At, B0); PG8_MMA(0, 1, At, B1); PG8_BAR; PG8_SCHED;
            PG8_LDA(At, 0, 1); PG8_STAGE(PG8_SB(0, 0), b2, voffB); PG8_STAGE(PG8_SB(0, 1), b2 + hstep, voffB); PG8_STAGE(PG8_SA(0, 0), a2, voffA);
            PG8_WAIT_V(8); PG8_WAIT_L(0); PG8_BAR; PG8_MMA(1, 0, At, B0); PG8_MMA(1, 1, At, B1); PG8_BAR; PG8_SCHED;
            PG8_LDB(B0, 1, 0); PG8_LDB(B1, 1, 1); PG8_SCHED; PG8_LDA(At, 1, 0); PG8_STAGE(PG8_SA(0, 1), a2 + hstep, voffA);
            PG8_WAIT_V(8); PG8_WAIT_L(0); PG8_BAR; PG8_MMA(0, 0, At, B0); PG8_MMA(0, 1, At, B1); PG8_BAR; PG8_SCHED;
            PG8_LDA(At, 1, 1); PG8_STAGE(PG8_SB(1, 0), b3, voffB); PG8_STAGE(PG8_SB(1, 1), b3 + hstep, voffB); PG8_STAGE(PG8_SA(1, 0), a3, voffA);
            PG8_WAIT_V(8); PG8_WAIT_L(0); PG8_BAR; PG8_MMA(1, 0, At, B0); PG8_MMA(1, 1, At, B1); PG8_BAR; PG8_SCHED;
            } else {
            PG8_LDB(B0, 0, 0); PG8_SCHED; PG8_LDA(At, 0, 0); PG8_STAGE(PG8_SA(1, 1), a1 + hstep, voffA);
            PG8_WAIT_L(8); PG8_BAR; PG8_WAIT_L(0); PG8_MMA(0, 0, At, B0); PG8_BAR; PG8_SCHED;
            PG8_LDB(B1, 0, 1); PG8_STAGE(PG8_SB(0, 0), b2, voffB);
            PG8_BAR; PG8_WAIT_L(0); PG8_MMA(0, 1, At, B1); PG8_BAR;
            PG8_LDA(At, 0, 1); PG8_STAGE(PG8_SA(0, 0), a2, voffA);
            PG8_BAR; PG8_WAIT_L(0); PG8_MMA(1, 0, At, B0); PG8_BAR; PG8_SCHED;
            PG8_STAGE(PG8_SB(0, 1), b2 + hstep, voffB);
            PG8_WAIT_V(6); PG8_BAR; PG8_MMA(1, 1, At, B1); PG8_BAR;
            PG8_LDB(B0, 1, 0); PG8_SCHED; PG8_LDA(At, 1, 0); PG8_STAGE(PG8_SA(0, 1), a2 + hstep, voffA);
            PG8_WAIT_L(8); PG8_BAR; PG8_WAIT_L(0); PG8_MMA(0, 0, At, B0); PG8_BAR; PG8_SCHED;
            PG8_LDB(B1, 1, 1); PG8_STAGE(PG8_SB(1, 0), b3, voffB);
            PG8_BAR; PG8_WAIT_L(0); PG8_MMA(0, 1, At, B1); PG8_BAR;
            PG8_LDA(At, 1, 1); PG8_STAGE(PG8_SA(1, 0), a3, voffA);
            PG8_BAR; PG8_WAIT_L(0); PG8_MMA(1, 0, At, B0); PG8_BAR; PG8_SCHED;
            PG8_STAGE(PG8_SB(1, 1), b3 + hstep, voffB);
            PG8_WAIT_V(6); PG8_BAR; PG8_MMA(1, 1, At, B1); PG8_BAR;
            }
        }
        if constexpr (ALIGN_EPI) { if (wr == 0) PG8_BAR; }
        if constexpr (!Epi::AFTER_DRAIN) { E(acc, cur, wr, wc, fr, fq); S.done(cur); }
        if (!has_next) break;
#pragma unroll
        for (int a = 0; a < 2; ++a)
#pragma unroll
            for (int b = 0; b < 2; ++b)
#pragma unroll
                for (int m = 0; m < 4; ++m)
#pragma unroll
                    for (int n = 0; n < 2; ++n) acc[a][b][m][n] = (f32x4){0.f, 0.f, 0.f, 0.f};
        cur = nxt; cA = nA; cB = nB; ++ui;
        if constexpr (ALIGN_EPI) { if (wr == 1) PG8_BAR; }
    }
    PG8_WAIT_V(0);
    if constexpr (!ALIGN_EPI) { if (wr == 0) PG8_BAR; }
    PG8_BAR;
    if constexpr (Epi::AFTER_DRAIN) { E.fused(acc, cur, wr, wc, fr, fq, lds, wid, lane); S.done(cur); }
#undef PG8_SA
#undef PG8_SB
#undef PG8_STAGE
#undef PG8_LDA
#undef PG8_LDB
#undef PG8_MMA
#undef PG8_WAIT_V
#undef PG8_WAIT_L
#undef PG8_BAR
#undef PG8_SCHED
}
}
#define GAS __attribute__((address_space(1)))
#define LAS __attribute__((address_space(3)))
typedef unsigned short bf16;
typedef unsigned v4u __attribute__((ext_vector_type(4)));
typedef float f32x4 __attribute__((ext_vector_type(4)));
typedef short bf16x8 __attribute__((ext_vector_type(8)));
typedef GAS unsigned gu32;
typedef GAS unsigned long long gu64;
#define RLX_AGENT __ATOMIC_RELAXED, __HIP_MEMORY_SCOPE_AGENT
#define LDS_WAIT() asm volatile("s_waitcnt lgkmcnt(0)" ::: "memory")
#define VM_WAIT() asm volatile("s_waitcnt vmcnt(0)" ::: "memory")
__device__ __forceinline__ unsigned long long rt() { return __builtin_amdgcn_s_memrealtime(); }
__device__ __forceinline__ unsigned f2bf(float f) { unsigned u = __builtin_bit_cast(unsigned, f); return (u + 0x7fffu + ((u >> 16) & 1u)) >> 16; }
__device__ __forceinline__ unsigned pk2(float lo, float hi) { return f2bf(lo) | (f2bf(hi) << 16); }
#define XB_TMO      128
#define XB_XCNT(j)  (256  + 64 * (j))
#define XB_XSUB(j)  (1280 + 64 * (j))
#define XB_XGEN(j)  (2304 + 64 * (j))
#define XB_TOP      3328
#define XB_TOPGEN   3392
#define XCD_BAR_WORDS 3456
#define XB_SPIN_CAP (1u << 24)

__device__ __forceinline__ unsigned xb_ld(unsigned* p)              { return __hip_atomic_load(p, __ATOMIC_RELAXED, __HIP_MEMORY_SCOPE_AGENT); }
__device__ __forceinline__ unsigned xb_add(unsigned* p, unsigned v) { return __hip_atomic_fetch_add(p, v, __ATOMIC_RELAXED, __HIP_MEMORY_SCOPE_AGENT); }
__device__ __forceinline__ unsigned xb_xcc_id() { return (unsigned)__builtin_amdgcn_s_getreg((3 << 11) | 20) & 0xFu; }
#define XB_SPIN(cond, bar) do { unsigned _sp = 0; while (cond) { __builtin_amdgcn_s_sleep(1); \
    if ((++_sp & 255u) == 0u) { if (xb_ld(&(bar)[XB_TMO])) break; if (_sp > XB_SPIN_CAP) { atomicAdd(&(bar)[XB_TMO], 1u); break; } } } } while (0)

struct XcdBarrier {
    unsigned* bar; unsigned x;
    volatile LAS unsigned* st;
};

__device__ __forceinline__ XcdBarrier xcd_barrier_post(unsigned* bar, volatile LAS unsigned* st) {
    XcdBarrier b; b.bar = bar; b.x = xb_xcc_id(); b.st = st;
    if (threadIdx.x == 0) (void)xb_add(&bar[XB_XCNT(b.x)], 1u);
    return b;
}
__device__ __forceinline__ void xcd_barrier_complete(unsigned* bar, unsigned x, unsigned& nloc, unsigned& nx) {
    const unsigned G = gridDim.x * gridDim.y * gridDim.z;
    unsigned sum, cnt, mine, sp = 0u;
    for (;;) {
        sum = 0u; cnt = 0u; mine = 0u;
#pragma unroll
        for (unsigned j = 0; j < 16; ++j) { const unsigned c = xb_ld(&bar[XB_XCNT(j)]); sum += c; cnt += (c > 0u) ? 1u : 0u; mine = (j == x) ? c : mine; }
        if (sum == G) break;
        __builtin_amdgcn_s_sleep(1);
        if ((++sp & 255u) == 0u) { if (xb_ld(&bar[XB_TMO])) break; if (sp > XB_SPIN_CAP) { atomicAdd(&bar[XB_TMO], 1u); break; } }
    }
    nloc = mine > 0u ? mine : 1u; nx = cnt > 0u ? cnt : 1u;
}

__device__ __forceinline__ void xcd_barrier(const XcdBarrier& b) {
    asm volatile("s_waitcnt vmcnt(0)" ::: "memory");
    __syncthreads();
    if (threadIdx.x == 0) {
        unsigned* bar = b.bar;
        __builtin_amdgcn_s_waitcnt(0);
        unsigned nloc = b.st[0], nx = b.st[1];
        if (nloc == 0u) { xcd_barrier_complete(bar, b.x, nloc, nx); b.st[0] = nloc; b.st[1] = nx; }
        const unsigned old = xb_add(&bar[XB_XSUB(b.x)], 1u);
        const unsigned gen = old / nloc;
        if (old + 1u == (gen + 1u) * nloc) {
            __builtin_amdgcn_fence(__ATOMIC_RELEASE, "agent");
            asm volatile("s_waitcnt vmcnt(0)" ::: "memory");
            const unsigned og = xb_add(&bar[XB_TOP], 1u);
            const unsigned tg = og / nx;
            if (og + 1u == (tg + 1u) * nx) xb_add(&bar[XB_TOPGEN], 1u);
            else XB_SPIN(xb_ld(&bar[XB_TOPGEN]) == tg, bar);
            __builtin_amdgcn_fence(__ATOMIC_ACQUIRE, "agent");
            xb_add(&bar[XB_XGEN(b.x)], 1u);
            asm volatile("s_waitcnt vmcnt(0)" ::: "memory");
        } else {
            XB_SPIN(xb_ld(&bar[XB_XGEN(b.x)]) == gen, bar);
            __builtin_amdgcn_fence(__ATOMIC_ACQUIRE, "agent");
            asm volatile("s_waitcnt vmcnt(0)" ::: "memory");
        }
    }
    __syncthreads();
}
__device__ __forceinline__ float wave_sum(float v) {
#pragma unroll
    for (int o = 1; o < 64; o <<= 1) v += __shfl_xor(v, o);
    return v;
}
__device__ __forceinline__ void p0_transpose_item(const float* W, int K, int N, bf16* WT, int row_off, LAS float* scr, int item, int lane) {
    const int nblk = N / 32, kb = item / nblk, nb = item % nblk, k0 = 64 * kb, n0 = 32 * nb;
#pragma unroll 8
    for (int i = 0; i < 32; ++i) { const int kk = 2 * i + (lane >> 5); scr[kk * 33 + (lane & 31)] = W[(size_t)(k0 + kk) * N + n0 + (lane & 31)]; }
    LDS_WAIT(); asm volatile("" ::: "memory");
    const int c = lane & 7;
#pragma unroll
    for (int j = 0; j < 4; ++j) { const int n = (lane >> 3) + 8 * j; const LAS float* s = scr + (8 * c) * 33 + n;
        v4u o; o.x = pk2(s[0 * 33], s[1 * 33]); o.y = pk2(s[2 * 33], s[3 * 33]); o.z = pk2(s[4 * 33], s[5 * 33]); o.w = pk2(s[6 * 33], s[7 * 33]);
        *(GAS v4u*)(WT + (size_t)(row_off + n0 + n) * K + k0 + 8 * c) = o; }
    LDS_WAIT(); asm volatile("" ::: "memory");
}
__device__ __forceinline__ void p0_transpose_item_p(const float* W, int K, int N, bf16* WT, int pitch, int col_off, LAS float* scr, int item, int lane) {
    const int nblk = N / 32, kb = item / nblk, nb = item % nblk, k0 = 64 * kb, n0 = 32 * nb;
#pragma unroll 8
    for (int i = 0; i < 32; ++i) { const int kk = 2 * i + (lane >> 5); scr[kk * 33 + (lane & 31)] = W[(size_t)(k0 + kk) * N + n0 + (lane & 31)]; }
    LDS_WAIT(); asm volatile("" ::: "memory");
    const int c = lane & 7;
#pragma unroll
    for (int j = 0; j < 4; ++j) { const int n = (lane >> 3) + 8 * j; const LAS float* s = scr + (8 * c) * 33 + n;
        v4u o; o.x = pk2(s[0 * 33], s[1 * 33]); o.y = pk2(s[2 * 33], s[3 * 33]); o.z = pk2(s[4 * 33], s[5 * 33]); o.w = pk2(s[6 * 33], s[7 * 33]);
        *(GAS v4u*)(WT + (size_t)(n0 + n) * pitch + col_off + k0 + 8 * c) = o; }
    LDS_WAIT(); asm volatile("" ::: "memory");
}
#include <hip/hip_bf16.h>
#include <cmath>
namespace attn_body {
using bf16=__hip_bfloat16;
using bf16x8=__attribute__((ext_vector_type(8)))short;
using s16x4=__attribute__((ext_vector_type(4)))short;
using f32x16=__attribute__((ext_vector_type(16)))float;
using u32x4=__attribute__((ext_vector_type(4)))unsigned;
constexpr int D=64;
constexpr int NW=8,QBLK=32,QB=QBLK*NW,KVBLK=64;
constexpr int ATTN_UNIT_ROWS=QB;
__device__ __forceinline__ int crow(int r,int hi){return (r&3)+8*(r>>2)+4*hi;}
#define SBAR() __builtin_amdgcn_sched_barrier(0)
constexpr int NSLOT=3, SLOTB=8192;
constexpr int LDS_K=0, LDS_V=NSLOT*SLOTB, LDS_WS=2*NSLOT*SLOTB, LDS_OST=LDS_WS+NW*64*4, LDS_BYTES=LDS_OST+NW*4096;
constexpr float C2=0.125f*1.4426950408889634f;
__device__ __forceinline__ void glds16(const void*gsrc,unsigned lds_dst){unsigned keep;
  asm volatile("s_mov_b32 %0, m0\n\ts_mov_b32 m0, %2\n\ts_nop 0\n\tglobal_load_lds_dwordx4 %1, off\n\ts_mov_b32 m0, %0":"=&s"(keep):"v"(gsrc),"s"(lds_dst):"memory");}
__device__ __forceinline__ float max3f(float a,float b,float c){float r;asm("v_max3_f32 %0, %1, %2, %3":"=v"(r):"v"(a),"v"(b),"v"(c));return r;}
__device__ __forceinline__ float max2f(float a,float b){float r;asm("v_max_f32_e32 %0, %1, %2":"=v"(r):"v"(a),"v"(b));return r;}
__device__ __forceinline__ float fadd_s(float a,float b){float r;asm("v_add_f32_e32 %0, %1, %2":"=v"(r):"v"(a),"v"(b));return r;}
__device__ __forceinline__ float fsub_s(float a,float b){float r;asm("v_sub_f32_e32 %0, %1, %2":"=v"(r):"v"(a),"v"(b));return r;}
typedef float f32x2_t __attribute__((ext_vector_type(2))); typedef __bf16 bf16x2_t __attribute__((ext_vector_type(2)));
__device__ __forceinline__ unsigned cvtpk_s(float lo,float hi){f32x2_t v={lo,hi};bf16x2_t b=__builtin_convertvector(v,bf16x2_t);return __builtin_bit_cast(unsigned,b);}
#define WAIT_BAR(N) asm volatile("s_waitcnt vmcnt(" #N ") lgkmcnt(0)\n\ts_barrier":::"memory")

__device__ __forceinline__ void qkt(f32x16&p0,f32x16&p1,const char*Kslot,const bf16x8*qr,const f32x16&negm,int r32,int hi){
  const char*kb=Kslot+hi*1024+r32*16;
  #pragma unroll
  for(int d0=0;d0<4;++d0){
    const bf16x8 b0=*reinterpret_cast<const bf16x8*>(kb+d0*2048);
    const bf16x8 b1=*reinterpret_cast<const bf16x8*>(kb+d0*2048+512);
    if(d0==0){p0=__builtin_amdgcn_mfma_f32_32x32x16_bf16(b0,qr[0],negm,0,0,0);p1=__builtin_amdgcn_mfma_f32_32x32x16_bf16(b1,qr[0],negm,0,0,0);}
    else{p0=__builtin_amdgcn_mfma_f32_32x32x16_bf16(b0,qr[d0],p0,0,0,0);p1=__builtin_amdgcn_mfma_f32_32x32x16_bf16(b1,qr[d0],p1,0,0,0);}}
}
typedef __attribute__((address_space(3))) const char* lds_cptr;
typedef short v4i16_t __attribute__((ext_vector_type(4)));
__device__ __forceinline__ void kload8(bf16x8*kf,lds_cptr kp){
  kf[0]=*(const __attribute__((address_space(3))) bf16x8*)(kp);      kf[1]=*(const __attribute__((address_space(3))) bf16x8*)(kp+512);
  kf[2]=*(const __attribute__((address_space(3))) bf16x8*)(kp+2048); kf[3]=*(const __attribute__((address_space(3))) bf16x8*)(kp+2560);
  kf[4]=*(const __attribute__((address_space(3))) bf16x8*)(kp+4096); kf[5]=*(const __attribute__((address_space(3))) bf16x8*)(kp+4608);
  kf[6]=*(const __attribute__((address_space(3))) bf16x8*)(kp+6144); kf[7]=*(const __attribute__((address_space(3))) bf16x8*)(kp+6656);
}
__device__ __forceinline__ void kload2(bf16x8*kf,lds_cptr kp,int j){ kf[2*j]=*(const __attribute__((address_space(3))) bf16x8*)(kp+j*2048); kf[2*j+1]=*(const __attribute__((address_space(3))) bf16x8*)(kp+j*2048+512); }
__device__ __forceinline__ s16x4 vtr(lds_cptr p){ return __builtin_bit_cast(s16x4,__builtin_amdgcn_ds_read_tr16_b64_v4i16((__attribute__((address_space(3))) v4i16_t*)p)); }
__device__ __forceinline__ float rowmax(const f32x16&p0,const f32x16&p1){
  float a=max3f(p0[0],p0[1],p1[0]),b=max3f(p0[2],p0[3],p1[1]);a=max3f(a,p1[2],p1[3]);
  #pragma unroll
  for(int r=4;r<16;r+=4){a=max3f(a,p0[r],p0[r+1]);b=max3f(b,p0[r+2],p0[r+3]);a=max3f(a,p1[r],p1[r+1]);b=max3f(b,p1[r+2],p1[r+3]);}
  const float m=max2f(a,b);
  auto rr=__builtin_amdgcn_permlane32_swap(__float_as_uint(m),__float_as_uint(m),false,false);
  return max2f(__uint_as_float(rr[0]),__uint_as_float(rr[1]));
}
__device__ __forceinline__ void pv(f32x16*o,int vb,bf16x8 pa0,bf16x8 pa1,bf16x8 pa2,bf16x8 pa3){
  #pragma unroll
  for(int d0=0;d0<2;++d0){s16x4 lo[4],hi[4];
    #pragma unroll
    for(int ks=0;ks<4;++ks){
      asm volatile("ds_read_b64_tr_b16 %0,%1 offset:%c2":"=&v"(lo[ks]):"v"(vb),"i"(d0*4096+ks*1024):"memory");
      asm volatile("ds_read_b64_tr_b16 %0,%1 offset:%c2":"=&v"(hi[ks]):"v"(vb),"i"(d0*4096+ks*1024+512):"memory");}
    asm volatile("s_waitcnt lgkmcnt(0)":::"memory");SBAR();
    #define PK(k) (bf16x8){lo[k][0],lo[k][1],lo[k][2],lo[k][3],hi[k][0],hi[k][1],hi[k][2],hi[k][3]}
    o[d0]=__builtin_amdgcn_mfma_f32_32x32x16_bf16(pa0,PK(0),o[d0],0,0,0);
    o[d0]=__builtin_amdgcn_mfma_f32_32x32x16_bf16(pa1,PK(1),o[d0],0,0,0);
    o[d0]=__builtin_amdgcn_mfma_f32_32x32x16_bf16(pa2,PK(2),o[d0],0,0,0);
    o[d0]=__builtin_amdgcn_mfma_f32_32x32x16_bf16(pa3,PK(3),o[d0],0,0,0);
    #undef PK
  }
}

#ifndef ATTN_STORE16
#define ATTN_STORE16(p,v) (*(u32x4*)(p)=(v))
#endif
template<int THRL> __device__ __forceinline__ void attn_unit(const bf16*Qw0,int QP,const bf16*Kh,int KP,const bf16*Vh,int VP,bf16*Ow0,int OP,int NT,char*shm,float mref){
  int tid=threadIdx.x; asm volatile("":"+v"(tid));
  const int lane=tid&63,r32=lane&31,hi=lane>>5; const int wid=__builtin_amdgcn_readfirstlane(tid>>6);
  const bf16*Qw=Qw0+(long)wid*QBLK*QP;
  const unsigned lds0=(unsigned)(uintptr_t)shm;
  float*wsf=(float*)(shm+LDS_WS)+wid*64;
  const bf16*ksrc=Kh+(long)lane*KP+wid*8;
  const bf16*vsrc=Vh+(long)(16*(wid&3)+(lane>>2))*VP+(wid>>2)*32+(lane&3)*8;
  const unsigned kdst=lds0+LDS_K+wid*1024, vdst=lds0+LDS_V+wid*1024;
  #define DMA_K(t,slot) glds16(ksrc+(long)(t)*KVBLK*KP,(unsigned)__builtin_amdgcn_readfirstlane(kdst+(slot)))
  #define DMA_V(t,slot) glds16(vsrc+(long)(t)*KVBLK*VP,(unsigned)__builtin_amdgcn_readfirstlane(vdst+(slot)))
  const int vb0=(int)(lds0+LDS_V)+((lane>>4)&1)*32+(lane&3)*8+(4*hi+((lane&15)>>2))*64;
  const char*Kbase=shm+LDS_K; bf16x8 kf[8];
  const lds_cptr shm3=(lds_cptr)shm; const lds_cptr kp0=shm3+LDS_K+hi*1024+r32*16; const lds_cptr vp0=shm3+LDS_V+((lane>>4)&1)*32+(lane&3)*8+(4*hi+((lane&15)>>2))*64;
  DMA_K(0,0);DMA_V(0,0);DMA_K(1,SLOTB);
  bf16x8 qr[4];
  #pragma unroll
  for(int d0=0;d0<4;++d0)qr[d0]=*reinterpret_cast<const bf16x8*>(&Qw[(long)r32*QP+d0*16+hi*8]);
  float l_reg=0.f;f32x16 o[2];o[0]=f32x16{};o[1]=f32x16{};f32x16 negm; _Pragma("unroll") for(int r=0;r<16;++r)negm[r]=-mref; asm volatile("":"+v"(negm));
  #define CMASK(P0,P1,t) do{}while(0)
  #define START(P0,P1) do{ _Pragma("unroll") for(int r=0;r<16;++r)P0[r]=__builtin_amdgcn_exp2f(P0[r]); }while(0)
  #define RESC() do{}while(0)
  f32x16 pA0,pA1,pB0,pB1;
  int sl_prev=0,sl_cur=0,sl_next=SLOTB;
  #define ROT() do{sl_prev=sl_cur;sl_cur=sl_next;sl_next=(sl_next==(NSLOT-1)*SLOTB)?0:sl_next+SLOTB;}while(0)
  DMA_K(2,2*SLOTB);
  WAIT_BAR(3);
  qkt(pA0,pA1,Kbase,qr,negm,r32,hi);asm volatile("s_nop 15\n\ts_nop 7":"+v"(pA0),"+v"(pA1));CMASK(pA0,pA1,0);
  START(pA0,pA1);
  _Pragma("unroll") for(int r=0;r<16;++r)pA1[r]=__builtin_amdgcn_exp2f(pA1[r]);
  WAIT_BAR(0);
  DMA_K(3,0);DMA_V(1,SLOTB);
  ROT();
  kload8(kf,kp0+sl_cur);
  WAIT_BAR(2);
  s16x4 vlo[8],vhi[8]; u32x4 pw0,pw1,pw2,pw3;
  #define PKW(P,B) cvtpk_s(P[B],P[B+1])
  #define PAF(k) __builtin_bit_cast(bf16x8,pw##k)
  #define VFR(i) (bf16x8){vlo[i][0],vlo[i][1],vlo[i][2],vlo[i][3],vhi[i][0],vhi[i][1],vhi[i][2],vhi[i][3]}
  #define PIN(x) asm volatile("":"+v"(x))
  #define MX3(a,b,c) __builtin_fmaxf(__builtin_fmaxf((a),(b)),(c))
  #define GAPA(MF,A0,A1,A2,A3,W0,W1,PW) do{ MF; sacc+=A0; sacc+=A1; sacc+=A2; sacc+=A3; PIN(sacc); W0; W1; PIN(PW); SBAR(); }while(0)
  #define EX(v) __builtin_amdgcn_exp2f(v)
  #define GAPB(MF,X,B) do{ MF; X[B]=EX(X[B]); X[B+1]=EX(X[B+1]); X[B+2]=EX(X[B+2]); X[B+3]=EX(X[B+3]); PIN(X); SBAR(); }while(0)
  #define VRD(i) do{ vlo[i]=vtr(vp_+(((i)>>2)*4096+((i)&3)*1024)); vhi[i]=vtr(vp_+(((i)>>2)*4096+((i)&3)*1024+512)); }while(0)
  #define KRD(G,j) do{ if(G){ kload2(kf,kp0+sl_next,j); SBAR(); } }while(0)
  #define STEP(C0,C1,P0,P1,t,GK,GV,GL) do{ SBAR(); \
    const lds_cptr vp_=vp0+sl_prev; \
    VRD(0); SBAR(); float sacc=(P0[0]+P0[1]); \
    GAPA(C0=__builtin_amdgcn_mfma_f32_32x32x16_bf16(kf[0],qr[0],negm,0,0,0), P0[2],P0[3],P0[4],P0[5],     pw0[0]=PKW(P0,0), pw0[1]=PKW(P0,2), pw0); \
    VRD(4); SBAR(); GAPA(C1=__builtin_amdgcn_mfma_f32_32x32x16_bf16(kf[1],qr[0],negm,0,0,0), P0[6],P0[7],P0[8],P0[9],     pw0[2]=PKW(P0,4), pw0[3]=PKW(P0,6), pw0); \
    VRD(1); SBAR(); GAPA(C0=__builtin_amdgcn_mfma_f32_32x32x16_bf16(kf[2],qr[1],C0,0,0,0),   P0[10],P0[11],P0[12],P0[13], pw1[0]=PKW(P0,8), pw1[1]=PKW(P0,10), pw1); \
    VRD(5); SBAR(); GAPA(C1=__builtin_amdgcn_mfma_f32_32x32x16_bf16(kf[3],qr[1],C1,0,0,0),   P0[14],P0[15],P1[0],P1[1],   pw1[2]=PKW(P0,12),pw1[3]=PKW(P0,14), pw1); \
    VRD(2); SBAR(); GAPA(C0=__builtin_amdgcn_mfma_f32_32x32x16_bf16(kf[4],qr[2],C0,0,0,0),   P1[2],P1[3],P1[4],P1[5],     pw2[0]=PKW(P1,0), pw2[1]=PKW(P1,2), pw2); \
    VRD(6); SBAR(); GAPA(C1=__builtin_amdgcn_mfma_f32_32x32x16_bf16(kf[5],qr[2],C1,0,0,0),   P1[6],P1[7],P1[8],P1[9],     pw2[2]=PKW(P1,4), pw2[3]=PKW(P1,6), pw2); \
    VRD(3); SBAR(); GAPA(C0=__builtin_amdgcn_mfma_f32_32x32x16_bf16(kf[6],qr[3],C0,0,0,0),   P1[10],P1[11],P1[12],P1[13], pw3[0]=PKW(P1,8), pw3[1]=PKW(P1,10), pw3); \
    VRD(7); SBAR(); GAPA(C1=__builtin_amdgcn_mfma_f32_32x32x16_bf16(kf[7],qr[3],C1,0,0,0),   P1[14],P1[15],0.f,0.f,       pw3[2]=PKW(P1,12),pw3[3]=PKW(P1,14), pw3); \
    l_reg+=sacc; \
    if(GK){DMA_K((t)+3,sl_cur);} if(GV){DMA_V((t)+1,sl_next);} \
    CMASK(C0,C1,t); \
    SBAR(); \
    GAPB(o[0]=__builtin_amdgcn_mfma_f32_32x32x16_bf16(PAF(0),VFR(0),o[0],0,0,0), C0,0); \
    GAPB(o[1]=__builtin_amdgcn_mfma_f32_32x32x16_bf16(PAF(0),VFR(4),o[1],0,0,0), C0,4); \
    KRD(GL,0); GAPB(o[0]=__builtin_amdgcn_mfma_f32_32x32x16_bf16(PAF(1),VFR(1),o[0],0,0,0), C0,8); \
    KRD(GL,1); GAPB(o[1]=__builtin_amdgcn_mfma_f32_32x32x16_bf16(PAF(1),VFR(5),o[1],0,0,0), C0,12); \
    KRD(GL,2); GAPB(o[0]=__builtin_amdgcn_mfma_f32_32x32x16_bf16(PAF(2),VFR(2),o[0],0,0,0), C1,0); \
    KRD(GL,3); GAPB(o[1]=__builtin_amdgcn_mfma_f32_32x32x16_bf16(PAF(2),VFR(6),o[1],0,0,0), C1,4); \
    GAPB(o[0]=__builtin_amdgcn_mfma_f32_32x32x16_bf16(PAF(3),VFR(3),o[0],0,0,0), C1,8); \
    GAPB(o[1]=__builtin_amdgcn_mfma_f32_32x32x16_bf16(PAF(3),VFR(7),o[1],0,0,0), C1,12); \
    }while(0)
  int t=1;
  #undef CMASK
  #define CMASK(P0,P1,t) do{}while(0)
  for(;t+5<NT;t+=2){
    STEP(pB0,pB1,pA0,pA1,t,true,true,true);     WAIT_BAR(2); RESC(); ROT();
    STEP(pA0,pA1,pB0,pB1,t+1,true,true,true);   WAIT_BAR(2); RESC(); ROT();
  }
  #undef CMASK
  #define CMASK(P0,P1,t) do{}while(0)
  #define ENDW(tt) do{ if((tt)+3<NT){WAIT_BAR(2);} else if((tt)+2<NT){WAIT_BAR(1);} else {WAIT_BAR(0);} }while(0)
  for(;t+1<NT;t+=2){
    STEP(pB0,pB1,pA0,pA1,t,(t+3<NT),(t+1<NT),(t+1<NT));       ENDW(t);   RESC(); ROT();
    STEP(pA0,pA1,pB0,pB1,t+1,(t+4<NT),(t+2<NT),(t+2<NT));     ENDW(t+1); RESC(); ROT();
  }
  STEP(pB0,pB1,pA0,pA1,NT-1,false,false,false); RESC();
  { float sacc=pB0[0]+pB0[1]; _Pragma("unroll") for(int r=2;r<16;++r)sacc+=pB0[r]; _Pragma("unroll") for(int r=0;r<16;++r)sacc+=pB1[r]; l_reg+=sacc;
    pw0=(u32x4){PKW(pB0,0),PKW(pB0,2),PKW(pB0,4),PKW(pB0,6)};pw1=(u32x4){PKW(pB0,8),PKW(pB0,10),PKW(pB0,12),PKW(pB0,14)};pw2=(u32x4){PKW(pB1,0),PKW(pB1,2),PKW(pB1,4),PKW(pB1,6)};pw3=(u32x4){PKW(pB1,8),PKW(pB1,10),PKW(pB1,12),PKW(pB1,14)};
    SBAR(); pv(o,vb0+sl_cur,PAF(0),PAF(1),PAF(2),PAF(3)); }
  #undef PKW
  #undef PAF
  #undef VFR
  #undef PIN
  #undef MX3
  #undef GAPA
  #undef GAPB
  #undef EX
  #undef VRD
  #undef KRD
  #undef STEP
  #undef ENDW
  {auto rr=__builtin_amdgcn_permlane32_swap(__float_as_uint(l_reg),__float_as_uint(l_reg),false,false);l_reg=__uint_as_float(rr[0])+__uint_as_float(rr[1]);}
  if(hi==0)wsf[32+r32]=l_reg;asm volatile("s_waitcnt lgkmcnt(0)":::"memory");
  float rli[16];
  #pragma unroll
  for(int r=0;r<16;++r)rli[r]=__builtin_amdgcn_rcpf(wsf[32+crow(r,hi)]);
  bf16*Ow=Ow0+(long)wid*QBLK*OP;
  { bf16*stg=(bf16*)(shm+LDS_OST)+wid*2048;
    #pragma unroll
    for(int r=0;r<16;++r){const int orow=crow(r,hi);
      #pragma unroll
      for(int d0=0;d0<2;++d0)stg[orow*64+d0*32+r32]=__float2bfloat16(o[d0][r]*rli[r]);}
    asm volatile("s_waitcnt lgkmcnt(0)":::"memory");
    #pragma unroll
    for(int i=0;i<4;++i){const int row=i*8+(lane>>3),ch=lane&7; const u32x4 v=*(const u32x4*)(stg+row*64+ch*8); ATTN_STORE16(Ow+(long)row*OP+ch*8,v);} }
  asm volatile("s_waitcnt lgkmcnt(0)\n\ts_barrier":::"memory");
  #undef DMA_K
  #undef DMA_V
  #undef CMASK
  #undef START
  #undef RESC
  #undef ROT
}
__device__ __forceinline__ void pv128(f32x16*o,int vb,bf16x8 pa0,bf16x8 pa1,bf16x8 pa2,bf16x8 pa3){
  #pragma unroll
  for(int d0=0;d0<4;++d0){s16x4 lo[4],hi[4];
    #pragma unroll
    for(int ks=0;ks<4;++ks){
      asm volatile("ds_read_b64_tr_b16 %0,%1 offset:%c2":"=&v"(lo[ks]):"v"(vb),"i"(d0*4096+ks*1024):"memory");
      asm volatile("ds_read_b64_tr_b16 %0,%1 offset:%c2":"=&v"(hi[ks]):"v"(vb),"i"(d0*4096+ks*1024+512):"memory");}
    asm volatile("s_waitcnt lgkmcnt(0)":::"memory");SBAR();
    #define PK(k) (bf16x8){lo[k][0],lo[k][1],lo[k][2],lo[k][3],hi[k][0],hi[k][1],hi[k][2],hi[k][3]}
    o[d0]=__builtin_amdgcn_mfma_f32_32x32x16_bf16(pa0,PK(0),o[d0],0,0,0);
    o[d0]=__builtin_amdgcn_mfma_f32_32x32x16_bf16(pa1,PK(1),o[d0],0,0,0);
    o[d0]=__builtin_amdgcn_mfma_f32_32x32x16_bf16(pa2,PK(2),o[d0],0,0,0);
    o[d0]=__builtin_amdgcn_mfma_f32_32x32x16_bf16(pa3,PK(3),o[d0],0,0,0);
    #undef PK
  }
}
constexpr int V128_V=NSLOT*SLOTB, V128_WS=V128_V+NSLOT*2*SLOTB, V128_Q=V128_WS+NW*64*4, V128_BYTES=V128_Q+NW*4096;
template<int THRL> __device__ __forceinline__ void attn_unit128(const bf16*Qw0,int QP,const bf16*Kh,int KP,const bf16*Vh,int VP,bf16*Ow0,int OP,int NT,char*shm,float kmax2){
  int tid=threadIdx.x; asm volatile("":"+v"(tid));
  const int lane=tid&63,r32=lane&31,hi=lane>>5; const int wid=__builtin_amdgcn_readfirstlane(tid>>6);
  const bf16*Qw=Qw0+(long)wid*QBLK*QP;
  const unsigned lds0=(unsigned)(uintptr_t)shm;
  float*wsf=(float*)(shm+V128_WS)+wid*64;
  const bf16*ksrc=Kh+(long)lane*KP+wid*8;
  const bf16*vsrc=Vh+(long)(16*(wid&3)+(lane>>2))*VP+(wid>>2)*32+(lane&3)*8;
  const unsigned kdst=lds0+LDS_K+wid*1024, vdst=lds0+V128_V+wid*1024;
  #define DMA_K(t,slot) glds16(ksrc+(long)(t)*KVBLK*KP,(unsigned)__builtin_amdgcn_readfirstlane(kdst+(slot)))
  #define DMA_V(t,slot) do{ glds16(vsrc+(long)(t)*KVBLK*VP,(unsigned)__builtin_amdgcn_readfirstlane(vdst+2*(slot))); glds16(vsrc+(long)(t)*KVBLK*VP+64,(unsigned)__builtin_amdgcn_readfirstlane(vdst+2*(slot)+8192)); }while(0)
  const int vb0=(int)(lds0+V128_V)+((lane>>4)&1)*32+(lane&3)*8+(4*hi+((lane&15)>>2))*64;
  const char*Kbase=shm+LDS_K; bf16x8 kf[8];
  const lds_cptr shm3=(lds_cptr)shm; const lds_cptr kp0=shm3+LDS_K+hi*1024+r32*16; const lds_cptr vp0=shm3+V128_V+((lane>>4)&1)*32+(lane&3)*8+(4*hi+((lane&15)>>2))*64;
  DMA_K(0,0);DMA_V(0,0);DMA_K(1,SLOTB);
  bf16x8 qr[4];
  #pragma unroll
  for(int d0=0;d0<4;++d0)qr[d0]=*reinterpret_cast<const bf16x8*>(&Qw[(long)r32*QP+d0*16+hi*8]);
  const lds_cptr qlp=shm3+V128_Q+wid*4096+lane*16;
  { __attribute__((address_space(3))) bf16x8* qw_=(__attribute__((address_space(3))) bf16x8*)(__attribute__((address_space(3))) char*)qlp; qw_[0]=qr[0]; qw_[64]=qr[1]; qw_[128]=qr[2]; qw_[192]=qr[3]; }
  float mhat,l_reg=0.f;
  { float qq=0.f; _Pragma("unroll") for(int d0=0;d0<4;++d0) _Pragma("unroll") for(int j=0;j<8;++j){ const float x=__uint_as_float(((unsigned)(unsigned short)qr[d0][j])<<16); qq+=x*x; }
    qq+=__shfl_xor(qq,32); mhat=fminf(sqrtf(qq*kmax2)*1.01f+1e-20f,96.0f); }
  f32x16 negm; _Pragma("unroll") for(int r=0;r<16;++r)negm[r]=-mhat; asm volatile("":"+v"(negm));
  f32x16 o[4];
  _Pragma("unroll") for(int d_=0;d_<4;++d_){ _Pragma("unroll") for(int r=0;r<16;++r)o[d_][r]=0.f; asm volatile("":"+v"(o[d_])); }
  #define CMASK(P0,P1,t) do{}while(0)
  #define START(P0,P1) do{ _Pragma("unroll") for(int r=0;r<16;++r)P0[r]=__builtin_amdgcn_exp2f(P0[r]); }while(0)
  #define RESC() do{}while(0)
  f32x16 pA0,pA1,pB0,pB1;
  int sl_prev=0,sl_cur=0,sl_next=SLOTB;
  #define ROT() do{sl_prev=sl_cur;sl_cur=sl_next;sl_next=(sl_next==(NSLOT-1)*SLOTB)?0:sl_next+SLOTB;}while(0)
  DMA_K(2,2*SLOTB);
  WAIT_BAR(4);
  qkt(pA0,pA1,Kbase,qr,negm,r32,hi);asm volatile("s_nop 15\n\ts_nop 7":"+v"(pA0),"+v"(pA1));CMASK(pA0,pA1,0);
  START(pA0,pA1);
  _Pragma("unroll") for(int r=0;r<16;++r)pA1[r]=__builtin_amdgcn_exp2f(pA1[r]);
  WAIT_BAR(0);
  DMA_K(3,0);DMA_V(1,SLOTB);
  ROT();
  kload8(kf,kp0+sl_cur);
  WAIT_BAR(3);
  s16x4 vlo[4],vhi[4]; u32x4 pw0,pw1,pw2,pw3;
  #define PKW(P,B) cvtpk_s(P[B],P[B+1])
  #define PAF(k) __builtin_bit_cast(bf16x8,pw##k)
  #define VFR(i) (bf16x8){vlo[i][0],vlo[i][1],vlo[i][2],vlo[i][3],vhi[i][0],vhi[i][1],vhi[i][2],vhi[i][3]}
  #define PIN(x) asm volatile("":"+v"(x))
  #define MX3(a,b,c) __builtin_fmaxf(__builtin_fmaxf((a),(b)),(c))
  #define GAPA(MF,A0,A1,A2,A3,W0,W1,PW) do{ MF; sacc+=A0; sacc+=A1; sacc+=A2; sacc+=A3; PIN(sacc); W0; W1; PIN(PW); SBAR(); }while(0)
  #define EX(v) __builtin_amdgcn_exp2f(v)
  #define GAPB(MF,X,B) do{ MF; X[B]=EX(X[B]); X[B+1]=EX(X[B+1]); X[B+2]=EX(X[B+2]); X[B+3]=EX(X[B+3]); PIN(X); }while(0)
  #define GAPB2(MF,X,B) do{ MF; X[B]=EX(X[B]); X[B+1]=EX(X[B+1]); PIN(X); }while(0)
  #define VRW(e,d0,ks) do{ vlo[e]=vtr(vp_+((d0)*4096+(ks)*1024)); vhi[e]=vtr(vp_+((d0)*4096+(ks)*1024+512)); }while(0)
  #define KRD(G,j) do{ if(G){ kload2(kf,kp0+sl_next,j); SBAR(); } }while(0)
  #define STEP(C0,C1,P0,P1,t,GK,GV,GL) do{ SBAR(); \
    const lds_cptr vp_=vp0+2*sl_prev; \
    const bf16x8 q0_=*(const __attribute__((address_space(3))) bf16x8*)(qlp), q1_=*(const __attribute__((address_space(3))) bf16x8*)(qlp+1024);     \
    float sacc=(P0[0]+P0[1]); \
    GAPA(C0=__builtin_amdgcn_mfma_f32_32x32x16_bf16(kf[0],q0_,negm,0,0,0), P0[2],P0[3],P0[4],P0[5],     pw0[0]=PKW(P0,0), pw0[1]=PKW(P0,2), pw0); \
    GAPA(C1=__builtin_amdgcn_mfma_f32_32x32x16_bf16(kf[1],q0_,negm,0,0,0), P0[6],P0[7],P0[8],P0[9],     pw0[2]=PKW(P0,4), pw0[3]=PKW(P0,6), pw0); \
    const bf16x8 q2_=*(const __attribute__((address_space(3))) bf16x8*)(qlp+2048); SBAR(); \
    GAPA(C0=__builtin_amdgcn_mfma_f32_32x32x16_bf16(kf[2],q1_,C0,0,0,0),   P0[10],P0[11],P0[12],P0[13], pw1[0]=PKW(P0,8), pw1[1]=PKW(P0,10), pw1); \
    GAPA(C1=__builtin_amdgcn_mfma_f32_32x32x16_bf16(kf[3],q1_,C1,0,0,0),   P0[14],P0[15],P1[0],P1[1],   pw1[2]=PKW(P0,12),pw1[3]=PKW(P0,14), pw1); \
    const bf16x8 q3_=*(const __attribute__((address_space(3))) bf16x8*)(qlp+3072); SBAR(); \
    VRW(0,0,0); SBAR(); GAPA(C0=__builtin_amdgcn_mfma_f32_32x32x16_bf16(kf[4],q2_,C0,0,0,0),   P1[2],P1[3],P1[4],P1[5],     pw2[0]=PKW(P1,0), pw2[1]=PKW(P1,2), pw2); \
    VRW(1,1,0); SBAR(); GAPA(C1=__builtin_amdgcn_mfma_f32_32x32x16_bf16(kf[5],q2_,C1,0,0,0),   P1[6],P1[7],P1[8],P1[9],     pw2[2]=PKW(P1,4), pw2[3]=PKW(P1,6), pw2); \
    VRW(2,0,1); SBAR(); GAPA(C0=__builtin_amdgcn_mfma_f32_32x32x16_bf16(kf[6],q3_,C0,0,0,0),   P1[10],P1[11],P1[12],P1[13], pw3[0]=PKW(P1,8), pw3[1]=PKW(P1,10), pw3); \
    VRW(3,1,1); SBAR(); GAPA(C1=__builtin_amdgcn_mfma_f32_32x32x16_bf16(kf[7],q3_,C1,0,0,0),   P1[14],P1[15],0.f,0.f,       pw3[2]=PKW(P1,12),pw3[3]=PKW(P1,14), pw3); \
    l_reg+=sacc; \
    if(GK){DMA_K((t)+3,sl_cur);} if(GV){DMA_V((t)+1,sl_next);} \
      \
    SBAR(); \
    GAPB2(o[0]=__builtin_amdgcn_mfma_f32_32x32x16_bf16(PAF(0),VFR(0),o[0],0,0,0), C0,0); VRW(0,0,2); SBAR(); \
    GAPB2(o[1]=__builtin_amdgcn_mfma_f32_32x32x16_bf16(PAF(0),VFR(1),o[1],0,0,0), C0,2); VRW(1,1,2); SBAR(); \
    KRD(GL,0); GAPB2(o[0]=__builtin_amdgcn_mfma_f32_32x32x16_bf16(PAF(1),VFR(2),o[0],0,0,0), C0,4); VRW(2,0,3); SBAR(); \
    KRD(GL,1); GAPB2(o[1]=__builtin_amdgcn_mfma_f32_32x32x16_bf16(PAF(1),VFR(3),o[1],0,0,0), C0,6); VRW(3,1,3); SBAR(); \
    KRD(GL,2); GAPB2(o[0]=__builtin_amdgcn_mfma_f32_32x32x16_bf16(PAF(2),VFR(0),o[0],0,0,0), C0,8); VRW(0,2,0); SBAR(); \
    KRD(GL,3); GAPB2(o[1]=__builtin_amdgcn_mfma_f32_32x32x16_bf16(PAF(2),VFR(1),o[1],0,0,0), C0,10); VRW(1,3,0); SBAR(); \
    GAPB2(o[0]=__builtin_amdgcn_mfma_f32_32x32x16_bf16(PAF(3),VFR(2),o[0],0,0,0), C0,12); VRW(2,2,1); SBAR(); \
    GAPB2(o[1]=__builtin_amdgcn_mfma_f32_32x32x16_bf16(PAF(3),VFR(3),o[1],0,0,0), C0,14); VRW(3,3,1); SBAR(); \
    GAPB2(o[2]=__builtin_amdgcn_mfma_f32_32x32x16_bf16(PAF(0),VFR(0),o[2],0,0,0), C1,0); VRW(0,2,2); SBAR(); \
    GAPB2(o[3]=__builtin_amdgcn_mfma_f32_32x32x16_bf16(PAF(0),VFR(1),o[3],0,0,0), C1,2); VRW(1,3,2); SBAR(); \
    GAPB2(o[2]=__builtin_amdgcn_mfma_f32_32x32x16_bf16(PAF(1),VFR(2),o[2],0,0,0), C1,4); VRW(2,2,3); SBAR(); \
    GAPB2(o[3]=__builtin_amdgcn_mfma_f32_32x32x16_bf16(PAF(1),VFR(3),o[3],0,0,0), C1,6); VRW(3,3,3); SBAR(); \
    GAPB2(o[2]=__builtin_amdgcn_mfma_f32_32x32x16_bf16(PAF(2),VFR(0),o[2],0,0,0), C1,8); SBAR(); \
    GAPB2(o[3]=__builtin_amdgcn_mfma_f32_32x32x16_bf16(PAF(2),VFR(1),o[3],0,0,0), C1,10); SBAR(); \
    GAPB2(o[2]=__builtin_amdgcn_mfma_f32_32x32x16_bf16(PAF(3),VFR(2),o[2],0,0,0), C1,12); SBAR(); \
    GAPB2(o[3]=__builtin_amdgcn_mfma_f32_32x32x16_bf16(PAF(3),VFR(3),o[3],0,0,0), C1,14);  \
    }while(0)
  int t=1;
  #undef CMASK
  #define CMASK(P0,P1,t) do{}while(0)
  for(;t+5<NT;t+=2){
    STEP(pB0,pB1,pA0,pA1,t,true,true,true);     WAIT_BAR(3); RESC(); ROT();
    STEP(pA0,pA1,pB0,pB1,t+1,true,true,true);   WAIT_BAR(3); RESC(); ROT();
  }
  #undef CMASK
  #define CMASK(P0,P1,t) do{}while(0)
  #define ENDW(tt) do{ if((tt)+3<NT){WAIT_BAR(3);} else if((tt)+2<NT){WAIT_BAR(2);} else {WAIT_BAR(0);} }while(0)
  for(;t+1<NT;t+=2){
    STEP(pB0,pB1,pA0,pA1,t,(t+3<NT),(t+1<NT),(t+1<NT));       ENDW(t);   RESC(); ROT();
    STEP(pA0,pA1,pB0,pB1,t+1,(t+4<NT),(t+2<NT),(t+2<NT));     ENDW(t+1); RESC(); ROT();
  }
  STEP(pB0,pB1,pA0,pA1,NT-1,false,false,false); RESC();
  { float sacc=pB0[0]+pB0[1]; _Pragma("unroll") for(int r=2;r<16;++r)sacc+=pB0[r]; _Pragma("unroll") for(int r=0;r<16;++r)sacc+=pB1[r]; l_reg+=sacc;
    pw0=(u32x4){PKW(pB0,0),PKW(pB0,2),PKW(pB0,4),PKW(pB0,6)};pw1=(u32x4){PKW(pB0,8),PKW(pB0,10),PKW(pB0,12),PKW(pB0,14)};pw2=(u32x4){PKW(pB1,0),PKW(pB1,2),PKW(pB1,4),PKW(pB1,6)};pw3=(u32x4){PKW(pB1,8),PKW(pB1,10),PKW(pB1,12),PKW(pB1,14)};
    SBAR(); pv128(o,vb0+2*sl_cur,PAF(0),PAF(1),PAF(2),PAF(3)); }
  #undef PKW
  #undef PAF
  #undef VFR
  #undef PIN
  #undef MX3
  #undef GAPA
  #undef GAPB
  #undef GAPB2
  #undef EX
  #undef VRW
  #undef KRD
  #undef STEP
  #undef ENDW
  {auto rr=__builtin_amdgcn_permlane32_swap(__float_as_uint(l_reg),__float_as_uint(l_reg),false,false);l_reg=__uint_as_float(rr[0])+__uint_as_float(rr[1]);}
  if(hi==0)wsf[32+r32]=l_reg;asm volatile("s_waitcnt lgkmcnt(0)":::"memory");
  float rli[16];
  #pragma unroll
  for(int r=0;r<16;++r)rli[r]=__builtin_amdgcn_rcpf(wsf[32+crow(r,hi)]);
  bf16*Ow=Ow0+(long)wid*QBLK*OP;
  asm volatile("s_waitcnt lgkmcnt(0)\n\ts_barrier":::"memory");
  { bf16*stg=(bf16*)(shm)+wid*4096;
    #pragma unroll
    for(int r=0;r<16;++r){const int orow=crow(r,hi);
      #pragma unroll
      for(int d0=0;d0<4;++d0)stg[orow*128+d0*32+r32]=__float2bfloat16(o[d0][r]*rli[r]);}
    asm volatile("s_waitcnt lgkmcnt(0)":::"memory");
    #pragma unroll
    for(int i=0;i<8;++i){const int row=i*4+(lane>>4),ch=lane&15; const u32x4 v=*(const u32x4*)(stg+row*128+ch*8); ATTN_STORE16(Ow+(long)row*OP+ch*8,v);} }
  asm volatile("s_waitcnt lgkmcnt(0)\n\ts_barrier":::"memory");
  #undef DMA_K
  #undef DMA_V
  #undef CMASK
  #undef START
  #undef RESC
  #undef ROT
}
constexpr int ATTN_LDS_BYTES=LDS_BYTES;
#undef SBAR
#undef WAIT_BAR
}
#ifndef PROBE_MASK
#define PROBE_MASK 0ull
#endif
#ifndef PROBE_AMP
#define PROBE_AMP 4
#endif

constexpr int NWAVES = 8;
constexpr int DM = 1024, SEQ = 8192, NB = 2, CTXL = 256, NLAT = NB * SEQ, T = NLAT + NB * CTXL  , NKEY = SEQ + CTXL  ;
constexpr int NPXA = 2304, NPXB = 4096, INC = NPXA + NPXB;
constexpr float EPS = 1e-6f;
constexpr size_t MiB = 1u << 20;
constexpr size_t WS_CTL = 0, CTL_ZERO_BYTES = 1 * MiB, WS_MOD = 512 * 1024;
constexpr size_t WS_KMAX = 768 * 1024;
constexpr size_t WS_ROPE = 1 * MiB, WS_LAM = 1 * MiB + 65536;
constexpr size_t WS_WIN = 2 * MiB, WS_WA = 15 * MiB, WS_WB = 16 * MiB, WS_WC = 17 * MiB, WS_WO = 18 * MiB, WS_WQ = 20 * MiB;
constexpr size_t WS_U16 = 22 * MiB, WS_V16 = 54 * MiB;
constexpr size_t WS_SU = WS_U16 + 12 * MiB, WS_SV = WS_V16 + 12 * MiB; constexpr int ROW6 = 768;
constexpr size_t TAB_L = 16 * MiB;
static_assert(WS_SU + TAB_L + 16384 * 4 <= WS_V16 && WS_SV + TAB_L + 16384 * 4 <= 86 * MiB, "expert table regions");
constexpr size_t WS_X = 86 * MiB;
constexpr size_t WS_R1 = 152 * MiB;
constexpr size_t WS_R2 = 227 * MiB;
constexpr size_t SZ_QA = (size_t)NB * 4 * 2 * NKEY * 64 * 2, SZ_VA = (size_t)NB * 4 * NKEY * 128 * 2, SZ_QB = (size_t)NB * 8 * NKEY * 64 * 2, SZ_KB = (size_t)NB * 2 * NKEY * 64 * 2;
constexpr size_t WS_QA = WS_R2, WS_KA = WS_QA + SZ_QA, WS_VA = WS_KA + SZ_QA, WS_QB = WS_VA + SZ_VA, WS_KB = WS_QB + SZ_QB, WS_VB = WS_KB + SZ_KB;
constexpr size_t WS_MB = WS_R2, WS_EIDX = WS_R2 + 33 * MiB, WS_GW = WS_EIDX + (size_t)T * 128 * 4;
constexpr size_t WS_R3 = 306 * MiB;
constexpr size_t WS_R4 = 438 * MiB;
constexpr size_t SZ_O = (size_t)T * 512 * 2;
constexpr size_t WS_OABC = WS_R4, WS_HX = WS_R4;
constexpr size_t WS_SSQ = 488 * MiB;
constexpr size_t WS_BQ = 490 * MiB;
constexpr size_t WS_END = 491 * MiB;
static_assert(WS_VB + SZ_KB <= WS_R3 && WS_GW + (size_t)T * 128 * 4 <= WS_R3 && WS_R1 + (size_t)T * NPXA * 2 <= WS_R2 && WS_R3 + (size_t)T * NPXB * 2 <= WS_R4 && WS_OABC + 3 * SZ_O <= WS_END, "d_ws map");
constexpr int CW_TMO = 0, CW_BAR = 4096;
static_assert(CW_BAR * 4 + 3456 * 4 <= WS_MOD && WS_MOD + (size_t)2 * 3 * 6144 * 4 <= WS_KMAX && WS_KMAX + 512 <= CTL_ZERO_BYTES, "control-region map");

constexpr int RING_BYTES = 131072, LDSCTL_OFF = RING_BYTES, MISC_OFF = LDSCTL_OFF + 320, LDS_BYTES = 147456;

struct Args { const float* in[27]; float* out; unsigned char* ws; int ph_lo, ph_hi; };
struct Frame { LAS unsigned char* lds; volatile LAS unsigned* MISC; gu32* ctl; int tid, lane, wave, G, bid; };

typedef float f32x16 __attribute__((ext_vector_type(16)));
typedef short s16x4 __attribute__((ext_vector_type(4)));
typedef unsigned u32x2 __attribute__((ext_vector_type(2)));
typedef float f32x2 __attribute__((ext_vector_type(2)));
typedef float v32f __attribute__((ext_vector_type(32))); typedef __bf16 v32bf __attribute__((ext_vector_type(32))); typedef unsigned v6u __attribute__((ext_vector_type(6))); typedef unsigned v3u __attribute__((ext_vector_type(3)));
__device__ __forceinline__ float bf2f(unsigned short b) { return __uint_as_float((unsigned)b << 16); }
__device__ __forceinline__ float bflo(unsigned w) { return __uint_as_float(w << 16); }
__device__ __forceinline__ float bfhi(unsigned w) { return __uint_as_float(w & 0xffff0000u); }
__device__ __forceinline__ float sigm(float x) { return __builtin_amdgcn_rcpf(1.0f + __expf(-x)); }
__device__ __forceinline__ int mod_index(int row) { return row < SEQ ? 0 : (row < NLAT ? 1 : 2); }
__device__ __forceinline__ void row_to_bn(int row, int& b, int& nd) { if (row < NLAT) { b = row >> 13; nd = row & (SEQ - 1); } else { const int r = row - NLAT; b = r >> 8; nd = SEQ + (r & 255); } }

__device__ __forceinline__ void ph_prep0(const Args& a, Frame& F) {
    const int gtid = (F.G - 1 - F.bid) * 512 + F.tid;
    if (gtid < 2048) {
        const int pos = gtid >> 4, i = gtid & 15;
        double inv = 1.0; for (int k = 0; k < i; ++k) inv *= 0.5623413251903491;
        const double x = (double)pos * inv, TWO_PI = 6.283185307179586476925;
        const double kk = rint(x / TWO_PI), y = x - kk * TWO_PI, y2 = y * y;
        double ts = 1.0, tc = 1.0;
        for (int n = 14; n >= 1; --n) { ts = 1.0 - ts * y2 / (double)((2 * n) * (2 * n + 1)); tc = 1.0 - tc * y2 / (double)((2 * n - 1) * (2 * n)); }
        float* rp = (float*)(a.ws + WS_ROPE) + gtid * 2; rp[0] = (float)tc; rp[1] = (float)(y * ts);
    }
    if (gtid >= 2048 && gtid < 2050) {
        const int l = gtid - 2048; float s1 = 0.f, s2 = 0.f;
        for (int d = 0; d < 64; ++d) { s1 += a.in[7][l * 64 + d] * a.in[8][l * 64 + d]; s2 += a.in[9][l * 64 + d] * a.in[10][l * 64 + d]; }
        const float lam_init = l == 0 ? 0.2f : 0.35550906759096926f;
        float* lp = (float*)(a.ws + WS_LAM); lp[l * 2] = expf(s1) - expf(s2) + lam_init; lp[l * 2 + 1] = 1.0f - lam_init;
    }
    if (F.bid < 192) {
        float* MOD = (float*)(a.ws + WS_MOD); LAS float* sc = (LAS float*)F.lds; LAS float* red = sc + 3072;
        for (int i = F.tid; i < 3072; i += 512) { const int k = i & 1023; const float c = i < 1024 ? a.in[1][k] : (i < 2048 ? a.in[1][1024 + k] : a.in[3][k]); sc[i] = c * sigm(c); }
        __syncthreads();
        for (int u = F.bid; u < 192; u += F.G) {
            const int l = u / 96, cc = u % 96, kg = F.tid >> 4, c4 = F.tid & 15;
            const f32x4* W = (const f32x4*)(a.in[4] + (size_t)l * 1024 * 6144 + (size_t)(kg * 32) * 6144 + cc * 64 + 4 * c4);
            f32x4 s0 = {0.f, 0.f, 0.f, 0.f}, s1 = s0, s2 = s0;
#pragma unroll
            for (int h = 0; h < 2; ++h) { f32x4 w[16];
#pragma unroll
                for (int kk = 0; kk < 16; ++kk) w[kk] = W[(size_t)(h * 16 + kk) * (6144 / 4)];
#pragma unroll
                for (int kk = 0; kk < 16; ++kk) { const int k = kg * 32 + h * 16 + kk; s0 += sc[k] * w[kk]; s1 += sc[1024 + k] * w[kk]; s2 += sc[2048 + k] * w[kk]; } }
            *(LAS f32x4*)(red + (kg * 3 + 0) * 64 + 4 * c4) = s0; *(LAS f32x4*)(red + (kg * 3 + 1) * 64 + 4 * c4) = s1; *(LAS f32x4*)(red + (kg * 3 + 2) * 64 + 4 * c4) = s2;
            __syncthreads();
            if (F.tid < 192) { const int mi = F.tid >> 6, c = F.tid & 63; float s = a.in[5][l * 6144 + cc * 64 + c];
                for (int g = 0; g < 32; ++g) s += red[(g * 3 + mi) * 64 + c];
                MOD[(l * 3 + mi) * 6144 + cc * 64 + c] = s; }
            __syncthreads();
        }
    }
}
__device__ __forceinline__ void ph_convw(const Args& a, Frame& F, int l, int vb, int vG) {
    LAS float* scr = (LAS float*)(F.lds + F.wave * 16384);
    const int gw = vb * NWAVES + F.wave, NGW = vG * NWAVES;
    constexpr int I_IN = 16 * 200, I_BR = 8 * 32, I_O = 16 * 32, NITEMS = I_IN + 3 * I_BR + 2 * I_O;
    for (int it = gw; it < NITEMS; it += NGW) {
        int r = it;
        if (r < I_IN) { p0_transpose_item(a.in[6] + (size_t)l * 1024 * INC, 1024, INC, (bf16*)(a.ws + WS_WIN), 0, scr, r, F.lane); continue; } r -= I_IN;
        if (r < I_BR) { p0_transpose_item_p(a.in[18] + (size_t)l * 512 * 1024, 512, 1024, (bf16*)(a.ws + WS_WA), 1536, 0, scr, r, F.lane); continue; } r -= I_BR;
        if (r < I_BR) { p0_transpose_item_p(a.in[19] + (size_t)l * 512 * 1024, 512, 1024, (bf16*)(a.ws + WS_WA), 1536, 512, scr, r, F.lane); continue; } r -= I_BR;
        if (r < I_BR) { p0_transpose_item_p(a.in[20] + (size_t)l * 512 * 1024, 512, 1024, (bf16*)(a.ws + WS_WA), 1536, 1024, scr, r, F.lane); continue; } r -= I_BR;
        if (r < I_O) { p0_transpose_item(a.in[21] + (size_t)l * 1024 * 1024, 1024, 1024, (bf16*)(a.ws + WS_WO), 0, scr, r, F.lane); continue; } r -= I_O;
        p0_transpose_item(a.in[22] + (size_t)l * 1024 * 1024, 1024, 1024, (bf16*)(a.ws + WS_WQ), 0, scr, r, F.lane);
    }
    const int gtid = vb * 512 + F.tid, NT = vG * 512; constexpr int NI = 2 * 16384 * 32, NIH = 16384 * 32;
    const f32x4* us = (const f32x4*)(a.in[24] + (size_t)l * 16384 * 1024); const f32x4* vs = (const f32x4*)(a.in[25] + (size_t)l * 16384 * 1024);
    for (int i0 = gtid; i0 < NI; i0 += 2 * NT) { f32x4 p_[2][8];
#pragma unroll
        for (int u_ = 0; u_ < 2; ++u_) { const int i = min(i0 + u_ * NT, NI - 1); const bool isv = i >= NIH; const int j = isv ? i - NIH : i; const f32x4* sp = (isv ? vs : us) + 8 * (size_t)j;
#pragma unroll
            for (int q = 0; q < 8; ++q) p_[u_][q] = sp[q]; }
#pragma unroll
        for (int u_ = 0; u_ < 2; ++u_) { const int i = min(i0 + u_ * NT, NI - 1); const bool isv = i >= NIH; const int j = isv ? i - NIH : i;
            float m = 0.f;
#pragma unroll
            for (int q = 0; q < 8; ++q) m = fmaxf(fmaxf(m, fmaxf(fabsf(p_[u_][q][0]), fabsf(p_[u_][q][1]))), fmaxf(fabsf(p_[u_][q][2]), fabsf(p_[u_][q][3])));
#pragma unroll
            for (int o = 16; o >= 1; o >>= 1) m = fmaxf(m, __shfl_xor(m, o));
            const float sc = m > 0.f ? 7.5f * __builtin_amdgcn_rcpf(m) : 1.0f, inv = m > 0.f ? m * (1.0f / 7.5f) : 1.0f;
            v32bf bv;
#pragma unroll
            for (int q = 0; q < 8; ++q) { bv[4 * q] = (__bf16)(p_[u_][q][0] * sc); bv[4 * q + 1] = (__bf16)(p_[u_][q][1] * sc); bv[4 * q + 2] = (__bf16)(p_[u_][q][2] * sc); bv[4 * q + 3] = (__bf16)(p_[u_][q][3] * sc); }
            const v6u o = __builtin_amdgcn_cvt_scalef32_pk32_fp6_bf16(bv, 1.0f);
            if (i0 + u_ * NT < NI) { unsigned char* dp = a.ws + (isv ? WS_V16 : WS_U16) + (size_t)l * TAB_L + (size_t)(j >> 5) * ROW6 + 24 * (j & 31);
                *(u32x2*)dp = (u32x2){o[0], o[1]}; *(u32x2*)(dp + 8) = (u32x2){o[2], o[3]}; *(u32x2*)(dp + 16) = (u32x2){o[4], o[5]};
                if ((j & 31) == 0) ((float*)(a.ws + (isv ? WS_SV : WS_SU) + (size_t)l * TAB_L))[j >> 5] = inv; } } }
}
__device__ __forceinline__ void ph_mod(const Args& a, Frame& F, int l, int which) {
    const float* MOD = (const float*)(a.ws + WS_MOD) + (size_t)l * 3 * 6144 + (which ? 3072 : 0);
    const bool from_in = (l == 0 && which == 0);
    const float* X = from_in ? a.in[0] : (const float*)(a.ws + WS_X); const float* XC = from_in ? a.in[2] - (size_t)NLAT * DM : X; bf16* HX = (bf16*)(a.ws + WS_HX);
    const int gw = F.bid * NWAVES + F.wave, NGW = F.G * NWAVES; const int TL = (l == 1 && which == 1) ? NLAT : T;
    for (int row0 = gw; row0 < TL; row0 += 2 * NGW) {
        f32x4 v[2][4]; float ss[2];
#pragma unroll
        for (int u_ = 0; u_ < 2; ++u_) { const int row = min(row0 + u_ * NGW, TL - 1); const f32x4* xr = (const f32x4*)((row < NLAT ? X : XC) + (size_t)row * DM) + F.lane; ss[u_] = 0.f;
#pragma unroll
            for (int j = 0; j < 4; ++j) v[u_][j] = xr[64 * j]; }
#pragma unroll
        for (int u_ = 0; u_ < 2; ++u_) {
#pragma unroll
            for (int j = 0; j < 4; ++j) ss[u_] += (v[u_][j][0] * v[u_][j][0] + v[u_][j][1] * v[u_][j][1]) + (v[u_][j][2] * v[u_][j][2] + v[u_][j][3] * v[u_][j][3]); }
#pragma unroll
        for (int u_ = 0; u_ < 2; ++u_) { const int row = row0 + u_ * NGW; if (row < TL) {
            const float* sh = MOD + mod_index(row) * 6144; const float* sc = sh + 1024;
            const float rstd = rsqrtf(wave_sum(ss[u_]) * (1.0f / DM) + EPS);
#pragma unroll
            for (int j = 0; j < 4; ++j) { const int c = 4 * F.lane + 256 * j; const f32x4 s1 = *(const f32x4*)(sc + c), s0 = *(const f32x4*)(sh + c);
                const f32x4 h = v[u_][j] * rstd * (s1 + 1.0f) + s0; u32x2 o; o.x = pk2(h[0], h[1]); o.y = pk2(h[2], h[3]); *(u32x2*)(HX + (size_t)row * DM + c) = o; } } }
    }
}
__device__ __forceinline__ void ph_post(const Args& a, Frame& F, int l) {
    const bf16* PXa = (const bf16*)(a.ws + WS_R1); const float* rope = (const float*)(a.ws + WS_ROPE);
    const int gw = F.bid * NWAVES + F.wave, NGW = F.G * NWAVES, lane = F.lane;
    float km0_ = 0.f, km1_ = 0.f;
    {
        const int c = lane & 7, g8 = lane >> 3;
        float qw[8], kw[8];
#pragma unroll
        for (int j = 0; j < 8; ++j) { qw[j] = a.in[12][l * 64 + 8 * c + j]; kw[j] = a.in[13][l * 64 + 8 * c + j]; }
        float& km0 = km0_; float& km1 = km1_;
        for (int row = gw; row < T; row += NGW) {
            int b, nd; row_to_bn(row, b, nd);
            const bool lat = row < NLAT; const int pos = (c & 4) ? (nd & 63) : ((nd >> 6) & 127);
            float cs[8], sn[8];
            { const f32x4* rp = (const f32x4*)(rope + (pos * 16 + 8 * (c & 1)) * 2);
              const f32x4 r0 = rp[0], r1 = rp[1], r2 = rp[2], r3 = rp[3];
              cs[0] = r0[0]; sn[0] = r0[1]; cs[1] = r0[2]; sn[1] = r0[3]; cs[2] = r1[0]; sn[2] = r1[1]; cs[3] = r1[2]; sn[3] = r1[3];
              cs[4] = r2[0]; sn[4] = r2[1]; cs[5] = r2[2]; sn[5] = r2[3]; cs[6] = r3[0]; sn[6] = r3[1]; cs[7] = r3[2]; sn[7] = r3[3]; }
            const bf16* pr = PXa + (size_t)row * NPXA;
            v4u wv[5];
#pragma unroll
            for (int it = 0; it < 5; ++it) { const int hv = min(8 * it + g8, 35); wv[it] = *(const v4u*)(pr + hv * 64 + 8 * c); }
#pragma unroll
            for (int it = 0; it < 5; ++it) {
                const int hv = 8 * it + g8;
                float x[8]; x[0] = bflo(wv[it].x); x[1] = bfhi(wv[it].x); x[2] = bflo(wv[it].y); x[3] = bfhi(wv[it].y); x[4] = bflo(wv[it].z); x[5] = bfhi(wv[it].z); x[6] = bflo(wv[it].w); x[7] = bfhi(wv[it].w);
                const bool is_v = (hv >= 8 && hv < 16) || hv == 18 || hv == 19;
                const bool nrm = (hv == 16 || hv == 17 || hv >= 28);
                float ss = 0.f;
#pragma unroll
                for (int j = 0; j < 8; ++j) ss += x[j] * x[j];
                ss += __shfl_xor(ss, 1); ss += __shfl_xor(ss, 2); ss += __shfl_xor(ss, 4);
                const float rs = rsqrtf(ss * (1.0f / 64.0f) + EPS);
                if (it == 0) { if (b == 0) km0 = fmaxf(km0, ss); else km1 = fmaxf(km1, ss); }
                const float qs = hv >= 20 ? 0.18033688011112042f : 1.0f;
#pragma unroll
                for (int j = 0; j < 8; ++j) { if (nrm) x[j] *= rs * (hv >= 28 ? qw[j] : kw[j]); }
                const bool rot = lat && !is_v;
#pragma unroll
                for (int j = 0; j < 8; ++j) { const float p = __shfl_xor(x[j], 2); const float r = x[j] * cs[j] + ((c & 2) ? p : -p) * sn[j]; x[j] = (rot ? r : x[j]) * qs; }
                v4u o; o.x = pk2(x[0], x[1]); o.y = pk2(x[2], x[3]); o.z = pk2(x[4], x[5]); o.w = pk2(x[6], x[7]);
                unsigned off;
                if (hv < 8) off = (unsigned)WS_KA + (((unsigned)(b * 8 + hv) * NKEY + nd) * 64 + 8 * c) * 2;
                else if (hv < 16) off = (unsigned)WS_VA + (((unsigned)(b * 4 + ((hv - 8) >> 1)) * NKEY + nd) * 128 + ((hv - 8) & 1) * 64 + 8 * c) * 2;
                else if (hv < 18) off = (unsigned)WS_KB + (((unsigned)(b * 2 + (hv - 16)) * NKEY + nd) * 64 + 8 * c) * 2;
                else if (hv < 20) off = (unsigned)WS_VB + (((unsigned)(b * 2 + (hv - 18)) * NKEY + nd) * 64 + 8 * c) * 2;
                else if (hv < 28) off = (unsigned)WS_QA + (((unsigned)(b * 8 + (hv - 20)) * NKEY + nd) * 64 + 8 * c) * 2;
                else off = (unsigned)WS_QB + (((unsigned)(b * 8 + (hv - 28)) * NKEY + nd) * 64 + 8 * c) * 2;
                if (hv < 36) *(v4u*)(a.ws + off) = o;
            }
        }
    }
    { LAS float* KM = (LAS float*)(F.lds + 70656);
      if ((lane & 7) == 0) { KM[(F.wave * 2 + 0) * 8 + (lane >> 3)] = km0_; KM[(F.wave * 2 + 1) * 8 + (lane >> 3)] = km1_; }
      __syncthreads();
      int t_ = F.tid; asm volatile("" : "+v"(t_));
      if (t_ < 16) { float m = 0.f;
#pragma unroll
          for (int w_ = 0; w_ < 8; ++w_) m = fmaxf(m, KM[w_ * 16 + t_]);
          atomicMax((unsigned*)(a.ws + WS_KMAX) + l * 64 + t_, __float_as_uint(m)); } }
    const bf16* PXb = (const bf16*)(a.ws + WS_R3); bf16* OC = (bf16*)(a.ws + WS_OABC) + 1024;
    LAS unsigned short* UL = (LAS unsigned short*)F.lds;
    LAS float* RED = (LAS float*)(F.lds + 65536);
    LAS float* STAT = (LAS float*)(F.lds + 68608);
    LAS float* MSK = (LAS float*)(F.lds + 69632);
    constexpr int TT = 33;
    const int c = F.tid;
    float w[31];
#pragma unroll
    for (int k = 0; k < 31; ++k) w[k] = a.in[14][(size_t)l * 31 * 512 + k * 512 + c];
    int vz; asm volatile("v_mov_b32 %0, 0" : "=v"(vz));
    const float cb = a.in[15][l * 512 + c], lnw = a.in[16][l * 512 + c], lnb = a.in[17][l * 512 + c];
    for (int ct = F.bid; ct < (l == 0 ? T / TT : (NLAT + TT - 1) / TT); ct += F.G) {
        const int t0 = ct * TT;
        int bnd = -1; { const int lo_ = t0 - 15, hi_ = t0 + TT + 15; if (lo_ < 0) bnd = 0; else if (SEQ > lo_ && SEQ < hi_) bnd = SEQ; else if (NLAT > lo_ && NLAT < hi_) bnd = NLAT; else if (NLAT + CTXL > lo_ && NLAT + CTXL < hi_) bnd = NLAT + CTXL; else if (hi_ > T) bnd = T; }
        if (F.tid < 128) { const int p = F.tid >> 6, i = F.tid & 63; const int r = t0 - 15 + i;
            MSK[p * 64 + i] = (i < TT + 30 && r >= 0 && r < T && (bnd < 0 || ((r < bnd) == (p == 0)))) ? 1.f : 0.f;
            MSK[128 + p * 64 + i] = (i < TT && (bnd < 0 ? p == 0 : (((t0 + i) < bnd) == (p == 0)))) ? 1.f : 0.f; }
        __syncthreads();
        float y[TT];
#pragma unroll
        for (int n = 0; n < TT; ++n) y[n] = 0.f;
        const int npass = bnd < 0 ? 1 : 2;
        for (int pass = 0; pass < npass; ++pass) {
            __syncthreads();
            { v4u ga_[8], gg_[8];
#pragma unroll
              for (int q = 0; q < 8; ++q) { const int it = min(F.tid + 512 * q, (TT + 30) * 64 - 1); const int i = it >> 6, j8 = (it & 63) * 8; const int r = min(max(t0 - 15 + i, 0), T - 1);
                  ga_[q] = *(const v4u*)(PXb + (size_t)r * NPXB + j8); gg_[q] = *(const v4u*)(PXb + (size_t)r * NPXB + 512 + j8); }
#pragma unroll
              for (int q = 0; q < 8; ++q) { const int it = F.tid + 512 * q; if (it < (TT + 30) * 64) { const int i = it >> 6, j8 = (it & 63) * 8; const float mk = MSK[pass * 64 + i];
                  v4u o;
#pragma unroll
                  for (int e = 0; e < 4; ++e) { const float u0 = bflo(ga_[q][e]) * sigm(bflo(gg_[q][e])) * mk, u1 = bfhi(ga_[q][e]) * sigm(bfhi(gg_[q][e])) * mk; o[e] = pk2(u0, u1); }
                  *(LAS v4u*)(UL + i * 512 + j8) = o; } }
            }
            __syncthreads();
            float u[TT + 30];
#pragma unroll
            for (int i = 0; i < TT + 30; ++i) u[i] = bf2f(UL[i * 512 + c]);
#pragma unroll
            for (int n = 0; n < TT; ++n) { float acc = cb;
#pragma unroll
                for (int k = 0; k < 31; ++k) acc += w[k] * u[n + k];
                y[n] += acc * MSK[128 + pass * 64 + n + vz]; if ((n & 3) == 3) __builtin_amdgcn_sched_barrier(0); }
        }
#pragma unroll
        for (int n = 0; n < TT; ++n) { float s1 = y[n], s2 = y[n] * y[n];
#pragma unroll
            for (int o = 32; o >= 1; o >>= 1) { s1 += __shfl_xor(s1, o); s2 += __shfl_xor(s2, o); }
            if (lane == 0) { RED[(F.wave * TT + n) * 2] = s1; RED[(F.wave * TT + n) * 2 + 1] = s2; } }
        __syncthreads();
        if (F.tid < TT) { const int n = F.tid; float s1 = 0.f, s2 = 0.f;
#pragma unroll
            for (int wv_ = 0; wv_ < 8; ++wv_) { s1 += RED[(wv_ * TT + n) * 2]; s2 += RED[(wv_ * TT + n) * 2 + 1]; }
            const float mu = s1 * (1.0f / 512.0f), var = fmaxf(s2 * (1.0f / 512.0f) - mu * mu, 0.f);
            STAT[2 * n] = mu; STAT[2 * n + 1] = rsqrtf(var + EPS); }
        __syncthreads();
#pragma unroll
        for (int n = 0; n < TT; ++n) {
            if ((n & 7) == 7) __builtin_amdgcn_sched_barrier(0);
            const float yn = (y[n] - STAT[2 * n + vz]) * STAT[2 * n + 1 + vz] * lnw + lnb;
            OC[(size_t)(t0 + n) * 1536 + c] = (unsigned short)f2bf(yn * sigm(yn)); }
        __syncthreads();
    }
}
__device__ __forceinline__ void ph_attn(const Args& a, Frame& F, int l, char* shm) {
    typedef attn_body::bf16 abf;
    const int xcd = F.bid & 7, idx = F.bid >> 3;
    const int nA = (F.G == 256) ? 2 + ((l == 0 && F.bid < 16) ? 1 : 0) : 0;
    for (int j = 0; j < nA; ++j) {
        const int st = j < 2 ? 2 * xcd + j : F.bid, qb = j < 2 ? idx : 32;
        const int kt0 = qb == 32 ? 128 : 0, NT = qb == 32 ? 4 : 132;
        const abf* Qp = (const abf*)(a.ws + WS_QA) + ((size_t)st * NKEY + qb * 256) * 64; const abf* Kp = (const abf*)(a.ws + WS_KA) + ((size_t)st * NKEY + kt0 * 64) * 64;
        const abf* Vp = (const abf*)(a.ws + WS_VA) + ((size_t)(st >> 1) * NKEY + kt0 * 64) * 128;
        abf* Op = (abf*)(a.ws + WS_R1) + ((size_t)st * NKEY + qb * 256) * 128;
        attn_body::attn_unit128<8>(Qp, 64, Kp, 64, Vp, 128, Op, 128, NT, shm, __uint_as_float(__hip_atomic_load((unsigned*)(a.ws + WS_KMAX) + l * 64 + st, __ATOMIC_RELAXED, __HIP_MEMORY_SCOPE_AGENT)));
    }
    float mq = 0.f, mk = 0.f; for (int d = 0; d < 64; ++d) { mq = fmaxf(mq, fabsf(a.in[12][l * 64 + d])); mk = fmaxf(mk, fabsf(a.in[13][l * 64 + d])); }
    const float mrefB = 64.0f * mq * mk * 0.18033688011112042f * 1.02f;
    const int nB = (F.G == 256) ? 2 + ((l == 0 && F.bid >= 16 && F.bid < 32) ? 1 : 0) : 0;
    for (int j = 0; j < nB; ++j) {
        const int st = j < 2 ? 2 * xcd + j : F.bid - 16, qb = j < 2 ? idx : 32;
        const int kt0 = qb == 32 ? 128 : 0, NT = qb == 32 ? 4 : 132;
        const int b = st >> 3, qh = st & 7, kvh = b * 2 + (qh >> 2);
        const abf* Qp = (const abf*)(a.ws + WS_QB) + ((size_t)st * NKEY + qb * 256) * 64; const abf* Kp = (const abf*)(a.ws + WS_KB) + ((size_t)kvh * NKEY + kt0 * 64) * 64;
        const abf* Vp = (const abf*)(a.ws + WS_VB) + ((size_t)kvh * NKEY + kt0 * 64) * 64;
        const int trow = qb == 32 ? NLAT + b * CTXL : b * SEQ + qb * 256;
        abf* Op = (abf*)(a.ws + WS_OABC) + (size_t)trow * 1536 + 512 + qh * 64;
        attn_body::attn_unit<8>(Qp, 64, Kp, 64, Vp, 64, Op, 1536, NT, shm, mrefB);
    }
}
__device__ __forceinline__ void ph_comb(const Args& a, Frame& F, int l) {
    const bf16* OA2 = (const bf16*)(a.ws + WS_R1); bf16* OA = (bf16*)(a.ws + WS_OABC);
    const float lam = ((const float*)(a.ws + WS_LAM))[l * 2], oml = ((const float*)(a.ws + WS_LAM))[l * 2 + 1];
    const int gw = F.bid * NWAVES + F.wave, NGW = F.G * NWAVES, lane = F.lane;
    const float w0 = a.in[11][l * 128 + 2 * lane] * oml, w1 = a.in[11][l * 128 + 2 * lane + 1] * oml;
    const int NIT = (l == 0 ? T : NLAT) * 4;
    for (int it0 = gw; it0 < NIT; it0 += 4 * NGW) {
        unsigned p1[4], p2[4]; int rowv[4], hv_[4];
#pragma unroll
        for (int j = 0; j < 4; ++j) { const int it = min(it0 + j * NGW, NIT - 1); const int row = it >> 2, h = it & 3; int b, nd; row_to_bn(row, b, nd); rowv[j] = row; hv_[j] = h;
            p1[j] = *(const unsigned*)(OA2 + ((size_t)((b * 4 + h) * 2 + 0) * NKEY + nd) * 128 + 2 * lane); p2[j] = *(const unsigned*)(OA2 + ((size_t)((b * 4 + h) * 2 + 1) * NKEY + nd) * 128 + 2 * lane); }
#pragma unroll
        for (int j = 0; j < 4; ++j) { if (it0 + j * NGW < NIT) {
            const float x0 = bflo(p1[j]) - lam * bflo(p2[j]), x1 = bfhi(p1[j]) - lam * bfhi(p2[j]);
            const float rstd = rsqrtf(wave_sum(x0 * x0 + x1 * x1) * (1.0f / 128.0f) + EPS);
            *(unsigned*)(OA + (size_t)rowv[j] * 1536 + hv_[j] * 128 + 2 * lane) = pk2(x0 * rstd * w0, x1 * rstd * w1); } }
    }
}
__constant__ unsigned char PK_CAND[50] = {0,1,2,3,4,5,6,7,8,9,10,11,12,13,14,15, 16,17,18,19,20,21,22,23, 32,33,34,35,36, 48,49,50,51, 64,65,66, 80,81, 96,97, 112,113, 128, 144, 160, 176, 192, 208, 224, 240};
__device__ __forceinline__ void ce_desc(float& x, float& y) { float hi_, lo_; asm("v_max_f32_e32 %0, %1, %2" : "=v"(hi_) : "v"(x), "v"(y)); asm("v_min_f32_e32 %0, %1, %2" : "=v"(lo_) : "v"(x), "v"(y)); x = hi_; y = lo_; }
__device__ __forceinline__ void sort16_desc(float (&v)[16]) {
#pragma unroll
    for (int k = 2; k <= 16; k <<= 1)
#pragma unroll
        for (int j = k >> 1; j > 0; j >>= 1)
#pragma unroll
            for (int i = 0; i < 16; ++i) { const int p = i ^ j; if (p > i) { if ((i & k) == 0) ce_desc(v[i], v[p]); else ce_desc(v[p], v[i]); } }
}
__device__ __forceinline__ void merge16_desc(float (&t)[16], const float (&v)[16]) {
#pragma unroll
    for (int i = 0; i < 16; ++i) { float m; asm("v_max_f32_e32 %0, %1, %2" : "=v"(m) : "v"(t[i]), "v"(v[15 - i])); t[i] = m; }
#pragma unroll
    for (int j = 8; j > 0; j >>= 1)
#pragma unroll
        for (int i = 0; i < 16; ++i) { const int p = i ^ j; if (p > i) ce_desc(t[i], t[p]); }
}
__device__ __forceinline__ void ph_topk(const Args& a, Frame& F, int l) {
    const float* PQ = (const float*)(a.ws + WS_R1); int* EIDX = (int*)(a.ws + WS_EIDX); float* GW = (float*)(a.ws + WS_GW);
    LAS unsigned char* KH = F.lds; LAS unsigned char* KLo = F.lds + 32768;
    LAS unsigned* XV = (LAS unsigned*)(F.lds + 65536);
    const int tid = F.tid, lane = F.lane, wave = F.wave;
    int cur_h = -1;
    for (int u = F.bid; u < ((l == 0 ? T : NLAT) / 256) * 8; u += F.G) {
        const int h = u & 7, t0 = (u >> 3) * 256;
        if (h != cur_h) { __syncthreads(); const float* ks = a.in[23] + ((size_t)l * 8 + h) * 2 * 128 * 64;
#pragma unroll
            for (int i = 0; i < 4; ++i) { const int ch = tid + 512 * i, krow = ch >> 3, c8 = ch & 7;
                const f32x4 x0 = *(const f32x4*)(ks + (size_t)krow * 64 + c8 * 8), x1 = *(const f32x4*)(ks + (size_t)krow * 64 + c8 * 8 + 4);
                float xs[8] = {x0[0], x0[1], x0[2], x0[3], x1[0], x1[1], x1[2], x1[3]}; unsigned hw[8], lw[8];
#pragma unroll
                for (int j = 0; j < 8; ++j) { hw[j] = f2bf(xs[j]); lw[j] = f2bf(xs[j] - __uint_as_float(hw[j] << 16)); }
                const int off = krow * 128 + ((c8 * 16) ^ ((krow & 7) << 4));
                *(LAS v4u*)(KH + off) = (v4u){hw[0] | (hw[1] << 16), hw[2] | (hw[3] << 16), hw[4] | (hw[5] << 16), hw[6] | (hw[7] << 16)};
                *(LAS v4u*)(KLo + off) = (v4u){lw[0] | (lw[1] << 16), lw[2] | (lw[3] << 16), lw[4] | (lw[5] << 16), lw[6] | (lw[7] << 16)}; }
            cur_h = h; __syncthreads(); }
        {
            const int r32 = lane & 31, hp = lane >> 5; const float* qp = PQ + (size_t)(t0 + 32 * wave + r32) * 1024 + h * 128 + hp * 8;
#pragma unroll
            for (int half = 0; half < 2; ++half) {
                bf16x8 bqh[4], bql[4];
#pragma unroll
                for (int ks = 0; ks < 4; ++ks) { const f32x4 x0 = *(const f32x4*)(qp + half * 64 + ks * 16), x1 = *(const f32x4*)(qp + half * 64 + ks * 16 + 4);
                    float xs[8] = {x0[0], x0[1], x0[2], x0[3], x1[0], x1[1], x1[2], x1[3]}; unsigned hw[8], lw[8];
#pragma unroll
                    for (int j = 0; j < 8; ++j) { hw[j] = f2bf(xs[j]); lw[j] = f2bf(xs[j] - __uint_as_float(hw[j] << 16)); }
                    bqh[ks] = __builtin_bit_cast(bf16x8, (v4u){hw[0] | (hw[1] << 16), hw[2] | (hw[3] << 16), hw[4] | (hw[5] << 16), hw[6] | (hw[7] << 16)});
                    bql[ks] = __builtin_bit_cast(bf16x8, (v4u){lw[0] | (lw[1] << 16), lw[2] | (lw[3] << 16), lw[4] | (lw[5] << 16), lw[6] | (lw[7] << 16)}); }
                float tv[16];
#pragma unroll
                for (int kt = 0; kt < 4; ++kt) {
                    f32x16 acc;
#pragma unroll
                    for (int r = 0; r < 16; ++r) acc[r] = 0.f;
                    const int krow = half * 128 + kt * 32 + r32;
#pragma unroll
                    for (int ks = 0; ks < 4; ++ks) { const int off = krow * 128 + ((32 * ks + 16 * hp) ^ ((krow & 7) << 4));
                        const bf16x8 ah = *(const LAS bf16x8*)(KH + off), al = *(const LAS bf16x8*)(KLo + off);
                        acc = __builtin_amdgcn_mfma_f32_32x32x16_bf16(ah, bqh[ks], acc, 0, 0, 0);
                        acc = __builtin_amdgcn_mfma_f32_32x32x16_bf16(al, bqh[ks], acc, 0, 0, 0);
                        acc = __builtin_amdgcn_mfma_f32_32x32x16_bf16(ah, bql[ks], acc, 0, 0, 0); }
                    float v[16];
#pragma unroll
                    for (int r = 0; r < 16; ++r) { const unsigned key = (unsigned)(32 * kt + (r & 3) + 8 * (r >> 2)) | (unsigned)(4 * hp); v[r] = __uint_as_float((__float_as_uint(acc[r]) & 0xffffff80u) | (127u - key)); }
                    sort16_desc(v);
                    if (kt == 0) {
#pragma unroll
                        for (int r = 0; r < 16; ++r) tv[r] = v[r]; }
                    else merge16_desc(tv, v);
                }
                float pv[16];
#pragma unroll
                for (int r = 0; r < 16; ++r) pv[r] = __shfl_xor(tv[r], 32);
                merge16_desc(tv, pv);
                if (hp == 0) { LAS unsigned* xo = XV + ((32 * wave + r32) * 2 + half) * 16;
#pragma unroll
                    for (int j = 0; j < 16; j += 4) *(LAS v4u*)(xo + j) = (v4u){__float_as_uint(tv[j]), __float_as_uint(tv[j + 1]), __float_as_uint(tv[j + 2]), __float_as_uint(tv[j + 3])}; }
            }
        }
        __syncthreads();
        if (tid < 256) {
            const int tok = tid; const LAS unsigned* xa = XV + (tok * 2) * 16; const LAS unsigned* xb = xa + 16;
            float fv[16];
#pragma unroll
            for (int r = 0; r < 16; ++r) fv[r] = -INFINITY;
            for (int ci = 0; ci < 50; ++ci) {
                const unsigned c = PK_CAND[ci];
                const float sm = __uint_as_float(xa[c >> 4] & 0xffffff80u) + __uint_as_float(xb[c & 15] & 0xffffff80u);
                float v = __uint_as_float((__float_as_uint(sm) & 0xffffff00u) | (255u - c));
#pragma unroll
                for (int r = 0; r < 16; ++r) { float hi_, lo_; asm("v_max_f32_e32 %0, %1, %2" : "=v"(hi_) : "v"(fv[r]), "v"(v)); asm("v_min_f32_e32 %0, %1, %2" : "=v"(lo_) : "v"(fv[r]), "v"(v)); fv[r] = hi_; v = lo_; }
            }
            float val[16]; int ex[16]; float mx = -INFINITY;
#pragma unroll
            for (int r = 0; r < 16; ++r) { const unsigned c = 255u - (__float_as_uint(fv[r]) & 255u); const unsigned ia = xa[c >> 4], ib = xb[c & 15];
                val[r] = __uint_as_float(ia & 0xffffff80u) + __uint_as_float(ib & 0xffffff80u); ex[r] = (int)((127u - (ia & 127u)) * 128u + (127u - (ib & 127u))); mx = fmaxf(mx, val[r]); }
            float sum = 0.f;
#pragma unroll
            for (int r = 0; r < 16; ++r) { val[r] = __expf(val[r] - mx); sum += val[r]; }
            const float inv = 1.0f / sum;
            int* eo = EIDX + (size_t)(t0 + tok) * 128 + h * 16; float* go = GW + (size_t)(t0 + tok) * 128 + h * 16;
#pragma unroll
            for (int r = 0; r < 16; r += 4) { *(v4u*)(eo + r) = (v4u){(unsigned)ex[r], (unsigned)ex[r + 1], (unsigned)ex[r + 2], (unsigned)ex[r + 3]};
                *(f32x4*)(go + r) = (f32x4){val[r] * inv, val[r + 1] * inv, val[r + 2] * inv, val[r + 3] * inv}; }
        }
        __syncthreads();
    }
}
__device__ __forceinline__ void fp8x16_to_f32(const v4u w, float (&f)[16]) {
#pragma unroll
    for (int q = 0; q < 4; ++q) { const auto lo = __builtin_amdgcn_cvt_pk_f32_fp8((int)w[q], false); const auto hi = __builtin_amdgcn_cvt_pk_f32_fp8((int)w[q], true);
        f[4 * q] = lo[0]; f[4 * q + 1] = lo[1]; f[4 * q + 2] = hi[0]; f[4 * q + 3] = hi[1]; }
}
__device__ __forceinline__ void xp_sort128(int& e_a, int& e_b, float& g_a, float& g_b, int lane) {
    asm volatile("" : "+v"(lane));
    unsigned a0 = ((unsigned)e_a << 7) | (unsigned)lane, a1 = ((unsigned)e_b << 7) | (unsigned)(64 + lane);
#pragma unroll
    for (int k = 2; k <= 128; k <<= 1) {
#pragma unroll
        for (int j = k >> 1; j >= 1; j >>= 1) {
            if (j == 64) { const unsigned lo = min(a0, a1), hi = max(a0, a1); a0 = lo; a1 = hi; }
            else {
                const bool lower = (lane & j) == 0;
                const bool asc0 = k >= 64 ? true : ((lane & k) == 0), asc1 = k == 64 ? false : (k == 128 ? true : ((lane & k) == 0));
                const unsigned o0 = (unsigned)__shfl_xor((int)a0, j), o1 = (unsigned)__shfl_xor((int)a1, j);
                a0 = (lower == asc0) ? min(a0, o0) : max(a0, o0); a1 = (lower == asc1) ? min(a1, o1) : max(a1, o1);
            }
        }
    }
    const int i0 = (int)(a0 & 127u), i1 = (int)(a1 & 127u);
    const float ga0 = __shfl(g_a, i0 & 63), gb0 = __shfl(g_b, i0 & 63), ga1 = __shfl(g_a, i1 & 63), gb1 = __shfl(g_b, i1 & 63);
    e_a = (int)(a0 >> 7); e_b = (int)(a1 >> 7); g_a = i0 < 64 ? ga0 : gb0; g_b = i1 < 64 ? ga1 : gb1;
}
template <int CTRL> __device__ __forceinline__ float dpp_f(float v) { return __builtin_bit_cast(float, __builtin_amdgcn_update_dpp(0, __builtin_bit_cast(int, v), CTRL, 0xf, 0xf, false)); }
#define XP_REDUCE8(D0, ZS) do { float e4[4], f2[2]; \
            _Pragma("unroll") for (int j = 0; j < 4; ++j) { const auto r = __builtin_amdgcn_permlane32_swap(__float_as_uint(d[(D0) + j]), __float_as_uint(d[(D0) + j + 4]), false, false); e4[j] = __uint_as_float(r[0]) + __uint_as_float(r[1]); } \
            _Pragma("unroll") for (int j = 0; j < 2; ++j) { const auto r = __builtin_amdgcn_permlane16_swap(__float_as_uint(e4[j]), __float_as_uint(e4[j + 2]), false, false); f2[j] = __uint_as_float(r[0]) + __uint_as_float(r[1]); } \
            const bool b3 = (lane & 8) != 0; \
            float zs = (b3 ? f2[1] : f2[0]) + dpp_f<0x128>(b3 ? f2[0] : f2[1]);     \
            zs += dpp_f<0xB1>(zs); zs += dpp_f<0x4E>(zs); zs += dpp_f<0x141>(zs);     \
            ZS = zs; } while (0)
#define XP_PAIRS(KB, KE) do { float z_a = 0.f, z_b = 0.f; \
        for (int k0 = (KB); k0 < (KE); k0 += 16) {     \
            v3u uw[16]; const int kk = k0 & 63; const int esel = k0 < 64 ? e_a : e_b; \
            _Pragma("unroll") for (int j = 0; j < 16; ++j) { const int so_ = __builtin_amdgcn_readlane(esel, kk + j) * ROW6; uw[j] = __builtin_bit_cast(v3u, __builtin_amdgcn_raw_buffer_load_b96(rU, voff, so_, 0)); } \
            float d[16]; \
            _Pragma("unroll") for (int j = 0; j < 16; j += 2) { const v6u pk = {uw[j].x, uw[j].y, uw[j].z, uw[j + 1].x, uw[j + 1].y, uw[j + 1].z}; const v32f r = __builtin_amdgcn_cvt_scalef32_pk32_f32_fp6(pk, 1.0f); \
                f32x2 s0 = {0.f, 0.f}, s1 = {0.f, 0.f}; \
                _Pragma("unroll") for (int i = 0; i < 8; ++i) { s0 = __builtin_elementwise_fma((f32x2){r[2 * i], r[2 * i + 1]}, hx2[i], s0); s1 = __builtin_elementwise_fma((f32x2){r[16 + 2 * i], r[17 + 2 * i]}, hx2[i], s1); } \
                d[j] = s0.x + s0.y; d[j + 1] = s1.x + s1.y; __builtin_amdgcn_sched_barrier(0); } \
            float zs0, zs1; XP_REDUCE8(0, zs0); XP_REDUCE8(8, zs1); \
              \
            const float t0 = __shfl(zs0, 8 * (lane & 7)), t1 = __shfl(zs1, 8 * (lane & 7)); \
            const int rel = lane - kk; const float tz = (rel & 8) ? t1 : t0; const bool mine = rel >= 0 && rel < 16; \
            if (k0 < 64) z_a = mine ? tz : z_a; else z_b = mine ? tz : z_b; } \
        float act_a, act_b; \
        { const float za = z_a * su_a, zb = z_b * su_b; act_a = 0.5f * za * (1.0f + erff(za * 0.70710678118654752f)) * g_a; act_b = 0.5f * zb * (1.0f + erff(zb * 0.70710678118654752f)) * g_b; } \
        for (int k0 = (KB); k0 < (KE); k0 += 16) {     \
            v3u vw[16]; const int kk = k0 & 63; const int esel = k0 < 64 ? e_a : e_b; const float asel = k0 < 64 ? act_a : act_b; \
            _Pragma("unroll") for (int j = 0; j < 16; ++j) { const int so_ = __builtin_amdgcn_readlane(esel, kk + j) * ROW6; vw[j] = __builtin_bit_cast(v3u, __builtin_amdgcn_raw_buffer_load_b96(rV, voff, so_, 0)); } \
            _Pragma("unroll") for (int j = 0; j < 16; j += 2) { const float act0 = __int_as_float(__builtin_amdgcn_readlane(__float_as_int(asel), kk + j)), act1 = __int_as_float(__builtin_amdgcn_readlane(__float_as_int(asel), kk + j + 1)); \
                const f32x2 a0 = {act0, act0}, a1 = {act1, act1}; \
                const v6u pk = {vw[j].x, vw[j].y, vw[j].z, vw[j + 1].x, vw[j + 1].y, vw[j + 1].z}; const v32f r = __builtin_amdgcn_cvt_scalef32_pk32_f32_fp6(pk, 1.0f); \
                _Pragma("unroll") for (int i = 0; i < 8; ++i) acc2[i] = __builtin_elementwise_fma((f32x2){r[2 * i], r[2 * i + 1]}, a0, acc2[i]); \
                __builtin_amdgcn_sched_barrier(0);     \
                _Pragma("unroll") for (int i = 0; i < 8; ++i) acc2[i] = __builtin_elementwise_fma((f32x2){r[16 + 2 * i], r[17 + 2 * i]}, a1, acc2[i]); \
                __builtin_amdgcn_sched_barrier(0); } } } while (0)
#define XP_UNPACK float acc[16]; _Pragma("unroll") for (int i = 0; i < 8; ++i) { acc[2 * i] = acc2[i].x; acc[2 * i + 1] = acc2[i].y; }
#define XP_LOAD_ROW(ROW) \
        f32x2 hx2[8]; f32x4 xrow[4];     \
        { const int mi_ = mod_index(ROW); const float* sh_ = MOD - 5120 + mi_ * 6144 + 3072; const float* sc_ = sh_ + 1024; float ss_ = 0.f; \
          _Pragma("unroll") for (int q = 0; q < 4; ++q) { xrow[q] = *(const f32x4*)(X + (size_t)(ROW) * DM + 16 * lane + 4 * q); ss_ += (xrow[q][0] * xrow[q][0] + xrow[q][1] * xrow[q][1]) + (xrow[q][2] * xrow[q][2] + xrow[q][3] * xrow[q][3]); } \
          const float rs_ = rsqrtf(wave_sum(ss_) * (1.0f / DM) + EPS); \
          _Pragma("unroll") for (int q = 0; q < 4; ++q) { const f32x4 s1_ = *(const f32x4*)(sc_ + 16 * lane + 4 * q), s0_ = *(const f32x4*)(sh_ + 16 * lane + 4 * q); const f32x4 h_ = xrow[q] * rs_ * (s1_ + 1.0f) + s0_; \
              hx2[2 * q] = (f32x2){h_[0], h_[1]}; hx2[2 * q + 1] = (f32x2){h_[2], h_[3]}; } } \
        int e_a = EIDX[(size_t)(ROW) * 128 + lane], e_b = EIDX[(size_t)(ROW) * 128 + 64 + lane]; \
        float g_a = GW[(size_t)(ROW) * 128 + lane], g_b = GW[(size_t)(ROW) * 128 + 64 + lane]; \
        xp_sort128(e_a, e_b, g_a, g_b, lane); \
        const float su_a = SU[e_a], su_b = SU[e_b]; g_a *= SV[e_a]; g_b *= SV[e_b];     \
        f32x2 acc2[8]; \
        _Pragma("unroll") for (int i = 0; i < 8; ++i) acc2[i] = (f32x2){0.f, 0.f};
#define XP_EPILOGUE(ROW) do { \
        const int mi = mod_index(ROW); const float* g2 = MOD + mi * 6144; float* xr = X + (size_t)(ROW) * DM + 16 * lane; \
        f32x4 xn[4]; float ss = 0.f; \
        _Pragma("unroll") for (int q = 0; q < 4; ++q) { const f32x4 g = *(const f32x4*)(g2 + 16 * lane + 4 * q); f32x4 x = xrow[q]; \
            x[0] += g[0] * acc[4 * q]; x[1] += g[1] * acc[4 * q + 1]; x[2] += g[2] * acc[4 * q + 2]; x[3] += g[3] * acc[4 * q + 3]; \
            xn[q] = x; ss += (x[0] * x[0] + x[1] * x[1]) + (x[2] * x[2] + x[3] * x[3]); } \
        const float rstd = rsqrtf(wave_sum(ss) * (1.0f / DM) + EPS); \
        if (l == 0) {     \
            const float* sh = (const float*)(a.ws + WS_MOD) + (size_t)(3 + mi) * 6144; const float* sc = sh + 1024; bf16* hxo = (bf16*)(a.ws + WS_HX) + (size_t)(ROW) * DM + 16 * lane; \
            _Pragma("unroll") for (int q = 0; q < 4; ++q) { *(f32x4*)(xr + 4 * q) = xn[q]; const f32x4 s1 = *(const f32x4*)(sc + 16 * lane + 4 * q), s0 = *(const f32x4*)(sh + 16 * lane + 4 * q); \
                const f32x4 hh = xn[q] * rstd * (s1 + 1.0f) + s0; u32x2 o; o.x = pk2(hh[0], hh[1]); o.y = pk2(hh[2], hh[3]); *(u32x2*)(hxo + 4 * q) = o; } \
        } else if ((ROW) < NLAT) {     \
            _Pragma("unroll") for (int q = 0; q < 4; ++q) *(f32x4*)(a.out + (size_t)(ROW) * DM + 16 * lane + 4 * q) = xn[q] * rstd * *(const f32x4*)(a.in[26] + 16 * lane + 4 * q); \
        } } while (0)
__device__ __forceinline__ void ph_expert(const Args& a, Frame& F, int l) {
    const __amdgpu_buffer_rsrc_t rU = __builtin_amdgcn_make_buffer_rsrc((void*)(a.ws + WS_U16 + (size_t)l * TAB_L), (short)0, 16384 * ROW6, 0x00020000), rV = __builtin_amdgcn_make_buffer_rsrc((void*)(a.ws + WS_V16 + (size_t)l * TAB_L), (short)0, 16384 * ROW6, 0x00020000);
    const float* SU = (const float*)(a.ws + WS_SU + (size_t)l * TAB_L); const float* SV = (const float*)(a.ws + WS_SV + (size_t)l * TAB_L);
    const int* EIDX = (const int*)(a.ws + WS_EIDX); const float* GW = (const float*)(a.ws + WS_GW); float* X = (float*)(a.ws + WS_X);
    const float* MOD = (const float*)(a.ws + WS_MOD) + (size_t)l * 3 * 6144 + 5120;
    const int gw = F.bid * NWAVES + F.wave, NGW = F.G * NWAVES, lane = F.lane; const int voff = 12 * lane;
    for (int row = gw; row < NLAT; row += NGW) {
        XP_LOAD_ROW(row)
        XP_PAIRS(0, 128);
        XP_UNPACK
        XP_EPILOGUE(row);
    }
    if (l == 0) {
        LAS float* PART = (LAS float*)F.lds;
        for (int r0 = NLAT + 2 * F.bid; r0 < T; r0 += 2 * F.G) {
            const int row = min(r0 + (F.wave >> 2), T - 1), qd = F.wave & 3;
            XP_LOAD_ROW(row)
            XP_PAIRS(32 * qd, 32 * qd + 32);
            XP_UNPACK
#pragma unroll
            for (int q = 0; q < 4; ++q) *(LAS f32x4*)(PART + F.wave * 1024 + 16 * lane + 4 * q) = (f32x4){acc[4 * q], acc[4 * q + 1], acc[4 * q + 2], acc[4 * q + 3]};
            __syncthreads();
            if (qd == 0 && r0 + (F.wave >> 2) < T) {
#pragma unroll
                for (int w_ = 1; w_ < 4; ++w_)
#pragma unroll
                    for (int q = 0; q < 4; ++q) { const f32x4 p = *(const LAS f32x4*)(PART + (F.wave + w_) * 1024 + 16 * lane + 4 * q); acc[4 * q] += p[0]; acc[4 * q + 1] += p[1]; acc[4 * q + 2] += p[2]; acc[4 * q + 3] += p[3]; }
                XP_EPILOGUE(row);
            }
            __syncthreads();
        }
    }
}
#undef XP_PAIRS
#undef XP_REDUCE8
#undef XP_UNPACK
#undef XP_LOAD_ROW
#undef XP_EPILOGUE
__device__ __forceinline__ void ph_final(const Args& a, Frame& F) {
    const float* X = (const float*)(a.ws + WS_X); const float* fw = a.in[26];
    const int gw = F.bid * NWAVES + F.wave, NGW = F.G * NWAVES;
    for (int row = gw; row < NLAT; row += NGW) {
        const f32x4* xr = (const f32x4*)(X + (size_t)row * DM) + F.lane; f32x4 v[4]; float ss = 0.f;
#pragma unroll
        for (int j = 0; j < 4; ++j) { v[j] = xr[64 * j]; ss += (v[j][0] * v[j][0] + v[j][1] * v[j][1]) + (v[j][2] * v[j][2] + v[j][3] * v[j][3]); }
        const float rstd = rsqrtf(wave_sum(ss) * (1.0f / DM) + EPS);
#pragma unroll
        for (int j = 0; j < 4; ++j) { const int c = 4 * F.lane + 256 * j; *(f32x4*)(a.out + (size_t)row * DM + c) = v[j] * rstd * *(const f32x4*)(fw + c); }
    }
}
__device__ __forceinline__ f32x16 small_tile_mma(const bf16* A, int lda, const bf16* Bt, int ldb, int K, int lane) {
    const int r32 = lane & 31, hp = lane >> 5;
    const bf16* ap = A + (size_t)r32 * lda + 8 * hp; const bf16* bp = Bt + (size_t)r32 * ldb + 8 * hp;
    f32x16 acc;
#pragma unroll
    for (int r = 0; r < 16; ++r) acc[r] = 0.f;
#pragma unroll 1
    for (int k0 = 0; k0 < K; k0 += 128) {
        bf16x8 af[8], bfr[8];
#pragma unroll
        for (int s_ = 0; s_ < 8; ++s_) { af[s_] = *(const bf16x8*)(ap + k0 + 16 * s_); bfr[s_] = *(const bf16x8*)(bp + k0 + 16 * s_); }
#pragma unroll
        for (int s_ = 0; s_ < 8; ++s_) acc = __builtin_amdgcn_mfma_f32_32x32x16_bf16(af[s_], bfr[s_], acc, 0, 0, 0);
    }
    return acc;
}
__device__ __forceinline__ void ph_biasq(const Args& a, Frame& F, int l) {
    const bf16* Wq = (const bf16*)(a.ws + WS_WQ); const float* MOD = (const float*)(a.ws + WS_MOD) + (size_t)l * 3 * 6144 + 3072; float* BQ = (float*)(a.ws + WS_BQ) + l * 3 * 1024;
    const int gw = F.bid * NWAVES + F.wave, NGW = F.G * NWAVES, lane = F.lane;
    for (int it = gw; it < 3 * 1024; it += NGW) { const int mi = it >> 10, n = it & 1023;
        const v4u w0 = *(const v4u*)(Wq + (size_t)n * 1024 + 16 * lane), w1 = *(const v4u*)(Wq + (size_t)n * 1024 + 16 * lane + 8); const f32x4* sp = (const f32x4*)(MOD + mi * 6144 + 16 * lane);
        const f32x4 a0 = sp[0], a1 = sp[1], a2 = sp[2], a3 = sp[3];
        float v = (a0[0] * bflo(w0.x) + a0[1] * bfhi(w0.x)) + (a0[2] * bflo(w0.y) + a0[3] * bfhi(w0.y)) + (a1[0] * bflo(w0.z) + a1[1] * bfhi(w0.z)) + (a1[2] * bflo(w0.w) + a1[3] * bfhi(w0.w))
                + (a2[0] * bflo(w1.x) + a2[1] * bfhi(w1.x)) + (a2[2] * bflo(w1.y) + a2[3] * bfhi(w1.y)) + (a3[0] * bflo(w1.z) + a3[1] * bfhi(w1.z)) + (a3[2] * bflo(w1.w) + a3[3] * bfhi(w1.w));
        v = wave_sum(v); if (lane == 0) BQ[mi * 1024 + n] = v; }
}
__device__ __forceinline__ void ctx_small_q(const Args& a, Frame& F) {
    unsigned char* ws = a.ws; const int lane = F.lane, r32 = lane & 31, hp = lane >> 5; constexpr int AP = 1032;
    LAS unsigned short* A32 = (LAS unsigned short*)F.lds;
    const float* X = (const float*)(ws + WS_X); const float* sh = (const float*)(ws + WS_MOD) + 2 * 6144 + 3072; const float* sc = sh + 1024;
    for (int t0 = F.bid * 2; t0 < 512; t0 += F.G * 2) {
        const int row0 = NLAT + 32 * (t0 >> 5);
#pragma unroll
        for (int q = 0; q < 4; ++q) { const int rl = F.wave * 4 + q; const f32x4* xr = (const f32x4*)(X + (size_t)(row0 + rl) * DM) + lane; f32x4 v[4]; float ss = 0.f;
#pragma unroll
            for (int j = 0; j < 4; ++j) { v[j] = xr[64 * j]; ss += (v[j][0] * v[j][0] + v[j][1] * v[j][1]) + (v[j][2] * v[j][2] + v[j][3] * v[j][3]); }
            const float rstd = rsqrtf(wave_sum(ss) * (1.0f / DM) + EPS);
#pragma unroll
            for (int j = 0; j < 4; ++j) { const int c = 4 * lane + 256 * j; const f32x4 s1 = *(const f32x4*)(sc + c), s0 = *(const f32x4*)(sh + c); const f32x4 h = v[j] * rstd * (s1 + 1.0f) + s0;
                u32x2 o; o.x = pk2(h[0], h[1]); o.y = pk2(h[2], h[3]); *(LAS u32x2*)(A32 + rl * AP + c) = o; } }
        __syncthreads();
        if (F.wave < 2 && t0 + F.wave < 512) { const int col0 = 32 * ((t0 + F.wave) & 31);
            const LAS unsigned short* ap = A32 + r32 * AP + 8 * hp; const bf16* bp = (const bf16*)(ws + WS_WQ) + (size_t)(col0 + r32) * 1024 + 8 * hp;
            f32x16 acc;
#pragma unroll
            for (int r = 0; r < 16; ++r) acc[r] = 0.f;
#pragma unroll 1
            for (int k0 = 0; k0 < 1024; k0 += 128) { bf16x8 af[8], bfr[8];
#pragma unroll
                for (int s_ = 0; s_ < 8; ++s_) { af[s_] = *(const LAS bf16x8*)(ap + k0 + 16 * s_); bfr[s_] = *(const bf16x8*)(bp + k0 + 16 * s_); }
#pragma unroll
                for (int s_ = 0; s_ < 8; ++s_) acc = __builtin_amdgcn_mfma_f32_32x32x16_bf16(af[s_], bfr[s_], acc, 0, 0, 0); }
            float* PQ = (float*)(ws + WS_R1);
#pragma unroll
            for (int r = 0; r < 16; ++r) { const int row = row0 + (r & 3) + 8 * (r >> 2) + 4 * hp; PQ[(size_t)row * 1024 + col0 + r32] = acc[r]; } }
        __syncthreads();
    }
}
__device__ __forceinline__ void ctx_small(const Args& a, Frame& F, int which  ) {
    if (F.wave >= 2) return;
    unsigned char* ws = a.ws; const int lane = F.lane, r32 = lane & 31, hp = lane >> 5;
    for (int tile = F.bid * 2 + F.wave; tile < 512; tile += F.G * 2) {
        const int row0 = NLAT + 32 * (tile >> 5), col0 = 32 * (tile & 31);
        if (which == 2) {
            const bf16* OABC = (const bf16*)(ws + WS_OABC); const bf16* Wcat = (const bf16*)(ws + WS_WA); const bf16* gate = (const bf16*)(ws + WS_R3) + 1024; bf16* Mb = (bf16*)(ws + WS_MB);
            float macc[16];
#pragma unroll
            for (int r = 0; r < 16; ++r) macc[r] = 0.f;
            for (int br = 0; br < 3; ++br) {
                const f32x16 acc = small_tile_mma(OABC + (size_t)row0 * 1536 + 512 * br, 1536, Wcat + (size_t)col0 * 1536 + 512 * br, 1536, 512, lane);
#pragma unroll
                for (int r = 0; r < 16; ++r) { const int row = row0 + (r & 3) + 8 * (r >> 2) + 4 * hp; macc[r] += sigm(bf2f(gate[(size_t)row * NPXB + 1024 * br + col0 + r32])) * acc[r]; }
            }
#pragma unroll
            for (int r = 0; r < 16; ++r) { const int row = row0 + (r & 3) + 8 * (r >> 2) + 4 * hp; Mb[(size_t)row * 1024 + col0 + r32] = (unsigned short)f2bf(macc[r]); }
        } else if (which == 3) {
            const f32x16 acc = small_tile_mma((const bf16*)(ws + WS_MB) + (size_t)row0 * 1024, 1024, (const bf16*)(ws + WS_WO) + (size_t)col0 * 1024, 1024, 1024, lane);
            const float g1 = ((const float*)(ws + WS_MOD))[2 * 6144 + 2048 + col0 + r32]; float* X = (float*)(ws + WS_X);
#pragma unroll
            for (int r = 0; r < 16; ++r) { const int row = row0 + (r & 3) + 8 * (r >> 2) + 4 * hp; X[(size_t)row * 1024 + col0 + r32] = a.in[2][(size_t)(row - NLAT) * 1024 + col0 + r32] + g1 * acc[r]; }
        } else {
            const f32x16 acc = small_tile_mma((const bf16*)(ws + WS_HX) + (size_t)row0 * 1024, 1024, (const bf16*)(ws + WS_WQ) + (size_t)col0 * 1024, 1024, 1024, lane);
            float* PQ = (float*)(ws + WS_R1);
#pragma unroll
            for (int r = 0; r < 16; ++r) { const int row = row0 + (r & 3) + 8 * (r >> 2) + 4 * hp; PQ[(size_t)row * 1024 + col0 + r32] = acc[r]; }
        }
    }
}
#define GEMM_RUN(EPI, g, E) do { pg8::StaticOrder S_; S_.init((g).M, (g).N, F.G, F.bid); pg8::gemm_phase<EPI, pg8::StaticOrder, true, true>(F.lds, g, S_, E); } while (0)

constexpr int N_PHASES = 25;
#ifndef MK_ONE_LAUNCH
#define MK_ONE_LAUNCH 1
#endif
__global__ void __launch_bounds__(NWAVES * 64, 2) mk_fwd(Args args) {
    extern __shared__ __attribute__((aligned(16))) unsigned char lds_raw[];
    Frame F;
    F.lds = (LAS unsigned char*)lds_raw; F.MISC = (volatile LAS unsigned*)(F.lds + MISC_OFF);
    F.tid = threadIdx.x; F.lane = F.tid & 63; F.wave = __builtin_amdgcn_readfirstlane(F.tid >> 6); F.G = gridDim.x; F.bid = blockIdx.x;
    F.ctl = (gu32*)(args.ws + WS_CTL);
    for (int u = F.tid; u < (LDS_BYTES - LDSCTL_OFF) / 4; u += NWAVES * 64) ((LAS unsigned*)(F.lds + LDSCTL_OFF))[u] = 0u;
    __syncthreads();
    XcdBarrier bar; bar.bar = (unsigned*)(F.ctl + CW_BAR); bar.x = 0; bar.st = nullptr;
    const bool multi = (args.ph_hi - args.ph_lo) > 1;
    if (multi) bar = xcd_barrier_post((unsigned*)(F.ctl + CW_BAR), F.MISC + 8);
    unsigned char* ws = args.ws;
    const int lo = args.ph_lo, hi = args.ph_hi;
    if (PROBE_MASK != 0ull) { if (F.tid == 0) { const unsigned long long now_ = __builtin_amdgcn_s_memrealtime(); F.MISC[16] = (unsigned)now_; F.MISC[17] = (unsigned)(now_ >> 32); } __syncthreads(); }
#define IN(k) (lo <= (k) && (k) < hi)
#define SEAM(k) do { if (IN(k) && IN((k) + 1)) { xcd_barrier(bar); \
    if (PROBE_MASK != 0ull) { if (F.tid == 0) { unsigned long long now_ = __builtin_amdgcn_s_memrealtime(); const unsigned long long prev_ = ((unsigned long long)F.MISC[17] << 32) | F.MISC[16]; \
        if ((PROBE_MASK >> (k)) & 1ull) { const unsigned long long until_ = now_ + PROBE_AMP * (now_ - prev_); while (__builtin_amdgcn_s_memrealtime() < until_) __builtin_amdgcn_s_sleep(32); now_ = __builtin_amdgcn_s_memrealtime(); } \
        F.MISC[16] = (unsigned)now_; F.MISC[17] = (unsigned)(now_ >> 32); } __syncthreads(); } } } while (0)
#ifndef ONLY_PHASE
#define ONLY_PHASE(s) 1
#endif
#define LAYER(l, B) \
    if (ONLY_PHASE(1) && IN((B) + 1) && (l) == 0) { ph_mod(args, F, l, 0); } if ((l) == 0) SEAM((B) + 1); \
    if (ONLY_PHASE(2) && IN((B) + 2)) { pg8::Gemm g{(const pg8::bf16_t*)(ws + WS_HX), (const pg8::bf16_t*)(ws + WS_WIN), T, INC, DM}; pg8::EpiG1 E{(pg8::bf16_t*)(ws + WS_R1), (pg8::bf16_t*)(ws + WS_R3)}; GEMM_RUN(pg8::EpiG1, g, E); } SEAM((B) + 2); \
    if (ONLY_PHASE(3) && IN((B) + 3)) { ph_post(args, F, l); } SEAM((B) + 3); \
    if (ONLY_PHASE(4) && IN((B) + 4)) { ph_attn(args, F, l, (char*)lds_raw); } SEAM((B) + 4); \
    if (ONLY_PHASE(5) && IN((B) + 5)) { ph_comb(args, F, l); } SEAM((B) + 5); \
    if (ONLY_PHASE(6) && IN((B) + 6)) { const pg8::bf16_t* gate = (const pg8::bf16_t*)(ws + WS_R3) + 1024; \
        if ((l) == 0) ctx_small(args, F, 2); \
        pg8::Gemm g{(const pg8::bf16_t*)(ws + WS_OABC), (const pg8::bf16_t*)(ws + WS_WA), NLAT, DM, 1536}; pg8::EpiG2 E{gate + 2048, (pg8::bf16_t*)(ws + WS_MB)}; pg8::MidG2 Mh{gate}; \
        { pg8::StaticOrder S_; S_.init(g.M, g.N, F.G, F.bid); pg8::gemm_phase<pg8::EpiG2, pg8::StaticOrder, true, true, pg8::MidG2>(F.lds, g, S_, E, Mh); } } SEAM((B) + 6); \
    if (ONLY_PHASE(7) && IN((B) + 7)) { ph_biasq(args, F, l); if ((l) == 0) ctx_small(args, F, 3); pg8::Gemm g{(const pg8::bf16_t*)(ws + WS_MB), (const pg8::bf16_t*)(ws + WS_WO), NLAT, DM, DM}; pg8::EpiG3 E{(float*)(ws + WS_X), (l) == 0 ? args.in[0] : (const float*)(ws + WS_X), (const float*)(ws + WS_MOD) + (size_t)(l) * 3 * 6144 + 2048, (pg8::bf16_t*)(ws + WS_HX), (const float*)(ws + WS_MOD) + (size_t)(l) * 3 * 6144 + 4096, (float*)(ws + WS_SSQ)}; GEMM_RUN(pg8::EpiG3, g, E); } SEAM((B) + 7); \
    if (ONLY_PHASE(9) && IN((B) + 9)) { if ((l) == 0) ctx_small_q(args, F); pg8::Gemm g{(const pg8::bf16_t*)(ws + WS_HX), (const pg8::bf16_t*)(ws + WS_WQ), NLAT, DM, DM}; pg8::EpiG4 E{(float*)(ws + WS_R1), (const float*)(ws + WS_SSQ), (const float*)(ws + WS_BQ) + (l) * 3 * 1024}; GEMM_RUN(pg8::EpiG4, g, E); } SEAM((B) + 9); \
    if (ONLY_PHASE(10) && IN((B) + 10)) { ph_topk(args, F, l); \
          \
        if ((l) == 0 && F.bid >= 16) ph_convw(args, F, 1, F.bid - 16, F.G - 16); } SEAM((B) + 10); \
    if (ONLY_PHASE(11) && IN((B) + 11)) { ph_expert(args, F, l); } if ((l) == 0) SEAM((B) + 11);

    if (ONLY_PHASE(0) && IN(0)) { ph_prep0(args, F); ph_convw(args, F, 0, F.bid, F.G); } SEAM(0);
    LAYER(0, 0)
    LAYER(1, 12)
    if (PROBE_MASK != 0ull && ((PROBE_MASK >> 23) & 1ull) && IN(23)) { __syncthreads(); if (F.tid == 0) { const unsigned long long now_ = __builtin_amdgcn_s_memrealtime(); const unsigned long long prev_ = ((unsigned long long)F.MISC[17] << 32) | F.MISC[16];
        const unsigned long long until_ = now_ + PROBE_AMP * (now_ - prev_); while (__builtin_amdgcn_s_memrealtime() < until_) __builtin_amdgcn_s_sleep(32); } __syncthreads(); }
#undef IN
#undef SEAM
}

extern "C" void kernel_launch(void* const* d_in, const int* in_sizes, int n_in, void* d_out, int out_size, void* d_ws, size_t ws_size, hipStream_t stream) {
    static int grid = 0;
    if (grid == 0) {
        if (n_in != 27 || out_size != NLAT * DM || ws_size < WS_END) { fprintf(stderr, "kernel_launch: unexpected shapes (n_in %d, out %d, ws %zu)\n", n_in, out_size, ws_size); grid = -1; return; }
        int dev = 0, cus = 0, per_cu = 0;
        if (hipGetDevice(&dev) != hipSuccess || hipDeviceGetAttribute(&cus, hipDeviceAttributeMultiprocessorCount, dev) != hipSuccess) { grid = -1; return; }
        if (hipFuncSetAttribute((const void*)mk_fwd, hipFuncAttributeMaxDynamicSharedMemorySize, LDS_BYTES) != hipSuccess) { fprintf(stderr, "kernel_launch: hipFuncSetAttribute failed\n"); grid = -1; return; }
        if (hipOccupancyMaxActiveBlocksPerMultiprocessor(&per_cu, (const void*)mk_fwd, NWAVES * 64, LDS_BYTES) != hipSuccess || per_cu < 1) { fprintf(stderr, "kernel_launch: occupancy query says %d blocks per CU\n", per_cu); (void)hipGetLastError(); grid = -1; return; }
        if (cus < 256) { fprintf(stderr, "kernel_launch: this kernel's phase maps are built for 256 workgroups (one per CU); the device reports %d CUs\n", cus); grid = -1; return; }
        grid = 256;
    }
    if (grid < 0) return;
    (void)hipMemsetAsync((char*)d_ws + WS_CTL, 0, CTL_ZERO_BYTES, stream);
    Args a{};
    for (int i = 0; i < 27; ++i) a.in[i] = (const float*)d_in[i];
    a.out = (float*)d_out; a.ws = (unsigned char*)d_ws;
#if MK_ONE_LAUNCH
    a.ph_lo = 0; a.ph_hi = N_PHASES;
    hipLaunchKernelGGL(mk_fwd, dim3(grid), dim3(NWAVES * 64), LDS_BYTES, stream, a);
#else
    for (int ph = 0; ph < N_PHASES; ++ph) { a.ph_lo = ph; a.ph_hi = ph + 1; hipLaunchKernelGGL(mk_fwd, dim3(grid), dim3(NWAVES * 64), LDS_BYTES, stream, a); }
#endif
}
```

```cpp
#include <hip/hip_runtime.h>
#include <cstdio>
#include <cstdint>
#include <cmath>
namespace pg8 {
#define PG8_LAS __attribute__((address_space(3)))
typedef unsigned short bf16_t;
typedef short bf16x8 __attribute__((ext_vector_type(8)));
typedef float f32x4 __attribute__((ext_vector_type(4)));
typedef unsigned u32x4 __attribute__((ext_vector_type(4)));
constexpr int BM = 256, BK = 64, HALF = 128, HTB = HALF * BK * 2  , STAGE_BYTES = 8 * HTB, NXCD = 8, WGM = 8;

__host__ __device__ __forceinline__ int lds_byte(int r, int c) { const int st = (r >> 4) * 2 + (c >> 5), rr = r & 15, cc = c & 31, ob = rr * 64 + cc * 2; return st * 1024 + (ob ^ (((ob >> 9) & 1) << 5)); }
__host__ __device__ __forceinline__ void stage_rc(int b, int& R, int& C) { const int st = b / 1024, sb = b % 1024, swz = sb ^ (((sb >> 9) & 1) << 5); R = (st >> 1) * 16 + swz / 64; C = (st & 1) * 32 + (swz % 64) / 2; }
__host__ __device__ __forceinline__ int perm32(int rho) { const int n = rho >> 4, i = rho & 15; return 8 * (i >> 2) + 4 * n + (i & 3); }

struct Unit { int pm, pn; };
struct Gemm { const bf16_t* A; const bf16_t* Bt; int M, N, K; };

struct StaticOrder {
    int nM, nN, nwg, G, c;
    __host__ __device__ void init(int M, int N, int G_, int c_) { nM = M / BM; nN = N / BM; nwg = nM * nN; G = G_; c = c_; }
    __host__ __device__ bool next(int i, Unit& u) const {
        const long L = (long)i * G + c; if (L >= nwg) return false;
        int wgid = (int)L; { const int q = nwg / NXCD, r = nwg % NXCD, xcd = wgid % NXCD, off = wgid / NXCD; wgid = (xcd < r ? xcd * (q + 1) : r * (q + 1) + (xcd - r) * q) + off; }
        const int nig = WGM * nN, gid = wgid / nig, fm = gid * WGM, gsz = (nM - fm) < WGM ? (nM - fm) : WGM;
        u.pm = fm + ((wgid % nig) % gsz); u.pn = (wgid % nig) / gsz; return true;
    }
    __device__ __forceinline__ void a_ready(const Unit&) const {}
    __device__ __forceinline__ void done(const Unit&) const {}
};

__device__ __forceinline__ unsigned cvt_pk_bf16(float lo, float hi) { unsigned r; asm volatile("v_cvt_pk_bf16_f32 %0, %1, %2" : "=v"(r) : "v"(lo), "v"(hi)); return r; }
typedef float f32x2 __attribute__((ext_vector_type(2)));
__device__ __forceinline__ float sigmoidf_(float x) { return __builtin_amdgcn_rcpf(1.0f + __expf(-x)); }
__device__ __forceinline__ float bf_lo(unsigned w) { return __uint_as_float(w << 16); }
__device__ __forceinline__ float bf_hi(unsigned w) { return __uint_as_float(w & 0xffff0000u); }
struct EpiG1 {
    static constexpr bool PERM = true, AFTER_DRAIN = false;
    bf16_t* Oa; bf16_t* Ob;
    __device__ __forceinline__ void operator()(const f32x4 (&acc)[2][2][4][2], const Unit& u, int wr, int wc, int fr, int fq) const {
        const int row0 = u.pm * BM + wr * 64 + fr; int colt = u.pn * BM; bf16_t* base = Oa; int ldc = 2304;
        if (colt >= 2304) { base = Ob; ldc = 4096; colt -= 2304; }
        const int col0 = colt + wc * 32 + 8 * fq;
#pragma unroll
        for (int ai = 0; ai < 2; ++ai)
#pragma unroll
            for (int m = 0; m < 4; ++m) { bf16_t* rowp = base + (size_t)(row0 + ai * HALF + m * 16) * ldc + col0;
#pragma unroll
                for (int bj = 0; bj < 2; ++bj) { const f32x4 v0 = acc[ai][bj][m][0], v1 = acc[ai][bj][m][1];
                    u32x4 w; w.x = cvt_pk_bf16(v0[0], v0[1]); w.y = cvt_pk_bf16(v0[2], v0[3]); w.z = cvt_pk_bf16(v1[0], v1[1]); w.w = cvt_pk_bf16(v1[2], v1[3]);
                    *(u32x4*)(rowp + bj * HALF) = w; } }
    }
};
struct MidG2 {
    static constexpr int SEG = 8;
    const bf16_t* gate;
    __device__ __forceinline__ void operator()(f32x4 (&acc)[2][2][4][2], const Unit& u, int wr, int wc, int fr, int fq, int seg) const {
        const int row0 = u.pm * BM + wr * 64 + fr; const int col0 = u.pn * BM + wc * 32 + 8 * fq; const bf16_t* gp = gate + (seg - 1) * 1024;
#define PG8_RATIO(N, D) ((1.0f + __expf(-(D))) * __builtin_amdgcn_rcpf(1.0f + __expf(-(N))))
#pragma unroll
        for (int ai = 0; ai < 2; ++ai)
#pragma unroll
          for (int mh = 0; mh < 2; ++mh) {
            u32x4 gn[2][2], gd[2][2];
#pragma unroll
            for (int mm = 0; mm < 2; ++mm)
#pragma unroll
                for (int bj = 0; bj < 2; ++bj) { const bf16_t* p = gp + (size_t)(row0 + ai * HALF + (2 * mh + mm) * 16) * 4096 + col0 + bj * HALF; gn[mm][bj] = *(const u32x4*)p; gd[mm][bj] = *(const u32x4*)(p + 1024); }
#pragma unroll
            for (int mm = 0; mm < 2; ++mm)
#pragma unroll
                for (int bj = 0; bj < 2; ++bj) { f32x4& v0 = acc[ai][bj][2 * mh + mm][0]; f32x4& v1 = acc[ai][bj][2 * mh + mm][1]; const u32x4 a_ = gn[mm][bj], b_ = gd[mm][bj];
                    v0[0] *= PG8_RATIO(bf_lo(a_.x), bf_lo(b_.x)); v0[1] *= PG8_RATIO(bf_hi(a_.x), bf_hi(b_.x)); v0[2] *= PG8_RATIO(bf_lo(a_.y), bf_lo(b_.y)); v0[3] *= PG8_RATIO(bf_hi(a_.y), bf_hi(b_.y));
                    v1[0] *= PG8_RATIO(bf_lo(a_.z), bf_lo(b_.z)); v1[1] *= PG8_RATIO(bf_hi(a_.z), bf_hi(b_.z)); v1[2] *= PG8_RATIO(bf_lo(a_.w), bf_lo(b_.w)); v1[3] *= PG8_RATIO(bf_hi(a_.w), bf_hi(b_.w)); }
            __builtin_amdgcn_sched_barrier(0);
          }
#undef PG8_RATIO
    }
};
struct EpiG2 {
    static constexpr bool PERM = true, AFTER_DRAIN = false;
    const bf16_t* gate;   bf16_t* Mb;
    __device__ __forceinline__ void operator()(const f32x4 (&acc)[2][2][4][2], const Unit& u, int wr, int wc, int fr, int fq) const {
        const int row0 = u.pm * BM + wr * 64 + fr; const int col0 = u.pn * BM + wc * 32 + 8 * fq;
#pragma unroll
        for (int ai = 0; ai < 2; ++ai)
#pragma unroll
            for (int m = 0; m < 4; ++m) { const size_t row = (size_t)(row0 + ai * HALF + m * 16);
#pragma unroll
                for (int bj = 0; bj < 2; ++bj) { const int c = col0 + bj * HALF;
                    const u32x4 gw = *(const u32x4*)(gate + row * 4096 + c);
                    f32x4 v0 = acc[ai][bj][m][0], v1 = acc[ai][bj][m][1];
                    v0[0] *= sigmoidf_(bf_lo(gw.x)); v0[1] *= sigmoidf_(bf_hi(gw.x)); v0[2] *= sigmoidf_(bf_lo(gw.y)); v0[3] *= sigmoidf_(bf_hi(gw.y));
                    v1[0] *= sigmoidf_(bf_lo(gw.z)); v1[1] *= sigmoidf_(bf_hi(gw.z)); v1[2] *= sigmoidf_(bf_lo(gw.w)); v1[3] *= sigmoidf_(bf_hi(gw.w));
                    u32x4 w; w.x = cvt_pk_bf16(v0[0], v0[1]); w.y = cvt_pk_bf16(v0[2], v0[3]); w.z = cvt_pk_bf16(v1[0], v1[1]); w.w = cvt_pk_bf16(v1[2], v1[3]);
                    *(u32x4*)(Mb + row * 1024 + c) = w; } }
    }
};
struct EpiG3 {
    static constexpr bool PERM = true, AFTER_DRAIN = false;
    float* X; const float* base;   const float* g1;
    bf16_t* Xs; const float* sc2;   float* SSQ;
    __device__ __forceinline__ void operator()(const f32x4 (&acc)[2][2][4][2], const Unit& u, int wr, int wc, int fr, int fq) const {
        const int row0 = u.pm * BM + wr * 64 + fr; const int col0 = u.pn * BM + wc * 32 + 8 * fq;
        const int rt = u.pm * BM; const int mi = rt < 8192 ? 0 : (rt < 16384 ? 1 : 2); const float* gp = g1 + mi * 6144; const float* sp = sc2 + mi * 6144;
        float ssq[2][4];
#pragma unroll
        for (int ai = 0; ai < 2; ++ai)
#pragma unroll
            for (int m = 0; m < 4; ++m) ssq[ai][m] = 0.f;
#pragma unroll
        for (int bj = 0; bj < 2; ++bj) { const int c = col0 + bj * HALF; const f32x4 ga = *(const f32x4*)(gp + c), gb = *(const f32x4*)(gp + c + 4);
            const f32x4 sa = *(const f32x4*)(sp + c) + 1.0f, sb = *(const f32x4*)(sp + c + 4) + 1.0f;
#pragma unroll
            for (int ai = 0; ai < 2; ++ai)
#pragma unroll
                for (int m = 0; m < 4; ++m) { const size_t ro = (size_t)(row0 + ai * HALF + m * 16) * 1024 + c; float* xp = X + ro; const float* bp = base + ro;
                    const f32x4 x0 = *(const f32x4*)bp + ga * acc[ai][bj][m][0], x1 = *(const f32x4*)(bp + 4) + gb * acc[ai][bj][m][1];
                    *(f32x4*)xp = x0; *(f32x4*)(xp + 4) = x1;
                    ssq[ai][m] += (x0[0] * x0[0] + x0[1] * x0[1]) + (x0[2] * x0[2] + x0[3] * x0[3]) + (x1[0] * x1[0] + x1[1] * x1[1]) + (x1[2] * x1[2] + x1[3] * x1[3]);
                    const f32x4 y0 = x0 * sa, y1 = x1 * sb; u32x4 w; w.x = cvt_pk_bf16(y0[0], y0[1]); w.y = cvt_pk_bf16(y0[2], y0[3]); w.z = cvt_pk_bf16(y1[0], y1[1]); w.w = cvt_pk_bf16(y1[2], y1[3]);
                    *(u32x4*)(Xs + ro) = w; } }
#pragma unroll
        for (int ai = 0; ai < 2; ++ai)
#pragma unroll
            for (int m = 0; m < 4; ++m) { float v = ssq[ai][m]; v += __shfl_xor(v, 16); v += __shfl_xor(v, 32);
                if (fq == 0) SSQ[(size_t)(row0 + ai * HALF + m * 16) * 16 + u.pn * 4 + wc] = v; }
    }
};
struct EpiG4 {
    static constexpr bool PERM = true, AFTER_DRAIN = false;
    float* O; const float* SSQ; const float* biasq;
    __device__ __forceinline__ void operator()(const f32x4 (&acc)[2][2][4][2], const Unit& u, int wr, int wc, int fr, int fq) const {
        const int row0 = u.pm * BM + wr * 64 + fr; const int col0 = u.pn * BM + wc * 32 + 8 * fq;
        const int rt = u.pm * BM; const int mi = rt < 8192 ? 0 : (rt < 16384 ? 1 : 2); const float* bq = biasq + mi * 1024;
        f32x4 ba[2], bb[2];
#pragma unroll
        for (int bj = 0; bj < 2; ++bj) { ba[bj] = *(const f32x4*)(bq + col0 + bj * HALF); bb[bj] = *(const f32x4*)(bq + col0 + bj * HALF + 4); }
#pragma unroll
        for (int ai = 0; ai < 2; ++ai)
#pragma unroll
            for (int m = 0; m < 4; ++m) { const size_t row = (size_t)(row0 + ai * HALF + m * 16); const f32x4* sq = (const f32x4*)(SSQ + row * 16);
                const f32x4 s = (sq[0] + sq[1]) + (sq[2] + sq[3]); const float rstd = rsqrtf(((s[0] + s[1]) + (s[2] + s[3])) * (1.0f / 1024.0f) + 1e-6f);
                float* op = O + row * 1024 + col0;
#pragma unroll
                for (int bj = 0; bj < 2; ++bj) { *(f32x4*)(op + bj * HALF) = acc[ai][bj][m][0] * rstd + ba[bj]; *(f32x4*)(op + bj * HALF + 4) = acc[ai][bj][m][1] * rstd + bb[bj]; } }
    }
};
struct NoMid { static constexpr int SEG = 0; __device__ __forceinline__ void operator()(f32x4 (&)[2][2][4][2], const Unit&, int, int, int, int, int) const {} };
template <class Epi, class Sched, bool ALIGN_EPI = false, bool SP2 = false, class Mid = NoMid>
__device__ __forceinline__ void gemm_phase(PG8_LAS unsigned char* lds, const Gemm g, const Sched& S, const Epi& E, const Mid& Mh = Mid()) {
    const int tid = threadIdx.x, wid = __builtin_amdgcn_readfirstlane(tid >> 6), lane = tid & 63, wr = wid >> 2, wc = wid & 3, fr = lane & 15, fq = lane >> 4;
    const int K = g.K, nt = K / BK;
    unsigned voffA[2], voffB[2];
#pragma unroll
    for (int i = 0; i < 2; ++i) { int R, C; stage_rc(tid * 16 + i * 8192, R, C); const int Rb = Epi::PERM ? ((R & ~31) + perm32(R & 31)) : R;
        voffA[i] = (unsigned)(R * K + C) * 2u; voffB[i] = (unsigned)(Rb * K + C) * 2u; }
    const size_t kstep = (size_t)(BK * 2);
    const size_t hstep = (size_t)HALF * K * 2;
    const size_t tstep = 2 * hstep;
    const unsigned ldsw = (unsigned)wid * 1024u;
    const int aoff = lds_byte(wr * 64 + fr, fq * 8), boff = lds_byte(wc * 32 + fr, fq * 8);
#define PG8_SA(b, h) (((b) * 2 + (h)) * HTB)
#define PG8_SB(b, h) ((4 + (b) * 2 + (h)) * HTB)
#define PG8_STAGE(bufoff, gbase, voff) do { _Pragma("unroll") for (int _i = 0; _i < 2; ++_i) \
        __builtin_amdgcn_global_load_lds((const unsigned*)((const char*)(gbase) + (voff)[_i]), (PG8_LAS unsigned*)(lds + (bufoff) + ldsw + _i * 8192), 16, 0, 0); } while (0)
#define PG8_LDA(dst, b, h) do { _Pragma("unroll") for (int m = 0; m < 4; ++m) _Pragma("unroll") for (int k = 0; k < 2; ++k) dst[m][k] = *(const PG8_LAS bf16x8*)(lds + PG8_SA(b, h) + aoff + m * 2048 + k * 1024); } while (0)
#define PG8_LDB(dst, b, h) do { _Pragma("unroll") for (int n = 0; n < 2; ++n) _Pragma("unroll") for (int k = 0; k < 2; ++k) dst[n][k] = *(const PG8_LAS bf16x8*)(lds + PG8_SB(b, h) + boff + n * 2048 + k * 1024); } while (0)
#define PG8_MMA(ai, bj, At, Bt) do { __builtin_amdgcn_s_setprio(1); _Pragma("unroll") for (int m = 0; m < 4; ++m) _Pragma("unroll") for (int n = 0; n < 2; ++n) _Pragma("unroll") for (int k = 0; k < 2; ++k) \
        acc[ai][bj][m][n] = __builtin_amdgcn_mfma_f32_16x16x32_bf16(Bt[n][k], At[m][k], acc[ai][bj][m][n], 0, 0, 0); __builtin_amdgcn_s_setprio(0); } while (0)
#define PG8_WAIT_V(n) asm volatile("s_waitcnt vmcnt(" #n ")" ::: "memory")
#define PG8_WAIT_L(n) asm volatile("s_waitcnt lgkmcnt(" #n ")" ::: "memory")
#define PG8_BAR __builtin_amdgcn_s_barrier()
#define PG8_SCHED __builtin_amdgcn_sched_barrier(0)
    Unit cur, nxt; int ui = 0;
    if (!S.next(0, cur)) return;
    f32x4 acc[2][2][4][2];
#pragma unroll
    for (int a = 0; a < 2; ++a)
#pragma unroll
        for (int b = 0; b < 2; ++b)
#pragma unroll
            for (int m = 0; m < 4; ++m)
#pragma unroll
                for (int n = 0; n < 2; ++n) acc[a][b][m][n] = (f32x4){0.f, 0.f, 0.f, 0.f};
    bf16x8 At[4][2], B0[2][2], B1[2][2];
    const char* cA = (const char*)g.A + (size_t)cur.pm * tstep; const char* cB = (const char*)g.Bt + (size_t)cur.pn * tstep;
    S.a_ready(cur);
    if constexpr (SP2) {
        PG8_STAGE(PG8_SB(0, 0), cB, voffB); PG8_STAGE(PG8_SB(0, 1), cB + hstep, voffB); PG8_STAGE(PG8_SA(0, 0), cA, voffA); PG8_STAGE(PG8_SA(0, 1), cA + hstep, voffA);
        if (wr == 1) PG8_BAR;
        PG8_WAIT_V(2); PG8_BAR;
        PG8_STAGE(PG8_SB(1, 0), cB + kstep, voffB); PG8_STAGE(PG8_SA(1, 0), cA + kstep, voffA); PG8_STAGE(PG8_SB(1, 1), cB + hstep + kstep, voffB);
        PG8_WAIT_V(6); PG8_BAR;
    } else {
        PG8_STAGE(PG8_SB(0, 0), cB, voffB); PG8_STAGE(PG8_SA(0, 0), cA, voffA); PG8_STAGE(PG8_SB(0, 1), cB + hstep, voffB); PG8_STAGE(PG8_SA(0, 1), cA + hstep, voffA);
        if (wr == 1) PG8_BAR;
        PG8_WAIT_V(4); PG8_BAR;
        PG8_STAGE(PG8_SB(1, 0), cB + kstep, voffB); PG8_STAGE(PG8_SA(1, 0), cA + kstep, voffA); PG8_STAGE(PG8_SB(1, 1), cB + hstep + kstep, voffB);
        PG8_WAIT_V(6); PG8_BAR;
    }
    for (;;) {
        const bool has_next = S.next(ui + 1, nxt);
        const char* nA = has_next ? (const char*)g.A + (size_t)nxt.pm * tstep : cA; const char* nB = has_next ? (const char*)g.Bt + (size_t)nxt.pn * tstep : cB;
        for (int t = 0; t < nt; t += 2) {
            if constexpr (Mid::SEG > 0) { if (t != 0 && (t % Mid::SEG) == 0) Mh(acc, cur, wr, wc, fr, fq, t / Mid::SEG); }
            const bool last = (t == nt - 2);
            const char* a1 = cA + (size_t)(t + 1) * kstep;
            const char* a2 = last ? nA : cA + (size_t)(t + 2) * kstep; const char* b2 = last ? nB : cB + (size_t)(t + 2) * kstep;
            const char* a3 = a2 + kstep; const char* b3 = b2 + kstep;
            if (last && has_next) S.a_ready(nxt);
            if constexpr (SP2) {
            PG8_LDB(B0, 0, 0); PG8_LDB(B1, 0, 1); PG8_SCHED; PG8_LDA(At, 0, 0); PG8_STAGE(PG8_SA(1, 1), a1 + hstep, voffA);
            PG8_WAIT_V(8); PG8_WAIT_L(0); PG8_BAR; PG8_MMA(0, 0, At, B0); PG8_MMA(0, 1, At, B1); PG8_BAR; PG8_SCHED;
            PG8_LDA(At, 0, 1); PG8_STAGE(PG8_SB(0, 0), b2, voffB); PG8_STAGE(PG8_SB(0, 1), b2 + hstep, voffB); PG8_STAGE(PG8_SA(0, 0), a2, voffA);
            PG8_WAIT_V(8); PG8_WAIT_L(0); PG8_BAR; PG8_MMA(1, 0, At, B0); PG8_MMA(1, 1, At, B1); PG8_BAR; PG8_SCHED;
            PG8_LDB(B0, 1, 0); PG8_LDB(B1, 1, 1); PG8_SCHED; PG8_LDA(At, 1, 0); PG8_STAGE(PG8_SA(0, 1), a2 + hstep, voffA);
            PG8_WAIT_V(8); PG8_WAIT_L(0); PG8_BAR; PG8_MMA(0, 0, At, B0); PG8_MMA(0, 1, At, B1); PG8_BAR; PG8_SCHED;
            PG8_LDA(At, 1, 1); PG8_STAGE(PG8_SB(1, 0), b3, voffB); PG8_STAGE(PG8_SB(1, 1), b3 + hstep, voffB); PG8_STAGE(PG8_SA(1, 0), a3, voffA);
            PG8_WAIT_V(8); PG8_WAIT_L(0); PG8_BAR; PG8_MMA(1, 0, At, B0); PG8_MMA(1, 1, At, B1); PG8_BAR; PG8_SCHED;
            } else {
            PG8_LDB(B0, 0, 0); PG8_SCHED; PG8_LDA(At, 0, 0); PG8_STAGE(PG8_SA(1, 1), a1 + hstep, voffA);
            PG8_WAIT_L(8); PG8_BAR; PG8_WAIT_L(0); PG8_MMA(0, 0, At, B0); PG8_BAR; PG8_SCHED;
            PG8_LDB(B1, 0, 1); PG8_STAGE(PG8_SB(0, 0), b2, voffB);
            PG8_BAR; PG8_WAIT_L(0); PG8_MMA(0, 1, At, B1); PG8_BAR;
            PG8_LDA(At, 0, 1); PG8_STAGE(PG8_SA(0, 0), a2, voffA);
            PG8_BAR; PG8_WAIT_L(0); PG8_MMA(1, 0, At, B0); PG8_BAR; PG8_SCHED;
            PG8_STAGE(PG8_SB(0, 1), b2 + hstep, voffB);
            PG8_WAIT_V(6); PG8_BAR; PG8_MMA(1, 1, At, B1); PG8_BAR;
            PG8_LDB(B0, 1, 0); PG8_SCHED; PG8_LDA(At, 1, 0); PG8_STAGE(PG8_SA(0, 1), a2 + hstep, voffA);
            PG8_WAIT_L(8); PG8_BAR; PG8_WAIT_L(0); PG8_MMA(0, 0, At, B0); PG8_BAR; PG8_SCHED;
            PG8_LDB(B1, 1, 1); PG8_STAGE(PG8_SB(1, 0), b3, voffB);
            PG8_BAR; PG8_WAIT_L(0); PG8_MMA(0, 1, At, B1); PG8_BAR;
            PG8_LDA(At, 1, 1); PG8_STAGE(PG8_SA(1, 0), a3, voffA);
            PG8_BAR; PG8_WAIT_L(0); PG8_MMA(1, 0, At, B0); PG8_BAR; PG8_SCHED;
            PG8_STAGE(PG8_SB(1, 1), b3 + hstep, voffB);
            PG8_WAIT_V(6); PG8_BAR; PG8_MMA(1, 1, At, B1); PG8_BAR;
            }
        }
        if constexpr (ALIGN_EPI) { if (wr == 0) PG8_BAR; }
        if constexpr (!Epi::AFTER_DRAIN) { E(acc, cur, wr, wc, fr, fq); S.done(cur); }
        if (!has_next) break;
#pragma unroll
        for (int a = 0; a < 2; ++a)
#pragma unroll
            for (int b = 0; b < 2; ++b)
#pragma unroll
                for (int m = 0; m < 4; ++m)
#pragma unroll
                    for (int n = 0; n < 2; ++n) acc[a][b][m][n] = (f32x4){0.f, 0.f, 0.f, 0.f};
        cur = nxt; cA = nA; cB = nB; ++ui;
        if constexpr (ALIGN_EPI) { if (wr == 1) PG8_BAR; }
    }
    PG8_WAIT_V(0);
    if constexpr (!ALIGN_EPI) { if (wr == 0) PG8_BAR; }
    PG8_BAR;
    if constexpr (Epi::AFTER_DRAIN) { E.fused(acc, cur, wr, wc, fr, fq, lds, wid, lane); S.done(cur); }
#undef PG8_SA
#undef PG8_SB
#undef PG8_STAGE
#undef PG8_LDA
#undef PG8_LDB
#undef PG8_MMA
#undef PG8_WAIT_V
#undef PG8_WAIT_L
#undef PG8_BAR
#undef PG8_SCHED
}
}
#define GAS __attribute__((address_space(1)))
#define LAS __attribute__((address_space(3)))
typedef unsigned short bf16;
typedef unsigned v4u __attribute__((ext_vector_type(4)));
typedef float f32x4 __attribute__((ext_vector_type(4)));
typedef short bf16x8 __attribute__((ext_vector_type(8)));
typedef GAS unsigned gu32;
typedef GAS unsigned long long gu64;
#define RLX_AGENT __ATOMIC_RELAXED, __HIP_MEMORY_SCOPE_AGENT
#define LDS_WAIT() asm volatile("s_waitcnt lgkmcnt(0)" ::: "memory")
#define VM_WAIT() asm volatile("s_waitcnt vmcnt(0)" ::: "memory")
__device__ __forceinline__ unsigned long long rt() { return __builtin_amdgcn_s_memrealtime(); }
__device__ __forceinline__ unsigned f2bf(float f) { unsigned u = __builtin_bit_cast(unsigned, f); return (u + 0x7fffu + ((u >> 16) & 1u)) >> 16; }
__device__ __forceinline__ unsigned pk2(float lo, float hi) { return f2bf(lo) | (f2bf(hi) << 16); }
#define XB_TMO      128
#define XB_XCNT(j)  (256  + 64 * (j))
#define XB_XSUB(j)  (1280 + 64 * (j))
#define XB_XGEN(j)  (2304 + 64 * (j))
#define XB_TOP      3328
#define XB_TOPGEN   3392
#define XCD_BAR_WORDS 3456
#define XB_SPIN_CAP (1u << 24)

__device__ __forceinline__ unsigned xb_ld(unsigned* p)              { return __hip_atomic_load(p, __ATOMIC_RELAXED, __HIP_MEMORY_SCOPE_AGENT); }
__device__ __forceinline__ unsigned xb_add(unsigned* p, unsigned v) { return __hip_atomic_fetch_add(p, v, __ATOMIC_RELAXED, __HIP_MEMORY_SCOPE_AGENT); }
__device__ __forceinline__ unsigned xb_xcc_id() { return (unsigned)__builtin_amdgcn_s_getreg((3 << 11) | 20) & 0xFu; }
#define XB_SPIN(cond, bar) do { unsigned _sp = 0; while (cond) { __builtin_amdgcn_s_sleep(1); \
    if ((++_sp & 255u) == 0u) { if (xb_ld(&(bar)[XB_TMO])) break; if (_sp > XB_SPIN_CAP) { atomicAdd(&(bar)[XB_TMO], 1u); break; } } } } while (0)

struct XcdBarrier {
    unsigned* bar; unsigned x;
    volatile LAS unsigned* st;
};

__device__ __forceinline__ XcdBarrier xcd_barrier_post(unsigned* bar, volatile LAS unsigned* st) {
    XcdBarrier b; b.bar = bar; b.x = xb_xcc_id(); b.st = st;
    if (threadIdx.x == 0) (void)xb_add(&bar[XB_XCNT(b.x)], 1u);
    return b;
}
__device__ __forceinline__ void xcd_barrier_complete(unsigned* bar, unsigned x, unsigned& nloc, unsigned& nx) {
    const unsigned G = gridDim.x * gridDim.y * gridDim.z;
    unsigned sum, cnt, mine, sp = 0u;
    for (;;) {
        sum = 0u; cnt = 0u; mine = 0u;
#pragma unroll
        for (unsigned j = 0; j < 16; ++j) { const unsigned c = xb_ld(&bar[XB_XCNT(j)]); sum += c; cnt += (c > 0u) ? 1u : 0u; mine = (j == x) ? c : mine; }
        if (sum == G) break;
        __builtin_amdgcn_s_sleep(1);
        if ((++sp & 255u) == 0u) { if (xb_ld(&bar[XB_TMO])) break; if (sp > XB_SPIN_CAP) { atomicAdd(&bar[XB_TMO], 1u); break; } }
    }
    nloc = mine > 0u ? mine : 1u; nx = cnt > 0u ? cnt : 1u;
}

__device__ __forceinline__ void xcd_barrier(const XcdBarrier& b) {
    asm volatile("s_waitcnt vmcnt(0)" ::: "memory");
    __syncthreads();
    if (threadIdx.x == 0) {
        unsigned* bar = b.bar;
        __builtin_amdgcn_s_waitcnt(0);
        unsigned nloc = b.st[0], nx = b.st[1];
        if (nloc == 0u) { xcd_barrier_complete(bar, b.x, nloc, nx); b.st[0] = nloc; b.st[1] = nx; }
        const unsigned old = xb_add(&bar[XB_XSUB(b.x)], 1u);
        const unsigned gen = old / nloc;
        if (old + 1u == (gen + 1u) * nloc) {
            __builtin_amdgcn_fence(__ATOMIC_RELEASE, "agent");
            asm volatile("s_waitcnt vmcnt(0)" ::: "memory");
            const unsigned og = xb_add(&bar[XB_TOP], 1u);
            const unsigned tg = og / nx;
            if (og + 1u == (tg + 1u) * nx) xb_add(&bar[XB_TOPGEN], 1u);
            else XB_SPIN(xb_ld(&bar[XB_TOPGEN]) == tg, bar);
            __builtin_amdgcn_fence(__ATOMIC_ACQUIRE, "agent");
            xb_add(&bar[XB_XGEN(b.x)], 1u);
            asm volatile("s_waitcnt vmcnt(0)" ::: "memory");
        } else {
            XB_SPIN(xb_ld(&bar[XB_XGEN(b.x)]) == gen, bar);
            __builtin_amdgcn_fence(__ATOMIC_ACQUIRE, "agent");
            asm volatile("s_waitcnt vmcnt(0)" ::: "memory");
        }
    }
    __syncthreads();
}
__device__ __forceinline__ float wave_sum(float v) {
#pragma unroll
    for (int o = 1; o < 64; o <<= 1) v += __shfl_xor(v, o);
    return v;
}
__device__ __forceinline__ void p0_transpose_item(const float* W, int K, int N, bf16* WT, int row_off, LAS float* scr, int item, int lane) {
    const int nblk = N / 32, kb = item / nblk, nb = item % nblk, k0 = 64 * kb, n0 = 32 * nb;
#pragma unroll 8
    for (int i = 0; i < 32; ++i) { const int kk = 2 * i + (lane >> 5); scr[kk * 33 + (lane & 31)] = W[(size_t)(k0 + kk) * N + n0 + (lane & 31)]; }
    LDS_WAIT(); asm volatile("" ::: "memory");
    const int c = lane & 7;
#pragma unroll
    for (int j = 0; j < 4; ++j) { const int n = (lane >> 3) + 8 * j; const LAS float* s = scr + (8 * c) * 33 + n;
        v4u o; o.x = pk2(s[0 * 33], s[1 * 33]); o.y = pk2(s[2 * 33], s[3 * 33]); o.z = pk2(s[4 * 33], s[5 * 33]); o.w = pk2(s[6 * 33], s[7 * 33]);
        *(GAS v4u*)(WT + (size_t)(row_off + n0 + n) * K + k0 + 8 * c) = o; }
    LDS_WAIT(); asm volatile("" ::: "memory");
}
__device__ __forceinline__ void p0_transpose_item_p(const float* W, int K, int N, bf16* WT, int pitch, int col_off, LAS float* scr, int item, int lane) {
    const int nblk = N / 32, kb = item / nblk, nb = item % nblk, k0 = 64 * kb, n0 = 32 * nb;
#pragma unroll 8
    for (int i = 0; i < 32; ++i) { const int kk = 2 * i + (lane >> 5); scr[kk * 33 + (lane & 31)] = W[(size_t)(k0 + kk) * N + n0 + (lane & 31)]; }
    LDS_WAIT(); asm volatile("" ::: "memory");
    const int c = lane & 7;
#pragma unroll
    for (int j = 0; j < 4; ++j) { const int n = (lane >> 3) + 8 * j; const LAS float* s = scr + (8 * c) * 33 + n;
        v4u o; o.x = pk2(s[0 * 33], s[1 * 33]); o.y = pk2(s[2 * 33], s[3 * 33]); o.z = pk2(s[4 * 33], s[5 * 33]); o.w = pk2(s[6 * 33], s[7 * 33]);
        *(GAS v4u*)(WT + (size_t)(n0 + n) * pitch + col_off + k0 + 8 * c) = o; }
    LDS_WAIT(); asm volatile("" ::: "memory");
}
#include <hip/hip_bf16.h>
#include <cmath>
namespace attn_body {
using bf16=__hip_bfloat16;
using bf16x8=__attribute__((ext_vector_type(8)))short;
using s16x4=__attribute__((ext_vector_type(4)))short;
using f32x16=__attribute__((ext_vector_type(16)))float;
using u32x4=__attribute__((ext_vector_type(4)))unsigned;
constexpr int D=64;
constexpr int NW=8,QBLK=32,QB=QBLK*NW,KVBLK=64;
constexpr int ATTN_UNIT_ROWS=QB;
__device__ __forceinline__ int crow(int r,int hi){return (r&3)+8*(r>>2)+4*hi;}
#define SBAR() __builtin_amdgcn_sched_barrier(0)
constexpr int NSLOT=3, SLOTB=8192;
constexpr int LDS_K=0, LDS_V=NSLOT*SLOTB, LDS_WS=2*NSLOT*SLOTB, LDS_OST=LDS_WS+NW*64*4, LDS_BYTES=LDS_OST+NW*4096;
constexpr float C2=0.125f*1.4426950408889634f;
__device__ __forceinline__ void glds16(const void*gsrc,unsigned lds_dst){unsigned keep;
  asm volatile("s_mov_b32 %0, m0\n\ts_mov_b32 m0, %2\n\ts_nop 0\n\tglobal_load_lds_dwordx4 %1, off\n\ts_mov_b32 m0, %0":"=&s"(keep):"v"(gsrc),"s"(lds_dst):"memory");}
__device__ __forceinline__ float max3f(float a,float b,float c){float r;asm("v_max3_f32 %0, %1, %2, %3":"=v"(r):"v"(a),"v"(b),"v"(c));return r;}
__device__ __forceinline__ float max2f(float a,float b){float r;asm("v_max_f32_e32 %0, %1, %2":"=v"(r):"v"(a),"v"(b));return r;}
__device__ __forceinline__ float fadd_s(float a,float b){float r;asm("v_add_f32_e32 %0, %1, %2":"=v"(r):"v"(a),"v"(b));return r;}
__device__ __forceinline__ float fsub_s(float a,float b){float r;asm("v_sub_f32_e32 %0, %1, %2":"=v"(r):"v"(a),"v"(b));return r;}
typedef float f32x2_t __attribute__((ext_vector_type(2))); typedef __bf16 bf16x2_t __attribute__((ext_vector_type(2)));
__device__ __forceinline__ unsigned cvtpk_s(float lo,float hi){f32x2_t v={lo,hi};bf16x2_t b=__builtin_convertvector(v,bf16x2_t);return __builtin_bit_cast(unsigned,b);}
#define WAIT_BAR(N) asm volatile("s_waitcnt vmcnt(" #N ") lgkmcnt(0)\n\ts_barrier":::"memory")

__device__ __forceinline__ void qkt(f32x16&p0,f32x16&p1,const char*Kslot,const bf16x8*qr,const f32x16&negm,int r32,int hi){
  const char*kb=Kslot+hi*1024+r32*16;
  #pragma unroll
  for(int d0=0;d0<4;++d0){
    const bf16x8 b0=*reinterpret_cast<const bf16x8*>(kb+d0*2048);
    const bf16x8 b1=*reinterpret_cast<const bf16x8*>(kb+d0*2048+512);
    if(d0==0){p0=__builtin_amdgcn_mfma_f32_32x32x16_bf16(b0,qr[0],negm,0,0,0);p1=__builtin_amdgcn_mfma_f32_32x32x16_bf16(b1,qr[0],negm,0,0,0);}
    else{p0=__builtin_amdgcn_mfma_f32_32x32x16_bf16(b0,qr[d0],p0,0,0,0);p1=__builtin_amdgcn_mfma_f32_32x32x16_bf16(b1,qr[d0],p1,0,0,0);}}
}
typedef __attribute__((address_space(3))) const char* lds_cptr;
typedef short v4i16_t __attribute__((ext_vector_type(4)));
__device__ __forceinline__ void kload8(bf16x8*kf,lds_cptr kp){
  kf[0]=*(const __attribute__((address_space(3))) bf16x8*)(kp);      kf[1]=*(const __attribute__((address_space(3))) bf16x8*)(kp+512);
  kf[2]=*(const __attribute__((address_space(3))) bf16x8*)(kp+2048); kf[3]=*(const __attribute__((address_space(3))) bf16x8*)(kp+2560);
  kf[4]=*(const __attribute__((address_space(3))) bf16x8*)(kp+4096); kf[5]=*(const __attribute__((address_space(3))) bf16x8*)(kp+4608);
  kf[6]=*(const __attribute__((address_space(3))) bf16x8*)(kp+6144); kf[7]=*(const __attribute__((address_space(3))) bf16x8*)(kp+6656);
}
__device__ __forceinline__ void kload2(bf16x8*kf,lds_cptr kp,int j){ kf[2*j]=*(const __attribute__((address_space(3))) bf16x8*)(kp+j*2048); kf[2*j+1]=*(const __attribute__((address_space(3))) bf16x8*)(kp+j*2048+512); }
__device__ __forceinline__ s16x4 vtr(lds_cptr p){ return __builtin_bit_cast(s16x4,__builtin_amdgcn_ds_read_tr16_b64_v4i16((__attribute__((address_space(3))) v4i16_t*)p)); }
__device__ __forceinline__ float rowmax(const f32x16&p0,const f32x16&p1){
  float a=max3f(p0[0],p0[1],p1[0]),b=max3f(p0[2],p0[3],p1[1]);a=max3f(a,p1[2],p1[3]);
  #pragma unroll
  for(int r=4;r<16;r+=4){a=max3f(a,p0[r],p0[r+1]);b=max3f(b,p0[r+2],p0[r+3]);a=max3f(a,p1[r],p1[r+1]);b=max3f(b,p1[r+2],p1[r+3]);}
  const float m=max2f(a,b);
  auto rr=__builtin_amdgcn_permlane32_swap(__float_as_uint(m),__float_as_uint(m),false,false);
  return max2f(__uint_as_float(rr[0]),__uint_as_float(rr[1]));
}
__device__ __forceinline__ void pv(f32x16*o,int vb,bf16x8 pa0,bf16x8 pa1,bf16x8 pa2,bf16x8 pa3){
  #pragma unroll
  for(int d0=0;d0<2;++d0){s16x4 lo[4],hi[4];
    #pragma unroll
    for(int ks=0;ks<4;++ks){
      asm volatile("ds_read_b64_tr_b16 %0,%1 offset:%c2":"=&v"(lo[ks]):"v"(vb),"i"(d0*4096+ks*1024):"memory");
      asm volatile("ds_read_b64_tr_b16 %0,%1 offset:%c2":"=&v"(hi[ks]):"v"(vb),"i"(d0*4096+ks*1024+512):"memory");}
    asm volatile("s_waitcnt lgkmcnt(0)":::"memory");SBAR();
    #define PK(k) (bf16x8){lo[k][0],lo[k][1],lo[k][2],lo[k][3],hi[k][0],hi[k][1],hi[k][2],hi[k][3]}
    o[d0]=__builtin_amdgcn_mfma_f32_32x32x16_bf16(pa0,PK(0),o[d0],0,0,0);
    o[d0]=__builtin_amdgcn_mfma_f32_32x32x16_bf16(pa1,PK(1),o[d0],0,0,0);
    o[d0]=__builtin_amdgcn_mfma_f32_32x32x16_bf16(pa2,PK(2),o[d0],0,0,0);
    o[d0]=__builtin_amdgcn_mfma_f32_32x32x16_bf16(pa3,PK(3),o[d0],0,0,0);
    #undef PK
  }
}

#ifndef ATTN_STORE16
#define ATTN_STORE16(p,v) (*(u32x4*)(p)=(v))
#endif
template<int THRL> __device__ __forceinline__ void attn_unit(const bf16*Qw0,int QP,const bf16*Kh,int KP,const bf16*Vh,int VP,bf16*Ow0,int OP,int NT,char*shm,float mref){
  int tid=threadIdx.x; asm volatile("":"+v"(tid));
  const int lane=tid&63,r32=lane&31,hi=lane>>5; const int wid=__builtin_amdgcn_readfirstlane(tid>>6);
  const bf16*Qw=Qw0+(long)wid*QBLK*QP;
  const unsigned lds0=(unsigned)(uintptr_t)shm;
  float*wsf=(float*)(shm+LDS_WS)+wid*64;
  const bf16*ksrc=Kh+(long)lane*KP+wid*8;
  const bf16*vsrc=Vh+(long)(16*(wid&3)+(lane>>2))*VP+(wid>>2)*32+(lane&3)*8;
  const unsigned kdst=lds0+LDS_K+wid*1024, vdst=lds0+LDS_V+wid*1024;
  #define DMA_K(t,slot) glds16(ksrc+(long)(t)*KVBLK*KP,(unsigned)__builtin_amdgcn_readfirstlane(kdst+(slot)))
  #define DMA_V(t,slot) glds16(vsrc+(long)(t)*KVBLK*VP,(unsigned)__builtin_amdgcn_readfirstlane(vdst+(slot)))
  const int vb0=(int)(lds0+LDS_V)+((lane>>4)&1)*32+(lane&3)*8+(4*hi+((lane&15)>>2))*64;
  const char*Kbase=shm+LDS_K; bf16x8 kf[8];
  const lds_cptr shm3=(lds_cptr)shm; const lds_cptr kp0=shm3+LDS_K+hi*1024+r32*16; const lds_cptr vp0=shm3+LDS_V+((lane>>4)&1)*32+(lane&3)*8+(4*hi+((lane&15)>>2))*64;
  DMA_K(0,0);DMA_V(0,0);DMA_K(1,SLOTB);
  bf16x8 qr[4];
  #pragma unroll
  for(int d0=0;d0<4;++d0)qr[d0]=*reinterpret_cast<const bf16x8*>(&Qw[(long)r32*QP+d0*16+hi*8]);
  float l_reg=0.f;f32x16 o[2];o[0]=f32x16{};o[1]=f32x16{};f32x16 negm; _Pragma("unroll") for(int r=0;r<16;++r)negm[r]=-mref; asm volatile("":"+v"(negm));
  #define CMASK(P0,P1,t) do{}while(0)
  #define START(P0,P1) do{ _Pragma("unroll") for(int r=0;r<16;++r)P0[r]=__builtin_amdgcn_exp2f(P0[r]); }while(0)
  #define RESC() do{}while(0)
  f32x16 pA0,pA1,pB0,pB1;
  int sl_prev=0,sl_cur=0,sl_next=SLOTB;
  #define ROT() do{sl_prev=sl_cur;sl_cur=sl_next;sl_next=(sl_next==(NSLOT-1)*SLOTB)?0:sl_next+SLOTB;}while(0)
  DMA_K(2,2*SLOTB);
  WAIT_BAR(3);
  qkt(pA0,pA1,Kbase,qr,negm,r32,hi);asm volatile("s_nop 15\n\ts_nop 7":"+v"(pA0),"+v"(pA1));CMASK(pA0,pA1,0);
  START(pA0,pA1);
  _Pragma("unroll") for(int r=0;r<16;++r)pA1[r]=__builtin_amdgcn_exp2f(pA1[r]);
  WAIT_BAR(0);
  DMA_K(3,0);DMA_V(1,SLOTB);
  ROT();
  kload8(kf,kp0+sl_cur);
  WAIT_BAR(2);
  s16x4 vlo[8],vhi[8]; u32x4 pw0,pw1,pw2,pw3;
  #define PKW(P,B) cvtpk_s(P[B],P[B+1])
  #define PAF(k) __builtin_bit_cast(bf16x8,pw##k)
  #define VFR(i) (bf16x8){vlo[i][0],vlo[i][1],vlo[i][2],vlo[i][3],vhi[i][0],vhi[i][1],vhi[i][2],vhi[i][3]}
  #define PIN(x) asm volatile("":"+v"(x))
  #define MX3(a,b,c) __builtin_fmaxf(__builtin_fmaxf((a),(b)),(c))
  #define GAPA(MF,A0,A1,A2,A3,W0,W1,PW) do{ MF; sacc+=A0; sacc+=A1; sacc+=A2; sacc+=A3; PIN(sacc); W0; W1; PIN(PW); SBAR(); }while(0)
  #define EX(v) __builtin_amdgcn_exp2f(v)
  #define GAPB(MF,X,B) do{ MF; X[B]=EX(X[B]); X[B+1]=EX(X[B+1]); X[B+2]=EX(X[B+2]); X[B+3]=EX(X[B+3]); PIN(X); SBAR(); }while(0)
  #define VRD(i) do{ vlo[i]=vtr(vp_+(((i)>>2)*4096+((i)&3)*1024)); vhi[i]=vtr(vp_+(((i)>>2)*4096+((i)&3)*1024+512)); }while(0)
  #define KRD(G,j) do{ if(G){ kload2(kf,kp0+sl_next,j); SBAR(); } }while(0)
  #define STEP(C0,C1,P0,P1,t,GK,GV,GL) do{ SBAR(); \
    const lds_cptr vp_=vp0+sl_prev; \
    VRD(0); SBAR(); float sacc=(P0[0]+P0[1]); \
    GAPA(C0=__builtin_amdgcn_mfma_f32_32x32x16_bf16(kf[0],qr[0],negm,0,0,0), P0[2],P0[3],P0[4],P0[5],     pw0[0]=PKW(P0,0), pw0[1]=PKW(P0,2), pw0); \
    VRD(4); SBAR(); GAPA(C1=__builtin_amdgcn_mfma_f32_32x32x16_bf16(kf[1],qr[0],negm,0,0,0), P0[6],P0[7],P0[8],P0[9],     pw0[2]=PKW(P0,4), pw0[3]=PKW(P0,6), pw0); \
    VRD(1); SBAR(); GAPA(C0=__builtin_amdgcn_mfma_f32_32x32x16_bf16(kf[2],qr[1],C0,0,0,0),   P0[10],P0[11],P0[12],P0[13], pw1[0]=PKW(P0,8), pw1[1]=PKW(P0,10), pw1); \
    VRD(5); SBAR(); GAPA(C1=__builtin_amdgcn_mfma_f32_32x32x16_bf16(kf[3],qr[1],C1,0,0,0),   P0[14],P0[15],P1[0],P1[1],   pw1[2]=PKW(P0,12),pw1[3]=PKW(P0,14), pw1); \
    VRD(2); SBAR(); GAPA(C0=__builtin_amdgcn_mfma_f32_32x32x16_bf16(kf[4],qr[2],C0,0,0,0),   P1[2],P1[3],P1[4],P1[5],     pw2[0]=PKW(P1,0), pw2[1]=PKW(P1,2), pw2); \
    VRD(6); SBAR(); GAPA(C1=__builtin_amdgcn_mfma_f32_32x32x16_bf16(kf[5],qr[2],C1,0,0,0),   P1[6],P1[7],P1[8],P1[9],     pw2[2]=PKW(P1,4), pw2[3]=PKW(P1,6), pw2); \
    VRD(3); SBAR(); GAPA(C0=__builtin_amdgcn_mfma_f32_32x32x16_bf16(kf[6],qr[3],C0,0,0,0),   P1[10],P1[11],P1[12],P1[13], pw3[0]=PKW(P1,8), pw3[1]=PKW(P1,10), pw3); \
    VRD(7); SBAR(); GAPA(C1=__builtin_amdgcn_mfma_f32_32x32x16_bf16(kf[7],qr[3],C1,0,0,0),   P1[14],P1[15],0.f,0.f,       pw3[2]=PKW(P1,12),pw3[3]=PKW(P1,14), pw3); \
    l_reg+=sacc; \
    if(GK){DMA_K((t)+3,sl_cur);} if(GV){DMA_V((t)+1,sl_next);} \
    CMASK(C0,C1,t); \
    SBAR(); \
    GAPB(o[0]=__builtin_amdgcn_mfma_f32_32x32x16_bf16(PAF(0),VFR(0),o[0],0,0,0), C0,0); \
    GAPB(o[1]=__builtin_amdgcn_mfma_f32_32x32x16_bf16(PAF(0),VFR(4),o[1],0,0,0), C0,4); \
    KRD(GL,0); GAPB(o[0]=__builtin_amdgcn_mfma_f32_32x32x16_bf16(PAF(1),VFR(1),o[0],0,0,0), C0,8); \
    KRD(GL,1); GAPB(o[1]=__builtin_amdgcn_mfma_f32_32x32x16_bf16(PAF(1),VFR(5),o[1],0,0,0), C0,12); \
    KRD(GL,2); GAPB(o[0]=__builtin_amdgcn_mfma_f32_32x32x16_bf16(PAF(2),VFR(2),o[0],0,0,0), C1,0); \
    KRD(GL,3); GAPB(o[1]=__builtin_amdgcn_mfma_f32_32x32x16_bf16(PAF(2),VFR(6),o[1],0,0,0), C1,4); \
    GAPB(o[0]=__builtin_amdgcn_mfma_f32_32x32x16_bf16(PAF(3),VFR(3),o[0],0,0,0), C1,8); \
    GAPB(o[1]=__builtin_amdgcn_mfma_f32_32x32x16_bf16(PAF(3),VFR(7),o[1],0,0,0), C1,12); \
    }while(0)
  int t=1;
  #undef CMASK
  #define CMASK(P0,P1,t) do{}while(0)
  for(;t+5<NT;t+=2){
    STEP(pB0,pB1,pA0,pA1,t,true,true,true);     WAIT_BAR(2); RESC(); ROT();
    STEP(pA0,pA1,pB0,pB1,t+1,true,true,true);   WAIT_BAR(2); RESC(); ROT();
  }
  #undef CMASK
  #define CMASK(P0,P1,t) do{}while(0)
  #define ENDW(tt) do{ if((tt)+3<NT){WAIT_BAR(2);} else if((tt)+2<NT){WAIT_BAR(1);} else {WAIT_BAR(0);} }while(0)
  for(;t+1<NT;t+=2){
    STEP(pB0,pB1,pA0,pA1,t,(t+3<NT),(t+1<NT),(t+1<NT));       ENDW(t);   RESC(); ROT();
    STEP(pA0,pA1,pB0,pB1,t+1,(t+4<NT),(t+2<NT),(t+2<NT));     ENDW(t+1); RESC(); ROT();
  }
  STEP(pB0,pB1,pA0,pA1,NT-1,false,false,false); RESC();
  { float sacc=pB0[0]+pB0[1]; _Pragma("unroll") for(int r=2;r<16;++r)sacc+=pB0[r]; _Pragma("unroll") for(int r=0;r<16;++r)sacc+=pB1[r]; l_reg+=sacc;
    pw0=(u32x4){PKW(pB0,0),PKW(pB0,2),PKW(pB0,4),PKW(pB0,6)};pw1=(u32x4){PKW(pB0,8),PKW(pB0,10),PKW(pB0,12),PKW(pB0,14)};pw2=(u32x4){PKW(pB1,0),PKW(pB1,2),PKW(pB1,4),PKW(pB1,6)};pw3=(u32x4){PKW(pB1,8),PKW(pB1,10),PKW(pB1,12),PKW(pB1,14)};
    SBAR(); pv(o,vb0+sl_cur,PAF(0),PAF(1),PAF(2),PAF(3)); }
  #undef PKW
  #undef PAF
  #undef VFR
  #undef PIN
  #undef MX3
  #undef GAPA
  #undef GAPB
  #undef EX
  #undef VRD
  #undef KRD
  #undef STEP
  #undef ENDW
  {auto rr=__builtin_amdgcn_permlane32_swap(__float_as_uint(l_reg),__float_as_uint(l_reg),false,false);l_reg=__uint_as_float(rr[0])+__uint_as_float(rr[1]);}
  if(hi==0)wsf[32+r32]=l_reg;asm volatile("s_waitcnt lgkmcnt(0)":::"memory");
  float rli[16];
  #pragma unroll
  for(int r=0;r<16;++r)rli[r]=__builtin_amdgcn_rcpf(wsf[32+crow(r,hi)]);
  bf16*Ow=Ow0+(long)wid*QBLK*OP;
  { bf16*stg=(bf16*)(shm+LDS_OST)+wid*2048;
    #pragma unroll
    for(int r=0;r<16;++r){const int orow=crow(r,hi);
      #pragma unroll
      for(int d0=0;d0<2;++d0)stg[orow*64+d0*32+r32]=__float2bfloat16(o[d0][r]*rli[r]);}
    asm volatile("s_waitcnt lgkmcnt(0)":::"memory");
    #pragma unroll
    for(int i=0;i<4;++i){const int row=i*8+(lane>>3),ch=lane&7; const u32x4 v=*(const u32x4*)(stg+row*64+ch*8); ATTN_STORE16(Ow+(long)row*OP+ch*8,v);} }
  asm volatile("s_waitcnt lgkmcnt(0)\n\ts_barrier":::"memory");
  #undef DMA_K
  #undef DMA_V
  #undef CMASK
  #undef START
  #undef RESC
  #undef ROT
}
__device__ __forceinline__ void pv128(f32x16*o,int vb,bf16x8 pa0,bf16x8 pa1,bf16x8 pa2,bf16x8 pa3){
  #pragma unroll
  for(int d0=0;d0<4;++d0){s16x4 lo[4],hi[4];
    #pragma unroll
    for(int ks=0;ks<4;++ks){
      asm volatile("ds_read_b64_tr_b16 %0,%1 offset:%c2":"=&v"(lo[ks]):"v"(vb),"i"(d0*4096+ks*1024):"memory");
      asm volatile("ds_read_b64_tr_b16 %0,%1 offset:%c2":"=&v"(hi[ks]):"v"(vb),"i"(d0*4096+ks*1024+512):"memory");}
    asm volatile("s_waitcnt lgkmcnt(0)":::"memory");SBAR();
    #define PK(k) (bf16x8){lo[k][0],lo[k][1],lo[k][2],lo[k][3],hi[k][0],hi[k][1],hi[k][2],hi[k][3]}
    o[d0]=__builtin_amdgcn_mfma_f32_32x32x16_bf16(pa0,PK(0),o[d0],0,0,0);
    o[d0]=__builtin_amdgcn_mfma_f32_32x32x16_bf16(pa1,PK(1),o[d0],0,0,0);
    o[d0]=__builtin_amdgcn_mfma_f32_32x32x16_bf16(pa2,PK(2),o[d0],0,0,0);
    o[d0]=__builtin_amdgcn_mfma_f32_32x32x16_bf16(pa3,PK(3),o[d0],0,0,0);
    #undef PK
  }
}
constexpr int V128_V=NSLOT*SLOTB, V128_WS=V128_V+NSLOT*2*SLOTB, V128_Q=V128_WS+NW*64*4, V128_BYTES=V128_Q+NW*4096;
template<int THRL> __device__ __forceinline__ void attn_unit128(const bf16*Qw0,int QP,const bf16*Kh,int KP,const bf16*Vh,int VP,bf16*Ow0,int OP,int NT,char*shm,float kmax2){
  int tid=threadIdx.x; asm volatile("":"+v"(tid));
  const int lane=tid&63,r32=lane&31,hi=lane>>5; const int wid=__builtin_amdgcn_readfirstlane(tid>>6);
  const bf16*Qw=Qw0+(long)wid*QBLK*QP;
  const unsigned lds0=(unsigned)(uintptr_t)shm;
  float*wsf=(float*)(shm+V128_WS)+wid*64;
  const bf16*ksrc=Kh+(long)lane*KP+wid*8;
  const bf16*vsrc=Vh+(long)(16*(wid&3)+(lane>>2))*VP+(wid>>2)*32+(lane&3)*8;
  const unsigned kdst=lds0+LDS_K+wid*1024, vdst=lds0+V128_V+wid*1024;
  #define DMA_K(t,slot) glds16(ksrc+(long)(t)*KVBLK*KP,(unsigned)__builtin_amdgcn_readfirstlane(kdst+(slot)))
  #define DMA_V(t,slot) do{ glds16(vsrc+(long)(t)*KVBLK*VP,(unsigned)__builtin_amdgcn_readfirstlane(vdst+2*(slot))); glds16(vsrc+(long)(t)*KVBLK*VP+64,(unsigned)__builtin_amdgcn_readfirstlane(vdst+2*(slot)+8192)); }while(0)
  const int vb0=(int)(lds0+V128_V)+((lane>>4)&1)*32+(lane&3)*8+(4*hi+((lane&15)>>2))*64;
  const char*Kbase=shm+LDS_K; bf16x8 kf[8];
  const lds_cptr shm3=(lds_cptr)shm; const lds_cptr kp0=shm3+LDS_K+hi*1024+r32*16; const lds_cptr vp0=shm3+V128_V+((lane>>4)&1)*32+(lane&3)*8+(4*hi+((lane&15)>>2))*64;
  DMA_K(0,0);DMA_V(0,0);DMA_K(1,SLOTB);
  bf16x8 qr[4];
  #pragma unroll
  for(int d0=0;d0<4;++d0)qr[d0]=*reinterpret_cast<const bf16x8*>(&Qw[(long)r32*QP+d0*16+hi*8]);
  const lds_cptr qlp=shm3+V128_Q+wid*4096+lane*16;
  { __attribute__((address_space(3))) bf16x8* qw_=(__attribute__((address_space(3))) bf16x8*)(__attribute__((address_space(3))) char*)qlp; qw_[0]=qr[0]; qw_[64]=qr[1]; qw_[128]=qr[2]; qw_[192]=qr[3]; }
  float mhat,l_reg=0.f;
  { float qq=0.f; _Pragma("unroll") for(int d0=0;d0<4;++d0) _Pragma("unroll") for(int j=0;j<8;++j){ const float x=__uint_as_float(((unsigned)(unsigned short)qr[d0][j])<<16); qq+=x*x; }
    qq+=__shfl_xor(qq,32); mhat=fminf(sqrtf(qq*kmax2)*1.01f+1e-20f,96.0f); }
  f32x16 negm; _Pragma("unroll") for(int r=0;r<16;++r)negm[r]=-mhat; asm volatile("":"+v"(negm));
  f32x16 o[4];
  _Pragma("unroll") for(int d_=0;d_<4;++d_){ _Pragma("unroll") for(int r=0;r<16;++r)o[d_][r]=0.f; asm volatile("":"+v"(o[d_])); }
  #define CMASK(P0,P1,t) do{}while(0)
  #define START(P0,P1) do{ _Pragma("unroll") for(int r=0;r<16;++r)P0[r]=__builtin_amdgcn_exp2f(P0[r]); }while(0)
  #define RESC() do{}while(0)
  f32x16 pA0,pA1,pB0,pB1;
  int sl_prev=0,sl_cur=0,sl_next=SLOTB;
  #define ROT() do{sl_prev=sl_cur;sl_cur=sl_next;sl_next=(sl_next==(NSLOT-1)*SLOTB)?0:sl_next+SLOTB;}while(0)
  DMA_K(2,2*SLOTB);
  WAIT_BAR(4);
  qkt(pA0,pA1,Kbase,qr,negm,r32,hi);asm volatile("s_nop 15\n\ts_nop 7":"+v"(pA0),"+v"(pA1));CMASK(pA0,pA1,0);
  START(pA0,pA1);
  _Pragma("unroll") for(int r=0;r<16;++r)pA1[r]=__builtin_amdgcn_exp2f(pA1[r]);
  WAIT_BAR(0);
  DMA_K(3,0);DMA_V(1,SLOTB);
  ROT();
  kload8(kf,kp0+sl_cur);
  WAIT_BAR(3);
  s16x4 vlo[4],vhi[4]; u32x4 pw0,pw1,pw2,pw3;
  #define PKW(P,B) cvtpk_s(P[B],P[B+1])
  #define PAF(k) __builtin_bit_cast(bf16x8,pw##k)
  #define VFR(i) (bf16x8){vlo[i][0],vlo[i][1],vlo[i][2],vlo[i][3],vhi[i][0],vhi[i][1],vhi[i][2],vhi[i][3]}
  #define PIN(x) asm volatile("":"+v"(x))
  #define MX3(a,b,c) __builtin_fmaxf(__builtin_fmaxf((a),(b)),(c))
  #define GAPA(MF,A0,A1,A2,A3,W0,W1,PW) do{ MF; sacc+=A0; sacc+=A1; sacc+=A2; sacc+=A3; PIN(sacc); W0; W1; PIN(PW); SBAR(); }while(0)
  #define EX(v) __builtin_amdgcn_exp2f(v)
  #define GAPB(MF,X,B) do{ MF; X[B]=EX(X[B]); X[B+1]=EX(X[B+1]); X[B+2]=EX(X[B+2]); X[B+3]=EX(X[B+3]); PIN(X); }while(0)
  #define GAPB2(MF,X,B) do{ MF; X[B]=EX(X[B]); X[B+1]=EX(X[B+1]); PIN(X); }while(0)
  #define VRW(e,d0,ks) do{ vlo[e]=vtr(vp_+((d0)*4096+(ks)*1024)); vhi[e]=vtr(vp_+((d0)*4096+(ks)*1024+512)); }while(0)
  #define KRD(G,j) do{ if(G){ kload2(kf,kp0+sl_next,j); SBAR(); } }while(0)
  #define STEP(C0,C1,P0,P1,t,GK,GV,GL) do{ SBAR(); \
    const lds_cptr vp_=vp0+2*sl_prev; \
    const bf16x8 q0_=*(const __attribute__((address_space(3))) bf16x8*)(qlp), q1_=*(const __attribute__((address_space(3))) bf16x8*)(qlp+1024);     \
    float sacc=(P0[0]+P0[1]); \
    GAPA(C0=__builtin_amdgcn_mfma_f32_32x32x16_bf16(kf[0],q0_,negm,0,0,0), P0[2],P0[3],P0[4],P0[5],     pw0[0]=PKW(P0,0), pw0[1]=PKW(P0,2), pw0); \
    GAPA(C1=__builtin_amdgcn_mfma_f32_32x32x16_bf16(kf[1],q0_,negm,0,0,0), P0[6],P0[7],P0[8],P0[9],     pw0[2]=PKW(P0,4), pw0[3]=PKW(P0,6), pw0); \
    const bf16x8 q2_=*(const __attribute__((address_space(3))) bf16x8*)(qlp+2048); SBAR(); \
    GAPA(C0=__builtin_amdgcn_mfma_f32_32x32x16_bf16(kf[2],q1_,C0,0,0,0),   P0[10],P0[11],P0[12],P0[13], pw1[0]=PKW(P0,8), pw1[1]=PKW(P0,10), pw1); \
    GAPA(C1=__builtin_amdgcn_mfma_f32_32x32x16_bf16(kf[3],q1_,C1,0,0,0),   P0[14],P0[15],P1[0],P1[1],   pw1[2]=PKW(P0,12),pw1[3]=PKW(P0,14), pw1); \
    const bf16x8 q3_=*(const __attribute__((address_space(3))) bf16x8*)(qlp+3072); SBAR(); \
    VRW(0,0,0); SBAR(); GAPA(C0=__builtin_amdgcn_mfma_f32_32x32x16_bf16(kf[4],q2_,C0,0,0,0),   P1[2],P1[3],P1[4],P1[5],     pw2[0]=PKW(P1,0), pw2[1]=PKW(P1,2), pw2); \
    VRW(1,1,0); SBAR(); GAPA(C1=__builtin_amdgcn_mfma_f32_32x32x16_bf16(kf[5],q2_,C1,0,0,0),   P1[6],P1[7],P1[8],P1[9],     pw2[2]=PKW(P1,4), pw2[3]=PKW(P1,6), pw2); \
    VRW(2,0,1); SBAR(); GAPA(C0=__builtin_amdgcn_mfma_f32_32x32x16_bf16(kf[6],q3_,C0,0,0,0),   P1[10],P1[11],P1[12],P1[13], pw3[0]=PKW(P1,8), pw3[1]=PKW(P1,10), pw3); \
    VRW(3,1,1); SBAR(); GAPA(C1=__builtin_amdgcn_mfma_f32_32x32x16_bf16(kf[7],q3_,C1,0,0,0),   P1[14],P1[15],0.f,0.f,       pw3[2]=PKW(P1,12),pw3[3]=PKW(P1,14), pw3); \
    l_reg+=sacc; \
    if(GK){DMA_K((t)+3,sl_cur);} if(GV){DMA_V((t)+1,sl_next);} \
      \
    SBAR(); \
    GAPB2(o[0]=__builtin_amdgcn_mfma_f32_32x32x16_bf16(PAF(0),VFR(0),o[0],0,0,0), C0,0); VRW(0,0,2); SBAR(); \
    GAPB2(o[1]=__builtin_amdgcn_mfma_f32_32x32x16_bf16(PAF(0),VFR(1),o[1],0,0,0), C0,2); VRW(1,1,2); SBAR(); \
    KRD(GL,0); GAPB2(o[0]=__builtin_amdgcn_mfma_f32_32x32x16_bf16(PAF(1),VFR(2),o[0],0,0,0), C0,4); VRW(2,0,3); SBAR(); \
    KRD(GL,1); GAPB2(o[1]=__builtin_amdgcn_mfma_f32_32x32x16_bf16(PAF(1),VFR(3),o[1],0,0,0), C0,6); VRW(3,1,3); SBAR(); \
    KRD(GL,2); GAPB2(o[0]=__builtin_amdgcn_mfma_f32_32x32x16_bf16(PAF(2),VFR(0),o[0],0,0,0), C0,8); VRW(0,2,0); SBAR(); \
    KRD(GL,3); GAPB2(o[1]=__builtin_amdgcn_mfma_f32_32x32x16_bf16(PAF(2),VFR(1),o[1],0,0,0), C0,10); VRW(1,3,0); SBAR(); \
    GAPB2(o[0]=__builtin_amdgcn_mfma_f32_32x32x16_bf16(PAF(3),VFR(2),o[0],0,0,0), C0,12); VRW(2,2,1); SBAR(); \
    GAPB2(o[1]=__builtin_amdgcn_mfma_f32_32x32x16_bf16(PAF(3),VFR(3),o[1],0,0,0), C0,14); VRW(3,3,1); SBAR(); \
    GAPB2(o[2]=__builtin_amdgcn_mfma_f32_32x32x16_bf16(PAF(0),VFR(0),o[2],0,0,0), C1,0); VRW(0,2,2); SBAR(); \
    GAPB2(o[3]=__builtin_amdgcn_mfma_f32_32x32x16_bf16(PAF(0),VFR(1),o[3],0,0,0), C1,2); VRW(1,3,2); SBAR(); \
    GAPB2(o[2]=__builtin_amdgcn_mfma_f32_32x32x16_bf16(PAF(1),VFR(2),o[2],0,0,0), C1,4); VRW(2,2,3); SBAR(); \
    GAPB2(o[3]=__builtin_amdgcn_mfma_f32_32x32x16_bf16(PAF(1),VFR(3),o[3],0,0,0), C1,6); VRW(3,3,3); SBAR(); \
    GAPB2(o[2]=__builtin_amdgcn_mfma_f32_32x32x16_bf16(PAF(2),VFR(0),o[2],0,0,0), C1,8); SBAR(); \
    GAPB2(o[3]=__builtin_amdgcn_mfma_f32_32x32x16_bf16(PAF(2),VFR(1),o[3],0,0,0), C1,10); SBAR(); \
    GAPB2(o[2]=__builtin_amdgcn_mfma_f32_32x32x16_bf16(PAF(3),VFR(2),o[2],0,0,0), C1,12); SBAR(); \
    GAPB2(o[3]=__builtin_amdgcn_mfma_f32_32x32x16_bf16(PAF(3),VFR(3),o[3],0,0,0), C1,14);  \
    }while(0)
  int t=1;
  #undef CMASK
  #define CMASK(P0,P1,t) do{}while(0)
  for(;t+5<NT;t+=2){
    STEP(pB0,pB1,pA0,pA1,t,true,true,true);     WAIT_BAR(3); RESC(); ROT();
    STEP(pA0,pA1,pB0,pB1,t+1,true,true,true);   WAIT_BAR(3); RESC(); ROT();
  }
  #undef CMASK
  #define CMASK(P0,P1,t) do{}while(0)
  #define ENDW(tt) do{ if((tt)+3<NT){WAIT_BAR(3);} else if((tt)+2<NT){WAIT_BAR(2);} else {WAIT_BAR(0);} }while(0)
  for(;t+1<NT;t+=2){
    STEP(pB0,pB1,pA0,pA1,t,(t+3<NT),(t+1<NT),(t+1<NT));       ENDW(t);   RESC(); ROT();
    STEP(pA0,pA1,pB0,pB1,t+1,(t+4<NT),(t+2<NT),(t+2<NT));     ENDW(t+1); RESC(); ROT();
  }
  STEP(pB0,pB1,pA0,pA1,NT-1,false,false,false); RESC();
  { float sacc=pB0[0]+pB0[1]; _Pragma("unroll") for(int r=2;r<16;++r)sacc+=pB0[r]; _Pragma("unroll") for(int r=0;r<16;++r)sacc+=pB1[r]; l_reg+=sacc;
    pw0=(u32x4){PKW(pB0,0),PKW(pB0,2),PKW(pB0,4),PKW(pB0,6)};pw1=(u32x4){PKW(pB0,8),PKW(pB0,10),PKW(pB0,12),PKW(pB0,14)};pw2=(u32x4){PKW(pB1,0),PKW(pB1,2),PKW(pB1,4),PKW(pB1,6)};pw3=(u32x4){PKW(pB1,8),PKW(pB1,10),PKW(pB1,12),PKW(pB1,14)};
    SBAR(); pv128(o,vb0+2*sl_cur,PAF(0),PAF(1),PAF(2),PAF(3)); }
  #undef PKW
  #undef PAF
  #undef VFR
  #undef PIN
  #undef MX3
  #undef GAPA
  #undef GAPB
  #undef GAPB2
  #undef EX
  #undef VRW
  #undef KRD
  #undef STEP
  #undef ENDW
  {auto rr=__builtin_amdgcn_permlane32_swap(__float_as_uint(l_reg),__float_as_uint(l_reg),false,false);l_reg=__uint_as_float(rr[0])+__uint_as_float(rr[1]);}
  if(hi==0)wsf[32+r32]=l_reg;asm volatile("s_waitcnt lgkmcnt(0)":::"memory");
  float rli[16];
  #pragma unroll
  for(int r=0;r<16;++r)rli[r]=__builtin_amdgcn_rcpf(wsf[32+crow(r,hi)]);
  bf16*Ow=Ow0+(long)wid*QBLK*OP;
  asm volatile("s_waitcnt lgkmcnt(0)\n\ts_barrier":::"memory");
  { bf16*stg=(bf16*)(shm)+wid*4096;
    #pragma unroll
    for(int r=0;r<16;++r){const int orow=crow(r,hi);
      #pragma unroll
      for(int d0=0;d0<4;++d0)stg[orow*128+d0*32+r32]=__float2bfloat16(o[d0][r]*rli[r]);}
    asm volatile("s_waitcnt lgkmcnt(0)":::"memory");
    #pragma unroll
    for(int i=0;i<8;++i){const int row=i*4+(lane>>4),ch=lane&15; const u32x4 v=*(const u32x4*)(stg+row*128+ch*8); ATTN_STORE16(Ow+(long)row*OP+ch*8,v);} }
  asm volatile("s_waitcnt lgkmcnt(0)\n\ts_barrier":::"memory");
  #undef DMA_K
  #undef DMA_V
  #undef CMASK
  #undef START
  #undef RESC
  #undef ROT
}
constexpr int ATTN_LDS_BYTES=LDS_BYTES;
#undef SBAR
#undef WAIT_BAR
}
#ifndef PROBE_MASK
#define PROBE_MASK 0ull
#endif
#ifndef PROBE_AMP
#define PROBE_AMP 4
#endif

constexpr int NWAVES = 8;
constexpr int DM = 1024, SEQ = 8192, NB = 2, CTXL = 256, NLAT = NB * SEQ, T = NLAT + NB * CTXL  , NKEY = SEQ + CTXL  ;
constexpr int NPXA = 2304, NPXB = 4096, INC = NPXA + NPXB;
constexpr float EPS = 1e-6f;
constexpr size_t MiB = 1u << 20;
constexpr size_t WS_CTL = 0, CTL_ZERO_BYTES = 1 * MiB, WS_MOD = 512 * 1024;
constexpr size_t WS_KMAX = 768 * 1024;
constexpr size_t WS_ROPE = 1 * MiB, WS_LAM = 1 * MiB + 65536;
constexpr size_t WS_WIN = 2 * MiB, WS_WA = 15 * MiB, WS_WB = 16 * MiB, WS_WC = 17 * MiB, WS_WO = 18 * MiB, WS_WQ = 20 * MiB;
constexpr size_t WS_U16 = 22 * MiB, WS_V16 = 54 * MiB;
constexpr size_t WS_SU = WS_U16 + 12 * MiB, WS_SV = WS_V16 + 12 * MiB; constexpr int ROW6 = 768;
constexpr size_t TAB_L = 16 * MiB;
static_assert(WS_SU + TAB_L + 16384 * 4 <= WS_V16 && WS_SV + TAB_L + 16384 * 4 <= 86 * MiB, "expert table regions");
constexpr size_t WS_X = 86 * MiB;
constexpr size_t WS_R1 = 152 * MiB;
constexpr size_t WS_R2 = 227 * MiB;
constexpr size_t SZ_QA = (size_t)NB * 4 * 2 * NKEY * 64 * 2, SZ_VA = (size_t)NB * 4 * NKEY * 128 * 2, SZ_QB = (size_t)NB * 8 * NKEY * 64 * 2, SZ_KB = (size_t)NB * 2 * NKEY * 64 * 2;
constexpr size_t WS_QA = WS_R2, WS_KA = WS_QA + SZ_QA, WS_VA = WS_KA + SZ_QA, WS_QB = WS_VA + SZ_VA, WS_KB = WS_QB + SZ_QB, WS_VB = WS_KB + SZ_KB;
constexpr size_t WS_MB = WS_R2, WS_EIDX = WS_R2 + 33 * MiB, WS_GW = WS_EIDX + (size_t)T * 128 * 4;
constexpr size_t WS_R3 = 306 * MiB;
constexpr size_t WS_R4 = 438 * MiB;
constexpr size_t SZ_O = (size_t)T * 512 * 2;
constexpr size_t WS_OABC = WS_R4, WS_HX = WS_R4;
constexpr size_t WS_SSQ = 488 * MiB;
constexpr size_t WS_BQ = 490 * MiB;
constexpr size_t WS_END = 491 * MiB;
static_assert(WS_VB + SZ_KB <= WS_R3 && WS_GW + (size_t)T * 128 * 4 <= WS_R3 && WS_R1 + (size_t)T * NPXA * 2 <= WS_R2 && WS_R3 + (size_t)T * NPXB * 2 <= WS_R4 && WS_OABC + 3 * SZ_O <= WS_END, "d_ws map");
constexpr int CW_TMO = 0, CW_BAR = 4096;
static_assert(CW_BAR * 4 + 3456 * 4 <= WS_MOD && WS_MOD + (size_t)2 * 3 * 6144 * 4 <= WS_KMAX && WS_KMAX + 512 <= CTL_ZERO_BYTES, "control-region map");

constexpr int RING_BYTES = 131072, LDSCTL_OFF = RING_BYTES, MISC_OFF = LDSCTL_OFF + 320, LDS_BYTES = 147456;

struct Args { const float* in[27]; float* out; unsigned char* ws; int ph_lo, ph_hi; };
struct Frame { LAS unsigned char* lds; volatile LAS unsigned* MISC; gu32* ctl; int tid, lane, wave, G, bid; };

typedef float f32x16 __attribute__((ext_vector_type(16)));
typedef short s16x4 __attribute__((ext_vector_type(4)));
typedef unsigned u32x2 __attribute__((ext_vector_type(2)));
typedef float f32x2 __attribute__((ext_vector_type(2)));
typedef float v32f __attribute__((ext_vector_type(32))); typedef __bf16 v32bf __attribute__((ext_vector_type(32))); typedef unsigned v6u __attribute__((ext_vector_type(6))); typedef unsigned v3u __attribute__((ext_vector_type(3)));
__device__ __forceinline__ float bf2f(unsigned short b) { return __uint_as_float((unsigned)b << 16); }
__device__ __forceinline__ float bflo(unsigned w) { return __uint_as_float(w << 16); }
__device__ __forceinline__ float bfhi(unsigned w) { return __uint_as_float(w & 0xffff0000u); }
__device__ __forceinline__ float sigm(float x) { return __builtin_amdgcn_rcpf(1.0f + __expf(-x)); }
__device__ __forceinline__ int mod_index(int row) { return row < SEQ ? 0 : (row < NLAT ? 1 : 2); }
__device__ __forceinline__ void row_to_bn(int row, int& b, int& nd) { if (row < NLAT) { b = row >> 13; nd = row & (SEQ - 1); } else { const int r = row - NLAT; b = r >> 8; nd = SEQ + (r & 255); } }

__device__ __forceinline__ void ph_prep0(const Args& a, Frame& F) {
    const int gtid = (F.G - 1 - F.bid) * 512 + F.tid;
    if (gtid < 2048) {
        const int pos = gtid >> 4, i = gtid & 15;
        double inv = 1.0; for (int k = 0; k < i; ++k) inv *= 0.5623413251903491;
        const double x = (double)pos * inv, TWO_PI = 6.283185307179586476925;
        const double kk = rint(x / TWO_PI), y = x - kk * TWO_PI, y2 = y * y;
        double ts = 1.0, tc = 1.0;
        for (int n = 14; n >= 1; --n) { ts = 1.0 - ts * y2 / (double)((2 * n) * (2 * n + 1)); tc = 1.0 - tc * y2 / (double)((2 * n - 1) * (2 * n)); }
        float* rp = (float*)(a.ws + WS_ROPE) + gtid * 2; rp[0] = (float)tc; rp[1] = (float)(y * ts);
    }
    if (gtid >= 2048 && gtid < 2050) {
        const int l = gtid - 2048; float s1 = 0.f, s2 = 0.f;
        for (int d = 0; d < 64; ++d) { s1 += a.in[7][l * 64 + d] * a.in[8][l * 64 + d]; s2 += a.in[9][l * 64 + d] * a.in[10][l * 64 + d]; }
        const float lam_init = l == 0 ? 0.2f : 0.35550906759096926f;
        float* lp = (float*)(a.ws + WS_LAM); lp[l * 2] = expf(s1) - expf(s2) + lam_init; lp[l * 2 + 1] = 1.0f - lam_init;
    }
    if (F.bid < 192) {
        float* MOD = (float*)(a.ws + WS_MOD); LAS float* sc = (LAS float*)F.lds; LAS float* red = sc + 3072;
        for (int i = F.tid; i < 3072; i += 512) { const int k = i & 1023; const float c = i < 1024 ? a.in[1][k] : (i < 2048 ? a.in[1][1024 + k] : a.in[3][k]); sc[i] = c * sigm(c); }
        __syncthreads();
        for (int u = F.bid; u < 192; u += F.G) {
            const int l = u / 96, cc = u % 96, kg = F.tid >> 4, c4 = F.tid & 15;
            const f32x4* W = (const f32x4*)(a.in[4] + (size_t)l * 1024 * 6144 + (size_t)(kg * 32) * 6144 + cc * 64 + 4 * c4);
            f32x4 s0 = {0.f, 0.f, 0.f, 0.f}, s1 = s0, s2 = s0;
#pragma unroll
            for (int h = 0; h < 2; ++h) { f32x4 w[16];
#pragma unroll
                for (int kk = 0; kk < 16; ++kk) w[kk] = W[(size_t)(h * 16 + kk) * (6144 / 4)];
#pragma unroll
                for (int kk = 0; kk < 16; ++kk) { const int k = kg * 32 + h * 16 + kk; s0 += sc[k] * w[kk]; s1 += sc[1024 + k] * w[kk]; s2 += sc[2048 + k] * w[kk]; } }
            *(LAS f32x4*)(red + (kg * 3 + 0) * 64 + 4 * c4) = s0; *(LAS f32x4*)(red + (kg * 3 + 1) * 64 + 4 * c4) = s1; *(LAS f32x4*)(red + (kg * 3 + 2) * 64 + 4 * c4) = s2;
            __syncthreads();
            if (F.tid < 192) { const int mi = F.tid >> 6, c = F.tid & 63; float s = a.in[5][l * 6144 + cc * 64 + c];
                for (int g = 0; g < 32; ++g) s += red[(g * 3 + mi) * 64 + c];
                MOD[(l * 3 + mi) * 6144 + cc * 64 + c] = s; }
            __syncthreads();
        }
    }
}
__device__ __forceinline__ void ph_convw(const Args& a, Frame& F, int l, int vb, int vG, int parts) {
    LAS float* scr = (LAS float*)(F.lds + F.wave * 16384);
    const int gw = vb * NWAVES + F.wave, NGW = vG * NWAVES;
    constexpr int I_IN = 16 * 200, I_BR = 8 * 32, I_O = 16 * 32, NITEMS = I_IN + 3 * I_BR + 2 * I_O;
    if (parts & 1) for (int it = gw; it < NITEMS; it += NGW) {
        int r = it;
        if (r < I_IN) { p0_transpose_item(a.in[6] + (size_t)l * 1024 * INC, 1024, INC, (bf16*)(a.ws + WS_WIN), 0, scr, r, F.lane); continue; } r -= I_IN;
        if (r < I_BR) { p0_transpose_item_p(a.in[18] + (size_t)l * 512 * 1024, 512, 1024, (bf16*)(a.ws + WS_WA), 1536, 0, scr, r, F.lane); continue; } r -= I_BR;
        if (r < I_BR) { p0_transpose_item_p(a.in[19] + (size_t)l * 512 * 1024, 512, 1024, (bf16*)(a.ws + WS_WA), 1536, 512, scr, r, F.lane); continue; } r -= I_BR;
        if (r < I_BR) { p0_transpose_item_p(a.in[20] + (size_t)l * 512 * 1024, 512, 1024, (bf16*)(a.ws + WS_WA), 1536, 1024, scr, r, F.lane); continue; } r -= I_BR;
        if (r < I_O) { p0_transpose_item(a.in[21] + (size_t)l * 1024 * 1024, 1024, 1024, (bf16*)(a.ws + WS_WO), 0, scr, r, F.lane); continue; } r -= I_O;
        p0_transpose_item(a.in[22] + (size_t)l * 1024 * 1024, 1024, 1024, (bf16*)(a.ws + WS_WQ), 0, scr, r, F.lane);
    }
    const int gtid = vb * 512 + F.tid, NT = vG * 512; constexpr int NI = 2 * 16384 * 32, NIH = 16384 * 32;
    const f32x4* us = (const f32x4*)(a.in[24] + (size_t)l * 16384 * 1024); const f32x4* vs = (const f32x4*)(a.in[25] + (size_t)l * 16384 * 1024);
    const int ilo = (parts & 2) ? 0 : NIH, ihi = (parts & 4) ? NI : NIH;
    for (int i0 = ilo + gtid; i0 < ihi; i0 += 2 * NT) { f32x4 p_[2][8];
#pragma unroll
        for (int u_ = 0; u_ < 2; ++u_) { const int i = min(i0 + u_ * NT, ihi - 1); const bool isv = i >= NIH; const int j = isv ? i - NIH : i; const f32x4* sp = (isv ? vs : us) + 8 * (size_t)j;
#pragma unroll
            for (int q = 0; q < 8; ++q) p_[u_][q] = sp[q]; }
#pragma unroll
        for (int u_ = 0; u_ < 2; ++u_) { const int i = min(i0 + u_ * NT, ihi - 1); const bool isv = i >= NIH; const int j = isv ? i - NIH : i;
            float m = 0.f;
#pragma unroll
            for (int q = 0; q < 8; ++q) m = fmaxf(fmaxf(m, fmaxf(fabsf(p_[u_][q][0]), fabsf(p_[u_][q][1]))), fmaxf(fabsf(p_[u_][q][2]), fabsf(p_[u_][q][3])));
#pragma unroll
            for (int o = 16; o >= 1; o >>= 1) m = fmaxf(m, __shfl_xor(m, o));
            const float sc = m > 0.f ? 7.5f * __builtin_amdgcn_rcpf(m) : 1.0f, inv = m > 0.f ? m * (1.0f / 7.5f) : 1.0f;
            v32bf bv;
#pragma unroll
            for (int q = 0; q < 8; ++q) { bv[4 * q] = (__bf16)(p_[u_][q][0] * sc); bv[4 * q + 1] = (__bf16)(p_[u_][q][1] * sc); bv[4 * q + 2] = (__bf16)(p_[u_][q][2] * sc); bv[4 * q + 3] = (__bf16)(p_[u_][q][3] * sc); }
            const v6u o = __builtin_amdgcn_cvt_scalef32_pk32_fp6_bf16(bv, 1.0f);
            if (i0 + u_ * NT < ihi) { unsigned char* dp = a.ws + (isv ? WS_V16 : WS_U16) + (size_t)l * TAB_L + (size_t)(j >> 5) * ROW6 + 24 * (j & 31);
                *(u32x2*)dp = (u32x2){o[0], o[1]}; *(u32x2*)(dp + 8) = (u32x2){o[2], o[3]}; *(u32x2*)(dp + 16) = (u32x2){o[4], o[5]};
                if ((j & 31) == 0) ((float*)(a.ws + (isv ? WS_SV : WS_SU) + (size_t)l * TAB_L))[j >> 5] = inv; } } }
}
__device__ __forceinline__ void ph_mod(const Args& a, Frame& F, int l, int which) {
    const float* MOD = (const float*)(a.ws + WS_MOD) + (size_t)l * 3 * 6144 + (which ? 3072 : 0);
    const bool from_in = (l == 0 && which == 0);
    const float* X = from_in ? a.in[0] : (const float*)(a.ws + WS_X); const float* XC = from_in ? a.in[2] - (size_t)NLAT * DM : X; bf16* HX = (bf16*)(a.ws + WS_HX);
    const int gw = F.bid * NWAVES + F.wave, NGW = F.G * NWAVES; const int TL = (l == 1 && which == 1) ? NLAT : T;
    for (int row0 = gw; row0 < TL; row0 += 2 * NGW) {
        f32x4 v[2][4]; float ss[2];
#pragma unroll
        for (int u_ = 0; u_ < 2; ++u_) { const int row = min(row0 + u_ * NGW, TL - 1); const f32x4* xr = (const f32x4*)((row < NLAT ? X : XC) + (size_t)row * DM) + F.lane; ss[u_] = 0.f;
#pragma unroll
            for (int j = 0; j < 4; ++j) v[u_][j] = xr[64 * j]; }
#pragma unroll
        for (int u_ = 0; u_ < 2; ++u_) {
#pragma unroll
            for (int j = 0; j < 4; ++j) ss[u_] += (v[u_][j][0] * v[u_][j][0] + v[u_][j][1] * v[u_][j][1]) + (v[u_][j][2] * v[u_][j][2] + v[u_][j][3] * v[u_][j][3]); }
#pragma unroll
        for (int u_ = 0; u_ < 2; ++u_) { const int row = row0 + u_ * NGW; if (row < TL) {
            const float* sh = MOD + mod_index(row) * 6144; const float* sc = sh + 1024;
            const float rstd = rsqrtf(wave_sum(ss[u_]) * (1.0f / DM) + EPS);
#pragma unroll
            for (int j = 0; j < 4; ++j) { const int c = 4 * F.lane + 256 * j; const f32x4 s1 = *(const f32x4*)(sc + c), s0 = *(const f32x4*)(sh + c);
                const f32x4 h = v[u_][j] * rstd * (s1 + 1.0f) + s0; u32x2 o; o.x = pk2(h[0], h[1]); o.y = pk2(h[2], h[3]); *(u32x2*)(HX + (size_t)row * DM + c) = o; } } }
    }
}
__device__ __forceinline__ void ph_post(const Args& a, Frame& F, int l) {
    const bf16* PXa = (const bf16*)(a.ws + WS_R1); const float* rope = (const float*)(a.ws + WS_ROPE);
    const int gw = F.bid * NWAVES + F.wave, NGW = F.G * NWAVES, lane = F.lane;
    float km0_ = 0.f, km1_ = 0.f;
    {
        const int c = lane & 7, g8 = lane >> 3;
        float qw[8], kw[8];
#pragma unroll
        for (int j = 0; j < 8; ++j) { qw[j] = a.in[12][l * 64 + 8 * c + j]; kw[j] = a.in[13][l * 64 + 8 * c + j]; }
        float& km0 = km0_; float& km1 = km1_;
        for (int row = gw; row < T; row += NGW) {
            int b, nd; row_to_bn(row, b, nd);
            const bool lat = row < NLAT; const int pos = (c & 4) ? (nd & 63) : ((nd >> 6) & 127);
            float cs[8], sn[8];
            { const f32x4* rp = (const f32x4*)(rope + (pos * 16 + 8 * (c & 1)) * 2);
              const f32x4 r0 = rp[0], r1 = rp[1], r2 = rp[2], r3 = rp[3];
              cs[0] = r0[0]; sn[0] = r0[1]; cs[1] = r0[2]; sn[1] = r0[3]; cs[2] = r1[0]; sn[2] = r1[1]; cs[3] = r1[2]; sn[3] = r1[3];
              cs[4] = r2[0]; sn[4] = r2[1]; cs[5] = r2[2]; sn[5] = r2[3]; cs[6] = r3[0]; sn[6] = r3[1]; cs[7] = r3[2]; sn[7] = r3[3]; }
            const bf16* pr = PXa + (size_t)row * NPXA;
            v4u wv[5];
#pragma unroll
            for (int it = 0; it < 5; ++it) { const int hv = min(8 * it + g8, 35); wv[it] = *(const v4u*)(pr + hv * 64 + 8 * c); }
#pragma unroll
            for (int it = 0; it < 5; ++it) {
                const int hv = 8 * it + g8;
                float x[8]; x[0] = bflo(wv[it].x); x[1] = bfhi(wv[it].x); x[2] = bflo(wv[it].y); x[3] = bfhi(wv[it].y); x[4] = bflo(wv[it].z); x[5] = bfhi(wv[it].z); x[6] = bflo(wv[it].w); x[7] = bfhi(wv[it].w);
                const bool is_v = (hv >= 8 && hv < 16) || hv == 18 || hv == 19;
                const bool nrm = (hv == 16 || hv == 17 || hv >= 28);
                float ss = 0.f;
#pragma unroll
                for (int j = 0; j < 8; ++j) ss += x[j] * x[j];
                ss += __shfl_xor(ss, 1); ss += __shfl_xor(ss, 2); ss += __shfl_xor(ss, 4);
                const float rs = rsqrtf(ss * (1.0f / 64.0f) + EPS);
                if (it == 0) { if (b == 0) km0 = fmaxf(km0, ss); else km1 = fmaxf(km1, ss); }
                const float qs = hv >= 20 ? 0.18033688011112042f : 1.0f;
#pragma unroll
                for (int j = 0; j < 8; ++j) { if (nrm) x[j] *= rs * (hv >= 28 ? qw[j] : kw[j]); }
                const bool rot = lat && !is_v;
#pragma unroll
                for (int j = 0; j < 8; ++j) { const float p = __shfl_xor(x[j], 2); const float r = x[j] * cs[j] + ((c & 2) ? p : -p) * sn[j]; x[j] = (rot ? r : x[j]) * qs; }
                v4u o; o.x = pk2(x[0], x[1]); o.y = pk2(x[2], x[3]); o.z = pk2(x[4], x[5]); o.w = pk2(x[6], x[7]);
                unsigned off;
                if (hv < 8) off = (unsigned)WS_KA + (((unsigned)(b * 8 + hv) * NKEY + nd) * 64 + 8 * c) * 2;
                else if (hv < 16) off = (unsigned)WS_VA + (((unsigned)(b * 4 + ((hv - 8) >> 1)) * NKEY + nd) * 128 + ((hv - 8) & 1) * 64 + 8 * c) * 2;
                else if (hv < 18) off = (unsigned)WS_KB + (((unsigned)(b * 2 + (hv - 16)) * NKEY + nd) * 64 + 8 * c) * 2;
                else if (hv < 20) off = (unsigned)WS_VB + (((unsigned)(b * 2 + (hv - 18)) * NKEY + nd) * 64 + 8 * c) * 2;
                else if (hv < 28) off = (unsigned)WS_QA + (((unsigned)(b * 8 + (hv - 20)) * NKEY + nd) * 64 + 8 * c) * 2;
                else off = (unsigned)WS_QB + (((unsigned)(b * 8 + (hv - 28)) * NKEY + nd) * 64 + 8 * c) * 2;
                if (hv < 36) *(v4u*)(a.ws + off) = o;
            }
        }
    }
    { LAS float* KM = (LAS float*)(F.lds + 70656);
      if ((lane & 7) == 0) { KM[(F.wave * 2 + 0) * 8 + (lane >> 3)] = km0_; KM[(F.wave * 2 + 1) * 8 + (lane >> 3)] = km1_; }
      __syncthreads();
      int t_ = F.tid; asm volatile("" : "+v"(t_));
      if (t_ < 16) { float m = 0.f;
#pragma unroll
          for (int w_ = 0; w_ < 8; ++w_) m = fmaxf(m, KM[w_ * 16 + t_]);
          atomicMax((unsigned*)(a.ws + WS_KMAX) + l * 64 + t_, __float_as_uint(m)); } }
    const bf16* PXb = (const bf16*)(a.ws + WS_R3); bf16* OC = (bf16*)(a.ws + WS_OABC) + 1024;
    LAS unsigned short* UL = (LAS unsigned short*)F.lds;
    LAS float* RED = (LAS float*)(F.lds + 65536);
    LAS float* STAT = (LAS float*)(F.lds + 68608);
    LAS float* MSK = (LAS float*)(F.lds + 69632);
    constexpr int TT = 33;
    const int c = F.tid;
    float w[31];
#pragma unroll
    for (int k = 0; k < 31; ++k) w[k] = a.in[14][(size_t)l * 31 * 512 + k * 512 + c];
    int vz; asm volatile("v_mov_b32 %0, 0" : "=v"(vz));
    const float cb = a.in[15][l * 512 + c], lnw = a.in[16][l * 512 + c], lnb = a.in[17][l * 512 + c];
    for (int ct = F.bid; ct < (l == 0 ? T / TT : (NLAT + TT - 1) / TT); ct += F.G) {
        const int t0 = ct * TT;
        int bnd = -1; { const int lo_ = t0 - 15, hi_ = t0 + TT + 15; if (lo_ < 0) bnd = 0; else if (SEQ > lo_ && SEQ < hi_) bnd = SEQ; else if (NLAT > lo_ && NLAT < hi_) bnd = NLAT; else if (NLAT + CTXL > lo_ && NLAT + CTXL < hi_) bnd = NLAT + CTXL; else if (hi_ > T) bnd = T; }
        if (F.tid < 128) { const int p = F.tid >> 6, i = F.tid & 63; const int r = t0 - 15 + i;
            MSK[p * 64 + i] = (i < TT + 30 && r >= 0 && r < T && (bnd < 0 || ((r < bnd) == (p == 0)))) ? 1.f : 0.f;
            MSK[128 + p * 64 + i] = (i < TT && (bnd < 0 ? p == 0 : (((t0 + i) < bnd) == (p == 0)))) ? 1.f : 0.f; }
        __syncthreads();
        float y[TT];
#pragma unroll
        for (int n = 0; n < TT; ++n) y[n] = 0.f;
        const int npass = bnd < 0 ? 1 : 2;
        for (int pass = 0; pass < npass; ++pass) {
            __syncthreads();
            { v4u ga_[8], gg_[8];
#pragma unroll
              for (int q = 0; q < 8; ++q) { const int it = min(F.tid + 512 * q, (TT + 30) * 64 - 1); const int i = it >> 6, j8 = (it & 63) * 8; const int r = min(max(t0 - 15 + i, 0), T - 1);
                  ga_[q] = *(const v4u*)(PXb + (size_t)r * NPXB + j8); gg_[q] = *(const v4u*)(PXb + (size_t)r * NPXB + 512 + j8); }
#pragma unroll
              for (int q = 0; q < 8; ++q) { const int it = F.tid + 512 * q; if (it < (TT + 30) * 64) { const int i = it >> 6, j8 = (it & 63) * 8; const float mk = MSK[pass * 64 + i];
                  v4u o;
#pragma unroll
                  for (int e = 0; e < 4; ++e) { const float u0 = bflo(ga_[q][e]) * sigm(bflo(gg_[q][e])) * mk, u1 = bfhi(ga_[q][e]) * sigm(bfhi(gg_[q][e])) * mk; o[e] = pk2(u0, u1); }
                  *(LAS v4u*)(UL + i * 512 + j8) = o; } }
            }
            __syncthreads();
            float u[TT + 30];
#pragma unroll
            for (int i = 0; i < TT + 30; ++i) u[i] = bf2f(UL[i * 512 + c]);
#pragma unroll
            for (int n = 0; n < TT; ++n) { float acc = cb;
#pragma unroll
                for (int k = 0; k < 31; ++k) acc += w[k] * u[n + k];
                y[n] += acc * MSK[128 + pass * 64 + n + vz]; if ((n & 3) == 3) __builtin_amdgcn_sched_barrier(0); }
        }
#pragma unroll
        for (int n = 0; n < TT; ++n) { float s1 = y[n], s2 = y[n] * y[n];
#pragma unroll
            for (int o = 32; o >= 1; o >>= 1) { s1 += __shfl_xor(s1, o); s2 += __shfl_xor(s2, o); }
            if (lane == 0) { RED[(F.wave * TT + n) * 2] = s1; RED[(F.wave * TT + n) * 2 + 1] = s2; } }
        __syncthreads();
        if (F.tid < TT) { const int n = F.tid; float s1 = 0.f, s2 = 0.f;
#pragma unroll
            for (int wv_ = 0; wv_ < 8; ++wv_) { s1 += RED[(wv_ * TT + n) * 2]; s2 += RED[(wv_ * TT + n) * 2 + 1]; }
            const float mu = s1 * (1.0f / 512.0f), var = fmaxf(s2 * (1.0f / 512.0f) - mu * mu, 0.f);
            STAT[2 * n] = mu; STAT[2 * n + 1] = rsqrtf(var + EPS); }
        __syncthreads();
#pragma unroll
        for (int n = 0; n < TT; ++n) {
            if ((n & 7) == 7) __builtin_amdgcn_sched_barrier(0);
            const float yn = (y[n] - STAT[2 * n + vz]) * STAT[2 * n + 1 + vz] * lnw + lnb;
            OC[(size_t)(t0 + n) * 1536 + c] = (unsigned short)f2bf(yn * sigm(yn)); }
        __syncthreads();
    }
}
__device__ __forceinline__ void ph_attn(const Args& a, Frame& F, int l, char* shm) {
    typedef attn_body::bf16 abf;
    const int xcd = F.bid & 7, idx = F.bid >> 3;
    const int nA = (F.G == 256) ? 2 + ((l == 0 && F.bid < 16) ? 1 : 0) : 0;
    for (int j = 0; j < nA; ++j) {
        const int st = j < 2 ? 2 * xcd + j : F.bid, qb = j < 2 ? idx : 32;
        const int kt0 = qb == 32 ? 128 : 0, NT = qb == 32 ? 4 : 132;
        const abf* Qp = (const abf*)(a.ws + WS_QA) + ((size_t)st * NKEY + qb * 256) * 64; const abf* Kp = (const abf*)(a.ws + WS_KA) + ((size_t)st * NKEY + kt0 * 64) * 64;
        const abf* Vp = (const abf*)(a.ws + WS_VA) + ((size_t)(st >> 1) * NKEY + kt0 * 64) * 128;
        abf* Op = (abf*)(a.ws + WS_R1) + ((size_t)st * NKEY + qb * 256) * 128;
        attn_body::attn_unit128<8>(Qp, 64, Kp, 64, Vp, 128, Op, 128, NT, shm, __uint_as_float(__hip_atomic_load((unsigned*)(a.ws + WS_KMAX) + l * 64 + st, __ATOMIC_RELAXED, __HIP_MEMORY_SCOPE_AGENT)));
    }
    float mq = 0.f, mk = 0.f; for (int d = 0; d < 64; ++d) { mq = fmaxf(mq, fabsf(a.in[12][l * 64 + d])); mk = fmaxf(mk, fabsf(a.in[13][l * 64 + d])); }
    const float mrefB = 64.0f * mq * mk * 0.18033688011112042f * 1.02f;
    const int nB = (F.G == 256) ? 2 + ((l == 0 && F.bid >= 16 && F.bid < 32) ? 1 : 0) : 0;
    for (int j = 0; j < nB; ++j) {
        const int st = j < 2 ? 2 * xcd + j : F.bid - 16, qb = j < 2 ? idx : 32;
        const int kt0 = qb == 32 ? 128 : 0, NT = qb == 32 ? 4 : 132;
        const int b = st >> 3, qh = st & 7, kvh = b * 2 + (qh >> 2);
        const abf* Qp = (const abf*)(a.ws + WS_QB) + ((size_t)st * NKEY + qb * 256) * 64; const abf* Kp = (const abf*)(a.ws + WS_KB) + ((size_t)kvh * NKEY + kt0 * 64) * 64;
        const abf* Vp = (const abf*)(a.ws + WS_VB) + ((size_t)kvh * NKEY + kt0 * 64) * 64;
        const int trow = qb == 32 ? NLAT + b * CTXL : b * SEQ + qb * 256;
        abf* Op = (abf*)(a.ws + WS_OABC) + (size_t)trow * 1536 + 512 + qh * 64;
        attn_body::attn_unit<8>(Qp, 64, Kp, 64, Vp, 64, Op, 1536, NT, shm, mrefB);
    }
}
__device__ __forceinline__ void ph_comb(const Args& a, Frame& F, int l) {
    const bf16* OA2 = (const bf16*)(a.ws + WS_R1); bf16* OA = (bf16*)(a.ws + WS_OABC);
    const float lam = ((const float*)(a.ws + WS_LAM))[l * 2], oml = ((const float*)(a.ws + WS_LAM))[l * 2 + 1];
    const int gw = F.bid * NWAVES + F.wave, NGW = F.G * NWAVES, lane = F.lane;
    const float w0 = a.in[11][l * 128 + 2 * lane] * oml, w1 = a.in[11][l * 128 + 2 * lane + 1] * oml;
    const int NIT = (l == 0 ? T : NLAT) * 4;
    for (int it0 = gw; it0 < NIT; it0 += 4 * NGW) {
        unsigned p1[4], p2[4]; int rowv[4], hv_[4];
#pragma unroll
        for (int j = 0; j < 4; ++j) { const int it = min(it0 + j * NGW, NIT - 1); const int row = it >> 2, h = it & 3; int b, nd; row_to_bn(row, b, nd); rowv[j] = row; hv_[j] = h;
            p1[j] = *(const unsigned*)(OA2 + ((size_t)((b * 4 + h) * 2 + 0) * NKEY + nd) * 128 + 2 * lane); p2[j] = *(const unsigned*)(OA2 + ((size_t)((b * 4 + h) * 2 + 1) * NKEY + nd) * 128 + 2 * lane); }
#pragma unroll
        for (int j = 0; j < 4; ++j) { if (it0 + j * NGW < NIT) {
            const float x0 = bflo(p1[j]) - lam * bflo(p2[j]), x1 = bfhi(p1[j]) - lam * bfhi(p2[j]);
            const float rstd = rsqrtf(wave_sum(x0 * x0 + x1 * x1) * (1.0f / 128.0f) + EPS);
            *(unsigned*)(OA + (size_t)rowv[j] * 1536 + hv_[j] * 128 + 2 * lane) = pk2(x0 * rstd * w0, x1 * rstd * w1); } }
    }
}
__constant__ unsigned char PK_CAND[50] = {0,1,2,3,4,5,6,7,8,9,10,11,12,13,14,15, 16,17,18,19,20,21,22,23, 32,33,34,35,36, 48,49,50,51, 64,65,66, 80,81, 96,97, 112,113, 128, 144, 160, 176, 192, 208, 224, 240};
__device__ __forceinline__ void ce_desc(float& x, float& y) { float hi_, lo_; asm("v_max_f32_e32 %0, %1, %2" : "=v"(hi_) : "v"(x), "v"(y)); asm("v_min_f32_e32 %0, %1, %2" : "=v"(lo_) : "v"(x), "v"(y)); x = hi_; y = lo_; }
__device__ __forceinline__ void sort16_desc(float (&v)[16]) {
#pragma unroll
    for (int k = 2; k <= 16; k <<= 1)
#pragma unroll
        for (int j = k >> 1; j > 0; j >>= 1)
#pragma unroll
            for (int i = 0; i < 16; ++i) { const int p = i ^ j; if (p > i) { if ((i & k) == 0) ce_desc(v[i], v[p]); else ce_desc(v[p], v[i]); } }
}
__device__ __forceinline__ void merge16_desc(float (&t)[16], const float (&v)[16]) {
#pragma unroll
    for (int i = 0; i < 16; ++i) { float m; asm("v_max_f32_e32 %0, %1, %2" : "=v"(m) : "v"(t[i]), "v"(v[15 - i])); t[i] = m; }
#pragma unroll
    for (int j = 8; j > 0; j >>= 1)
#pragma unroll
        for (int i = 0; i < 16; ++i) { const int p = i ^ j; if (p > i) ce_desc(t[i], t[p]); }
}
__device__ __forceinline__ void ph_topk(const Args& a, Frame& F, int l) {
    const float* PQ = (const float*)(a.ws + WS_R1); int* EIDX = (int*)(a.ws + WS_EIDX); float* GW = (float*)(a.ws + WS_GW);
    LAS unsigned char* KH = F.lds; LAS unsigned char* KLo = F.lds + 32768;
    LAS unsigned* XV = (LAS unsigned*)(F.lds + 65536);
    const int tid = F.tid, lane = F.lane, wave = F.wave;
    int cur_h = -1;
    for (int u = F.bid; u < ((l == 0 ? T : NLAT) / 256) * 8; u += F.G) {
        const int h = u & 7, t0 = (u >> 3) * 256;
        if (h != cur_h) { __syncthreads(); const float* ks = a.in[23] + ((size_t)l * 8 + h) * 2 * 128 * 64;
#pragma unroll
            for (int i = 0; i < 4; ++i) { const int ch = tid + 512 * i, krow = ch >> 3, c8 = ch & 7;
                const f32x4 x0 = *(const f32x4*)(ks + (size_t)krow * 64 + c8 * 8), x1 = *(const f32x4*)(ks + (size_t)krow * 64 + c8 * 8 + 4);
                float xs[8] = {x0[0], x0[1], x0[2], x0[3], x1[0], x1[1], x1[2], x1[3]}; unsigned hw[8], lw[8];
#pragma unroll
                for (int j = 0; j < 8; ++j) { hw[j] = f2bf(xs[j]); lw[j] = f2bf(xs[j] - __uint_as_float(hw[j] << 16)); }
                const int off = krow * 128 + ((c8 * 16) ^ ((krow & 7) << 4));
                *(LAS v4u*)(KH + off) = (v4u){hw[0] | (hw[1] << 16), hw[2] | (hw[3] << 16), hw[4] | (hw[5] << 16), hw[6] | (hw[7] << 16)};
                *(LAS v4u*)(KLo + off) = (v4u){lw[0] | (lw[1] << 16), lw[2] | (lw[3] << 16), lw[4] | (lw[5] << 16), lw[6] | (lw[7] << 16)}; }
            cur_h = h; __syncthreads(); }
        {
            const int r32 = lane & 31, hp = lane >> 5; const float* qp = PQ + (size_t)(t0 + 32 * wave + r32) * 1024 + h * 128 + hp * 8;
#pragma unroll
            for (int half = 0; half < 2; ++half) {
                bf16x8 bqh[4], bql[4];
#pragma unroll
                for (int ks = 0; ks < 4; ++ks) { const f32x4 x0 = *(const f32x4*)(qp + half * 64 + ks * 16), x1 = *(const f32x4*)(qp + half * 64 + ks * 16 + 4);
                    float xs[8] = {x0[0], x0[1], x0[2], x0[3], x1[0], x1[1], x1[2], x1[3]}; unsigned hw[8], lw[8];
#pragma unroll
                    for (int j = 0; j < 8; ++j) { hw[j] = f2bf(xs[j]); lw[j] = f2bf(xs[j] - __uint_as_float(hw[j] << 16)); }
                    bqh[ks] = __builtin_bit_cast(bf16x8, (v4u){hw[0] | (hw[1] << 16), hw[2] | (hw[3] << 16), hw[4] | (hw[5] << 16), hw[6] | (hw[7] << 16)});
                    bql[ks] = __builtin_bit_cast(bf16x8, (v4u){lw[0] | (lw[1] << 16), lw[2] | (lw[3] << 16), lw[4] | (lw[5] << 16), lw[6] | (lw[7] << 16)}); }
                float tv[16];
#pragma unroll
                for (int kt = 0; kt < 4; ++kt) {
                    f32x16 acc;
#pragma unroll
                    for (int r = 0; r < 16; ++r) acc[r] = 0.f;
                    const int krow = half * 128 + kt * 32 + r32;
#pragma unroll
                    for (int ks = 0; ks < 4; ++ks) { const int off = krow * 128 + ((32 * ks + 16 * hp) ^ ((krow & 7) << 4));
                        const bf16x8 ah = *(const LAS bf16x8*)(KH + off), al = *(const LAS bf16x8*)(KLo + off);
                        acc = __builtin_amdgcn_mfma_f32_32x32x16_bf16(ah, bqh[ks], acc, 0, 0, 0);
                        acc = __builtin_amdgcn_mfma_f32_32x32x16_bf16(al, bqh[ks], acc, 0, 0, 0);
                        acc = __builtin_amdgcn_mfma_f32_32x32x16_bf16(ah, bql[ks], acc, 0, 0, 0); }
                    float v[16];
#pragma unroll
                    for (int r = 0; r < 16; ++r) { const unsigned key = (unsigned)(32 * kt + (r & 3) + 8 * (r >> 2)) | (unsigned)(4 * hp); v[r] = __uint_as_float((__float_as_uint(acc[r]) & 0xffffff80u) | (127u - key)); }
                    sort16_desc(v);
                    if (kt == 0) {
#pragma unroll
                        for (int r = 0; r < 16; ++r) tv[r] = v[r]; }
                    else merge16_desc(tv, v);
                }
                float pv[16];
#pragma unroll
                for (int r = 0; r < 16; ++r) pv[r] = __shfl_xor(tv[r], 32);
                merge16_desc(tv, pv);
                if (hp == 0) { LAS unsigned* xo = XV + ((32 * wave + r32) * 2 + half) * 16;
#pragma unroll
                    for (int j = 0; j < 16; j += 4) *(LAS v4u*)(xo + j) = (v4u){__float_as_uint(tv[j]), __float_as_uint(tv[j + 1]), __float_as_uint(tv[j + 2]), __float_as_uint(tv[j + 3])}; }
            }
        }
        __syncthreads();
        if (tid < 256) {
            const int tok = tid; const LAS unsigned* xa = XV + (tok * 2) * 16; const LAS unsigned* xb = xa + 16;
            float fv[16];
#pragma unroll
            for (int r = 0; r < 16; ++r) fv[r] = -INFINITY;
            for (int ci = 0; ci < 50; ++ci) {
                const unsigned c = PK_CAND[ci];
                const float sm = __uint_as_float(xa[c >> 4] & 0xffffff80u) + __uint_as_float(xb[c & 15] & 0xffffff80u);
                float v = __uint_as_float((__float_as_uint(sm) & 0xffffff00u) | (255u - c));
#pragma unroll
                for (int r = 0; r < 16; ++r) { float hi_, lo_; asm("v_max_f32_e32 %0, %1, %2" : "=v"(hi_) : "v"(fv[r]), "v"(v)); asm("v_min_f32_e32 %0, %1, %2" : "=v"(lo_) : "v"(fv[r]), "v"(v)); fv[r] = hi_; v = lo_; }
            }
            float val[16]; int ex[16]; float mx = -INFINITY;
#pragma unroll
            for (int r = 0; r < 16; ++r) { const unsigned c = 255u - (__float_as_uint(fv[r]) & 255u); const unsigned ia = xa[c >> 4], ib = xb[c & 15];
                val[r] = __uint_as_float(ia & 0xffffff80u) + __uint_as_float(ib & 0xffffff80u); ex[r] = (int)((127u - (ia & 127u)) * 128u + (127u - (ib & 127u))); mx = fmaxf(mx, val[r]); }
            float sum = 0.f;
#pragma unroll
            for (int r = 0; r < 16; ++r) { val[r] = __expf(val[r] - mx); sum += val[r]; }
            const float inv = 1.0f / sum;
            int* eo = EIDX + (size_t)(t0 + tok) * 128 + h * 16; float* go = GW + (size_t)(t0 + tok) * 128 + h * 16;
#pragma unroll
            for (int r = 0; r < 16; r += 4) { *(v4u*)(eo + r) = (v4u){(unsigned)ex[r], (unsigned)ex[r + 1], (unsigned)ex[r + 2], (unsigned)ex[r + 3]};
                *(f32x4*)(go + r) = (f32x4){val[r] * inv, val[r + 1] * inv, val[r + 2] * inv, val[r + 3] * inv}; }
        }
        __syncthreads();
    }
}
__device__ __forceinline__ void fp8x16_to_f32(const v4u w, float (&f)[16]) {
#pragma unroll
    for (int q = 0; q < 4; ++q) { const auto lo = __builtin_amdgcn_cvt_pk_f32_fp8((int)w[q], false); const auto hi = __builtin_amdgcn_cvt_pk_f32_fp8((int)w[q], true);
        f[4 * q] = lo[0]; f[4 * q + 1] = lo[1]; f[4 * q + 2] = hi[0]; f[4 * q + 3] = hi[1]; }
}
__device__ __forceinline__ void xp_sort128(int& e_a, int& e_b, float& g_a, float& g_b, int lane) {
    asm volatile("" : "+v"(lane));
    unsigned a0 = ((unsigned)e_a << 7) | (unsigned)lane, a1 = ((unsigned)e_b << 7) | (unsigned)(64 + lane);
#pragma unroll
    for (int k = 2; k <= 128; k <<= 1) {
#pragma unroll
        for (int j = k >> 1; j >= 1; j >>= 1) {
            if (j == 64) { const unsigned lo = min(a0, a1), hi = max(a0, a1); a0 = lo; a1 = hi; }
            else {
                const bool lower = (lane & j) == 0;
                const bool asc0 = k >= 64 ? true : ((lane & k) == 0), asc1 = k == 64 ? false : (k == 128 ? true : ((lane & k) == 0));
                const unsigned o0 = (unsigned)__shfl_xor((int)a0, j), o1 = (unsigned)__shfl_xor((int)a1, j);
                a0 = (lower == asc0) ? min(a0, o0) : max(a0, o0); a1 = (lower == asc1) ? min(a1, o1) : max(a1, o1);
            }
        }
    }
    const int i0 = (int)(a0 & 127u), i1 = (int)(a1 & 127u);
    const float ga0 = __shfl(g_a, i0 & 63), gb0 = __shfl(g_b, i0 & 63), ga1 = __shfl(g_a, i1 & 63), gb1 = __shfl(g_b, i1 & 63);
    e_a = (int)(a0 >> 7); e_b = (int)(a1 >> 7); g_a = i0 < 64 ? ga0 : gb0; g_b = i1 < 64 ? ga1 : gb1;
}
template <int CTRL> __device__ __forceinline__ float dpp_f(float v) { return __builtin_bit_cast(float, __builtin_amdgcn_update_dpp(0, __builtin_bit_cast(int, v), CTRL, 0xf, 0xf, false)); }
#define XP_REDUCE8(D0, ZS) do { float e4[4], f2[2]; \
            _Pragma("unroll") for (int j = 0; j < 4; ++j) { const auto r = __builtin_amdgcn_permlane32_swap(__float_as_uint(d[(D0) + j]), __float_as_uint(d[(D0) + j + 4]), false, false); e4[j] = __uint_as_float(r[0]) + __uint_as_float(r[1]); } \
            _Pragma("unroll") for (int j = 0; j < 2; ++j) { const auto r = __builtin_amdgcn_permlane16_swap(__float_as_uint(e4[j]), __float_as_uint(e4[j + 2]), false, false); f2[j] = __uint_as_float(r[0]) + __uint_as_float(r[1]); } \
            const bool b3 = (lane & 8) != 0; \
            float zs = (b3 ? f2[1] : f2[0]) + dpp_f<0x128>(b3 ? f2[0] : f2[1]);     \
            zs += dpp_f<0xB1>(zs); zs += dpp_f<0x4E>(zs); zs += dpp_f<0x141>(zs);     \
            ZS = zs; } while (0)
#define XP_PAIRS(KB, KE) do { float z_a = 0.f, z_b = 0.f; \
        for (int k0 = (KB); k0 < (KE); k0 += 16) {     \
            v3u uw[16]; const int kk = k0 & 63; const int esel = k0 < 64 ? e_a : e_b; \
            _Pragma("unroll") for (int j = 0; j < 16; ++j) { const int so_ = __builtin_amdgcn_readlane(esel, kk + j) * ROW6; uw[j] = __builtin_bit_cast(v3u, __builtin_amdgcn_raw_buffer_load_b96(rU, voff, so_, 0)); } \
            float d[16]; \
            _Pragma("unroll") for (int j = 0; j < 16; j += 2) { const v6u pk = {uw[j].x, uw[j].y, uw[j].z, uw[j + 1].x, uw[j + 1].y, uw[j + 1].z}; const v32f r = __builtin_amdgcn_cvt_scalef32_pk32_f32_fp6(pk, 1.0f); \
                f32x2 s0 = {0.f, 0.f}, s1 = {0.f, 0.f}; \
                _Pragma("unroll") for (int i = 0; i < 8; ++i) { s0 = __builtin_elementwise_fma((f32x2){r[2 * i], r[2 * i + 1]}, hx2[i], s0); s1 = __builtin_elementwise_fma((f32x2){r[16 + 2 * i], r[17 + 2 * i]}, hx2[i], s1); } \
                d[j] = s0.x + s0.y; d[j + 1] = s1.x + s1.y; __builtin_amdgcn_sched_barrier(0); } \
            float zs0, zs1; XP_REDUCE8(0, zs0); XP_REDUCE8(8, zs1); \
              \
            const float t0 = __shfl(zs0, 8 * (lane & 7)), t1 = __shfl(zs1, 8 * (lane & 7)); \
            const int rel = lane - kk; const float tz = (rel & 8) ? t1 : t0; const bool mine = rel >= 0 && rel < 16; \
            if (k0 < 64) z_a = mine ? tz : z_a; else z_b = mine ? tz : z_b; } \
        float act_a, act_b; \
        { const float za = z_a * su_a, zb = z_b * su_b; act_a = 0.5f * za * (1.0f + erff(za * 0.70710678118654752f)) * g_a; act_b = 0.5f * zb * (1.0f + erff(zb * 0.70710678118654752f)) * g_b; } \
        for (int k0 = (KB); k0 < (KE); k0 += 16) {     \
            v3u vw[16]; const int kk = k0 & 63; const int esel = k0 < 64 ? e_a : e_b; const float asel = k0 < 64 ? act_a : act_b; \
            _Pragma("unroll") for (int j = 0; j < 16; ++j) { const int so_ = __builtin_amdgcn_readlane(esel, kk + j) * ROW6; vw[j] = __builtin_bit_cast(v3u, __builtin_amdgcn_raw_buffer_load_b96(rV, voff, so_, 0)); } \
            _Pragma("unroll") for (int j = 0; j < 16; j += 2) { const float act0 = __int_as_float(__builtin_amdgcn_readlane(__float_as_int(asel), kk + j)), act1 = __int_as_float(__builtin_amdgcn_readlane(__float_as_int(asel), kk + j + 1)); \
                const f32x2 a0 = {act0, act0}, a1 = {act1, act1}; \
                const v6u pk = {vw[j].x, vw[j].y, vw[j].z, vw[j + 1].x, vw[j + 1].y, vw[j + 1].z}; const v32f r = __builtin_amdgcn_cvt_scalef32_pk32_f32_fp6(pk, 1.0f); \
                _Pragma("unroll") for (int i = 0; i < 8; ++i) acc2[i] = __builtin_elementwise_fma((f32x2){r[2 * i], r[2 * i + 1]}, a0, acc2[i]); \
                __builtin_amdgcn_sched_barrier(0);     \
                _Pragma("unroll") for (int i = 0; i < 8; ++i) acc2[i] = __builtin_elementwise_fma((f32x2){r[16 + 2 * i], r[17 + 2 * i]}, a1, acc2[i]); \
                __builtin_amdgcn_sched_barrier(0); } } } while (0)
#define XP_UNPACK float acc[16]; _Pragma("unroll") for (int i = 0; i < 8; ++i) { acc[2 * i] = acc2[i].x; acc[2 * i + 1] = acc2[i].y; }
#define XP_LOAD_ROW(ROW) \
        f32x2 hx2[8]; f32x4 xrow[4];     \
        { const int mi_ = mod_index(ROW); const float* sh_ = MOD - 5120 + mi_ * 6144 + 3072; const float* sc_ = sh_ + 1024; float ss_ = 0.f; \
          _Pragma("unroll") for (int q = 0; q < 4; ++q) { xrow[q] = *(const f32x4*)(X + (size_t)(ROW) * DM + 16 * lane + 4 * q); ss_ += (xrow[q][0] * xrow[q][0] + xrow[q][1] * xrow[q][1]) + (xrow[q][2] * xrow[q][2] + xrow[q][3] * xrow[q][3]); } \
          const float rs_ = rsqrtf(wave_sum(ss_) * (1.0f / DM) + EPS); \
          _Pragma("unroll") for (int q = 0; q < 4; ++q) { const f32x4 s1_ = *(const f32x4*)(sc_ + 16 * lane + 4 * q), s0_ = *(const f32x4*)(sh_ + 16 * lane + 4 * q); const f32x4 h_ = xrow[q] * rs_ * (s1_ + 1.0f) + s0_; \
              hx2[2 * q] = (f32x2){h_[0], h_[1]}; hx2[2 * q + 1] = (f32x2){h_[2], h_[3]}; } } \
        int e_a = EIDX[(size_t)(ROW) * 128 + lane], e_b = EIDX[(size_t)(ROW) * 128 + 64 + lane]; \
        float g_a = GW[(size_t)(ROW) * 128 + lane], g_b = GW[(size_t)(ROW) * 128 + 64 + lane]; \
        xp_sort128(e_a, e_b, g_a, g_b, lane); \
        const float su_a = SU[e_a], su_b = SU[e_b]; g_a *= SV[e_a]; g_b *= SV[e_b];     \
        f32x2 acc2[8]; \
        _Pragma("unroll") for (int i = 0; i < 8; ++i) acc2[i] = (f32x2){0.f, 0.f};
#define XP_EPILOGUE(ROW) do { \
        const int mi = mod_index(ROW); const float* g2 = MOD + mi * 6144; float* xr = X + (size_t)(ROW) * DM + 16 * lane; \
        f32x4 xn[4]; float ss = 0.f; \
        _Pragma("unroll") for (int q = 0; q < 4; ++q) { const f32x4 g = *(const f32x4*)(g2 + 16 * lane + 4 * q); f32x4 x = xrow[q]; \
            x[0] += g[0] * acc[4 * q]; x[1] += g[1] * acc[4 * q + 1]; x[2] += g[2] * acc[4 * q + 2]; x[3] += g[3] * acc[4 * q + 3]; \
            xn[q] = x; ss += (x[0] * x[0] + x[1] * x[1]) + (x[2] * x[2] + x[3] * x[3]); } \
        const float rstd = rsqrtf(wave_sum(ss) * (1.0f / DM) + EPS); \
        if (l == 0) {     \
            const float* sh = (const float*)(a.ws + WS_MOD) + (size_t)(3 + mi) * 6144; const float* sc = sh + 1024; bf16* hxo = (bf16*)(a.ws + WS_HX) + (size_t)(ROW) * DM + 16 * lane; \
            _Pragma("unroll") for (int q = 0; q < 4; ++q) { *(f32x4*)(xr + 4 * q) = xn[q]; const f32x4 s1 = *(const f32x4*)(sc + 16 * lane + 4 * q), s0 = *(const f32x4*)(sh + 16 * lane + 4 * q); \
                const f32x4 hh = xn[q] * rstd * (s1 + 1.0f) + s0; u32x2 o; o.x = pk2(hh[0], hh[1]); o.y = pk2(hh[2], hh[3]); *(u32x2*)(hxo + 4 * q) = o; } \
        } else if ((ROW) < NLAT) {     \
            _Pragma("unroll") for (int q = 0; q < 4; ++q) *(f32x4*)(a.out + (size_t)(ROW) * DM + 16 * lane + 4 * q) = xn[q] * rstd * *(const f32x4*)(a.in[26] + 16 * lane + 4 * q); \
        } } while (0)
__device__ __forceinline__ void ph_expert(const Args& a, Frame& F, int l) {
    const __amdgpu_buffer_rsrc_t rU = __builtin_amdgcn_make_buffer_rsrc((void*)(a.ws + WS_U16 + (size_t)l * TAB_L), (short)0, 16384 * ROW6, 0x00020000), rV = __builtin_amdgcn_make_buffer_rsrc((void*)(a.ws + WS_V16 + (size_t)l * TAB_L), (short)0, 16384 * ROW6, 0x00020000);
    const float* SU = (const float*)(a.ws + WS_SU + (size_t)l * TAB_L); const float* SV = (const float*)(a.ws + WS_SV + (size_t)l * TAB_L);
    const int* EIDX = (const int*)(a.ws + WS_EIDX); const float* GW = (const float*)(a.ws + WS_GW); float* X = (float*)(a.ws + WS_X);
    const float* MOD = (const float*)(a.ws + WS_MOD) + (size_t)l * 3 * 6144 + 5120;
    const int gw = F.bid * NWAVES + F.wave, NGW = F.G * NWAVES, lane = F.lane; const int voff = 12 * lane;
    for (int row = gw; row < NLAT; row += NGW) {
        XP_LOAD_ROW(row)
        XP_PAIRS(0, 128);
        XP_UNPACK
        XP_EPILOGUE(row);
    }
    if (l == 0) {
        LAS float* PART = (LAS float*)F.lds;
        for (int r0 = NLAT + 2 * F.bid; r0 < T; r0 += 2 * F.G) {
            const int row = min(r0 + (F.wave >> 2), T - 1), qd = F.wave & 3;
            XP_LOAD_ROW(row)
            XP_PAIRS(32 * qd, 32 * qd + 32);
            XP_UNPACK
#pragma unroll
            for (int q = 0; q < 4; ++q) *(LAS f32x4*)(PART + F.wave * 1024 + 16 * lane + 4 * q) = (f32x4){acc[4 * q], acc[4 * q + 1], acc[4 * q + 2], acc[4 * q + 3]};
            __syncthreads();
            if (qd == 0 && r0 + (F.wave >> 2) < T) {
#pragma unroll
                for (int w_ = 1; w_ < 4; ++w_)
#pragma unroll
                    for (int q = 0; q < 4; ++q) { const f32x4 p = *(const LAS f32x4*)(PART + (F.wave + w_) * 1024 + 16 * lane + 4 * q); acc[4 * q] += p[0]; acc[4 * q + 1] += p[1]; acc[4 * q + 2] += p[2]; acc[4 * q + 3] += p[3]; }
                XP_EPILOGUE(row);
            }
            __syncthreads();
        }
    }
}
#undef XP_PAIRS
#undef XP_REDUCE8
#undef XP_UNPACK
#undef XP_LOAD_ROW
#undef XP_EPILOGUE
__device__ __forceinline__ void ph_final(const Args& a, Frame& F) {
    const float* X = (const float*)(a.ws + WS_X); const float* fw = a.in[26];
    const int gw = F.bid * NWAVES + F.wave, NGW = F.G * NWAVES;
    for (int row = gw; row < NLAT; row += NGW) {
        const f32x4* xr = (const f32x4*)(X + (size_t)row * DM) + F.lane; f32x4 v[4]; float ss = 0.f;
#pragma unroll
        for (int j = 0; j < 4; ++j) { v[j] = xr[64 * j]; ss += (v[j][0] * v[j][0] + v[j][1] * v[j][1]) + (v[j][2] * v[j][2] + v[j][3] * v[j][3]); }
        const float rstd = rsqrtf(wave_sum(ss) * (1.0f / DM) + EPS);
#pragma unroll
        for (int j = 0; j < 4; ++j) { const int c = 4 * F.lane + 256 * j; *(f32x4*)(a.out + (size_t)row * DM + c) = v[j] * rstd * *(const f32x4*)(fw + c); }
    }
}
__device__ __forceinline__ f32x16 small_tile_mma(const bf16* A, int lda, const bf16* Bt, int ldb, int K, int lane) {
    const int r32 = lane & 31, hp = lane >> 5;
    const bf16* ap = A + (size_t)r32 * lda + 8 * hp; const bf16* bp = Bt + (size_t)r32 * ldb + 8 * hp;
    f32x16 acc;
#pragma unroll
    for (int r = 0; r < 16; ++r) acc[r] = 0.f;
#pragma unroll 1
    for (int k0 = 0; k0 < K; k0 += 128) {
        bf16x8 af[8], bfr[8];
#pragma unroll
        for (int s_ = 0; s_ < 8; ++s_) { af[s_] = *(const bf16x8*)(ap + k0 + 16 * s_); bfr[s_] = *(const bf16x8*)(bp + k0 + 16 * s_); }
#pragma unroll
        for (int s_ = 0; s_ < 8; ++s_) acc = __builtin_amdgcn_mfma_f32_32x32x16_bf16(af[s_], bfr[s_], acc, 0, 0, 0);
    }
    return acc;
}
__device__ __forceinline__ void ph_biasq(const Args& a, Frame& F, int l) {
    const bf16* Wq = (const bf16*)(a.ws + WS_WQ); const float* MOD = (const float*)(a.ws + WS_MOD) + (size_t)l * 3 * 6144 + 3072; float* BQ = (float*)(a.ws + WS_BQ) + l * 3 * 1024;
    const int gw = F.bid * NWAVES + F.wave, NGW = F.G * NWAVES, lane = F.lane;
    for (int it = gw; it < 3 * 1024; it += NGW) { const int mi = it >> 10, n = it & 1023;
        const v4u w0 = *(const v4u*)(Wq + (size_t)n * 1024 + 16 * lane), w1 = *(const v4u*)(Wq + (size_t)n * 1024 + 16 * lane + 8); const f32x4* sp = (const f32x4*)(MOD + mi * 6144 + 16 * lane);
        const f32x4 a0 = sp[0], a1 = sp[1], a2 = sp[2], a3 = sp[3];
        float v = (a0[0] * bflo(w0.x) + a0[1] * bfhi(w0.x)) + (a0[2] * bflo(w0.y) + a0[3] * bfhi(w0.y)) + (a1[0] * bflo(w0.z) + a1[1] * bfhi(w0.z)) + (a1[2] * bflo(w0.w) + a1[3] * bfhi(w0.w))
                + (a2[0] * bflo(w1.x) + a2[1] * bfhi(w1.x)) + (a2[2] * bflo(w1.y) + a2[3] * bfhi(w1.y)) + (a3[0] * bflo(w1.z) + a3[1] * bfhi(w1.z)) + (a3[2] * bflo(w1.w) + a3[3] * bfhi(w1.w));
        v = wave_sum(v); if (lane == 0) BQ[mi * 1024 + n] = v; }
}
__device__ __forceinline__ void ctx_small_q(const Args& a, Frame& F) {
    unsigned char* ws = a.ws; const int lane = F.lane, r32 = lane & 31, hp = lane >> 5; constexpr int AP = 1032;
    LAS unsigned short* A32 = (LAS unsigned short*)F.lds;
    const float* X = (const float*)(ws + WS_X); const float* sh = (const float*)(ws + WS_MOD) + 2 * 6144 + 3072; const float* sc = sh + 1024;
    for (int t0 = F.bid * 2; t0 < 512; t0 += F.G * 2) {
        const int row0 = NLAT + 32 * (t0 >> 5);
#pragma unroll
        for (int q = 0; q < 4; ++q) { const int rl = F.wave * 4 + q; const f32x4* xr = (const f32x4*)(X + (size_t)(row0 + rl) * DM) + lane; f32x4 v[4]; float ss = 0.f;
#pragma unroll
            for (int j = 0; j < 4; ++j) { v[j] = xr[64 * j]; ss += (v[j][0] * v[j][0] + v[j][1] * v[j][1]) + (v[j][2] * v[j][2] + v[j][3] * v[j][3]); }
            const float rstd = rsqrtf(wave_sum(ss) * (1.0f / DM) + EPS);
#pragma unroll
            for (int j = 0; j < 4; ++j) { const int c = 4 * lane + 256 * j; const f32x4 s1 = *(const f32x4*)(sc + c), s0 = *(const f32x4*)(sh + c); const f32x4 h = v[j] * rstd * (s1 + 1.0f) + s0;
                u32x2 o; o.x = pk2(h[0], h[1]); o.y = pk2(h[2], h[3]); *(LAS u32x2*)(A32 + rl * AP + c) = o; } }
        __syncthreads();
        if (F.wave < 2 && t0 + F.wave < 512) { const int col0 = 32 * ((t0 + F.wave) & 31);
            const LAS unsigned short* ap = A32 + r32 * AP + 8 * hp; const bf16* bp = (const bf16*)(ws + WS_WQ) + (size_t)(col0 + r32) * 1024 + 8 * hp;
            f32x16 acc;
#pragma unroll
            for (int r = 0; r < 16; ++r) acc[r] = 0.f;
#pragma unroll 1
            for (int k0 = 0; k0 < 1024; k0 += 128) { bf16x8 af[8], bfr[8];
#pragma unroll
                for (int s_ = 0; s_ < 8; ++s_) { af[s_] = *(const LAS bf16x8*)(ap + k0 + 16 * s_); bfr[s_] = *(const bf16x8*)(bp + k0 + 16 * s_); }
#pragma unroll
                for (int s_ = 0; s_ < 8; ++s_) acc = __builtin_amdgcn_mfma_f32_32x32x16_bf16(af[s_], bfr[s_], acc, 0, 0, 0); }
            float* PQ = (float*)(ws + WS_R1);
#pragma unroll
            for (int r = 0; r < 16; ++r) { const int row = row0 + (r & 3) + 8 * (r >> 2) + 4 * hp; PQ[(size_t)row * 1024 + col0 + r32] = acc[r]; } }
        __syncthreads();
    }
}
__device__ __forceinline__ void ctx_small(const Args& a, Frame& F, int which  ) {
    if (F.wave >= 2) return;
    unsigned char* ws = a.ws; const int lane = F.lane, r32 = lane & 31, hp = lane >> 5;
    for (int tile = F.bid * 2 + F.wave; tile < 512; tile += F.G * 2) {
        const int row0 = NLAT + 32 * (tile >> 5), col0 = 32 * (tile & 31);
        if (which == 2) {
            const bf16* OABC = (const bf16*)(ws + WS_OABC); const bf16* Wcat = (const bf16*)(ws + WS_WA); const bf16* gate = (const bf16*)(ws + WS_R3) + 1024; bf16* Mb = (bf16*)(ws + WS_MB);
            float macc[16];
#pragma unroll
            for (int r = 0; r < 16; ++r) macc[r] = 0.f;
            for (int br = 0; br < 3; ++br) {
                const f32x16 acc = small_tile_mma(OABC + (size_t)row0 * 1536 + 512 * br, 1536, Wcat + (size_t)col0 * 1536 + 512 * br, 1536, 512, lane);
#pragma unroll
                for (int r = 0; r < 16; ++r) { const int row = row0 + (r & 3) + 8 * (r >> 2) + 4 * hp; macc[r] += sigm(bf2f(gate[(size_t)row * NPXB + 1024 * br + col0 + r32])) * acc[r]; }
            }
#pragma unroll
            for (int r = 0; r < 16; ++r) { const int row = row0 + (r & 3) + 8 * (r >> 2) + 4 * hp; Mb[(size_t)row * 1024 + col0 + r32] = (unsigned short)f2bf(macc[r]); }
        } else if (which == 3) {
            const f32x16 acc = small_tile_mma((const bf16*)(ws + WS_MB) + (size_t)row0 * 1024, 1024, (const bf16*)(ws + WS_WO) + (size_t)col0 * 1024, 1024, 1024, lane);
            const float g1 = ((const float*)(ws + WS_MOD))[2 * 6144 + 2048 + col0 + r32]; float* X = (float*)(ws + WS_X);
#pragma unroll
            for (int r = 0; r < 16; ++r) { const int row = row0 + (r & 3) + 8 * (r >> 2) + 4 * hp; X[(size_t)row * 1024 + col0 + r32] = a.in[2][(size_t)(row - NLAT) * 1024 + col0 + r32] + g1 * acc[r]; }
        } else {
            const f32x16 acc = small_tile_mma((const bf16*)(ws + WS_HX) + (size_t)row0 * 1024, 1024, (const bf16*)(ws + WS_WQ) + (size_t)col0 * 1024, 1024, 1024, lane);
            float* PQ = (float*)(ws + WS_R1);
#pragma unroll
            for (int r = 0; r < 16; ++r) { const int row = row0 + (r & 3) + 8 * (r >> 2) + 4 * hp; PQ[(size_t)row * 1024 + col0 + r32] = acc[r]; }
        }
    }
}
#define GEMM_RUN(EPI, g, E) do { pg8::StaticOrder S_; S_.init((g).M, (g).N, F.G, F.bid); pg8::gemm_phase<EPI, pg8::StaticOrder, true, true>(F.lds, g, S_, E); } while (0)

constexpr int N_PHASES = 25;
#ifndef MK_ONE_LAUNCH
#define MK_ONE_LAUNCH 1
#endif
__global__ void __launch_bounds__(NWAVES * 64, 2) mk_fwd(Args args) {
    extern __shared__ __attribute__((aligned(16))) unsigned char lds_raw[];
    Frame F;
    F.lds = (LAS unsigned char*)lds_raw; F.MISC = (volatile LAS unsigned*)(F.lds + MISC_OFF);
    F.tid = threadIdx.x; F.lane = F.tid & 63; F.wave = __builtin_amdgcn_readfirstlane(F.tid >> 6); F.G = gridDim.x; F.bid = blockIdx.x;
    F.ctl = (gu32*)(args.ws + WS_CTL);
    for (int u = F.tid; u < (LDS_BYTES - LDSCTL_OFF) / 4; u += NWAVES * 64) ((LAS unsigned*)(F.lds + LDSCTL_OFF))[u] = 0u;
    __syncthreads();
    XcdBarrier bar; bar.bar = (unsigned*)(F.ctl + CW_BAR); bar.x = 0; bar.st = nullptr;
    const bool multi = (args.ph_hi - args.ph_lo) > 1;
    if (multi) bar = xcd_barrier_post((unsigned*)(F.ctl + CW_BAR), F.MISC + 8);
    unsigned char* ws = args.ws;
    const int lo = args.ph_lo, hi = args.ph_hi;
    if (PROBE_MASK != 0ull) { if (F.tid == 0) { const unsigned long long now_ = __builtin_amdgcn_s_memrealtime(); F.MISC[16] = (unsigned)now_; F.MISC[17] = (unsigned)(now_ >> 32); } __syncthreads(); }
#define IN(k) (lo <= (k) && (k) < hi)
#define SEAM(k) do { if (IN(k) && IN((k) + 1)) { xcd_barrier(bar); \
    if (PROBE_MASK != 0ull) { if (F.tid == 0) { unsigned long long now_ = __builtin_amdgcn_s_memrealtime(); const unsigned long long prev_ = ((unsigned long long)F.MISC[17] << 32) | F.MISC[16]; \
        if ((PROBE_MASK >> (k)) & 1ull) { const unsigned long long until_ = now_ + PROBE_AMP * (now_ - prev_); while (__builtin_amdgcn_s_memrealtime() < until_) __builtin_amdgcn_s_sleep(32); now_ = __builtin_amdgcn_s_memrealtime(); } \
        F.MISC[16] = (unsigned)now_; F.MISC[17] = (unsigned)(now_ >> 32); } __syncthreads(); } } } while (0)
#ifndef ONLY_PHASE
#define ONLY_PHASE(s) 1
#endif
#define LAYER(l, B) \
    if (ONLY_PHASE(1) && IN((B) + 1) && (l) == 0) { ph_mod(args, F, l, 0); } if ((l) == 0) SEAM((B) + 1); \
    if (ONLY_PHASE(2) && IN((B) + 2)) { pg8::Gemm g{(const pg8::bf16_t*)(ws + WS_HX), (const pg8::bf16_t*)(ws + WS_WIN), T, INC, DM}; pg8::EpiG1 E{(pg8::bf16_t*)(ws + WS_R1), (pg8::bf16_t*)(ws + WS_R3)}; GEMM_RUN(pg8::EpiG1, g, E); \
          \
        if ((l) == 0 && F.bid >= 114) ph_convw(args, F, 0, F.bid - 114, F.G - 114, 6); } SEAM((B) + 2); \
    if (ONLY_PHASE(3) && IN((B) + 3)) { ph_post(args, F, l); } SEAM((B) + 3); \
    if (ONLY_PHASE(4) && IN((B) + 4)) { ph_attn(args, F, l, (char*)lds_raw); } SEAM((B) + 4); \
    if (ONLY_PHASE(5) && IN((B) + 5)) { ph_comb(args, F, l); } SEAM((B) + 5); \
    if (ONLY_PHASE(6) && IN((B) + 6)) { const pg8::bf16_t* gate = (const pg8::bf16_t*)(ws + WS_R3) + 1024; \
        if ((l) == 0) ctx_small(args, F, 2); \
        pg8::Gemm g{(const pg8::bf16_t*)(ws + WS_OABC), (const pg8::bf16_t*)(ws + WS_WA), NLAT, DM, 1536}; pg8::EpiG2 E{gate + 2048, (pg8::bf16_t*)(ws + WS_MB)}; pg8::MidG2 Mh{gate}; \
        { pg8::StaticOrder S_; S_.init(g.M, g.N, F.G, F.bid); pg8::gemm_phase<pg8::EpiG2, pg8::StaticOrder, true, true, pg8::MidG2>(F.lds, g, S_, E, Mh); } } SEAM((B) + 6); \
    if (ONLY_PHASE(7) && IN((B) + 7)) { ph_biasq(args, F, l); if ((l) == 0) ctx_small(args, F, 3); pg8::Gemm g{(const pg8::bf16_t*)(ws + WS_MB), (const pg8::bf16_t*)(ws + WS_WO), NLAT, DM, DM}; pg8::EpiG3 E{(float*)(ws + WS_X), (l) == 0 ? args.in[0] : (const float*)(ws + WS_X), (const float*)(ws + WS_MOD) + (size_t)(l) * 3 * 6144 + 2048, (pg8::bf16_t*)(ws + WS_HX), (const float*)(ws + WS_MOD) + (size_t)(l) * 3 * 6144 + 4096, (float*)(ws + WS_SSQ)}; GEMM_RUN(pg8::EpiG3, g, E); } SEAM((B) + 7); \
    if (ONLY_PHASE(9) && IN((B) + 9)) { if ((l) == 0) ctx_small_q(args, F); pg8::Gemm g{(const pg8::bf16_t*)(ws + WS_HX), (const pg8::bf16_t*)(ws + WS_WQ), NLAT, DM, DM}; pg8::EpiG4 E{(float*)(ws + WS_R1), (const float*)(ws + WS_SSQ), (const float*)(ws + WS_BQ) + (l) * 3 * 1024}; GEMM_RUN(pg8::EpiG4, g, E); } SEAM((B) + 9); \
    if (ONLY_PHASE(10) && IN((B) + 10)) { ph_topk(args, F, l); \
          \
        if ((l) == 0 && F.bid >= 16) ph_convw(args, F, 1, F.bid - 16, F.G - 16, 7); } SEAM((B) + 10); \
    if (ONLY_PHASE(11) && IN((B) + 11)) { ph_expert(args, F, l); } if ((l) == 0) SEAM((B) + 11);

    if (ONLY_PHASE(0) && IN(0)) { ph_prep0(args, F); ph_convw(args, F, 0, F.bid, F.G, 1); } SEAM(0);
    LAYER(0, 0)
    LAYER(1, 12)
    if (PROBE_MASK != 0ull && ((PROBE_MASK >> 23) & 1ull) && IN(23)) { __syncthreads(); if (F.tid == 0) { const unsigned long long now_ = __builtin_amdgcn_s_memrealtime(); const unsigned long long prev_ = ((unsigned long long)F.MISC[17] << 32) | F.MISC[16];
        const unsigned long long until_ = now_ + PROBE_AMP * (now_ - prev_); while (__builtin_amdgcn_s_memrealtime() < until_) __builtin_amdgcn_s_sleep(32); } __syncthreads(); }
#undef IN
#undef SEAM
}

extern "C" void kernel_launch(void* const* d_in, const int* in_sizes, int n_in, void* d_out, int out_size, void* d_ws, size_t ws_size, hipStream_t stream) {
    static int grid = 0;
    if (grid == 0) {
        if (n_in != 27 || out_size != NLAT * DM || ws_size < WS_END) { fprintf(stderr, "kernel_launch: unexpected shapes (n_in %d, out %d, ws %zu)\n", n_in, out_size, ws_size); grid = -1; return; }
        int dev = 0, cus = 0, per_cu = 0;
        if (hipGetDevice(&dev) != hipSuccess || hipDeviceGetAttribute(&cus, hipDeviceAttributeMultiprocessorCount, dev) != hipSuccess) { grid = -1; return; }
        if (hipFuncSetAttribute((const void*)mk_fwd, hipFuncAttributeMaxDynamicSharedMemorySize, LDS_BYTES) != hipSuccess) { fprintf(stderr, "kernel_launch: hipFuncSetAttribute failed\n"); grid = -1; return; }
        if (hipOccupancyMaxActiveBlocksPerMultiprocessor(&per_cu, (const void*)mk_fwd, NWAVES * 64, LDS_BYTES) != hipSuccess || per_cu < 1) { fprintf(stderr, "kernel_launch: occupancy query says %d blocks per CU\n", per_cu); (void)hipGetLastError(); grid = -1; return; }
        if (cus < 256) { fprintf(stderr, "kernel_launch: this kernel's phase maps are built for 256 workgroups (one per CU); the device reports %d CUs\n", cus); grid = -1; return; }
        grid = 256;
    }
    if (grid < 0) return;
    (void)hipMemsetAsync((char*)d_ws + WS_CTL, 0, CTL_ZERO_BYTES, stream);
    Args a{};
    for (int i = 0; i < 27; ++i) a.in[i] = (const float*)d_in[i];
    a.out = (float*)d_out; a.ws = (unsigned char*)d_ws;
#if MK_ONE_LAUNCH
    a.ph_lo = 0; a.ph_hi = N_PHASES;
    hipLaunchKernelGGL(mk_fwd, dim3(grid), dim3(NWAVES * 64), LDS_BYTES, stream, a);
#else
    for (int ph = 0; ph < N_PHASES; ++ph) { a.ph_lo = ph; a.ph_hi = ph + 1; hipLaunchKernelGGL(mk_fwd, dim3(grid), dim3(NWAVES * 64), LDS_BYTES, stream, a); }
#endif
}
```
